# Optimizing an MI355X kernel written in HIP

```python
import jax
import jax.numpy as jnp
from jax import lax
import numpy as np

D_MODEL = 1024
BATCH = 2
SEQ = 8192
DEPTH = 2

HEAD_DIM = 64
SWA_Q_HEADS = 8
SWA_KV_HEADS = 2
SWA_WINDOW = 128
SWA_BLOCK = 128
MOBA_HEADS = 8
MOBA_BLOCK = 256
MOBA_TOPK = 3
MOBA_Q_CHUNK = 128
GLA_HEADS = 4
GLA_DK = 64
GLA_DV = 128
GLA_GATE_RANK = 16
GLA_GATE_TEMP = 16.0
GLA_CHUNK = 64
N_BRANCH = 3
SWA_OUT_W = SWA_Q_HEADS * HEAD_DIM
MOBA_OUT_W = MOBA_HEADS * HEAD_DIM
GLA_OUT_W = GLA_HEADS * GLA_DV
D_FF = 2816
N_EXPERTS = 8
TOP_K = 2
D_FF_EXPERT = 1408
RMS_EPS = 1e-6
N_DENSE = (DEPTH + 1) // 2
N_MOE = DEPTH // 2
IN_WIDTHS = (SWA_Q_HEADS * HEAD_DIM, SWA_KV_HEADS * HEAD_DIM, SWA_KV_HEADS * HEAD_DIM,
             MOBA_HEADS * HEAD_DIM, MOBA_HEADS * HEAD_DIM, MOBA_HEADS * HEAD_DIM,
             GLA_HEADS * GLA_DK, GLA_HEADS * GLA_DK, GLA_HEADS * GLA_DV, GLA_HEADS * GLA_DV,
             GLA_GATE_RANK, N_BRANCH * D_MODEL)
IN_TOTAL = sum(IN_WIDTHS)

kernel_name = 'hybrid_swa_moba_gla_moe_block'


def rms_norm(x, g):
    xf = x.astype(jnp.float32)
    y = xf * lax.rsqrt(jnp.mean(xf * xf, axis=-1, keepdims=True) + RMS_EPS)
    return (y * g.astype(jnp.float32)).astype(x.dtype)


def swa_sink_attention(q, k, v, sinks):
    B, S, _, dh = q.shape
    nb = S // SWA_BLOCK
    G = SWA_Q_HEADS // SWA_KV_HEADS
    qb = q.reshape(B, nb, SWA_BLOCK, SWA_KV_HEADS, G, dh)
    kb = k.reshape(B, nb, SWA_BLOCK, SWA_KV_HEADS, dh)
    vb = v.reshape(B, nb, SWA_BLOCK, SWA_KV_HEADS, dh)
    zk = jnp.zeros_like(kb[:, :1])
    k2 = jnp.concatenate([jnp.concatenate([zk, kb[:, :-1]], axis=1), kb], axis=2)
    v2 = jnp.concatenate([jnp.concatenate([zk, vb[:, :-1]], axis=1), vb], axis=2)
    s = jnp.einsum('bnqhgd,bnkhd->bnhgqk', qb, k2).astype(jnp.float32) * (dh ** -0.5)
    qi = jnp.arange(SWA_BLOCK)[:, None]
    kj = jnp.arange(2 * SWA_BLOCK)[None, :]
    rel = qi + SWA_BLOCK - kj
    band = (rel >= 0) & (rel < SWA_WINDOW)
    blk = jnp.arange(nb)[:, None, None]
    mask = band[None] & ((blk > 0) | (kj >= SWA_BLOCK)[None])
    s = jnp.where(mask[None, :, None, None], s, -jnp.inf)
    sink = sinks.astype(jnp.float32).reshape(SWA_KV_HEADS, G)[None, None, :, :, None, None]
    sink = jnp.broadcast_to(sink, s.shape[:-1] + (1,))
    p = jax.nn.softmax(jnp.concatenate([s, sink], axis=-1), axis=-1)[..., :-1]
    o = jnp.einsum('bnhgqk,bnkhd->bnqhgd', p.astype(v.dtype), v2)
    return o.reshape(B, S, SWA_Q_HEADS * dh)


def moba_attention(q, k, v):
    B, S, H, dh = q.shape
    nblk = -(-S // MOBA_BLOCK)
    s_pad = nblk * MOBA_BLOCK
    padw = ((0, 0), (0, s_pad - S), (0, 0), (0, 0))
    kb = jnp.pad(k, padw).reshape(B, nblk, MOBA_BLOCK, H, dh).transpose(0, 3, 1, 2, 4)
    vb = jnp.pad(v, padw).reshape(B, nblk, MOBA_BLOCK, H, dh).transpose(0, 3, 1, 2, 4)
    kbar = jnp.mean(kb.astype(jnp.float32), axis=3).astype(q.dtype)
    qh = q.transpose(0, 2, 1, 3)
    topk = min(MOBA_TOPK, nblk)
    nq = S // MOBA_Q_CHUNK
    scale = dh ** -0.5
    bidx = jnp.arange(B)[:, None, None, None]
    hidx = jnp.arange(H)[None, :, None, None]
    blk_ids = jnp.arange(nblk)

    def chunk(ci):
        start = ci * MOBA_Q_CHUNK
        qc = lax.dynamic_slice_in_dim(qh, start, MOBA_Q_CHUNK, axis=2)
        cur = start // MOBA_BLOCK
        qpos = start + jnp.arange(MOBA_Q_CHUNK)
        gs = jnp.einsum('bhqd,bhnd->bhqn', qc, kbar).astype(jnp.float32)
        gs = jnp.where(blk_ids < cur, gs, -jnp.inf)
        _, idx = lax.top_k(gs, topk)
        valid = jnp.arange(topk) < cur
        kg = kb[bidx, hidx, idx]
        vg = vb[bidx, hidx, idx]
        s_sel = jnp.einsum('bhqd,bhqrkd->bhqrk', qc, kg).astype(jnp.float32) * scale
        s_sel = jnp.where(valid[:, None], s_sel, -jnp.inf).reshape(B, H, MOBA_Q_CHUNK, topk * MOBA_BLOCK)
        ko = lax.dynamic_index_in_dim(kb, cur, axis=2, keepdims=False)
        vo = lax.dynamic_index_in_dim(vb, cur, axis=2, keepdims=False)
        kpos = cur * MOBA_BLOCK + jnp.arange(MOBA_BLOCK)
        s_own = jnp.einsum('bhqd,bhkd->bhqk', qc, ko).astype(jnp.float32) * scale
        s_own = jnp.where(kpos[None, :] <= qpos[:, None], s_own, -jnp.inf)
        p = jax.nn.softmax(jnp.concatenate([s_sel, s_own], axis=-1), axis=-1).astype(v.dtype)
        p_sel = p[..., :topk * MOBA_BLOCK].reshape(B, H, MOBA_Q_CHUNK, topk, MOBA_BLOCK)
        p_own = p[..., topk * MOBA_BLOCK:]
        return (jnp.einsum('bhqrk,bhqrkd->bhqd', p_sel, vg)
                + jnp.einsum('bhqk,bhkd->bhqd', p_own, vo))

    out = lax.map(chunk, jnp.arange(nq))
    return out.transpose(1, 0, 3, 2, 4).reshape(B, S, H * dh)


def gla_attention(q, k, v, g_log):
    B, S, H, dk = q.shape
    dv = v.shape[-1]
    C = GLA_CHUNK
    nc = S // C

    def to_chunks(t):
        return t.astype(jnp.float32).reshape(B, nc, C, H, t.shape[-1]).transpose(0, 3, 1, 2, 4)

    qc = to_chunks(q) * (dk ** -0.5)
    kc = to_chunks(k)
    vc = to_chunks(v)
    b = jnp.cumsum(to_chunks(g_log), axis=3)
    b_last = b[:, :, :, -1:, :]
    q_in = qc * jnp.exp(b)
    k_in = kc * jnp.exp(-b)
    causal = jnp.tril(jnp.ones((C, C), dtype=bool))
    a = jnp.where(causal, jnp.einsum('bhntd,bhnsd->bhnts', q_in, k_in), 0.0)
    o_intra = jnp.einsum('bhnts,bhnse->bhnte', a, vc)
    u = jnp.einsum('bhnsd,bhnse->bhnde', kc * jnp.exp(b_last - b), vc)
    decay = jnp.exp(b_last[:, :, :, 0, :])

    def step(state, xs):
        u_n, d_n = xs
        return d_n[..., None] * state + u_n, state

    _, s_prev = lax.scan(step, jnp.zeros((B, H, dk, dv), jnp.float32),
                         (u.transpose(2, 0, 1, 3, 4), decay.transpose(2, 0, 1, 3)))
    s_prev = s_prev.transpose(1, 2, 0, 3, 4)
    o = o_intra + jnp.einsum('bhntd,bhnde->bhnte', q_in, s_prev)
    return o.transpose(0, 2, 3, 1, 4).reshape(B, S, H, dv)


def mixer_block(h, w_in, sinks, gla_w_gate, gla_b_gate, gla_norm_g, w_branch_a, w_branch_b, w_branch_c, w_o):
    B, S, _ = h.shape
    split_idx = [int(c) for c in np.cumsum(IN_WIDTHS)[:-1]]
    (a_q, a_k, a_v, b_q, b_k, b_v, c_q, c_k, c_v, c_r, c_g, gates) = jnp.split(h @ w_in, split_idx, axis=-1)
    o_a = swa_sink_attention(a_q.reshape(B, S, SWA_Q_HEADS, HEAD_DIM),
                             a_k.reshape(B, S, SWA_KV_HEADS, HEAD_DIM),
                             a_v.reshape(B, S, SWA_KV_HEADS, HEAD_DIM), sinks)
    o_b = moba_attention(b_q.reshape(B, S, MOBA_HEADS, HEAD_DIM),
                         b_k.reshape(B, S, MOBA_HEADS, HEAD_DIM),
                         b_v.reshape(B, S, MOBA_HEADS, HEAD_DIM))
    g_log = jax.nn.log_sigmoid((c_g @ gla_w_gate + gla_b_gate).astype(jnp.float32)) / GLA_GATE_TEMP
    o_c = gla_attention(c_q.reshape(B, S, GLA_HEADS, GLA_DK), c_k.reshape(B, S, GLA_HEADS, GLA_DK),
                        c_v.reshape(B, S, GLA_HEADS, GLA_DV), g_log.reshape(B, S, GLA_HEADS, GLA_DK))
    o_c = o_c * lax.rsqrt(jnp.mean(o_c * o_c, axis=-1, keepdims=True) + RMS_EPS)
    o_c = o_c * gla_norm_g.astype(jnp.float32).reshape(GLA_HEADS, GLA_DV)
    o_c = (o_c.reshape(B, S, GLA_OUT_W) * jax.nn.silu(c_r.astype(jnp.float32))).astype(h.dtype)
    g = jax.nn.sigmoid(gates).reshape(B, S, N_BRANCH, D_MODEL)
    y = g[:, :, 0] * (o_a @ w_branch_a) + g[:, :, 1] * (o_b @ w_branch_b) + g[:, :, 2] * (o_c @ w_branch_c)
    return y @ w_o


def swiglu(h, w_gate, w_up, w_down):
    return (jax.nn.silu(h @ w_gate) * (h @ w_up)) @ w_down


def moe_swiglu(h, w_router, w_gate, w_up, w_down):
    B, S, D = h.shape
    t = h.reshape(B * S, D)
    logits = (t @ w_router).astype(jnp.float32)
    top_v, top_i = lax.top_k(logits, TOP_K)
    top_p = jax.nn.softmax(top_v, axis=-1)
    combine = jnp.sum(jax.nn.one_hot(top_i, N_EXPERTS, dtype=jnp.float32) * top_p[..., None], axis=1)
    out = jnp.zeros_like(t)
    for e in range(N_EXPERTS):
        out = out + combine[:, e:e + 1].astype(t.dtype) * swiglu(t, w_gate[e], w_up[e], w_down[e])
    return out.reshape(B, S, D)


def setup_inputs(seed: int = 0) -> dict:
    key = jax.random.key(seed)
    ks = jax.random.split(key, 20)
    f32 = jnp.float32

    def nrm(k, shape, scale):
        return jax.random.normal(k, shape, f32) * scale

    def gain(k, shape):
        return 1.0 + 0.02 * jax.random.normal(k, shape, f32)

    return {
        'x': nrm(ks[0], (BATCH, SEQ, D_MODEL), 1.0),
        'norm1_g': gain(ks[1], (DEPTH, D_MODEL)),
        'w_in': nrm(ks[2], (DEPTH, D_MODEL, IN_TOTAL), D_MODEL ** -0.5),
        'swa_sinks': nrm(ks[3], (DEPTH, SWA_Q_HEADS), 0.5),
        'gla_w_gate': nrm(ks[4], (DEPTH, GLA_GATE_RANK, GLA_HEADS * GLA_DK), GLA_GATE_RANK ** -0.5),
        'gla_b_gate': nrm(ks[5], (DEPTH, GLA_HEADS * GLA_DK), 0.1),
        'gla_norm_g': gain(ks[6], (DEPTH, GLA_OUT_W)),
        'w_branch_a': nrm(ks[7], (DEPTH, SWA_OUT_W, D_MODEL), SWA_OUT_W ** -0.5),
        'w_branch_b': nrm(ks[8], (DEPTH, MOBA_OUT_W, D_MODEL), MOBA_OUT_W ** -0.5),
        'w_branch_c': nrm(ks[9], (DEPTH, GLA_OUT_W, D_MODEL), GLA_OUT_W ** -0.5),
        'w_o': nrm(ks[10], (DEPTH, D_MODEL, D_MODEL), D_MODEL ** -0.5),
        'norm2_g': gain(ks[11], (DEPTH, D_MODEL)),
        'ffn_w_gate': nrm(ks[12], (N_DENSE, D_MODEL, D_FF), D_MODEL ** -0.5),
        'ffn_w_up': nrm(ks[13], (N_DENSE, D_MODEL, D_FF), D_MODEL ** -0.5),
        'ffn_w_down': nrm(ks[14], (N_DENSE, D_FF, D_MODEL), D_FF ** -0.5),
        'moe_router': nrm(ks[15], (N_MOE, D_MODEL, N_EXPERTS), D_MODEL ** -0.5),
        'moe_w_gate': nrm(ks[16], (N_MOE, N_EXPERTS, D_MODEL, D_FF_EXPERT), D_MODEL ** -0.5),
        'moe_w_up': nrm(ks[17], (N_MOE, N_EXPERTS, D_MODEL, D_FF_EXPERT), D_MODEL ** -0.5),
        'moe_w_down': nrm(ks[18], (N_MOE, N_EXPERTS, D_FF_EXPERT, D_MODEL), D_FF_EXPERT ** -0.5),
        'final_norm_g': gain(ks[19], (D_MODEL,)),
    }


def reference(x, norm1_g, w_in, swa_sinks, gla_w_gate, gla_b_gate, gla_norm_g, w_branch_a, w_branch_b,
              w_branch_c, w_o, norm2_g, ffn_w_gate, ffn_w_up, ffn_w_down, moe_router, moe_w_gate, moe_w_up,
              moe_w_down, final_norm_g):
    for l in range(DEPTH):
        h = rms_norm(x, norm1_g[l])
        x = x + mixer_block(h, w_in[l], swa_sinks[l], gla_w_gate[l], gla_b_gate[l], gla_norm_g[l],
                            w_branch_a[l], w_branch_b[l], w_branch_c[l], w_o[l])
        h = rms_norm(x, norm2_g[l])
        j = l // 2
        if l % 2 == 0:
            x = x + swiglu(h, ffn_w_gate[j], ffn_w_up[j], ffn_w_down[j])
        else:
            x = x + moe_swiglu(h, moe_router[j], moe_w_gate[j], moe_w_up[j], moe_w_down[j])
    return rms_norm(x, final_norm_g)
```

```cpp
#include <hip/hip_runtime.h>
#include <cstdio>
#include <cstdint>
#include <cmath>

#define GAS __attribute__((address_space(1)))
#define LAS __attribute__((address_space(3)))
typedef unsigned short bf16;
typedef unsigned v4u __attribute__((ext_vector_type(4)));
typedef unsigned v2u __attribute__((ext_vector_type(2)));
typedef float f32x4 __attribute__((ext_vector_type(4)));
typedef GAS unsigned gu32;
#define RLX_AGENT __ATOMIC_RELAXED, __HIP_MEMORY_SCOPE_AGENT
#define LDS_WAIT() asm volatile("s_waitcnt lgkmcnt(0)" ::: "memory")
#define VM_WAIT() asm volatile("s_waitcnt vmcnt(0)" ::: "memory")
__device__ __forceinline__ unsigned f2bf(float f) { unsigned u = __builtin_bit_cast(unsigned, f); return (u + 0x7fffu + ((u >> 16) & 1u)) >> 16; }
__device__ __forceinline__ unsigned pk2(float lo, float hi) { return f2bf(lo) | (f2bf(hi) << 16); }
__device__ __forceinline__ float bf2f(unsigned short b) { return __builtin_bit_cast(float, (unsigned)b << 16); }
__device__ __forceinline__ float bflo(unsigned w) { return __builtin_bit_cast(float, w << 16); }
__device__ __forceinline__ float bfhi(unsigned w) { return __builtin_bit_cast(float, w & 0xffff0000u); }
__device__ __forceinline__ float wave_sum(float v) {
#pragma unroll
    for (int o = 1; o < 64; o <<= 1) v += __shfl_xor(v, o);
    return v;
}
__device__ __forceinline__ float wave_max(float v) {
#pragma unroll
    for (int o = 1; o < 64; o <<= 1) v = fmaxf(v, __shfl_xor(v, o));
    return v;
}

constexpr int NWAVES = 8;
constexpr int BATCH = 2, SEQ = 8192, DM = 1024, T = BATCH * SEQ;
constexpr int IN_TOTAL = 6928, NMAIN = 4096, NGATES = 3072;
constexpr int DFF = 2816, NEXP = 8, DFE = 1408;
constexpr float RMS_EPS = 1e-6f;
constexpr int XG_ROWS = 2 * T + 2048;

constexpr size_t MiB = 1u << 20;
constexpr size_t WS_CTL = 0, CTL_ZERO_BYTES = 1 * MiB;
constexpr size_t WS_SSQ = 1 * MiB;
constexpr size_t WS_KBP = 2 * MiB;
constexpr size_t WS_DEC = 2 * MiB + 256 * 1024;
constexpr size_t WS_TOKE = 2 * MiB + 512 * 1024;
constexpr size_t WS_TOKP = WS_TOKE + 128 * 1024;
constexpr size_t WS_TOKPOS = WS_TOKP + 128 * 1024;
constexpr size_t WS_RS2 = WS_TOKPOS + 128 * 1024;
constexpr size_t WS_CNT = WS_RS2 + 64 * 1024;
constexpr size_t WS_RSG = 3 * MiB;
constexpr size_t WS_PWG = 3 * MiB + 256 * 1024;
constexpr size_t WS_W = 4 * MiB;
constexpr size_t WO_IN = 0, WO_BR = 14 * MiB, WO_O = 17 * MiB, WO_GU = 19 * MiB, WO_D = 30 * MiB;
constexpr size_t WS_XB = 40 * MiB;
constexpr size_t WS_R = 72 * MiB;
constexpr size_t RO_AQ = 0, RO_BQ = 16 * MiB, RO_CR = 32 * MiB, RO_AK = 48 * MiB, RO_AV = 52 * MiB, RO_BK = 56 * MiB, RO_BV = 72 * MiB, RO_CQ = 88 * MiB, RO_CK = 96 * MiB, RO_CV = 104 * MiB, RO_GL = 120 * MiB;
constexpr size_t WS_GATES = WS_R + 48 * MiB;
constexpr size_t WS_S = 208 * MiB;
constexpr size_t WS_Y = 240 * MiB;
constexpr size_t WS_H = WS_R;
constexpr size_t WS_XG = WS_R;
constexpr size_t WS_HG = 140 * MiB;
constexpr size_t WS_WMGU = 234 * MiB;
constexpr size_t WS_WMD = 278 * MiB;
constexpr size_t WS_END = 300 * MiB;
static_assert(WS_HG + (size_t)XG_ROWS * DFE * 2 <= WS_WMGU && WS_XG + (size_t)XG_ROWS * DM * 2 <= WS_HG, "moe map");
static_assert(WS_GATES + (size_t)T * NGATES * 2 <= WS_Y && WS_H + (size_t)T * DFF * 2 <= WS_S, "overlay map");
constexpr int CW_BAR = 4096;

constexpr int RING_OFF = 0, RING_BYTES = 131072;
constexpr int LDSCTL_OFF = RING_BYTES, MISC_OFF = LDSCTL_OFF + 320;
constexpr int LDS_BYTES = 147456;
namespace pg8 {
#define PG8_LAS __attribute__((address_space(3)))
typedef unsigned short bf16_t;
typedef short bf16x8 __attribute__((ext_vector_type(8)));
typedef float f32x4 __attribute__((ext_vector_type(4)));
typedef unsigned u32x4 __attribute__((ext_vector_type(4)));
typedef unsigned u32x2 __attribute__((ext_vector_type(2)));
constexpr int BM = 256, BK = 64, HALF = 128, HTB = HALF * BK * 2  , STAGE_BYTES = 8 * HTB, NXCD = 8, WGM = 8;

__host__ __device__ __forceinline__ int lds_byte(int r, int c) { const int st = (r >> 4) * 2 + (c >> 5), rr = r & 15, cc = c & 31, ob = rr * 64 + cc * 2; return st * 1024 + (ob ^ (((ob >> 9) & 1) << 5)); }
__host__ __device__ __forceinline__ void stage_rc(int b, int& R, int& C) { const int st = b / 1024, sb = b % 1024, swz = sb ^ (((sb >> 9) & 1) << 5); R = (st >> 1) * 16 + swz / 64; C = (st & 1) * 32 + (swz % 64) / 2; }
__host__ __device__ __forceinline__ int perm32(int rho) { const int n = rho >> 4, i = rho & 15; return 8 * (i >> 2) + 4 * n + (i & 3); }

struct Unit { const char* A; const char* B; int pm, pn, aux; };

__device__ __forceinline__ bool static_tile(int nM, int nN, int G, int c, int i, int& pm, int& pn) {
    const int nwg = nM * nN; const long L = (long)i * G + c; if (L >= nwg) return false;
    int wgid = (int)L; { const int q = nwg / NXCD, r = nwg % NXCD, xcd = wgid % NXCD, off = wgid / NXCD; wgid = (xcd < r ? xcd * (q + 1) : r * (q + 1) + (xcd - r) * q) + off; }
    const int nig = WGM * nN, gid = wgid / nig, fm = gid * WGM, gsz = (nM - fm) < WGM ? (nM - fm) : WGM;
    pm = fm + ((wgid % nig) % gsz); pn = (wgid % nig) / gsz; return true;
}
struct DenseOrder {
    const char* A; const char* B; int nM, nN, G, c; size_t tstep;
    __device__ __forceinline__ void init(const void* A_, const void* B_, int M, int N, int K, int G_, int c_) { A = (const char*)A_; B = (const char*)B_; nM = M / BM; nN = N / BM; G = G_; c = c_; tstep = (size_t)BM * K * 2; }
    __device__ __forceinline__ bool next(int i, Unit& u) const { int pm, pn; if (!static_tile(nM, nN, G, c, i, pm, pn)) return false; u.pm = pm; u.pn = pn; u.aux = pn; u.A = A + (size_t)pm * tstep; u.B = B + (size_t)pn * tstep; return true; }
};

__device__ __forceinline__ unsigned cvt_pk_bf16(float lo, float hi) { unsigned r; asm volatile("v_cvt_pk_bf16_f32 %0, %1, %2" : "=v"(r) : "v"(lo), "v"(hi)); return r; }

template <class Epi, class Sched, bool ALIGN_EPI = true>
__device__ __forceinline__ void gemm_phase(PG8_LAS unsigned char* lds, const int K, const Sched& S, const Epi& E) {
    int tid_ = threadIdx.x; asm volatile("" : "+v"(tid_));
    const int tid = tid_, wid = __builtin_amdgcn_readfirstlane(tid >> 6), lane = tid & 63, wr = wid >> 2, wc = wid & 3, fr = lane & 15, fq = lane >> 4;
    const int nt = K / BK;
    unsigned voffA[2], voffB[2];
#pragma unroll
    for (int i = 0; i < 2; ++i) { int R, C; stage_rc(tid * 16 + i * 8192, R, C); const int Rb = Epi::PERM ? ((R & ~31) + perm32(R & 31)) : R;
        voffA[i] = (unsigned)(R * K + C) * 2u; voffB[i] = (unsigned)(Rb * K + C) * 2u; }
    const size_t kstep = (size_t)(BK * 2);
    const size_t hstep = (size_t)HALF * K * 2;
    const unsigned ldsw = (unsigned)wid * 1024u;
    const int aoff = lds_byte(wr * 64 + fr, fq * 8), boff = lds_byte(wc * 32 + fr, fq * 8);
#define PG8_SA(b, h) (((b) * 2 + (h)) * HTB)
#define PG8_SB(b, h) ((4 + (b) * 2 + (h)) * HTB)
#define PG8_STAGE(bufoff, gbase, voff) do { _Pragma("unroll") for (int _i = 0; _i < 2; ++_i) \
        __builtin_amdgcn_global_load_lds((const unsigned*)((const char*)(gbase) + (voff)[_i]), (PG8_LAS unsigned*)(lds + (bufoff) + ldsw + _i * 8192), 16, 0, 0); } while (0)
#define PG8_LDA(dst, b, h) do { _Pragma("unroll") for (int m = 0; m < 4; ++m) _Pragma("unroll") for (int k = 0; k < 2; ++k) dst[m][k] = *(const PG8_LAS bf16x8*)(lds + PG8_SA(b, h) + aoff + m * 2048 + k * 1024); } while (0)
#define PG8_LDB(dst, b, h) do { _Pragma("unroll") for (int n = 0; n < 2; ++n) _Pragma("unroll") for (int k = 0; k < 2; ++k) dst[n][k] = *(const PG8_LAS bf16x8*)(lds + PG8_SB(b, h) + boff + n * 2048 + k * 1024); } while (0)
#define PG8_MMA(ai, bj, At, Bt) do { __builtin_amdgcn_s_setprio(1); _Pragma("unroll") for (int m = 0; m < 4; ++m) _Pragma("unroll") for (int n = 0; n < 2; ++n) _Pragma("unroll") for (int k = 0; k < 2; ++k) \
        acc[ai][bj][m][n] = __builtin_amdgcn_mfma_f32_16x16x32_bf16(Bt[n][k], At[m][k], acc[ai][bj][m][n], 0, 0, 0); __builtin_amdgcn_s_setprio(0); } while (0)
#define PG8_WAIT_V(n) asm volatile("s_waitcnt vmcnt(" #n ")" ::: "memory")
#define PG8_WAIT_L(n) asm volatile("s_waitcnt lgkmcnt(" #n ")" ::: "memory")
#define PG8_BAR __builtin_amdgcn_s_barrier()
#define PG8_SCHED __builtin_amdgcn_sched_barrier(0)
    Unit cur, nxt; int ui = 0;
    if (!S.next(0, cur)) return;
    f32x4 acc[2][2][4][2];
#pragma unroll
    for (int a = 0; a < 2; ++a)
#pragma unroll
        for (int b = 0; b < 2; ++b)
#pragma unroll
            for (int m = 0; m < 4; ++m)
#pragma unroll
                for (int n = 0; n < 2; ++n) acc[a][b][m][n] = (f32x4){0.f, 0.f, 0.f, 0.f};
    bf16x8 At[4][2], B0[2][2], B1[2][2];
    const char* cA = cur.A; const char* cB = cur.B;
    PG8_STAGE(PG8_SB(0, 0), cB, voffB); PG8_STAGE(PG8_SB(0, 1), cB + hstep, voffB); PG8_STAGE(PG8_SA(0, 0), cA, voffA); PG8_STAGE(PG8_SA(0, 1), cA + hstep, voffA);
    if (wr == 1) PG8_BAR;
    PG8_WAIT_V(2); PG8_BAR;
    PG8_STAGE(PG8_SB(1, 0), cB + kstep, voffB); PG8_STAGE(PG8_SA(1, 0), cA + kstep, voffA); PG8_STAGE(PG8_SB(1, 1), cB + hstep + kstep, voffB);
    PG8_WAIT_V(6); PG8_BAR;
    for (;;) {
        const bool has_next = S.next(ui + 1, nxt);
        const char* nA = has_next ? nxt.A : cA; const char* nB = has_next ? nxt.B : cB;
        for (int t = 0; t < nt; t += 2) {
            const bool last = (t == nt - 2);
            const char* a1 = cA + (size_t)(t + 1) * kstep;
            const char* a2 = last ? nA : cA + (size_t)(t + 2) * kstep; const char* b2 = last ? nB : cB + (size_t)(t + 2) * kstep;
            const char* a3 = a2 + kstep; const char* b3 = b2 + kstep;
            PG8_LDB(B0, 0, 0); PG8_LDB(B1, 0, 1); PG8_SCHED; PG8_LDA(At, 0, 0); PG8_STAGE(PG8_SA(1, 1), a1 + hstep, voffA);
            PG8_WAIT_V(8); PG8_WAIT_L(0); PG8_BAR; PG8_MMA(0, 0, At, B0); PG8_MMA(0, 1, At, B1); PG8_BAR; PG8_SCHED;
            PG8_LDA(At, 0, 1); PG8_STAGE(PG8_SB(0, 0), b2, voffB); PG8_STAGE(PG8_SB(0, 1), b2 + hstep, voffB); PG8_STAGE(PG8_SA(0, 0), a2, voffA);
            PG8_WAIT_V(8); PG8_WAIT_L(0); PG8_BAR; PG8_MMA(1, 0, At, B0); PG8_MMA(1, 1, At, B1); PG8_BAR; PG8_SCHED;
            PG8_LDB(B0, 1, 0); PG8_LDB(B1, 1, 1); PG8_SCHED; PG8_LDA(At, 1, 0); PG8_STAGE(PG8_SA(0, 1), a2 + hstep, voffA);
            PG8_WAIT_V(8); PG8_WAIT_L(0); PG8_BAR; PG8_MMA(0, 0, At, B0); PG8_MMA(0, 1, At, B1); PG8_BAR; PG8_SCHED;
            PG8_LDA(At, 1, 1); PG8_STAGE(PG8_SB(1, 0), b3, voffB); PG8_STAGE(PG8_SB(1, 1), b3 + hstep, voffB); PG8_STAGE(PG8_SA(1, 0), a3, voffA);
            PG8_WAIT_V(8); PG8_WAIT_L(0); PG8_BAR; PG8_MMA(1, 0, At, B0); PG8_MMA(1, 1, At, B1); PG8_BAR; PG8_SCHED;
        }
        if constexpr (ALIGN_EPI) { if (wr == 0) PG8_BAR; }
        E(acc, cur, wr, wc, fr, fq);
        if (!has_next) break;
#pragma unroll
        for (int a = 0; a < 2; ++a)
#pragma unroll
            for (int b = 0; b < 2; ++b)
#pragma unroll
                for (int m = 0; m < 4; ++m)
#pragma unroll
                    for (int n = 0; n < 2; ++n) acc[a][b][m][n] = (f32x4){0.f, 0.f, 0.f, 0.f};
        cur = nxt; cA = nA; cB = nB; ++ui;
        if constexpr (ALIGN_EPI) { if (wr == 1) PG8_BAR; }
    }
    PG8_WAIT_V(0);
    if constexpr (!ALIGN_EPI) { if (wr == 0) PG8_BAR; }
    PG8_BAR;
#undef PG8_SA
#undef PG8_SB
#undef PG8_STAGE
#undef PG8_LDA
#undef PG8_LDB
#undef PG8_MMA
#undef PG8_WAIT_V
#undef PG8_WAIT_L
#undef PG8_BAR
#undef PG8_SCHED
}
}
#define XB_TMO      128
#define XB_XCNT(j)  (256  + 64 * (j))
#define XB_XSUB(j)  (1280 + 64 * (j))
#define XB_XGEN(j)  (2304 + 64 * (j))
#define XB_TOP      3328
#define XB_TOPGEN   3392
#define XCD_BAR_WORDS 3456
#define XB_SPIN_CAP (1u << 18)

__device__ __forceinline__ unsigned xb_ld(unsigned* p)              { return __hip_atomic_load(p, __ATOMIC_RELAXED, __HIP_MEMORY_SCOPE_AGENT); }
__device__ __forceinline__ unsigned xb_add(unsigned* p, unsigned v) { return __hip_atomic_fetch_add(p, v, __ATOMIC_RELAXED, __HIP_MEMORY_SCOPE_AGENT); }
__device__ __forceinline__ unsigned xb_xcc_id() { return (unsigned)__builtin_amdgcn_s_getreg((3 << 11) | 20) & 0xFu; }
#define XB_SPIN(cond, bar) do { unsigned _sp = 0; while (cond) { __builtin_amdgcn_s_sleep(1); \
    if ((++_sp & 255u) == 0u) { if (xb_ld(&(bar)[XB_TMO])) break; if (_sp > XB_SPIN_CAP) { atomicAdd(&(bar)[XB_TMO], 1u); break; } } } } while (0)

struct XcdBarrier {
    unsigned* bar; unsigned x;
    volatile LAS unsigned* st;
};

__device__ __forceinline__ XcdBarrier xcd_barrier_post(unsigned* bar, volatile LAS unsigned* st) {
    XcdBarrier b; b.bar = bar; b.x = xb_xcc_id(); b.st = st;
    if (threadIdx.x == 0) (void)xb_add(&bar[XB_XCNT(b.x)], 1u);
    return b;
}
__device__ __forceinline__ void xcd_barrier_complete(unsigned* bar, unsigned x, unsigned& nloc, unsigned& nx) {
    const unsigned G = gridDim.x * gridDim.y * gridDim.z;
    unsigned sum, cnt, mine, sp = 0u;
    for (;;) {
        sum = 0u; cnt = 0u; mine = 0u;
#pragma unroll
        for (unsigned j = 0; j < 16; ++j) { const unsigned c = xb_ld(&bar[XB_XCNT(j)]); sum += c; cnt += (c > 0u) ? 1u : 0u; mine = (j == x) ? c : mine; }
        if (sum == G) break;
        __builtin_amdgcn_s_sleep(1);
        if ((++sp & 255u) == 0u) { if (xb_ld(&bar[XB_TMO])) break; if (sp > XB_SPIN_CAP) { atomicAdd(&bar[XB_TMO], 1u); break; } }
    }
    nloc = mine > 0u ? mine : 1u; nx = cnt > 0u ? cnt : 1u;
}

__device__ __forceinline__ void xcd_barrier(const XcdBarrier& b) {
    asm volatile("s_waitcnt vmcnt(0)" ::: "memory");
    __syncthreads();
    if (threadIdx.x == 0) {
        unsigned* bar = b.bar;
        __builtin_amdgcn_s_waitcnt(0);
        unsigned nloc = b.st[0], nx = b.st[1];
        if (nloc == 0u) { xcd_barrier_complete(bar, b.x, nloc, nx); b.st[0] = nloc; b.st[1] = nx; }
        const unsigned old = xb_add(&bar[XB_XSUB(b.x)], 1u);
        const unsigned gen = old / nloc;
        if (old + 1u == (gen + 1u) * nloc) {
            __builtin_amdgcn_fence(__ATOMIC_RELEASE, "agent");
            asm volatile("s_waitcnt vmcnt(0)" ::: "memory");
            const unsigned og = xb_add(&bar[XB_TOP], 1u);
            const unsigned tg = og / nx;
            if (og + 1u == (tg + 1u) * nx) xb_add(&bar[XB_TOPGEN], 1u);
            else XB_SPIN(xb_ld(&bar[XB_TOPGEN]) == tg, bar);
            __builtin_amdgcn_fence(__ATOMIC_ACQUIRE, "agent");
            xb_add(&bar[XB_XGEN(b.x)], 1u);
            asm volatile("s_waitcnt vmcnt(0)" ::: "memory");
        } else {
            XB_SPIN(xb_ld(&bar[XB_XGEN(b.x)]) == gen, bar);
            __builtin_amdgcn_fence(__ATOMIC_ACQUIRE, "agent");
            asm volatile("s_waitcnt vmcnt(0)" ::: "memory");
        }
    }
    __syncthreads();
}
struct Params { const float* in[20]; float* out; unsigned char* ws; };
enum { I_X = 0, I_N1G, I_WIN, I_SINK, I_GWG, I_GBG, I_GNG, I_WA, I_WB, I_WC, I_WO, I_N2G, I_FG, I_FU, I_FD, I_RT, I_MG, I_MU, I_MD, I_FNG };

struct Frame {
    LAS unsigned char* lds;
    volatile LAS unsigned* MISC;
    gu32* ctl;
    int tid, lane, wave;
    int vcu, G;
};
__device__ __forceinline__ unsigned char* lws(const Params& P) { GAS unsigned char* w = (GAS unsigned char*)P.ws; asm volatile("" : "+s"(w)); return (unsigned char*)w; }
#define PH_BEGIN Frame F = F_in; { int t_ = threadIdx.x; asm volatile("" : "+v"(t_)); F.tid = t_; F.lane = t_ & 63; } Params P = P_in; P.ws = lws(P_in);

template <int MODE>
__device__ __forceinline__ void tr_item(const float* W, int ld, int sc, const float* g, const float* W2, int n0, bf16* dst, int dK, int drow, int k0, LAS float* scr, int lane) {
#pragma unroll 4
    for (int i = 0; i < 32; ++i) { const int kk = 2 * i + (lane >> 5), nn = lane & 31; const float* wr = W + (size_t)(k0 + kk) * ld + sc;
        float v;
        if (MODE == 0) v = wr[n0 + nn];
        else { v = 0.f;
#pragma unroll
            for (int r = 0; r < 16; ++r) v += wr[r] * W2[r * 256 + n0 + nn]; }
        if (g) v *= g[k0 + kk];
        scr[kk * 33 + nn] = v; }
    LDS_WAIT(); asm volatile("" ::: "memory");
    const int c = lane & 7;
#pragma unroll
    for (int j = 0; j < 4; ++j) { const int n = (lane >> 3) + 8 * j; const LAS float* s = scr + (8 * c) * 33 + n;
        v4u o; o.x = pk2(s[0 * 33], s[1 * 33]); o.y = pk2(s[2 * 33], s[3 * 33]); o.z = pk2(s[4 * 33], s[5 * 33]); o.w = pk2(s[6 * 33], s[7 * 33]);
        *(GAS v4u*)(dst + (size_t)(drow + n) * dK + k0 + 8 * c) = o; }
    LDS_WAIT(); asm volatile("" ::: "memory");
}
__device__ __forceinline__ void tr_job(int item, const float* W, int ld, int sc, int K, int N, const float* g, bf16* dst, int drow0, int gu_off, bool gu, LAS float* scr, int lane) {
    const int nblk = N / 32, kb = item / nblk, nb = item % nblk, n0 = 32 * nb;
    const int drow = gu ? (256 * (n0 / 128) + (n0 % 128) + gu_off) : (drow0 + n0);
    tr_item<0>(W, ld, sc, g, nullptr, n0, dst, K, drow, 64 * kb, scr, lane);
}
__device__ __forceinline__ void convert_layer_weights(const Frame& F_in, const Params& P_in, int l, int gw, int NGW, bool skip_ffn_down_region) {
    PH_BEGIN
    LAS float* scr = (LAS float*)(F.lds + RING_OFF + F.wave * 16384);
    unsigned char* ws = P.ws;
    bf16* Win = (bf16*)(ws + WS_W + WO_IN); bf16* Wbr = (bf16*)(ws + WS_W + WO_BR); bf16* Wo = (bf16*)(ws + WS_W + WO_O); bf16* Wgu = (bf16*)(ws + WS_W + WO_GU); bf16* Wd = (bf16*)(ws + WS_W + WO_D);
    const float* win = P.in[I_WIN] + (size_t)l * DM * IN_TOTAL; const float* n1g = P.in[I_N1G] + l * DM; const float* n2g = P.in[I_N2G] + l * DM;
    constexpr int J1 = 16 * (3840 / 32), J2 = 16 * (NGATES / 32), J3 = 16 * (256 / 32), J4 = 8 * (DM / 32), J7 = 16 * (DM / 32), J8 = 16 * (DFF / 32), J10 = (DFF / 64) * (DM / 32);
    const int NIT = J1 + J2 + J3 + 3 * J4 + J7 + ((l == 0) ? (2 * J8 + J10) : 0);
    for (int it = gw; it < NIT; it += NGW) {
        int r = it;
        if (r < J1) { tr_job(r, win, IN_TOTAL, 0, DM, 3840, n1g, Win, 0, 0, false, scr, F.lane); continue; } r -= J1;
        if (r < J2) { tr_job(r, win, IN_TOTAL, 3856, DM, NGATES, n1g, Win, NMAIN, 0, false, scr, F.lane); continue; } r -= J2;
        if (r < J3) { const int kb = r / 8, nb = r % 8; tr_item<1>(win, IN_TOTAL, 3840, n1g, P.in[I_GWG] + (size_t)l * 16 * 256, 32 * nb, Win, DM, 3840 + 32 * nb, 64 * kb, scr, F.lane); continue; } r -= J3;
        if (r < J4) { tr_job(r, P.in[I_WA] + (size_t)l * 512 * DM, DM, 0, 512, DM, nullptr, Wbr, 0, 0, false, scr, F.lane); continue; } r -= J4;
        if (r < J4) { tr_job(r, P.in[I_WB] + (size_t)l * 512 * DM, DM, 0, 512, DM, nullptr, Wbr + (size_t)DM * 512, 0, 0, false, scr, F.lane); continue; } r -= J4;
        if (r < J4) { tr_job(r, P.in[I_WC] + (size_t)l * 512 * DM, DM, 0, 512, DM, nullptr, Wbr + (size_t)2 * DM * 512, 0, 0, false, scr, F.lane); continue; } r -= J4;
        if (r < J7) { tr_job(r, P.in[I_WO] + (size_t)l * DM * DM, DM, 0, DM, DM, nullptr, Wo, 0, 0, false, scr, F.lane); continue; } r -= J7;
        if (r < J8) { tr_job(r, P.in[I_FG], DFF, 0, DM, DFF, n2g, Wgu, 0, 0, true, scr, F.lane); continue; } r -= J8;
        if (r < J8) { tr_job(r, P.in[I_FU], DFF, 0, DM, DFF, n2g, Wgu, 0, 128, true, scr, F.lane); continue; } r -= J8;
        tr_job(r, P.in[I_FD], DM, 0, DFF, DM, nullptr, Wd, 0, 0, false, scr, F.lane);
    }
}
__device__ __forceinline__ void convert_moe_weights(const Frame& F_in, const Params& P_in, int gw, int NGW) {
    PH_BEGIN
    LAS float* scr = (LAS float*)(F.lds + RING_OFF + F.wave * 16384);
    bf16* Wgu = (bf16*)(P.ws + WS_WMGU); bf16* Wd = (bf16*)(P.ws + WS_WMD);
    const float* n2g = P.in[I_N2G] + 1 * DM;
    constexpr int JG = 16 * (DFE / 32), JD = (DFE / 64) * (DM / 32), JE = 2 * JG + JD;
    for (int it = gw; it < NEXP * JE; it += NGW) {
        const int e = it / JE; int r = it % JE;
        if (r < JG) { tr_job(r, P.in[I_MG] + (size_t)e * DM * DFE, DFE, 0, DM, DFE, n2g, Wgu + (size_t)e * 2 * DFE * DM, 0, 0, true, scr, F.lane); continue; } r -= JG;
        if (r < JG) { tr_job(r, P.in[I_MU] + (size_t)e * DM * DFE, DFE, 0, DM, DFE, n2g, Wgu + (size_t)e * 2 * DFE * DM, 0, 128, true, scr, F.lane); continue; } r -= JG;
        tr_job(r, P.in[I_MD] + (size_t)e * DFE * DM, DM, 0, DFE, DM, nullptr, Wd + (size_t)e * DM * DFE, 0, 0, false, scr, F.lane);
    }
}
__device__ __forceinline__ void prep_x(const Frame& F_in, const Params& P_in, int gw, int NGW) {
    PH_BEGIN
    bf16* XB = (bf16*)(P.ws + WS_XB); float* SSQ = (float*)(P.ws + WS_SSQ);
    for (int m = gw; m < T; m += NGW) {
        const GAS f32x4* xr = (const GAS f32x4*)(P.in[I_X] + (size_t)m * DM) + F.lane;
        f32x4 v[4]; float s = 0.f;
#pragma unroll
        for (int j = 0; j < 4; ++j) { v[j] = xr[64 * j]; s += (v[j].x * v[j].x + v[j].y * v[j].y) + (v[j].z * v[j].z + v[j].w * v[j].w); }
        s = wave_sum(s) * (1.f / 16.f);
        GAS unsigned long long* o8 = (GAS unsigned long long*)(XB + (size_t)m * DM) + F.lane;
#pragma unroll
        for (int j = 0; j < 4; ++j) o8[64 * j] = (unsigned long long)pk2(v[j].x, v[j].y) | ((unsigned long long)pk2(v[j].z, v[j].w) << 32);
        if (F.lane < 16) SSQ[(size_t)m * 16 + F.lane] = s;
    }
}
__device__ __forceinline__ void final_phase(const Frame& F_in, const Params& P_in, int gw, int NGW, bool with_moe) {
    PH_BEGIN
    const float* g = P.in[I_FNG]; const bf16* YE = (const bf16*)(P.ws + WS_XG); const int* TOKPOS = (const int*)(P.ws + WS_TOKPOS);
    for (int m = gw; m < T; m += NGW) {
        GAS f32x4* xr = (GAS f32x4*)(P.out + (size_t)m * DM) + F.lane;
        f32x4 v[4]; float s = 0.f;
#pragma unroll
        for (int j = 0; j < 4; ++j) v[j] = xr[64 * j];
        if (with_moe) {
#pragma unroll
            for (int sl = 0; sl < 2; ++sl) { const int pos = TOKPOS[m * 2 + sl]; const GAS v2u* yr = (const GAS v2u*)(YE + (size_t)pos * DM) + F.lane;
#pragma unroll
                for (int j = 0; j < 4; ++j) { const v2u w = yr[64 * j]; v[j].x += bflo(w.x); v[j].y += bfhi(w.x); v[j].z += bflo(w.y); v[j].w += bfhi(w.y); } }
        }
#pragma unroll
        for (int j = 0; j < 4; ++j) s += (v[j].x * v[j].x + v[j].y * v[j].y) + (v[j].z * v[j].z + v[j].w * v[j].w);
        const float r = 1.0f / sqrtf(wave_sum(s) * (1.f / DM) + RMS_EPS);
#pragma unroll
        for (int j = 0; j < 4; ++j) { const f32x4 gg = *((const GAS f32x4*)g + F.lane + 64 * j); xr[64 * j] = (f32x4){v[j].x * r * gg.x, v[j].y * r * gg.y, v[j].z * r * gg.z, v[j].w * r * gg.w}; }
    }
}
namespace epi {
using pg8::f32x4; using pg8::Unit; using pg8::u32x4; using pg8::cvt_pk_bf16;
typedef const f32x4 (&Acc)[2][2][4][2];
__device__ __forceinline__ float sigmoidf_(float x) { return 1.0f / (1.0f + __expf(-x)); }
__device__ __forceinline__ float siluf_(float x) { return x / (1.0f + __expf(-x)); }
__device__ __forceinline__ float logsigmoidf_(float x) { return fminf(x, 0.f) - log1pf(__expf(-fabsf(x))); }
__device__ __forceinline__ u32x4 pack8(const f32x4& a, const f32x4& b) { u32x4 w; w.x = cvt_pk_bf16(a[0], a[1]); w.y = cvt_pk_bf16(a[2], a[3]); w.z = cvt_pk_bf16(b[0], b[1]); w.w = cvt_pk_bf16(b[2], b[3]); return w; }
__device__ __forceinline__ void unpack8(const u32x4& w, f32x4& a, f32x4& b) { a = (f32x4){bflo(w.x), bfhi(w.x), bflo(w.y), bfhi(w.y)}; b = (f32x4){bflo(w.z), bfhi(w.z), bflo(w.w), bfhi(w.w)}; }
__device__ __forceinline__ float row_rs(const float* ssq, int row) {
    const f32x4* p = (const f32x4*)(ssq + (size_t)row * 16); const f32x4 a = p[0], b = p[1], c = p[2], d = p[3];
    const float s = ((a[0] + a[1]) + (a[2] + a[3])) + ((b[0] + b[1]) + (b[2] + b[3])) + ((c[0] + c[1]) + (c[2] + c[3])) + ((d[0] + d[1]) + (d[2] + d[3]));
    return 1.0f / sqrtf(s * (1.0f / DM) + RMS_EPS);
}

struct EpiInproj {
    static constexpr bool PERM = true;
    unsigned char* R; const float* ssq; const float* gbias; float* kbp;
    template <int ACT, bool KSUM>
    __device__ __forceinline__ void store_half(Acc acc, const int bj, bf16* dst, const int ldc, const int col, const Unit& u, int wr, int fr) const {
        f32x4 ks0 = (f32x4){0.f, 0.f, 0.f, 0.f}, ks1 = ks0;
#pragma unroll
        for (int ai = 0; ai < 2; ++ai)
#pragma unroll
            for (int m = 0; m < 4; ++m) {
                const int row = u.pm * 256 + ai * 128 + wr * 64 + m * 16 + fr; const float rs = row_rs(ssq, row);
                f32x4 v0 = acc[ai][bj][m][0] * rs, v1 = acc[ai][bj][m][1] * rs;
                if (ACT == 1) {
#pragma unroll
                    for (int i = 0; i < 4; ++i) { v0[i] = siluf_(v0[i]); v1[i] = siluf_(v1[i]); }
                }
                if (KSUM) { ks0 += v0; ks1 += v1; }
                *(u32x4*)(dst + (size_t)row * ldc + col) = pack8(v0, v1);
            }
        if (KSUM) {
#pragma unroll
            for (int i = 0; i < 4; ++i) {
#pragma unroll
                for (int o = 1; o < 16; o <<= 1) { ks0[i] += __shfl_xor(ks0[i], o); ks1[i] += __shfl_xor(ks1[i], o); }
            }
            if (fr == 0) { float* kp = kbp + ((size_t)u.pm * 2 + wr) * 512 + col; *(f32x4*)kp = ks0; *(f32x4*)(kp + 4) = ks1; }
        }
    }
    __device__ __forceinline__ void operator()(Acc acc, const Unit& u, int wr, int wc, int fr, int fq) const {
        const int pn = u.pn; const int c0 = wc * 32 + 8 * fq;
        if (pn == 15) {
#pragma unroll
            for (int bj = 0; bj < 2; ++bj) { const int col = bj * 128 + c0; const f32x4 b0 = *(const f32x4*)(gbias + col), b1 = *(const f32x4*)(gbias + col + 4);
#pragma unroll
                for (int ai = 0; ai < 2; ++ai)
#pragma unroll
                    for (int m = 0; m < 4; ++m) {
                        const int row = u.pm * 256 + ai * 128 + wr * 64 + m * 16 + fr; const float rs = row_rs(ssq, row);
                        f32x4 v0 = acc[ai][bj][m][0] * rs + b0, v1 = acc[ai][bj][m][1] * rs + b1;
#pragma unroll
                        for (int i = 0; i < 4; ++i) { v0[i] = logsigmoidf_(v0[i]) * (1.0f / 16.0f); v1[i] = logsigmoidf_(v1[i]) * (1.0f / 16.0f); }
                        float* gl = (float*)(R + RO_GL) + (size_t)row * 256 + col; *(f32x4*)gl = v0; *(f32x4*)(gl + 4) = v1;
                    } }
        } else if (pn == 5 || pn == 6) {
            bf16* dst = (bf16*)(R + RO_BK); const int cb = (pn - 5) * 256 + c0;
            store_half<0, true>(acc, 0, dst, 512, cb, u, wr, fr); store_half<0, true>(acc, 1, dst, 512, cb + 128, u, wr, fr);
        } else if (pn == 13 || pn == 14) {
            bf16* dst = (bf16*)(R + RO_CR); const int cb = (pn - 13) * 256 + c0;
            store_half<1, false>(acc, 0, dst, 512, cb, u, wr, fr); store_half<1, false>(acc, 1, dst, 512, cb + 128, u, wr, fr);
        } else if (pn == 2) {
            store_half<0, false>(acc, 0, (bf16*)(R + RO_AK), 128, c0, u, wr, fr); store_half<0, false>(acc, 1, (bf16*)(R + RO_AV), 128, c0, u, wr, fr);
        } else {
            bf16* dst; int ldc, cb;
            if (pn < 2)        { dst = (bf16*)(R + RO_AQ); ldc = 512; cb = pn * 256; }
            else if (pn < 5)   { dst = (bf16*)(R + RO_BQ); ldc = 512; cb = (pn - 3) * 256; }
            else if (pn < 9)   { dst = (bf16*)(R + RO_BV); ldc = 512; cb = (pn - 7) * 256; }
            else if (pn == 9)  { dst = (bf16*)(R + RO_CQ); ldc = 256; cb = 0; }
            else if (pn == 10) { dst = (bf16*)(R + RO_CK); ldc = 256; cb = 0; }
            else               { dst = (bf16*)(R + RO_CV); ldc = 512; cb = (pn - 11) * 256; }
            store_half<0, false>(acc, 0, dst, ldc, cb + c0, u, wr, fr); store_half<0, false>(acc, 1, dst, ldc, cb + c0 + 128, u, wr, fr);
        }
    }
};
struct EpiGates {
    static constexpr bool PERM = true;
    bf16* G; const float* ssq;
    __device__ __forceinline__ void operator()(Acc acc, const Unit& u, int wr, int wc, int fr, int fq) const {
#pragma unroll
        for (int ai = 0; ai < 2; ++ai)
#pragma unroll
            for (int m = 0; m < 4; ++m) {
                const int row = u.pm * 256 + ai * 128 + wr * 64 + m * 16 + fr; const float rs = row_rs(ssq, row);
#pragma unroll
                for (int bj = 0; bj < 2; ++bj) { f32x4 v0 = acc[ai][bj][m][0] * rs, v1 = acc[ai][bj][m][1] * rs;
#pragma unroll
                    for (int i = 0; i < 4; ++i) { v0[i] = sigmoidf_(v0[i]); v1[i] = sigmoidf_(v1[i]); }
                    *(u32x4*)(G + (size_t)row * NGATES + u.pn * 256 + bj * 128 + wc * 32 + 8 * fq) = pack8(v0, v1); }
            }
    }
};
struct EpiBranch {
    static constexpr bool PERM = true;
    const bf16* G; bf16* Y;
    __device__ __forceinline__ void operator()(Acc acc, const Unit& u, int wr, int wc, int fr, int fq) const {
        const int seg = u.aux;
#pragma unroll
        for (int ai = 0; ai < 2; ++ai)
#pragma unroll
            for (int m = 0; m < 4; ++m) {
                const int row = u.pm * 256 + ai * 128 + wr * 64 + m * 16 + fr;
#pragma unroll
                for (int bj = 0; bj < 2; ++bj) { const int col = u.pn * 256 + bj * 128 + wc * 32 + 8 * fq;
                    const u32x4 gw = *(const u32x4*)(G + (size_t)row * NGATES + seg * DM + col); f32x4 g0, g1; unpack8(gw, g0, g1);
                    f32x4 y0 = acc[ai][bj][m][0] * g0, y1 = acc[ai][bj][m][1] * g1;
                    bf16* yp = Y + (size_t)row * DM + col;
                    if (seg > 0) { const u32x4 ow = *(const u32x4*)yp; f32x4 o0, o1; unpack8(ow, o0, o1); y0 += o0; y1 += o1; }
                    *(u32x4*)yp = pack8(y0, y1); }
            }
    }
};
struct EpiResid {
    static constexpr bool PERM = true;
    const float* base; float* out; bf16* XB; float* ssq;
    __device__ __forceinline__ void operator()(Acc acc, const Unit& u, int wr, int wc, int fr, int fq) const {
#pragma unroll
        for (int ai = 0; ai < 2; ++ai)
#pragma unroll
            for (int m = 0; m < 4; ++m) {
                const int row = u.pm * 256 + ai * 128 + wr * 64 + m * 16 + fr; float s = 0.f;
#pragma unroll
                for (int bj = 0; bj < 2; ++bj) { const size_t off = (size_t)row * DM + u.pn * 256 + bj * 128 + wc * 32 + 8 * fq;
                    const f32x4 x0 = *(const f32x4*)(base + off) + acc[ai][bj][m][0], x1 = *(const f32x4*)(base + off + 4) + acc[ai][bj][m][1];
                    *(f32x4*)(out + off) = x0; *(f32x4*)(out + off + 4) = x1;
                    *(u32x4*)(XB + off) = pack8(x0, x1);
                    s += ((x0[0] * x0[0] + x0[1] * x0[1]) + (x0[2] * x0[2] + x0[3] * x0[3])) + ((x1[0] * x1[0] + x1[1] * x1[1]) + (x1[2] * x1[2] + x1[3] * x1[3])); }
                s += __shfl_xor(s, 16); s += __shfl_xor(s, 32);
                if (fq == 0) ssq[(size_t)row * 16 + u.pn * 4 + wc] = s;
            }
    }
};
struct EpiSwiglu {
    static constexpr bool PERM = true;
    bf16* H; int ldh; const float* ssq; const float* rsg;
    __device__ __forceinline__ void operator()(Acc acc, const Unit& u, int wr, int wc, int fr, int fq) const {
#pragma unroll
        for (int ai = 0; ai < 2; ++ai)
#pragma unroll
            for (int m = 0; m < 4; ++m) {
                const int row = u.pm * 256 + ai * 128 + wr * 64 + m * 16 + fr; const float rs = rsg ? rsg[row] : row_rs(ssq, row);
                f32x4 g0 = acc[ai][0][m][0] * rs, g1 = acc[ai][0][m][1] * rs; const f32x4 u0 = acc[ai][1][m][0] * rs, u1 = acc[ai][1][m][1] * rs;
#pragma unroll
                for (int i = 0; i < 4; ++i) { g0[i] = siluf_(g0[i]) * u0[i]; g1[i] = siluf_(g1[i]) * u1[i]; }
                *(u32x4*)(H + (size_t)row * ldh + u.aux * 128 + wc * 32 + 8 * fq) = pack8(g0, g1);
            }
    }
};
struct EpiMoeDown {
    static constexpr bool PERM = true;
    bf16* YE; const float* pw;
    __device__ __forceinline__ void operator()(Acc acc, const Unit& u, int wr, int wc, int fr, int fq) const {
#pragma unroll
        for (int ai = 0; ai < 2; ++ai)
#pragma unroll
            for (int m = 0; m < 4; ++m) {
                const int row = u.pm * 256 + ai * 128 + wr * 64 + m * 16 + fr; const float p = pw[row];
#pragma unroll
                for (int bj = 0; bj < 2; ++bj) *(u32x4*)(YE + (size_t)row * DM + u.pn * 256 + bj * 128 + wc * 32 + 8 * fq) = pack8(acc[ai][bj][m][0] * p, acc[ai][bj][m][1] * p);
            }
    }
};
}
__device__ __forceinline__ float rdl(float v, int l) { return __builtin_bit_cast(float, __builtin_amdgcn_readlane(__builtin_bit_cast(int, v), l)); }
__device__ __forceinline__ float qdot64(float q, const bf16* p) {
    const GAS v4u* kp = (const GAS v4u*)p; float s = 0.f;
#pragma unroll
    for (int c = 0; c < 8; ++c) { const v4u w = kp[c];
        s += rdl(q, 8 * c + 0) * bflo(w.x) + rdl(q, 8 * c + 1) * bfhi(w.x) + rdl(q, 8 * c + 2) * bflo(w.y) + rdl(q, 8 * c + 3) * bfhi(w.y)
           + rdl(q, 8 * c + 4) * bflo(w.z) + rdl(q, 8 * c + 5) * bfhi(w.z) + rdl(q, 8 * c + 6) * bflo(w.w) + rdl(q, 8 * c + 7) * bfhi(w.w); }
    return s;
}
__device__ __forceinline__ float pv64(float o, float p, const bf16* V, size_t row0, int ldv, int vcol, int lane) {
#pragma unroll 16
    for (int j = 0; j < 64; ++j) o += rdl(p, j) * bf2f(V[(row0 + j) * ldv + vcol + lane]);
    return o;
}

__device__ __forceinline__ void swa_naive(const Frame& F_in, const Params& P_in, int l, int gw, int NGW) {
    PH_BEGIN
    bf16* AQ = (bf16*)(P.ws + WS_R + RO_AQ); const bf16* AK = (const bf16*)(P.ws + WS_R + RO_AK); const bf16* AV = (const bf16*)(P.ws + WS_R + RO_AV);
    const float* sinks = P.in[I_SINK] + l * 8; const int lane = F.lane;
    for (int item = gw; item < T * 8; item += NGW) {
        const int t = item >> 3, hq = item & 7, hkv = hq >> 2, tl = t & (SEQ - 1); const size_t rb = (size_t)(t - tl);
        const float q = bf2f(AQ[(size_t)t * 512 + hq * 64 + lane]) * 0.125f;
        const int kA = tl - 127 + lane, kB = tl - 63 + lane; const bool vA = kA >= 0, vB = kB >= 0;
        const int kA0 = tl - 127 < 0 ? 0 : tl - 127, kB0 = tl - 63 < 0 ? 0 : tl - 63;
        float sA = qdot64(q, AK + (rb + (vA ? kA : 0)) * 128 + hkv * 64), sB = qdot64(q, AK + (rb + (vB ? kB : 0)) * 128 + hkv * 64);
        sA = vA ? sA : -INFINITY; sB = vB ? sB : -INFINITY;
        const float sink = sinks[hq];
        const float m = fmaxf(wave_max(fmaxf(sA, sB)), sink);
        const float pA = vA ? __expf(sA - m) : 0.f, pB = vB ? __expf(sB - m) : 0.f;
        const float den = wave_sum(pA + pB) + __expf(sink - m);
        float o = 0.f;
        if (tl >= 127) { o = pv64(o, pA, AV, rb + tl - 127, 128, hkv * 64, lane); o = pv64(o, pB, AV, rb + tl - 63, 128, hkv * 64, lane); }
        else {
#pragma unroll 8
            for (int j = 0; j < 64; ++j) { const int ka = tl - 127 + j, kb = tl - 63 + j;
                o += rdl(pA, j) * bf2f(AV[(rb + (ka < 0 ? 0 : ka)) * 128 + hkv * 64 + lane]) + rdl(pB, j) * bf2f(AV[(rb + (kb < 0 ? 0 : kb)) * 128 + hkv * 64 + lane]); }
        }
        (void)kA0; (void)kB0;
        AQ[(size_t)t * 512 + hq * 64 + lane] = (bf16)f2bf(o / den);
    }
}

__device__ __forceinline__ void moba_naive(const Frame& F_in, const Params& P_in, int gw, int NGW) {
    PH_BEGIN
    bf16* BQ = (bf16*)(P.ws + WS_R + RO_BQ); const bf16* BK = (const bf16*)(P.ws + WS_R + RO_BK); const bf16* BV = (const bf16*)(P.ws + WS_R + RO_BV);
    const float* kbp = (const float*)(P.ws + WS_KBP); const int lane = F.lane;
    for (int item = gw; item < T * 8; item += NGW) {
        const int t = item >> 3, h = item & 7, b = t >> 13, tl = t & (SEQ - 1), cur = tl >> 8; const size_t rb = (size_t)b * SEQ;
        const float q = bf2f(BQ[(size_t)t * 512 + h * 64 + lane]);
        float gs = -INFINITY;
        { const int n = lane < cur ? lane : 0; const float* k0 = kbp + ((size_t)(b * 32 + n) * 2) * 512 + h * 64; float s = 0.f;
#pragma unroll 8
          for (int d = 0; d < 64; ++d) s += rdl(q, d) * (k0[d] + k0[512 + d]);
          if (lane < cur) gs = s * (1.0f / 256.0f); }
        const int nsel = cur < 3 ? cur : 3; int s0 = 0, s1 = 0, s2 = 0;
        for (int r = 0; r < nsel; ++r) { const float mx = wave_max(gs); const unsigned long long bal = __ballot(gs == mx); const int j = __ffsll((long long)bal) - 1;
            if (r == 0) s0 = j; else if (r == 1) s1 = j; else s2 = j; if (lane == j) gs = -INFINITY; }
        float m = -INFINITY, lsum = 0.f, o = 0.f; const float qs = q * 0.125f;
        for (int i = 0; i <= nsel; ++i) {
            const bool own = (i == nsel); const int blk = own ? cur : (i == 0 ? s0 : (i == 1 ? s1 : s2));
            for (int tile = 0; tile < 4; ++tile) {
                const int kp0 = blk * 256 + tile * 64; if (own && kp0 > tl) break;
                const int kpos = kp0 + lane; const bool valid = !own || kpos <= tl;
                float s = qdot64(qs, BK + (rb + kpos) * 512 + h * 64); s = valid ? s : -INFINITY;
                const float mn = fmaxf(m, wave_max(s)); const float sc = __expf(m - mn); const float p = valid ? __expf(s - mn) : 0.f;
                lsum = lsum * sc + wave_sum(p); o = pv64(o * sc, p, BV, rb + kp0, 512, h * 64, lane); m = mn;
            }
        }
        BQ[(size_t)t * 512 + h * 64 + lane] = (bf16)f2bf(o / lsum);
    }
}

__device__ __forceinline__ void gla_cumsum(const float* GL, size_t t0, int h, LAS float* bcum, int tid) {
    if (tid < 64) { float run = 0.f;
#pragma unroll 8
        for (int s = 0; s < 64; ++s) { run += GL[(t0 + s) * 256 + h * 64 + tid]; bcum[s * 64 + tid] = run; } }
}
__device__ __forceinline__ void gla_pass1(const Frame& F_in, const Params& P_in) {
    PH_BEGIN
    const float* GL = (const float*)(P.ws + WS_R + RO_GL); const bf16* CK = (const bf16*)(P.ws + WS_R + RO_CK); const bf16* CV = (const bf16*)(P.ws + WS_R + RO_CV);
    float* S = (float*)(P.ws + WS_S); float* DEC = (float*)(P.ws + WS_DEC);
    LAS float* bcum = (LAS float*)(F.lds); LAS float* kd = bcum + 4096; LAS float* vv = kd + 4096; const int tid = F.tid;
    for (int unit = F.vcu; unit < 8 * 128; unit += F.G) {
        const int bh = unit >> 7, n = unit & 127, b = bh >> 2, h = bh & 3; const size_t t0 = (size_t)b * SEQ + n * 64;
        gla_cumsum(GL, t0, h, bcum, tid);
        __syncthreads();
        for (int idx = tid; idx < 4096; idx += 512) { const int s = idx >> 6, d = idx & 63; kd[idx] = bf2f(CK[(t0 + s) * 256 + h * 64 + d]) * __expf(bcum[63 * 64 + d] - bcum[idx]); }
        for (int idx = tid; idx < 8192; idx += 512) { const int s = idx >> 7, e = idx & 127; vv[idx] = bf2f(CV[(t0 + s) * 512 + h * 128 + e]); }
        __syncthreads();
        { const int d = tid >> 3, e0 = (tid & 7) * 16; float a[16];
#pragma unroll
          for (int j = 0; j < 16; ++j) a[j] = 0.f;
          for (int s = 0; s < 64; ++s) { const float kv = kd[s * 64 + d];
#pragma unroll
              for (int j = 0; j < 16; ++j) a[j] += kv * vv[s * 128 + e0 + j]; }
          float* so = S + (((size_t)bh * 128 + n) * 64 + d) * 128 + e0;
#pragma unroll
          for (int j = 0; j < 16; j += 4) *(f32x4*)(so + j) = (f32x4){a[j], a[j + 1], a[j + 2], a[j + 3]};
          if (tid < 64) DEC[((size_t)bh * 128 + n) * 64 + tid] = __expf(bcum[63 * 64 + tid]); }
        __syncthreads();
    }
}
__device__ __forceinline__ void gla_scan(const Frame& F_in, const Params& P_in) {
    PH_BEGIN
    float* S = (float*)(P.ws + WS_S); const float* DEC = (const float*)(P.ws + WS_DEC);
    if (F.tid >= 256) return;
    for (int grp = F.vcu; grp < 256; grp += F.G) {
        const int idx = grp * 256 + F.tid, bh = idx >> 13, d = (idx >> 7) & 63, e = idx & 127;
        float* sp = S + ((size_t)bh * 128 * 64 + d) * 128 + e; const float* dp = DEC + (size_t)bh * 128 * 64 + d; float st = 0.f;
        for (int n0 = 0; n0 < 128; n0 += 8) { float u[8], dc[8];
#pragma unroll
            for (int j = 0; j < 8; ++j) { u[j] = sp[(size_t)(n0 + j) * 8192]; dc[j] = dp[(n0 + j) * 64]; }
#pragma unroll
            for (int j = 0; j < 8; ++j) { sp[(size_t)(n0 + j) * 8192] = st; st = dc[j] * st + u[j]; } }
    }
}
__device__ __forceinline__ void gla_pass3(const Frame& F_in, const Params& P_in, int l) {
    PH_BEGIN
    const float* GL = (const float*)(P.ws + WS_R + RO_GL); const bf16* CQ = (const bf16*)(P.ws + WS_R + RO_CQ); const bf16* CK = (const bf16*)(P.ws + WS_R + RO_CK); const bf16* CV = (const bf16*)(P.ws + WS_R + RO_CV);
    bf16* CR = (bf16*)(P.ws + WS_R + RO_CR); const float* S = (const float*)(P.ws + WS_S); const float* gng = P.in[I_GNG] + l * 512;
    LAS float* bcum = (LAS float*)(F.lds); LAS float* qin = bcum + 4096; LAS float* kin = qin + 4096; LAS float* am = kin + 4096; LAS float* vv = am + 4096; LAS float* sp = vv + 8192; const int tid = F.tid;
    for (int unit = F.vcu; unit < 8 * 128; unit += F.G) {
        const int bh = unit >> 7, n = unit & 127, b = bh >> 2, h = bh & 3; const size_t t0 = (size_t)b * SEQ + n * 64;
        gla_cumsum(GL, t0, h, bcum, tid);
        __syncthreads();
        for (int idx = tid; idx < 4096; idx += 512) { const int s = idx >> 6, d = idx & 63; const float bb = bcum[idx];
            qin[idx] = bf2f(CQ[(t0 + s) * 256 + h * 64 + d]) * 0.125f * __expf(bb); kin[idx] = bf2f(CK[(t0 + s) * 256 + h * 64 + d]) * __expf(-bb); }
        for (int idx = tid; idx < 8192; idx += 512) { const int s = idx >> 7, e = idx & 127; vv[idx] = bf2f(CV[(t0 + s) * 512 + h * 128 + e]); sp[idx] = S[(((size_t)bh * 128 + n) * 64) * 128 + idx]; }
        __syncthreads();
        for (int idx = tid; idx < 4096; idx += 512) { const int tt = idx >> 6, s = idx & 63; float a = 0.f;
            if (s <= tt) {
#pragma unroll 8
                for (int d = 0; d < 64; ++d) a += qin[tt * 64 + d] * kin[s * 64 + d]; }
            am[idx] = a; }
        __syncthreads();
        { const int tt = tid >> 3, e0 = (tid & 7) * 16; float o[16];
#pragma unroll
          for (int j = 0; j < 16; ++j) o[j] = 0.f;
          for (int s = 0; s <= tt; ++s) { const float a = am[tt * 64 + s];
#pragma unroll
              for (int j = 0; j < 16; ++j) o[j] += a * vv[s * 128 + e0 + j]; }
          for (int d = 0; d < 64; ++d) { const float qv = qin[tt * 64 + d];
#pragma unroll
              for (int j = 0; j < 16; ++j) o[j] += qv * sp[d * 128 + e0 + j]; }
          float ms = 0.f;
#pragma unroll
          for (int j = 0; j < 16; ++j) ms += o[j] * o[j];
          ms += __shfl_xor(ms, 1); ms += __shfl_xor(ms, 2); ms += __shfl_xor(ms, 4);
          const float rinv = 1.0f / sqrtf(ms * (1.0f / 128.0f) + RMS_EPS);
          bf16* crp = CR + (t0 + tt) * 512 + h * 128 + e0;
#pragma unroll
          for (int j = 0; j < 16; ++j) crp[j] = (bf16)f2bf(o[j] * rinv * gng[h * 128 + e0 + j] * bf2f(crp[j])); }
        __syncthreads();
    }
}
constexpr int TAB_OFF = LDSCTL_OFF + 1024;
__device__ __forceinline__ void route_r1(const Frame& F_in, const Params& P_in) {
    PH_BEGIN
    const float* Wr = P.in[I_RT]; const float* n2g = P.in[I_N2G] + 1 * DM;
    int* TOKE = (int*)(P.ws + WS_TOKE); float* TOKP = (float*)(P.ws + WS_TOKP); float* RS2 = (float*)(P.ws + WS_RS2); int* CNT = (int*)(P.ws + WS_CNT);
    LAS float* wrs = (LAS float*)(F.lds); LAS int* cnt_s = (LAS int*)(F.lds + 32768); const int tid = F.tid, lane = F.lane;
    for (int idx = tid; idx < 8192; idx += 512) wrs[idx] = Wr[idx] * n2g[idx >> 3];
    for (int tile = F.vcu; tile < T / 64; tile += F.G) {
        if (tid < 8) cnt_s[tid] = 0;
        __syncthreads();
        for (int i = 0; i < 8; ++i) {
            const int t = tile * 64 + F.wave * 8 + i;
            const GAS f32x4* xr = (const GAS f32x4*)(P.out + (size_t)t * DM) + lane;
            float s = 0.f, lg0 = 0.f, lg1 = 0.f, lg2 = 0.f, lg3 = 0.f, lg4 = 0.f, lg5 = 0.f, lg6 = 0.f, lg7 = 0.f;
#pragma unroll
            for (int j = 0; j < 4; ++j) { const f32x4 v = xr[64 * j]; s += (v.x * v.x + v.y * v.y) + (v.z * v.z + v.w * v.w);
#pragma unroll
                for (int c = 0; c < 4; ++c) { const LAS float* w = wrs + (256 * j + 4 * lane + c) * 8; const float xv = v[c];
                    lg0 += xv * w[0]; lg1 += xv * w[1]; lg2 += xv * w[2]; lg3 += xv * w[3]; lg4 += xv * w[4]; lg5 += xv * w[5]; lg6 += xv * w[6]; lg7 += xv * w[7]; } }
            s = wave_sum(s); lg0 = wave_sum(lg0); lg1 = wave_sum(lg1); lg2 = wave_sum(lg2); lg3 = wave_sum(lg3); lg4 = wave_sum(lg4); lg5 = wave_sum(lg5); lg6 = wave_sum(lg6); lg7 = wave_sum(lg7);
            const float r = 1.0f / sqrtf(s * (1.0f / DM) + RMS_EPS);
            int i1 = 0; float v1 = lg0;
            if (lg1 > v1) { v1 = lg1; i1 = 1; } if (lg2 > v1) { v1 = lg2; i1 = 2; } if (lg3 > v1) { v1 = lg3; i1 = 3; } if (lg4 > v1) { v1 = lg4; i1 = 4; }
            if (lg5 > v1) { v1 = lg5; i1 = 5; } if (lg6 > v1) { v1 = lg6; i1 = 6; } if (lg7 > v1) { v1 = lg7; i1 = 7; }
            int i2 = -1; float v2 = -INFINITY;
            if (i1 != 0 && lg0 > v2) { v2 = lg0; i2 = 0; } if (i1 != 1 && lg1 > v2) { v2 = lg1; i2 = 1; } if (i1 != 2 && lg2 > v2) { v2 = lg2; i2 = 2; } if (i1 != 3 && lg3 > v2) { v2 = lg3; i2 = 3; }
            if (i1 != 4 && lg4 > v2) { v2 = lg4; i2 = 4; } if (i1 != 5 && lg5 > v2) { v2 = lg5; i2 = 5; } if (i1 != 6 && lg6 > v2) { v2 = lg6; i2 = 6; } if (i1 != 7 && lg7 > v2) { v2 = lg7; i2 = 7; }
            const float p1 = 1.0f / (1.0f + __expf((v2 - v1) * r)), p2 = 1.0f - p1;
            if (lane == 0) { TOKE[t * 2] = i1; TOKE[t * 2 + 1] = i2; TOKP[t * 2] = p1; TOKP[t * 2 + 1] = p2; RS2[t] = r; atomicAdd((int*)&cnt_s[i1], 1); atomicAdd((int*)&cnt_s[i2], 1); }
        }
        __syncthreads();
        if (tid < 8) CNT[tile * 8 + tid] = cnt_s[tid];
        __syncthreads();
    }
}
__device__ __forceinline__ void moe_tables(const Frame& F_in, const Params& P_in, int tile) {
    PH_BEGIN
    const int* CNT = (const int*)(P.ws + WS_CNT); volatile LAS int* TAB = (volatile LAS int*)(F.lds + TAB_OFF); const int tid = F.tid;
    if (tid < 8) { int tot = 0, before = 0;
        for (int w = 0; w < T / 64; ++w) { const int c = CNT[w * 8 + tid]; if (w < tile) before += c; tot += c; }
        TAB[32 + tid] = tot; TAB[40 + tid] = before; }
    __syncthreads();
    if (tid == 0) { int mt = 0; for (int e = 0; e < 8; ++e) { TAB[e] = mt; TAB[16 + e] = mt * 256 + TAB[40 + e]; mt += (TAB[32 + e] + 255) >> 8; } TAB[8] = mt; }
    __syncthreads();
}
__device__ __forceinline__ void route_r2(const Frame& F_in, const Params& P_in) {
    PH_BEGIN
    const int* TOKE = (const int*)(P.ws + WS_TOKE); const float* TOKP = (const float*)(P.ws + WS_TOKP); const float* RS2 = (const float*)(P.ws + WS_RS2);
    int* TOKPOS = (int*)(P.ws + WS_TOKPOS); float* RSG = (float*)(P.ws + WS_RSG); float* PWG = (float*)(P.ws + WS_PWG);
    const bf16* XB = (const bf16*)(P.ws + WS_XB); bf16* XG = (bf16*)(P.ws + WS_XG);
    volatile LAS int* TAB = (volatile LAS int*)(F.lds + TAB_OFF); LAS int* pos_s = (LAS int*)(F.lds); const int tid = F.tid, lane = F.lane;
    for (int tile = F.vcu; tile < T / 64; tile += F.G) {
        moe_tables(F, P, tile);
        if (tid < 8) { int run = TAB[16 + tid];
            for (int i = 0; i < 128; ++i) if (TOKE[tile * 128 + i] == tid) { pos_s[i] = run; ++run; } }
        __syncthreads();
        for (int pr = F.wave * 16; pr < F.wave * 16 + 16; ++pr) {
            const int pos = pos_s[pr], t = tile * 64 + (pr >> 1);
            const GAS v4u* src = (const GAS v4u*)(XB + (size_t)t * DM); GAS v4u* dst = (GAS v4u*)(XG + (size_t)pos * DM);
            dst[lane] = src[lane]; dst[64 + lane] = src[64 + lane];
            if (lane == 0) { RSG[pos] = RS2[t]; PWG[pos] = TOKP[t * 2 + (pr & 1)]; TOKPOS[t * 2 + (pr & 1)] = pos; }
        }
        __syncthreads();
    }
}
struct MoeOrder {
    const char* A; const char* W; size_t wstride; size_t tstep; int nN, G, c; volatile LAS int* TAB;
    __device__ __forceinline__ bool next(int i, pg8::Unit& u) const {
        const int L = i * G + c; const int total = TAB[8] * nN; if (L >= total) return false;
        int e = 0;
#pragma unroll
        for (int k = 1; k < 8; ++k) if (L >= TAB[k] * nN) e = k;
        const int mt0 = TAB[e], mte = TAB[e + 1] - mt0, loc = L - mt0 * nN; const int pml = loc % mte, pn = loc / mte;
        u.pm = mt0 + pml; u.pn = pn; u.aux = pn; u.A = A + (size_t)u.pm * tstep; u.B = W + (size_t)e * wstride + (size_t)pn * tstep; return true;
    }
};
struct BranchOrder {
    const char* OA; const char* OB; const char* OC; const char* W; int G, c;
    __device__ __forceinline__ bool next(int i, pg8::Unit& u) const {
        const int seg = i % 3; int pm, pn; if (!pg8::static_tile(T / 256, DM / 256, G, c, i / 3, pm, pn)) return false;
        u.pm = pm; u.pn = pn; u.aux = seg; const char* o = seg == 0 ? OA : (seg == 1 ? OB : OC);
        u.A = o + (size_t)pm * 256 * 512 * 2; u.B = W + (size_t)seg * DM * 512 * 2 + (size_t)pn * 256 * 512 * 2; return true;
    }
};
template <int l>
__device__ __forceinline__ void layer_body(const Frame& F, const Params& P, const XcdBarrier& bar) {
#define GRID_BAR() xcd_barrier(bar)
    const int gw = F.vcu * NWAVES + F.wave, NGW = F.G * NWAVES;
    LAS unsigned char* ring = F.lds + RING_OFF;
    const int cb = (int)blockIdx.x;
#define WSP(T_, off) ((T_)(ws + (off)))

        { unsigned char* ws = lws(P); pg8::DenseOrder S; S.init(ws + WS_XB, ws + WS_W + WO_IN, T, NMAIN, DM, F.G, cb);
          epi::EpiInproj E{ws + WS_R, WSP(const float*, WS_SSQ), P.in[I_GBG] + l * 256, WSP(float*, WS_KBP)};
          pg8::gemm_phase<epi::EpiInproj, pg8::DenseOrder>(ring, DM, S, E); }
        GRID_BAR();
        swa_naive(F, P, l, gw, NGW);
        moba_naive(F, P, gw, NGW);
        __syncthreads();
        gla_pass1(F, P);
        GRID_BAR();
        gla_scan(F, P);
        GRID_BAR();
        gla_pass3(F, P, l);
        GRID_BAR();
        { unsigned char* ws = lws(P); pg8::DenseOrder S; S.init(ws + WS_XB, ws + WS_W + WO_IN + (size_t)NMAIN * DM * 2, T, NGATES, DM, F.G, cb);
          epi::EpiGates E{WSP(bf16*, WS_GATES), WSP(const float*, WS_SSQ)};
          pg8::gemm_phase<epi::EpiGates, pg8::DenseOrder>(ring, DM, S, E); }
        GRID_BAR();
        { unsigned char* ws = lws(P); BranchOrder S{(const char*)(ws + WS_R + RO_AQ), (const char*)(ws + WS_R + RO_BQ), (const char*)(ws + WS_R + RO_CR), (const char*)(ws + WS_W + WO_BR), F.G, cb};
          epi::EpiBranch E{WSP(const bf16*, WS_GATES), WSP(bf16*, WS_Y)};
          pg8::gemm_phase<epi::EpiBranch, BranchOrder>(ring, 512, S, E); }
        GRID_BAR();
        { unsigned char* ws = lws(P); pg8::DenseOrder S; S.init(ws + WS_Y, ws + WS_W + WO_O, T, DM, DM, F.G, cb);
          epi::EpiResid E{l == 0 ? P.in[I_X] : P.out, P.out, WSP(bf16*, WS_XB), WSP(float*, WS_SSQ)};
          pg8::gemm_phase<epi::EpiResid, pg8::DenseOrder>(ring, DM, S, E); }
        GRID_BAR();
        if constexpr (l == 0) {
            { unsigned char* ws = lws(P); pg8::DenseOrder S; S.init(ws + WS_XB, ws + WS_W + WO_GU, T, 2 * DFF, DM, F.G, cb);
              epi::EpiSwiglu E{(bf16*)(ws + WS_H), DFF, WSP(const float*, WS_SSQ), nullptr};
              pg8::gemm_phase<epi::EpiSwiglu, pg8::DenseOrder>(ring, DM, S, E); }
            GRID_BAR();
            { unsigned char* ws = lws(P); pg8::DenseOrder S; S.init(ws + WS_H, ws + WS_W + WO_D, T, DM, DFF, F.G, cb);
              epi::EpiResid E{P.out, P.out, WSP(bf16*, WS_XB), WSP(float*, WS_SSQ)};
              pg8::gemm_phase<epi::EpiResid, pg8::DenseOrder>(ring, DFF, S, E); }
            convert_layer_weights(F, P, 1, gw, NGW, true);
            GRID_BAR();
        } else {
            route_r1(F, P);
            GRID_BAR();
            route_r2(F, P);
            convert_moe_weights(F, P, gw, NGW);
            GRID_BAR();
            moe_tables(F, P, 0);
            { unsigned char* ws = lws(P); MoeOrder S{(const char*)(ws + WS_XG), (const char*)(ws + WS_WMGU), (size_t)2 * DFE * DM * 2, (size_t)256 * DM * 2, 2 * DFE / 256, F.G, cb, (volatile LAS int*)(F.lds + TAB_OFF)};
              epi::EpiSwiglu E{(bf16*)(ws + WS_HG), DFE, nullptr, (const float*)(ws + WS_RSG)};
              pg8::gemm_phase<epi::EpiSwiglu, MoeOrder>(ring, DM, S, E); }
            GRID_BAR();
            { unsigned char* ws = lws(P); MoeOrder S{(const char*)(ws + WS_HG), (const char*)(ws + WS_WMD), (size_t)DM * DFE * 2, (size_t)256 * DFE * 2, DM / 256, F.G, cb, (volatile LAS int*)(F.lds + TAB_OFF)};
              epi::EpiMoeDown E{(bf16*)(ws + WS_XG), (const float*)(ws + WS_PWG)};
              pg8::gemm_phase<epi::EpiMoeDown, MoeOrder>(ring, DFE, S, E); }
            GRID_BAR();
            final_phase(F, P, gw, NGW, true);
        }
}
__global__ void __launch_bounds__(NWAVES * 64, 2) fwd_kernel(Params P) {
    extern __shared__ __attribute__((aligned(16))) unsigned char lds[];
    Frame F;
    F.lds = (LAS unsigned char*)lds;
    F.MISC = (volatile LAS unsigned*)(F.lds + MISC_OFF);
    F.tid = threadIdx.x; F.lane = F.tid & 63; F.wave = __builtin_amdgcn_readfirstlane(F.tid >> 6);
    F.G = gridDim.x; { const int bx = blockIdx.x; F.vcu = (F.G % 8 == 0) ? (bx % 8) * (F.G / 8) + bx / 8 : bx; }
    F.ctl = (gu32*)(P.ws + WS_CTL);
    for (int u = F.tid; u < (LDS_BYTES - LDSCTL_OFF) / 4; u += NWAVES * 64) ((LAS unsigned*)(F.lds + LDSCTL_OFF))[u] = 0u;
    __syncthreads();
    XcdBarrier bar = xcd_barrier_post((unsigned*)(F.ctl + CW_BAR), F.MISC + 8);
#define GRID_BAR() xcd_barrier(bar)
    const int gw = F.vcu * NWAVES + F.wave, NGW = F.G * NWAVES;
    prep_x(F, P, gw, NGW);
    convert_layer_weights(F, P, 0, gw, NGW, false);
    GRID_BAR();

    layer_body<0>(F, P, bar);
    layer_body<1>(F, P, bar);
}

extern "C" void kernel_launch(void* const* d_in, const int* in_sizes, int n_in, void* d_out, int out_size, void* d_ws, size_t ws_size, hipStream_t stream) {
    static int grid = 0;
    if (grid == 0) {
        if (n_in != 20 || out_size != T * DM || ws_size < WS_END) { fprintf(stderr, "kernel_launch: unexpected shapes n_in %d out %d ws %zu (need %zu)\n", n_in, out_size, ws_size, (size_t)WS_END); grid = -1; return; }
        int dev = 0, cus = 0, per_cu = 0;
        if (hipGetDevice(&dev) != hipSuccess || hipDeviceGetAttribute(&cus, hipDeviceAttributeMultiprocessorCount, dev) != hipSuccess) { grid = -1; return; }
        if (hipFuncSetAttribute((const void*)fwd_kernel, hipFuncAttributeMaxDynamicSharedMemorySize, LDS_BYTES) != hipSuccess) { fprintf(stderr, "kernel_launch: hipFuncSetAttribute failed\n"); grid = -1; return; }
        if (hipOccupancyMaxActiveBlocksPerMultiprocessor(&per_cu, (const void*)fwd_kernel, NWAVES * 64, LDS_BYTES) != hipSuccess || per_cu < 1) { fprintf(stderr, "kernel_launch: occupancy query says %d\n", per_cu); per_cu = 1; }
        (void)hipGetLastError();
        grid = cus;
    }
    if (grid < 0) return;
    if (hipMemsetAsync((char*)d_ws + WS_CTL, 0, CTL_ZERO_BYTES, stream) != hipSuccess) { fprintf(stderr, "kernel_launch: memset failed\n"); return; }
    Params p{};
    for (int i = 0; i < 20; ++i) p.in[i] = (const float*)d_in[i];
    p.out = (float*)d_out; p.ws = (unsigned char*)d_ws;
    void* args[] = {&p};
    hipError_t e = hipLaunchCooperativeKernel((const void*)fwd_kernel, dim3(grid), dim3(NWAVES * 64), args, LDS_BYTES, stream);
    if (e != hipSuccess) fprintf(stderr, "kernel_launch: cooperative launch failed: %s (grid %d)\n", hipGetErrorString(e), grid);
}
```

```cpp
#include <hip/hip_runtime.h>
#include <cstdio>
#include <cstdint>
#include <cmath>

#define GAS __attribute__((address_space(1)))
#define LAS __attribute__((address_space(3)))
typedef unsigned short bf16;
typedef unsigned v4u __attribute__((ext_vector_type(4)));
typedef unsigned v2u __attribute__((ext_vector_type(2)));
typedef float f32x4 __attribute__((ext_vector_type(4)));
typedef GAS unsigned gu32;
#define RLX_AGENT __ATOMIC_RELAXED, __HIP_MEMORY_SCOPE_AGENT
#define LDS_WAIT() asm volatile("s_waitcnt lgkmcnt(0)" ::: "memory")
#define VM_WAIT() asm volatile("s_waitcnt vmcnt(0)" ::: "memory")
__device__ __forceinline__ unsigned f2bf(float f) { unsigned u = __builtin_bit_cast(unsigned, f); return (u + 0x7fffu + ((u >> 16) & 1u)) >> 16; }
__device__ __forceinline__ unsigned pk2(float lo, float hi) { return f2bf(lo) | (f2bf(hi) << 16); }
__device__ __forceinline__ float bf2f(unsigned short b) { return __builtin_bit_cast(float, (unsigned)b << 16); }
__device__ __forceinline__ float bflo(unsigned w) { return __builtin_bit_cast(float, w << 16); }
__device__ __forceinline__ float bfhi(unsigned w) { return __builtin_bit_cast(float, w & 0xffff0000u); }
__device__ __forceinline__ float wave_sum(float v) {
#pragma unroll
    for (int o = 1; o < 64; o <<= 1) v += __shfl_xor(v, o);
    return v;
}
__device__ __forceinline__ float wave_max(float v) {
#pragma unroll
    for (int o = 1; o < 64; o <<= 1) v = fmaxf(v, __shfl_xor(v, o));
    return v;
}

constexpr int NWAVES = 8;
constexpr int BATCH = 2, SEQ = 8192, DM = 1024, T = BATCH * SEQ;
constexpr int IN_TOTAL = 6928, NMAIN = 4096, NGATES = 3072;
constexpr int DFF = 2816, NEXP = 8, DFE = 1408;
constexpr float RMS_EPS = 1e-6f;
constexpr int XG_ROWS = 2 * T + 2048;

constexpr size_t MiB = 1u << 20;
constexpr size_t WS_CTL = 0, CTL_ZERO_BYTES = 1 * MiB;
constexpr size_t WS_SSQ = 1 * MiB;
constexpr size_t WS_KBP = 2 * MiB;
constexpr size_t WS_DEC = 2 * MiB + 256 * 1024;
constexpr size_t WS_TOKE = 2 * MiB + 512 * 1024;
constexpr size_t WS_TOKP = WS_TOKE + 128 * 1024;
constexpr size_t WS_TOKPOS = WS_TOKP + 128 * 1024;
constexpr size_t WS_RS2 = WS_TOKPOS + 128 * 1024;
constexpr size_t WS_CNT = WS_RS2 + 64 * 1024;
constexpr size_t WS_RSG = 3 * MiB;
constexpr size_t WS_PWG = 3 * MiB + 256 * 1024;
constexpr size_t WS_W = 4 * MiB;
constexpr size_t WO_IN = 0, WO_BR = 14 * MiB, WO_O = 17 * MiB, WO_GU = 19 * MiB, WO_D = 30 * MiB;
constexpr size_t WS_XB = 40 * MiB;
constexpr size_t WS_R = 72 * MiB;
constexpr size_t RO_AQ = 0, RO_BQ = 16 * MiB, RO_CR = 32 * MiB, RO_AK = 48 * MiB, RO_AV = 52 * MiB, RO_BK = 56 * MiB, RO_BV = 72 * MiB, RO_CQ = 88 * MiB, RO_CK = 96 * MiB, RO_CV = 104 * MiB, RO_GL = 120 * MiB;
constexpr size_t WS_GATES = WS_R + 48 * MiB;
constexpr size_t WS_S = 208 * MiB;
constexpr size_t WS_Y = 240 * MiB;
constexpr size_t WS_H = WS_R;
constexpr size_t WS_XG = WS_R;
constexpr size_t WS_HG = 140 * MiB;
constexpr size_t WS_WMGU = 234 * MiB;
constexpr size_t WS_WMD = 278 * MiB;
constexpr size_t WS_END = 300 * MiB;
static_assert(WS_HG + (size_t)XG_ROWS * DFE * 2 <= WS_WMGU && WS_XG + (size_t)XG_ROWS * DM * 2 <= WS_HG, "moe map");
static_assert(WS_GATES + (size_t)T * NGATES * 2 <= WS_Y && WS_H + (size_t)T * DFF * 2 <= WS_S, "overlay map");
constexpr int CW_BAR = 4096;

constexpr int RING_OFF = 0, RING_BYTES = 131072;
constexpr int LDSCTL_OFF = RING_BYTES, MISC_OFF = LDSCTL_OFF + 320;
constexpr int LDS_BYTES = 147456;
namespace pg8 {
#define PG8_LAS __attribute__((address_space(3)))
typedef unsigned short bf16_t;
typedef short bf16x8 __attribute__((ext_vector_type(8)));
typedef float f32x4 __attribute__((ext_vector_type(4)));
typedef unsigned u32x4 __attribute__((ext_vector_type(4)));
typedef unsigned u32x2 __attribute__((ext_vector_type(2)));
constexpr int BM = 256, BK = 64, HALF = 128, HTB = HALF * BK * 2  , STAGE_BYTES = 8 * HTB, NXCD = 8, WGM = 8;

__host__ __device__ __forceinline__ int lds_byte(int r, int c) { const int st = (r >> 4) * 2 + (c >> 5), rr = r & 15, cc = c & 31, ob = rr * 64 + cc * 2; return st * 1024 + (ob ^ (((ob >> 9) & 1) << 5)); }
__host__ __device__ __forceinline__ void stage_rc(int b, int& R, int& C) { const int st = b / 1024, sb = b % 1024, swz = sb ^ (((sb >> 9) & 1) << 5); R = (st >> 1) * 16 + swz / 64; C = (st & 1) * 32 + (swz % 64) / 2; }
__host__ __device__ __forceinline__ int perm32(int rho) { const int n = rho >> 4, i = rho & 15; return 8 * (i >> 2) + 4 * n + (i & 3); }

struct Unit { const char* A; const char* B; int pm, pn, aux; };

__device__ __forceinline__ bool static_tile(int nM, int nN, int G, int c, int i, int& pm, int& pn) {
    const int nwg = nM * nN; const long L = (long)i * G + c; if (L >= nwg) return false;
    int wgid = (int)L; { const int q = nwg / NXCD, r = nwg % NXCD, xcd = wgid % NXCD, off = wgid / NXCD; wgid = (xcd < r ? xcd * (q + 1) : r * (q + 1) + (xcd - r) * q) + off; }
    const int nig = WGM * nN, gid = wgid / nig, fm = gid * WGM, gsz = (nM - fm) < WGM ? (nM - fm) : WGM;
    pm = fm + ((wgid % nig) % gsz); pn = (wgid % nig) / gsz; return true;
}
struct DenseOrder {
    const char* A; const char* B; int nM, nN, G, c; size_t tstep;
    __device__ __forceinline__ void init(const void* A_, const void* B_, int M, int N, int K, int G_, int c_) { A = (const char*)A_; B = (const char*)B_; nM = M / BM; nN = N / BM; G = G_; c = c_; tstep = (size_t)BM * K * 2; }
    __device__ __forceinline__ bool next(int i, Unit& u) const { int pm, pn; if (!static_tile(nM, nN, G, c, i, pm, pn)) return false; u.pm = pm; u.pn = pn; u.aux = pn; u.A = A + (size_t)pm * tstep; u.B = B + (size_t)pn * tstep; return true; }
};

__device__ __forceinline__ unsigned cvt_pk_bf16(float lo, float hi) { unsigned r; asm volatile("v_cvt_pk_bf16_f32 %0, %1, %2" : "=v"(r) : "v"(lo), "v"(hi)); return r; }

template <class Epi, class Sched, bool ALIGN_EPI = true>
__device__ __forceinline__ void gemm_phase(PG8_LAS unsigned char* lds, const int K, const Sched& S, const Epi& E) {
    int tid_ = threadIdx.x; asm volatile("" : "+v"(tid_));
    const int tid = tid_, wid = __builtin_amdgcn_readfirstlane(tid >> 6), lane = tid & 63, wr = wid >> 2, wc = wid & 3, fr = lane & 15, fq = lane >> 4;
    const int nt = K / BK;
    unsigned voffA[2], voffB[2];
#pragma unroll
    for (int i = 0; i < 2; ++i) { int R, C; stage_rc(tid * 16 + i * 8192, R, C); const int Rb = Epi::PERM ? ((R & ~31) + perm32(R & 31)) : R;
        voffA[i] = (unsigned)(R * K + C) * 2u; voffB[i] = (unsigned)(Rb * K + C) * 2u; }
    const size_t kstep = (size_t)(BK * 2);
    const size_t hstep = (size_t)HALF * K * 2;
    const unsigned ldsw = (unsigned)wid * 1024u;
    const int aoff = lds_byte(wr * 64 + fr, fq * 8), boff = lds_byte(wc * 32 + fr, fq * 8);
#define PG8_SA(b, h) (((b) * 2 + (h)) * HTB)
#define PG8_SB(b, h) ((4 + (b) * 2 + (h)) * HTB)
#define PG8_STAGE(bufoff, gbase, voff) do { _Pragma("unroll") for (int _i = 0; _i < 2; ++_i) \
        __builtin_amdgcn_global_load_lds((const unsigned*)((const char*)(gbase) + (voff)[_i]), (PG8_LAS unsigned*)(lds + (bufoff) + ldsw + _i * 8192), 16, 0, 0); } while (0)
#define PG8_LDA(dst, b, h) do { _Pragma("unroll") for (int m = 0; m < 4; ++m) _Pragma("unroll") for (int k = 0; k < 2; ++k) dst[m][k] = *(const PG8_LAS bf16x8*)(lds + PG8_SA(b, h) + aoff + m * 2048 + k * 1024); } while (0)
#define PG8_LDB(dst, b, h) do { _Pragma("unroll") for (int n = 0; n < 2; ++n) _Pragma("unroll") for (int k = 0; k < 2; ++k) dst[n][k] = *(const PG8_LAS bf16x8*)(lds + PG8_SB(b, h) + boff + n * 2048 + k * 1024); } while (0)
#define PG8_MMA(ai, bj, At, Bt) do { __builtin_amdgcn_s_setprio(1); _Pragma("unroll") for (int m = 0; m < 4; ++m) _Pragma("unroll") for (int n = 0; n < 2; ++n) _Pragma("unroll") for (int k = 0; k < 2; ++k) \
        acc[ai][bj][m][n] = __builtin_amdgcn_mfma_f32_16x16x32_bf16(Bt[n][k], At[m][k], acc[ai][bj][m][n], 0, 0, 0); __builtin_amdgcn_s_setprio(0); } while (0)
#define PG8_WAIT_V(n) asm volatile("s_waitcnt vmcnt(" #n ")" ::: "memory")
#define PG8_WAIT_L(n) asm volatile("s_waitcnt lgkmcnt(" #n ")" ::: "memory")
#define PG8_BAR __builtin_amdgcn_s_barrier()
#define PG8_SCHED __builtin_amdgcn_sched_barrier(0)
    Unit cur, nxt; int ui = 0;
    if (!S.next(0, cur)) return;
    f32x4 acc[2][2][4][2];
#pragma unroll
    for (int a = 0; a < 2; ++a)
#pragma unroll
        for (int b = 0; b < 2; ++b)
#pragma unroll
            for (int m = 0; m < 4; ++m)
#pragma unroll
                for (int n = 0; n < 2; ++n) acc[a][b][m][n] = (f32x4){0.f, 0.f, 0.f, 0.f};
    bf16x8 At[4][2], B0[2][2], B1[2][2];
    const char* cA = cur.A; const char* cB = cur.B;
    PG8_STAGE(PG8_SB(0, 0), cB, voffB); PG8_STAGE(PG8_SB(0, 1), cB + hstep, voffB); PG8_STAGE(PG8_SA(0, 0), cA, voffA); PG8_STAGE(PG8_SA(0, 1), cA + hstep, voffA);
    if (wr == 1) PG8_BAR;
    PG8_WAIT_V(2); PG8_BAR;
    PG8_STAGE(PG8_SB(1, 0), cB + kstep, voffB); PG8_STAGE(PG8_SA(1, 0), cA + kstep, voffA); PG8_STAGE(PG8_SB(1, 1), cB + hstep + kstep, voffB);
    PG8_WAIT_V(6); PG8_BAR;
    for (;;) {
        const bool has_next = S.next(ui + 1, nxt);
        const char* nA = has_next ? nxt.A : cA; const char* nB = has_next ? nxt.B : cB;
        for (int t = 0; t < nt; t += 2) {
            const bool last = (t == nt - 2);
            const char* a1 = cA + (size_t)(t + 1) * kstep;
            const char* a2 = last ? nA : cA + (size_t)(t + 2) * kstep; const char* b2 = last ? nB : cB + (size_t)(t + 2) * kstep;
            const char* a3 = a2 + kstep; const char* b3 = b2 + kstep;
            PG8_LDB(B0, 0, 0); PG8_LDB(B1, 0, 1); PG8_SCHED; PG8_LDA(At, 0, 0); PG8_STAGE(PG8_SA(1, 1), a1 + hstep, voffA);
            PG8_WAIT_V(8); PG8_WAIT_L(0); PG8_BAR; PG8_MMA(0, 0, At, B0); PG8_MMA(0, 1, At, B1); PG8_BAR; PG8_SCHED;
            PG8_LDA(At, 0, 1); PG8_STAGE(PG8_SB(0, 0), b2, voffB); PG8_STAGE(PG8_SB(0, 1), b2 + hstep, voffB); PG8_STAGE(PG8_SA(0, 0), a2, voffA);
            PG8_WAIT_V(8); PG8_WAIT_L(0); PG8_BAR; PG8_MMA(1, 0, At, B0); PG8_MMA(1, 1, At, B1); PG8_BAR; PG8_SCHED;
            PG8_LDB(B0, 1, 0); PG8_LDB(B1, 1, 1); PG8_SCHED; PG8_LDA(At, 1, 0); PG8_STAGE(PG8_SA(0, 1), a2 + hstep, voffA);
            PG8_WAIT_V(8); PG8_WAIT_L(0); PG8_BAR; PG8_MMA(0, 0, At, B0); PG8_MMA(0, 1, At, B1); PG8_BAR; PG8_SCHED;
            PG8_LDA(At, 1, 1); PG8_STAGE(PG8_SB(1, 0), b3, voffB); PG8_STAGE(PG8_SB(1, 1), b3 + hstep, voffB); PG8_STAGE(PG8_SA(1, 0), a3, voffA);
            PG8_WAIT_V(8); PG8_WAIT_L(0); PG8_BAR; PG8_MMA(1, 0, At, B0); PG8_MMA(1, 1, At, B1); PG8_BAR; PG8_SCHED;
        }
        if constexpr (ALIGN_EPI) { if (wr == 0) PG8_BAR; }
        E(acc, cur, wr, wc, fr, fq);
        if (!has_next) break;
#pragma unroll
        for (int a = 0; a < 2; ++a)
#pragma unroll
            for (int b = 0; b < 2; ++b)
#pragma unroll
                for (int m = 0; m < 4; ++m)
#pragma unroll
                    for (int n = 0; n < 2; ++n) acc[a][b][m][n] = (f32x4){0.f, 0.f, 0.f, 0.f};
        cur = nxt; cA = nA; cB = nB; ++ui;
        if constexpr (ALIGN_EPI) { if (wr == 1) PG8_BAR; }
    }
    PG8_WAIT_V(0);
    if constexpr (!ALIGN_EPI) { if (wr == 0) PG8_BAR; }
    PG8_BAR;
#undef PG8_SA
#undef PG8_SB
#undef PG8_STAGE
#undef PG8_LDA
#undef PG8_LDB
#undef PG8_MMA
#undef PG8_WAIT_V
#undef PG8_WAIT_L
#undef PG8_BAR
#undef PG8_SCHED
}
}
#define XB_TMO      128
#define XB_XCNT(j)  (256  + 64 * (j))
#define XB_XSUB(j)  (1280 + 64 * (j))
#define XB_XGEN(j)  (2304 + 64 * (j))
#define XB_TOP      3328
#define XB_TOPGEN   3392
#define XCD_BAR_WORDS 3456
#define XB_SPIN_CAP (1u << 18)

__device__ __forceinline__ unsigned xb_ld(unsigned* p)              { return __hip_atomic_load(p, __ATOMIC_RELAXED, __HIP_MEMORY_SCOPE_AGENT); }
__device__ __forceinline__ unsigned xb_add(unsigned* p, unsigned v) { return __hip_atomic_fetch_add(p, v, __ATOMIC_RELAXED, __HIP_MEMORY_SCOPE_AGENT); }
__device__ __forceinline__ unsigned xb_xcc_id() { return (unsigned)__builtin_amdgcn_s_getreg((3 << 11) | 20) & 0xFu; }
#define XB_SPIN(cond, bar) do { unsigned _sp = 0; while (cond) { __builtin_amdgcn_s_sleep(1); \
    if ((++_sp & 255u) == 0u) { if (xb_ld(&(bar)[XB_TMO])) break; if (_sp > XB_SPIN_CAP) { atomicAdd(&(bar)[XB_TMO], 1u); break; } } } } while (0)

struct XcdBarrier {
    unsigned* bar; unsigned x;
    volatile LAS unsigned* st;
};

__device__ __forceinline__ XcdBarrier xcd_barrier_post(unsigned* bar, volatile LAS unsigned* st) {
    XcdBarrier b; b.bar = bar; b.x = xb_xcc_id(); b.st = st;
    if (threadIdx.x == 0) (void)xb_add(&bar[XB_XCNT(b.x)], 1u);
    return b;
}
__device__ __forceinline__ void xcd_barrier_complete(unsigned* bar, unsigned x, unsigned& nloc, unsigned& nx) {
    const unsigned G = gridDim.x * gridDim.y * gridDim.z;
    unsigned sum, cnt, mine, sp = 0u;
    for (;;) {
        sum = 0u; cnt = 0u; mine = 0u;
#pragma unroll
        for (unsigned j = 0; j < 16; ++j) { const unsigned c = xb_ld(&bar[XB_XCNT(j)]); sum += c; cnt += (c > 0u) ? 1u : 0u; mine = (j == x) ? c : mine; }
        if (sum == G) break;
        __builtin_amdgcn_s_sleep(1);
        if ((++sp & 255u) == 0u) { if (xb_ld(&bar[XB_TMO])) break; if (sp > XB_SPIN_CAP) { atomicAdd(&bar[XB_TMO], 1u); break; } }
    }
    nloc = mine > 0u ? mine : 1u; nx = cnt > 0u ? cnt : 1u;
}

__device__ __forceinline__ void xcd_barrier(const XcdBarrier& b) {
    asm volatile("s_waitcnt vmcnt(0)" ::: "memory");
    __syncthreads();
    if (threadIdx.x == 0) {
        unsigned* bar = b.bar;
        __builtin_amdgcn_s_waitcnt(0);
        unsigned nloc = b.st[0], nx = b.st[1];
        if (nloc == 0u) { xcd_barrier_complete(bar, b.x, nloc, nx); b.st[0] = nloc; b.st[1] = nx; }
        const unsigned old = xb_add(&bar[XB_XSUB(b.x)], 1u);
        const unsigned gen = old / nloc;
        if (old + 1u == (gen + 1u) * nloc) {
            __builtin_amdgcn_fence(__ATOMIC_RELEASE, "agent");
            asm volatile("s_waitcnt vmcnt(0)" ::: "memory");
            const unsigned og = xb_add(&bar[XB_TOP], 1u);
            const unsigned tg = og / nx;
            if (og + 1u == (tg + 1u) * nx) xb_add(&bar[XB_TOPGEN], 1u);
            else XB_SPIN(xb_ld(&bar[XB_TOPGEN]) == tg, bar);
            __builtin_amdgcn_fence(__ATOMIC_ACQUIRE, "agent");
            xb_add(&bar[XB_XGEN(b.x)], 1u);
            asm volatile("s_waitcnt vmcnt(0)" ::: "memory");
        } else {
            XB_SPIN(xb_ld(&bar[XB_XGEN(b.x)]) == gen, bar);
            __builtin_amdgcn_fence(__ATOMIC_ACQUIRE, "agent");
            asm volatile("s_waitcnt vmcnt(0)" ::: "memory");
        }
    }
    __syncthreads();
}
struct Params { const float* in[20]; float* out; unsigned char* ws; };
enum { I_X = 0, I_N1G, I_WIN, I_SINK, I_GWG, I_GBG, I_GNG, I_WA, I_WB, I_WC, I_WO, I_N2G, I_FG, I_FU, I_FD, I_RT, I_MG, I_MU, I_MD, I_FNG };

struct Frame {
    LAS unsigned char* lds;
    volatile LAS unsigned* MISC;
    gu32* ctl;
    int tid, lane, wave;
    int vcu, G;
};
__device__ __forceinline__ unsigned char* lws(const Params& P) { GAS unsigned char* w = (GAS unsigned char*)P.ws; asm volatile("" : "+s"(w)); return (unsigned char*)w; }
#define PH_BEGIN Frame F = F_in; { int t_ = threadIdx.x; asm volatile("" : "+v"(t_)); F.tid = t_; F.lane = t_ & 63; } Params P = P_in; P.ws = lws(P_in);

template <int MODE>
__device__ __forceinline__ void tr_item(const float* W, int ld, int sc, const float* g, const float* W2, int n0, bf16* dst, int dK, int drow, int k0, LAS float* scr, int lane) {
#pragma unroll 4
    for (int i = 0; i < 32; ++i) { const int kk = 2 * i + (lane >> 5), nn = lane & 31; const float* wr = W + (size_t)(k0 + kk) * ld + sc;
        float v;
        if (MODE == 0) v = wr[n0 + nn];
        else { v = 0.f;
#pragma unroll
            for (int r = 0; r < 16; ++r) v += wr[r] * W2[r * 256 + n0 + nn]; }
        if (g) v *= g[k0 + kk];
        scr[kk * 33 + nn] = v; }
    LDS_WAIT(); asm volatile("" ::: "memory");
    const int c = lane & 7;
#pragma unroll
    for (int j = 0; j < 4; ++j) { const int n = (lane >> 3) + 8 * j; const LAS float* s = scr + (8 * c) * 33 + n;
        v4u o; o.x = pk2(s[0 * 33], s[1 * 33]); o.y = pk2(s[2 * 33], s[3 * 33]); o.z = pk2(s[4 * 33], s[5 * 33]); o.w = pk2(s[6 * 33], s[7 * 33]);
        *(GAS v4u*)(dst + (size_t)(drow + n) * dK + k0 + 8 * c) = o; }
    LDS_WAIT(); asm volatile("" ::: "memory");
}
__device__ __forceinline__ void tr_job(int item, const float* W, int ld, int sc, int K, int N, const float* g, bf16* dst, int drow0, int gu_off, bool gu, LAS float* scr, int lane) {
    const int nblk = N / 32, kb = item / nblk, nb = item % nblk, n0 = 32 * nb;
    const int drow = gu ? (256 * (n0 / 128) + (n0 % 128) + gu_off) : (drow0 + n0);
    tr_item<0>(W, ld, sc, g, nullptr, n0, dst, K, drow, 64 * kb, scr, lane);
}
__device__ __forceinline__ void convert_layer_weights(const Frame& F_in, const Params& P_in, int l, int gw, int NGW, bool skip_ffn_down_region) {
    PH_BEGIN
    LAS float* scr = (LAS float*)(F.lds + RING_OFF + F.wave * 16384);
    unsigned char* ws = P.ws;
    bf16* Win = (bf16*)(ws + WS_W + WO_IN); bf16* Wbr = (bf16*)(ws + WS_W + WO_BR); bf16* Wo = (bf16*)(ws + WS_W + WO_O); bf16* Wgu = (bf16*)(ws + WS_W + WO_GU); bf16* Wd = (bf16*)(ws + WS_W + WO_D);
    const float* win = P.in[I_WIN] + (size_t)l * DM * IN_TOTAL; const float* n1g = P.in[I_N1G] + l * DM; const float* n2g = P.in[I_N2G] + l * DM;
    constexpr int J1 = 16 * (3840 / 32), J2 = 16 * (NGATES / 32), J3 = 16 * (256 / 32), J4 = 8 * (DM / 32), J7 = 16 * (DM / 32), J8 = 16 * (DFF / 32), J10 = (DFF / 64) * (DM / 32);
    const int NIT = J1 + J2 + J3 + 3 * J4 + J7 + ((l == 0) ? (2 * J8 + J10) : 0);
    for (int it = gw; it < NIT; it += NGW) {
        int r = it;
        if (r < J1) { tr_job(r, win, IN_TOTAL, 0, DM, 3840, n1g, Win, 0, 0, false, scr, F.lane); continue; } r -= J1;
        if (r < J2) { tr_job(r, win, IN_TOTAL, 3856, DM, NGATES, n1g, Win, NMAIN, 0, false, scr, F.lane); continue; } r -= J2;
        if (r < J3) { const int kb = r / 8, nb = r % 8; tr_item<1>(win, IN_TOTAL, 3840, n1g, P.in[I_GWG] + (size_t)l * 16 * 256, 32 * nb, Win, DM, 3840 + 32 * nb, 64 * kb, scr, F.lane); continue; } r -= J3;
        if (r < J4) { tr_job(r, P.in[I_WA] + (size_t)l * 512 * DM, DM, 0, 512, DM, nullptr, Wbr, 0, 0, false, scr, F.lane); continue; } r -= J4;
        if (r < J4) { tr_job(r, P.in[I_WB] + (size_t)l * 512 * DM, DM, 0, 512, DM, nullptr, Wbr + (size_t)DM * 512, 0, 0, false, scr, F.lane); continue; } r -= J4;
        if (r < J4) { tr_job(r, P.in[I_WC] + (size_t)l * 512 * DM, DM, 0, 512, DM, nullptr, Wbr + (size_t)2 * DM * 512, 0, 0, false, scr, F.lane); continue; } r -= J4;
        if (r < J7) { tr_job(r, P.in[I_WO] + (size_t)l * DM * DM, DM, 0, DM, DM, nullptr, Wo, 0, 0, false, scr, F.lane); continue; } r -= J7;
        if (r < J8) { tr_job(r, P.in[I_FG], DFF, 0, DM, DFF, n2g, Wgu, 0, 0, true, scr, F.lane); continue; } r -= J8;
        if (r < J8) { tr_job(r, P.in[I_FU], DFF, 0, DM, DFF, n2g, Wgu, 0, 128, true, scr, F.lane); continue; } r -= J8;
        tr_job(r, P.in[I_FD], DM, 0, DFF, DM, nullptr, Wd, 0, 0, false, scr, F.lane);
    }
}
__device__ __forceinline__ void convert_moe_weights(const Frame& F_in, const Params& P_in, int gw, int NGW) {
    PH_BEGIN
    LAS float* scr = (LAS float*)(F.lds + RING_OFF + F.wave * 16384);
    bf16* Wgu = (bf16*)(P.ws + WS_WMGU); bf16* Wd = (bf16*)(P.ws + WS_WMD);
    const float* n2g = P.in[I_N2G] + 1 * DM;
    constexpr int JG = 16 * (DFE / 32), JD = (DFE / 64) * (DM / 32), JE = 2 * JG + JD;
    for (int it = gw; it < NEXP * JE; it += NGW) {
        const int e = it / JE; int r = it % JE;
        if (r < JG) { tr_job(r, P.in[I_MG] + (size_t)e * DM * DFE, DFE, 0, DM, DFE, n2g, Wgu + (size_t)e * 2 * DFE * DM, 0, 0, true, scr, F.lane); continue; } r -= JG;
        if (r < JG) { tr_job(r, P.in[I_MU] + (size_t)e * DM * DFE, DFE, 0, DM, DFE, n2g, Wgu + (size_t)e * 2 * DFE * DM, 0, 128, true, scr, F.lane); continue; } r -= JG;
        tr_job(r, P.in[I_MD] + (size_t)e * DFE * DM, DM, 0, DFE, DM, nullptr, Wd + (size_t)e * DM * DFE, 0, 0, false, scr, F.lane);
    }
}
__device__ __forceinline__ void prep_x(const Frame& F_in, const Params& P_in, int gw, int NGW) {
    PH_BEGIN
    bf16* XB = (bf16*)(P.ws + WS_XB); float* SSQ = (float*)(P.ws + WS_SSQ);
    for (int m = gw; m < T; m += NGW) {
        const GAS f32x4* xr = (const GAS f32x4*)(P.in[I_X] + (size_t)m * DM) + F.lane;
        f32x4 v[4]; float s = 0.f;
#pragma unroll
        for (int j = 0; j < 4; ++j) { v[j] = xr[64 * j]; s += (v[j].x * v[j].x + v[j].y * v[j].y) + (v[j].z * v[j].z + v[j].w * v[j].w); }
        s = wave_sum(s) * (1.f / 16.f);
        GAS unsigned long long* o8 = (GAS unsigned long long*)(XB + (size_t)m * DM) + F.lane;
#pragma unroll
        for (int j = 0; j < 4; ++j) o8[64 * j] = (unsigned long long)pk2(v[j].x, v[j].y) | ((unsigned long long)pk2(v[j].z, v[j].w) << 32);
        if (F.lane < 16) SSQ[(size_t)m * 16 + F.lane] = s;
    }
}
__device__ __forceinline__ void final_phase(const Frame& F_in, const Params& P_in, int gw, int NGW, bool with_moe) {
    PH_BEGIN
    const float* g = P.in[I_FNG]; const bf16* YE = (const bf16*)(P.ws + WS_XG); const int* TOKPOS = (const int*)(P.ws + WS_TOKPOS);
    for (int m = gw; m < T; m += NGW) {
        GAS f32x4* xr = (GAS f32x4*)(P.out + (size_t)m * DM) + F.lane;
        f32x4 v[4]; float s = 0.f;
#pragma unroll
        for (int j = 0; j < 4; ++j) v[j] = xr[64 * j];
        if (with_moe) {
#pragma unroll
            for (int sl = 0; sl < 2; ++sl) { const int pos = TOKPOS[m * 2 + sl]; const GAS v2u* yr = (const GAS v2u*)(YE + (size_t)pos * DM) + F.lane;
#pragma unroll
                for (int j = 0; j < 4; ++j) { const v2u w = yr[64 * j]; v[j].x += bflo(w.x); v[j].y += bfhi(w.x); v[j].z += bflo(w.y); v[j].w += bfhi(w.y); } }
        }
#pragma unroll
        for (int j = 0; j < 4; ++j) s += (v[j].x * v[j].x + v[j].y * v[j].y) + (v[j].z * v[j].z + v[j].w * v[j].w);
        const float r = 1.0f / sqrtf(wave_sum(s) * (1.f / DM) + RMS_EPS);
#pragma unroll
        for (int j = 0; j < 4; ++j) { const f32x4 gg = *((const GAS f32x4*)g + F.lane + 64 * j); xr[64 * j] = (f32x4){v[j].x * r * gg.x, v[j].y * r * gg.y, v[j].z * r * gg.z, v[j].w * r * gg.w}; }
    }
}
#include <hip/hip_bf16.h>
#include <cmath>
namespace attn_body {
using bf16=__hip_bfloat16;
using bf16x8=__attribute__((ext_vector_type(8)))short;
using s16x4=__attribute__((ext_vector_type(4)))short;
using f32x16=__attribute__((ext_vector_type(16)))float;
using u32x4=__attribute__((ext_vector_type(4)))unsigned;
constexpr int D=64;
constexpr int NW=8,QBLK=32,QB=QBLK*NW,KVBLK=64;
__device__ __forceinline__ int crow(int r,int hi){return (r&3)+8*(r>>2)+4*hi;}
#define SBAR() __builtin_amdgcn_sched_barrier(0)
template<bool WIN> __device__ __forceinline__ void amask(f32x16&p0,f32x16&p1,int krel0,int qrel,int hi){
  const float NEG=-INFINITY; const int kb=krel0+4*hi;
  #pragma unroll
  for(int r=0;r<16;++r){const int kv=kb+(r&3)+8*(r>>2);
    if(kv>qrel||(WIN&&kv<=qrel-128))p0[r]=NEG; if(kv+32>qrel||(WIN&&kv+32<=qrel-128))p1[r]=NEG;}
}

constexpr int NSLOT=3, SLOTB=8192;
constexpr int LDS_K=0, LDS_V=NSLOT*SLOTB, LDS_WS=2*NSLOT*SLOTB, LDS_OST=LDS_WS+NW*64*4, LDS_BYTES=LDS_OST+NW*4096;
constexpr float C2=0.125f*1.4426950408889634f;
__device__ __forceinline__ void glds16(const void*gsrc,unsigned lds_dst){unsigned keep;
  asm volatile("s_mov_b32 %0, m0\n\ts_mov_b32 m0, %2\n\ts_nop 0\n\tglobal_load_lds_dwordx4 %1, off\n\ts_mov_b32 m0, %0":"=&s"(keep):"v"(gsrc),"s"(lds_dst):"memory");}
__device__ __forceinline__ float max3f(float a,float b,float c){float r;asm("v_max3_f32 %0, %1, %2, %3":"=v"(r):"v"(a),"v"(b),"v"(c));return r;}
__device__ __forceinline__ float max2f(float a,float b){float r;asm("v_max_f32_e32 %0, %1, %2":"=v"(r):"v"(a),"v"(b));return r;}
__device__ __forceinline__ float fadd_s(float a,float b){float r;asm("v_add_f32_e32 %0, %1, %2":"=v"(r):"v"(a),"v"(b));return r;}
__device__ __forceinline__ float fsub_s(float a,float b){float r;asm("v_sub_f32_e32 %0, %1, %2":"=v"(r):"v"(a),"v"(b));return r;}
typedef float f32x2_t __attribute__((ext_vector_type(2))); typedef __bf16 bf16x2_t __attribute__((ext_vector_type(2)));
__device__ __forceinline__ unsigned cvtpk_s(float lo,float hi){f32x2_t v={lo,hi};bf16x2_t b=__builtin_convertvector(v,bf16x2_t);return __builtin_bit_cast(unsigned,b);}
#define WAIT_BAR(N) asm volatile("s_waitcnt vmcnt(" #N ") lgkmcnt(0)\n\ts_barrier":::"memory")

__device__ __forceinline__ void qkt(f32x16&p0,f32x16&p1,const char*Kslot,const bf16x8*qr,const f32x16&negm,int r32,int hi){
  const char*kb=Kslot+hi*1024+r32*16;
  #pragma unroll
  for(int d0=0;d0<4;++d0){
    const bf16x8 b0=*reinterpret_cast<const bf16x8*>(kb+d0*2048);
    const bf16x8 b1=*reinterpret_cast<const bf16x8*>(kb+d0*2048+512);
    if(d0==0){p0=__builtin_amdgcn_mfma_f32_32x32x16_bf16(b0,qr[0],negm,0,0,0);p1=__builtin_amdgcn_mfma_f32_32x32x16_bf16(b1,qr[0],negm,0,0,0);}
    else{p0=__builtin_amdgcn_mfma_f32_32x32x16_bf16(b0,qr[d0],p0,0,0,0);p1=__builtin_amdgcn_mfma_f32_32x32x16_bf16(b1,qr[d0],p1,0,0,0);}}
}
typedef __attribute__((address_space(3))) const char* lds_cptr;
typedef short v4i16_t __attribute__((ext_vector_type(4)));
__device__ __forceinline__ void kload8(bf16x8*kf,lds_cptr kp){
  kf[0]=*(const __attribute__((address_space(3))) bf16x8*)(kp);      kf[1]=*(const __attribute__((address_space(3))) bf16x8*)(kp+512);
  kf[2]=*(const __attribute__((address_space(3))) bf16x8*)(kp+2048); kf[3]=*(const __attribute__((address_space(3))) bf16x8*)(kp+2560);
  kf[4]=*(const __attribute__((address_space(3))) bf16x8*)(kp+4096); kf[5]=*(const __attribute__((address_space(3))) bf16x8*)(kp+4608);
  kf[6]=*(const __attribute__((address_space(3))) bf16x8*)(kp+6144); kf[7]=*(const __attribute__((address_space(3))) bf16x8*)(kp+6656);
}
__device__ __forceinline__ void kload2(bf16x8*kf,lds_cptr kp,int j){ kf[2*j]=*(const __attribute__((address_space(3))) bf16x8*)(kp+j*2048); kf[2*j+1]=*(const __attribute__((address_space(3))) bf16x8*)(kp+j*2048+512); }
__device__ __forceinline__ s16x4 vtr(lds_cptr p){ return __builtin_bit_cast(s16x4,__builtin_amdgcn_ds_read_tr16_b64_v4i16((__attribute__((address_space(3))) v4i16_t*)p)); }
__device__ __forceinline__ float rowmax(const f32x16&p0,const f32x16&p1){
  float a=max3f(p0[0],p0[1],p1[0]),b=max3f(p0[2],p0[3],p1[1]);a=max3f(a,p1[2],p1[3]);
  #pragma unroll
  for(int r=4;r<16;r+=4){a=max3f(a,p0[r],p0[r+1]);b=max3f(b,p0[r+2],p0[r+3]);a=max3f(a,p1[r],p1[r+1]);b=max3f(b,p1[r+2],p1[r+3]);}
  const float m=max2f(a,b);
  auto rr=__builtin_amdgcn_permlane32_swap(__float_as_uint(m),__float_as_uint(m),false,false);
  return max2f(__uint_as_float(rr[0]),__uint_as_float(rr[1]));
}
__device__ __forceinline__ void pv(f32x16*o,int vb,bf16x8 pa0,bf16x8 pa1,bf16x8 pa2,bf16x8 pa3){
  #pragma unroll
  for(int d0=0;d0<2;++d0){s16x4 lo[4],hi[4];
    #pragma unroll
    for(int ks=0;ks<4;++ks){
      asm volatile("ds_read_b64_tr_b16 %0,%1 offset:%c2":"=&v"(lo[ks]):"v"(vb),"i"(d0*4096+ks*1024):"memory");
      asm volatile("ds_read_b64_tr_b16 %0,%1 offset:%c2":"=&v"(hi[ks]):"v"(vb),"i"(d0*4096+ks*1024+512):"memory");}
    asm volatile("s_waitcnt lgkmcnt(0)":::"memory");SBAR();
    #define PK(k) (bf16x8){lo[k][0],lo[k][1],lo[k][2],lo[k][3],hi[k][0],hi[k][1],hi[k][2],hi[k][3]}
    o[d0]=__builtin_amdgcn_mfma_f32_32x32x16_bf16(pa0,PK(0),o[d0],0,0,0);
    o[d0]=__builtin_amdgcn_mfma_f32_32x32x16_bf16(pa1,PK(1),o[d0],0,0,0);
    o[d0]=__builtin_amdgcn_mfma_f32_32x32x16_bf16(pa2,PK(2),o[d0],0,0,0);
    o[d0]=__builtin_amdgcn_mfma_f32_32x32x16_bf16(pa3,PK(3),o[d0],0,0,0);
    #undef PK
  }
}

#ifndef ATTN_STORE16
#define ATTN_STORE16(p,v) (*(u32x4*)(p)=(v))
#endif
template<int MODE,int THRL> __device__ __forceinline__ void attn_unit(const bf16*Qw0,bf16*Ow0,const int QP,const bf16*__restrict__ Kt0,const bf16*__restrict__ Vt0,const int KP,const int NT,const int koff,const unsigned selmask,const float sinkl2,char*shm){
  int tid_=threadIdx.x; asm volatile("":"+v"(tid_));
  const int tid=tid_,lane=tid&63,r32=lane&31,hi=lane>>5; const int wid=__builtin_amdgcn_readfirstlane(tid>>6);
  const bf16*Qw=Qw0+(long)(wid*QBLK)*QP;
  const bf16*Kh=Kt0,*Vh=Vt0;
  const unsigned lds0=(unsigned)(uintptr_t)shm;
  float*wsf=(float*)(shm+LDS_WS)+wid*64;
  const bf16*ksrc=Kh+(long)lane*KP+wid*8;
  const bf16*vsrc=Vh+(long)(16*(wid&3)+(lane>>2))*KP+(wid>>2)*32+(lane&3)*8;
  const unsigned kdst=lds0+LDS_K+wid*1024, vdst=lds0+LDS_V+wid*1024;
  #define DMA_K(t,slot) glds16(ksrc+(long)(t)*KVBLK*KP,(unsigned)__builtin_amdgcn_readfirstlane(kdst+(slot)))
  #define DMA_V(t,slot) glds16(vsrc+(long)(t)*KVBLK*KP,(unsigned)__builtin_amdgcn_readfirstlane(vdst+(slot)))
  const int vb0=(int)(lds0+LDS_V)+((lane>>4)&1)*32+(lane&3)*8+(4*hi+((lane&15)>>2))*64;
  const char*Kbase=shm+LDS_K; bf16x8 kf[8];
  const lds_cptr shm3=(lds_cptr)shm; const lds_cptr kp0=shm3+LDS_K+hi*1024+r32*16; const lds_cptr vp0=shm3+LDS_V+((lane>>4)&1)*32+(lane&3)*8+(4*hi+((lane&15)>>2))*64;
  DMA_K(0,0);DMA_V(0,0);DMA_K(1,SLOTB);
  bf16x8 qr[4];
  #pragma unroll
  for(int d0=0;d0<4;++d0)qr[d0]=*reinterpret_cast<const bf16x8*>(&Qw[(long)r32*QP+d0*16+hi*8]);
  float mhat=0.f,l_reg=0.f;f32x16 o[2];o[0]=f32x16{};o[1]=f32x16{};f32x16 negm=f32x16{};asm volatile("":"+v"(negm));
  const int qrel=wid*QBLK+r32;
  #define CMASK(P0,P1,t) do{ if(MODE==1){amask<true>(P0,P1,koff+64*(t),qrel,hi);} else {const int jb_=(t)-(NT-4); if(jb_>=0)amask<false>(P0,P1,64*jb_,qrel,hi);} }while(0)
  #define NEGM_SET(t) do{ float c_=-mhat; if(MODE==0){ if((t)<NT-4 && !((selmask>>((t)>>2))&1u)) c_=-INFINITY; } \
      _Pragma("unroll") for(int r=0;r<16;++r)negm[r]=c_; asm volatile("":"+v"(negm)); }while(0)
  bool resc=false;
  #define START(P0,P1) do{ const float rm=rowmax(P0,P1); resc=false; \
    if(__any(rm>(float)THRL)){ const float dl=__builtin_fmaxf(rm,0.f); mhat+=dl; \
      _Pragma("unroll") for(int r=0;r<16;++r){P0[r]-=dl;P1[r]-=dl;} } \
    _Pragma("unroll") for(int r=0;r<16;++r)P0[r]=__builtin_amdgcn_exp2f(P0[r]); }while(0)
  #define RESC() do{ if(resc){ asm volatile("s_waitcnt lgkmcnt(0)":::"memory"); \
      _Pragma("unroll") for(int d_=0;d_<2;++d_) _Pragma("unroll") for(int r=0;r<16;++r)o[d_][r]*=wsf[crow(r,hi)]; } }while(0)
  f32x16 pA0,pA1,pB0,pB1;
  int sl_prev=0,sl_cur=0,sl_next=SLOTB;
  #define ROT() do{sl_prev=sl_cur;sl_cur=sl_next;sl_next=(sl_next==(NSLOT-1)*SLOTB)?0:sl_next+SLOTB;}while(0)
  DMA_K(2,2*SLOTB);
  WAIT_BAR(3);
  NEGM_SET(0);
  qkt(pA0,pA1,Kbase,qr,negm,r32,hi);asm volatile("s_nop 15\n\ts_nop 7":"+v"(pA0),"+v"(pA1));CMASK(pA0,pA1,0);
  START(pA0,pA1);
  _Pragma("unroll") for(int r=0;r<16;++r)pA1[r]=__builtin_amdgcn_exp2f(pA1[r]);
  WAIT_BAR(0);
  DMA_K(3,0);DMA_V(1,SLOTB);
  ROT();
  kload8(kf,kp0+sl_cur);
  WAIT_BAR(2);
  s16x4 vlo[8],vhi[8]; u32x4 pw0,pw1,pw2,pw3;
  #define PKW(P,B) cvtpk_s(P[B],P[B+1])
  #define PAF(k) __builtin_bit_cast(bf16x8,pw##k)
  #define VFR(i) (bf16x8){vlo[i][0],vlo[i][1],vlo[i][2],vlo[i][3],vhi[i][0],vhi[i][1],vhi[i][2],vhi[i][3]}
  #define PIN(x) asm volatile("":"+v"(x))
  #define MX3(a,b,c) __builtin_fmaxf(__builtin_fmaxf((a),(b)),(c))
  #define GAPA(MF,A0,A1,A2,A3,W0,W1,PW) do{ MF; sacc+=A0; sacc+=A1; sacc+=A2; sacc+=A3; PIN(sacc); W0; W1; PIN(PW); SBAR(); }while(0)
  #define EX(v) __builtin_amdgcn_exp2f(v)
  #define GAPB(MF,X,B) do{ MF; X[B]=EX(X[B]); X[B+1]=EX(X[B+1]); X[B+2]=EX(X[B+2]); X[B+3]=EX(X[B+3]); PIN(X); SBAR(); }while(0)
  #define VRD(i) do{ vlo[i]=vtr(vp_+(((i)>>2)*4096+((i)&3)*1024)); vhi[i]=vtr(vp_+(((i)>>2)*4096+((i)&3)*1024+512)); }while(0)
  #define KRD(G,j) do{ if(G){ kload2(kf,kp0+sl_next,j); SBAR(); } }while(0)
  #define STEP(C0,C1,P0,P1,t,GK,GV,GL) do{ NEGM_SET(t); SBAR(); \
    const lds_cptr vp_=vp0+sl_prev; \
    VRD(0); SBAR(); float sacc=(P0[0]+P0[1]); \
    GAPA(C0=__builtin_amdgcn_mfma_f32_32x32x16_bf16(kf[0],qr[0],negm,0,0,0), P0[2],P0[3],P0[4],P0[5],     pw0[0]=PKW(P0,0), pw0[1]=PKW(P0,2), pw0); \
    VRD(4); SBAR(); GAPA(C1=__builtin_amdgcn_mfma_f32_32x32x16_bf16(kf[1],qr[0],negm,0,0,0), P0[6],P0[7],P0[8],P0[9],     pw0[2]=PKW(P0,4), pw0[3]=PKW(P0,6), pw0); \
    VRD(1); SBAR(); GAPA(C0=__builtin_amdgcn_mfma_f32_32x32x16_bf16(kf[2],qr[1],C0,0,0,0),   P0[10],P0[11],P0[12],P0[13], pw1[0]=PKW(P0,8), pw1[1]=PKW(P0,10), pw1); \
    VRD(5); SBAR(); GAPA(C1=__builtin_amdgcn_mfma_f32_32x32x16_bf16(kf[3],qr[1],C1,0,0,0),   P0[14],P0[15],P1[0],P1[1],   pw1[2]=PKW(P0,12),pw1[3]=PKW(P0,14), pw1); \
    VRD(2); SBAR(); GAPA(C0=__builtin_amdgcn_mfma_f32_32x32x16_bf16(kf[4],qr[2],C0,0,0,0),   P1[2],P1[3],P1[4],P1[5],     pw2[0]=PKW(P1,0), pw2[1]=PKW(P1,2), pw2); \
    VRD(6); SBAR(); GAPA(C1=__builtin_amdgcn_mfma_f32_32x32x16_bf16(kf[5],qr[2],C1,0,0,0),   P1[6],P1[7],P1[8],P1[9],     pw2[2]=PKW(P1,4), pw2[3]=PKW(P1,6), pw2); \
    VRD(3); SBAR(); GAPA(C0=__builtin_amdgcn_mfma_f32_32x32x16_bf16(kf[6],qr[3],C0,0,0,0),   P1[10],P1[11],P1[12],P1[13], pw3[0]=PKW(P1,8), pw3[1]=PKW(P1,10), pw3); \
    VRD(7); SBAR(); GAPA(C1=__builtin_amdgcn_mfma_f32_32x32x16_bf16(kf[7],qr[3],C1,0,0,0),   P1[14],P1[15],0.f,0.f,       pw3[2]=PKW(P1,12),pw3[3]=PKW(P1,14), pw3); \
    l_reg+=sacc; \
    if(GK){DMA_K((t)+3,sl_cur);} if(GV){DMA_V((t)+1,sl_next);} \
    CMASK(C0,C1,t); \
    { float a=MX3(C0[0],C0[1],C1[0]),b=MX3(C0[2],C0[3],C1[1]); a=MX3(a,C1[2],C1[3]); \
      _Pragma("unroll") for(int r=4;r<16;r+=4){a=MX3(a,C0[r],C0[r+1]);b=MX3(b,C0[r+2],C0[r+3]);a=MX3(a,C1[r],C1[r+1]);b=MX3(b,C1[r+2],C1[r+3]);} \
      float rm=__builtin_fmaxf(a,b); { auto rr=__builtin_amdgcn_permlane32_swap(__float_as_uint(rm),__float_as_uint(rm),false,false); rm=__builtin_fmaxf(__uint_as_float(rr[0]),__uint_as_float(rr[1])); } \
      resc=false; \
      if(__builtin_expect(__any(rm>(float)THRL),0)){ const float dl=__builtin_fmaxf(rm,0.f); mhat+=dl; \
        _Pragma("unroll") for(int r=0;r<16;++r){C0[r]-=dl;C1[r]-=dl;} \
        const float f=__builtin_amdgcn_exp2f(-dl); l_reg*=f; if(hi==0)wsf[r32]=f; resc=true; } } \
    SBAR(); \
    GAPB(o[0]=__builtin_amdgcn_mfma_f32_32x32x16_bf16(PAF(0),VFR(0),o[0],0,0,0), C0,0); \
    GAPB(o[1]=__builtin_amdgcn_mfma_f32_32x32x16_bf16(PAF(0),VFR(4),o[1],0,0,0), C0,4); \
    KRD(GL,0); GAPB(o[0]=__builtin_amdgcn_mfma_f32_32x32x16_bf16(PAF(1),VFR(1),o[0],0,0,0), C0,8); \
    KRD(GL,1); GAPB(o[1]=__builtin_amdgcn_mfma_f32_32x32x16_bf16(PAF(1),VFR(5),o[1],0,0,0), C0,12); \
    KRD(GL,2); GAPB(o[0]=__builtin_amdgcn_mfma_f32_32x32x16_bf16(PAF(2),VFR(2),o[0],0,0,0), C1,0); \
    KRD(GL,3); GAPB(o[1]=__builtin_amdgcn_mfma_f32_32x32x16_bf16(PAF(2),VFR(6),o[1],0,0,0), C1,4); \
    GAPB(o[0]=__builtin_amdgcn_mfma_f32_32x32x16_bf16(PAF(3),VFR(3),o[0],0,0,0), C1,8); \
    GAPB(o[1]=__builtin_amdgcn_mfma_f32_32x32x16_bf16(PAF(3),VFR(7),o[1],0,0,0), C1,12); \
    }while(0)
  int t=1;
  #undef CMASK
  #define CMASK(P0,P1,t) do{}while(0)
  for(;t+5<NT;t+=2){
    STEP(pB0,pB1,pA0,pA1,t,true,true,true);     WAIT_BAR(2); RESC(); ROT();
    STEP(pA0,pA1,pB0,pB1,t+1,true,true,true);   WAIT_BAR(2); RESC(); ROT();
  }
  #undef CMASK
  #define CMASK(P0,P1,t) do{ if(MODE==1){amask<true>(P0,P1,koff+64*(t),qrel,hi);} else {const int jb_=(t)-(NT-4); if(jb_>=0)amask<false>(P0,P1,64*jb_,qrel,hi);} }while(0)
  #define ENDW(tt) do{ if((tt)+3<NT){WAIT_BAR(2);} else if((tt)+2<NT){WAIT_BAR(1);} else {WAIT_BAR(0);} }while(0)
  for(;t+1<NT;t+=2){
    STEP(pB0,pB1,pA0,pA1,t,(t+3<NT),(t+1<NT),(t+1<NT));       ENDW(t);   RESC(); ROT();
    STEP(pA0,pA1,pB0,pB1,t+1,(t+4<NT),(t+2<NT),(t+2<NT));     ENDW(t+1); RESC(); ROT();
  }
  STEP(pB0,pB1,pA0,pA1,NT-1,false,false,false); RESC();
  { float sacc=pB0[0]+pB0[1]; _Pragma("unroll") for(int r=2;r<16;++r)sacc+=pB0[r]; _Pragma("unroll") for(int r=0;r<16;++r)sacc+=pB1[r]; l_reg+=sacc;
    pw0=(u32x4){PKW(pB0,0),PKW(pB0,2),PKW(pB0,4),PKW(pB0,6)};pw1=(u32x4){PKW(pB0,8),PKW(pB0,10),PKW(pB0,12),PKW(pB0,14)};pw2=(u32x4){PKW(pB1,0),PKW(pB1,2),PKW(pB1,4),PKW(pB1,6)};pw3=(u32x4){PKW(pB1,8),PKW(pB1,10),PKW(pB1,12),PKW(pB1,14)};
    SBAR(); pv(o,vb0+sl_cur,PAF(0),PAF(1),PAF(2),PAF(3)); }
  #undef PKW
  #undef PAF
  #undef VFR
  #undef PIN
  #undef MX3
  #undef GAPA
  #undef GAPB
  #undef EX
  #undef VRD
  #undef KRD
  #undef STEP
  #undef ENDW
  {auto rr=__builtin_amdgcn_permlane32_swap(__float_as_uint(l_reg),__float_as_uint(l_reg),false,false);l_reg=__uint_as_float(rr[0])+__uint_as_float(rr[1]);}
  if(MODE==1)l_reg+=__builtin_amdgcn_exp2f(sinkl2-mhat);
  if(hi==0)wsf[32+r32]=l_reg;asm volatile("s_waitcnt lgkmcnt(0)":::"memory");
  float rli[16];
  #pragma unroll
  for(int r=0;r<16;++r)rli[r]=__builtin_amdgcn_rcpf(wsf[32+crow(r,hi)]);
  bf16*Ow=Ow0+(long)(wid*QBLK)*QP;
  { bf16*stg=(bf16*)(shm+LDS_OST)+wid*2048;
    #pragma unroll
    for(int r=0;r<16;++r){const int orow=crow(r,hi);
      #pragma unroll
      for(int d0=0;d0<2;++d0)stg[orow*64+d0*32+r32]=__float2bfloat16(o[d0][r]*rli[r]);}
    asm volatile("s_waitcnt lgkmcnt(0)":::"memory");
    #pragma unroll
    for(int i=0;i<4;++i){const int row=i*8+(lane>>3),ch=lane&7; const u32x4 v=*(const u32x4*)(stg+row*64+ch*8); ATTN_STORE16(Ow+(long)row*QP+ch*8,v);} }
  asm volatile("s_waitcnt lgkmcnt(0)\n\ts_barrier":::"memory");
  #undef DMA_K
  #undef DMA_V
  #undef CMASK
  #undef START
  #undef NEGM_SET
  #undef RESC
  #undef ROT
}
constexpr int ATTN_LDS_BYTES=LDS_BYTES;
#undef SBAR
#undef WAIT_BAR
}
constexpr float ATT_C2 = 0.125f * 1.4426950408889634f;
__device__ __forceinline__ void swa_phase(const Frame& F_in, const Params& P_in, int l) {
    PH_BEGIN
    bf16* AQ = (bf16*)(P.ws + WS_R + RO_AQ); const bf16* AK = (const bf16*)(P.ws + WS_R + RO_AK); const bf16* AV = (const bf16*)(P.ws + WS_R + RO_AV);
    const float* sinks = P.in[I_SINK] + l * 8; char* shm = (char*)F.lds;
    for (int idx = F.vcu; idx < 256; idx += F.G) {
        const int bh = idx >> 4, s = idx & 15, b = bh >> 3, hq = bh & 7, hkv = hq >> 2; const float sk = sinks[hq] * 1.4426950408889634f;
        for (int i = 0; i < 2; ++i) {
            const int qb = i ? 31 - s : s; const size_t row0 = (size_t)b * SEQ + (size_t)qb * 256; const int koff = qb ? -128 : 0, NT = qb ? 6 : 4;
            attn_body::attn_unit<1, 8>((const attn_body::bf16*)(AQ + row0 * 512 + hq * 64), (attn_body::bf16*)(AQ + row0 * 512 + hq * 64), 512,
                (const attn_body::bf16*)(AK + (size_t)((long)row0 + koff) * 128 + hkv * 64), (const attn_body::bf16*)(AV + (size_t)((long)row0 + koff) * 128 + hkv * 64), 128, NT, koff, 0u, sk, shm);
        }
    }
}
__device__ __forceinline__ void moba_phase(const Frame& F_in, const Params& P_in) {
    PH_BEGIN
    bf16* BQ = (bf16*)(P.ws + WS_R + RO_BQ); const bf16* BK = (const bf16*)(P.ws + WS_R + RO_BK); const bf16* BV = (const bf16*)(P.ws + WS_R + RO_BV);
    const float* kbp = (const float*)(P.ws + WS_KBP); char* shm = (char*)F.lds; const int tid = F.tid;
    LAS float* kb_s = (LAS float*)(F.lds + 98304); LAS unsigned* sel_s = (LAS unsigned*)(F.lds + 98304 + 8192);
    for (int idx = F.vcu; idx < 256; idx += F.G) {
        const int bh = idx >> 4, s = idx & 15, b = bh >> 3, h = bh & 7;
        for (int i = 0; i < 2; ++i) {
            const int qb = i ? s : 31 - s; const size_t row0 = (size_t)b * SEQ + (size_t)qb * 256;
            for (int e = tid; e < qb * 64; e += 512) { const int n = e >> 6, d = e & 63; const float* kp = kbp + ((size_t)(b * 32 + n) * 2) * 512 + h * 64 + d; kb_s[e] = kp[0] + kp[512]; }
            __syncthreads();
            if (tid < 256) {
                const GAS v4u* qp = (const GAS v4u*)(BQ + (row0 + tid) * 512 + h * 64); float q[64];
#pragma unroll
                for (int c = 0; c < 8; ++c) { const v4u w = qp[c]; q[8 * c] = bflo(w.x); q[8 * c + 1] = bfhi(w.x); q[8 * c + 2] = bflo(w.y); q[8 * c + 3] = bfhi(w.y); q[8 * c + 4] = bflo(w.z); q[8 * c + 5] = bfhi(w.z); q[8 * c + 6] = bflo(w.w); q[8 * c + 7] = bfhi(w.w); }
                float v1 = -INFINITY, v2 = -INFINITY, v3 = -INFINITY; int i1 = 0, i2 = 0, i3 = 0;
                for (int n = 0; n < qb; ++n) { const LAS f32x4* kr = (const LAS f32x4*)(kb_s + n * 64); float sc = 0.f;
#pragma unroll
                    for (int c = 0; c < 16; ++c) { const f32x4 kv = kr[c]; sc += (q[4 * c] * kv.x + q[4 * c + 1] * kv.y) + (q[4 * c + 2] * kv.z + q[4 * c + 3] * kv.w); }
                    if (sc > v1) { v3 = v2; i3 = i2; v2 = v1; i2 = i1; v1 = sc; i1 = n; } else if (sc > v2) { v3 = v2; i3 = i2; v2 = sc; i2 = n; } else if (sc > v3) { v3 = sc; i3 = n; } }
                unsigned mask;
                if (qb <= 3) mask = (1u << qb) - 1u; else mask = (1u << i1) | (1u << i2) | (1u << i3);
                sel_s[tid] = mask;
            }
            __syncthreads();
            const unsigned selmask = sel_s[F.wave * 32 + (F.lane & 31)];
            attn_body::attn_unit<0, 8>((const attn_body::bf16*)(BQ + row0 * 512 + h * 64), (attn_body::bf16*)(BQ + row0 * 512 + h * 64), 512,
                (const attn_body::bf16*)(BK + (size_t)b * SEQ * 512 + h * 64), (const attn_body::bf16*)(BV + (size_t)b * SEQ * 512 + h * 64), 512, 4 * (qb + 1), 0, selmask, 0.f, shm);
        }
    }
}
namespace epi {
using pg8::f32x4; using pg8::Unit; using pg8::u32x4; using pg8::cvt_pk_bf16;
typedef const f32x4 (&Acc)[2][2][4][2];
__device__ __forceinline__ float sigmoidf_(float x) { return 1.0f / (1.0f + __expf(-x)); }
__device__ __forceinline__ float siluf_(float x) { return x / (1.0f + __expf(-x)); }
__device__ __forceinline__ float logsigmoidf_(float x) { return fminf(x, 0.f) - log1pf(__expf(-fabsf(x))); }
__device__ __forceinline__ u32x4 pack8(const f32x4& a, const f32x4& b) { u32x4 w; w.x = cvt_pk_bf16(a[0], a[1]); w.y = cvt_pk_bf16(a[2], a[3]); w.z = cvt_pk_bf16(b[0], b[1]); w.w = cvt_pk_bf16(b[2], b[3]); return w; }
__device__ __forceinline__ void unpack8(const u32x4& w, f32x4& a, f32x4& b) { a = (f32x4){bflo(w.x), bfhi(w.x), bflo(w.y), bfhi(w.y)}; b = (f32x4){bflo(w.z), bfhi(w.z), bflo(w.w), bfhi(w.w)}; }
__device__ __forceinline__ float row_rs(const float* ssq, int row) {
    const f32x4* p = (const f32x4*)(ssq + (size_t)row * 16); const f32x4 a = p[0], b = p[1], c = p[2], d = p[3];
    const float s = ((a[0] + a[1]) + (a[2] + a[3])) + ((b[0] + b[1]) + (b[2] + b[3])) + ((c[0] + c[1]) + (c[2] + c[3])) + ((d[0] + d[1]) + (d[2] + d[3]));
    return 1.0f / sqrtf(s * (1.0f / DM) + RMS_EPS);
}

struct EpiInproj {
    static constexpr bool PERM = true;
    unsigned char* R; const float* ssq; const float* gbias; float* kbp;
    template <int ACT, bool KSUM>
    __device__ __forceinline__ void store_half(Acc acc, const int bj, bf16* dst, const int ldc, const int col, const Unit& u, int wr, int fr, const float sc = 1.0f) const {
        f32x4 ks0 = (f32x4){0.f, 0.f, 0.f, 0.f}, ks1 = ks0;
#pragma unroll
        for (int ai = 0; ai < 2; ++ai)
#pragma unroll
            for (int m = 0; m < 4; ++m) {
                const int row = u.pm * 256 + ai * 128 + wr * 64 + m * 16 + fr; const float rs = row_rs(ssq, row) * sc;
                f32x4 v0 = acc[ai][bj][m][0] * rs, v1 = acc[ai][bj][m][1] * rs;
                if (ACT == 1) {
#pragma unroll
                    for (int i = 0; i < 4; ++i) { v0[i] = siluf_(v0[i]); v1[i] = siluf_(v1[i]); }
                }
                if (KSUM) { ks0 += v0; ks1 += v1; }
                *(u32x4*)(dst + (size_t)row * ldc + col) = pack8(v0, v1);
            }
        if (KSUM) {
#pragma unroll
            for (int i = 0; i < 4; ++i) {
#pragma unroll
                for (int o = 1; o < 16; o <<= 1) { ks0[i] += __shfl_xor(ks0[i], o); ks1[i] += __shfl_xor(ks1[i], o); }
            }
            if (fr == 0) { float* kp = kbp + ((size_t)u.pm * 2 + wr) * 512 + col; *(f32x4*)kp = ks0; *(f32x4*)(kp + 4) = ks1; }
        }
    }
    __device__ __forceinline__ void operator()(Acc acc, const Unit& u, int wr, int wc, int fr, int fq) const {
        const int pn = u.pn; const int c0 = wc * 32 + 8 * fq;
        if (pn == 15) {
#pragma unroll
            for (int bj = 0; bj < 2; ++bj) { const int col = bj * 128 + c0; const f32x4 b0 = *(const f32x4*)(gbias + col), b1 = *(const f32x4*)(gbias + col + 4);
#pragma unroll
                for (int ai = 0; ai < 2; ++ai)
#pragma unroll
                    for (int m = 0; m < 4; ++m) {
                        const int row = u.pm * 256 + ai * 128 + wr * 64 + m * 16 + fr; const float rs = row_rs(ssq, row);
                        f32x4 v0 = acc[ai][bj][m][0] * rs + b0, v1 = acc[ai][bj][m][1] * rs + b1;
#pragma unroll
                        for (int i = 0; i < 4; ++i) { v0[i] = logsigmoidf_(v0[i]) * (1.0f / 16.0f); v1[i] = logsigmoidf_(v1[i]) * (1.0f / 16.0f); }
                        float* gl = (float*)(R + RO_GL) + (size_t)row * 256 + col; *(f32x4*)gl = v0; *(f32x4*)(gl + 4) = v1;
                    } }
        } else if (pn == 5 || pn == 6) {
            bf16* dst = (bf16*)(R + RO_BK); const int cb = (pn - 5) * 256 + c0;
            store_half<0, true>(acc, 0, dst, 512, cb, u, wr, fr); store_half<0, true>(acc, 1, dst, 512, cb + 128, u, wr, fr);
        } else if (pn == 13 || pn == 14) {
            bf16* dst = (bf16*)(R + RO_CR); const int cb = (pn - 13) * 256 + c0;
            store_half<1, false>(acc, 0, dst, 512, cb, u, wr, fr); store_half<1, false>(acc, 1, dst, 512, cb + 128, u, wr, fr);
        } else if (pn == 2) {
            store_half<0, false>(acc, 0, (bf16*)(R + RO_AK), 128, c0, u, wr, fr); store_half<0, false>(acc, 1, (bf16*)(R + RO_AV), 128, c0, u, wr, fr);
        } else {
            bf16* dst; int ldc, cb; float sc = 1.0f;
            if (pn < 2)        { dst = (bf16*)(R + RO_AQ); ldc = 512; cb = pn * 256; sc = ATT_C2; }
            else if (pn < 5)   { dst = (bf16*)(R + RO_BQ); ldc = 512; cb = (pn - 3) * 256; sc = ATT_C2; }
            else if (pn < 9)   { dst = (bf16*)(R + RO_BV); ldc = 512; cb = (pn - 7) * 256; }
            else if (pn == 9)  { dst = (bf16*)(R + RO_CQ); ldc = 256; cb = 0; }
            else if (pn == 10) { dst = (bf16*)(R + RO_CK); ldc = 256; cb = 0; }
            else               { dst = (bf16*)(R + RO_CV); ldc = 512; cb = (pn - 11) * 256; }
            store_half<0, false>(acc, 0, dst, ldc, cb + c0, u, wr, fr, sc); store_half<0, false>(acc, 1, dst, ldc, cb + c0 + 128, u, wr, fr, sc);
        }
    }
};
struct EpiGates {
    static constexpr bool PERM = true;
    bf16* G; const float* ssq;
    __device__ __forceinline__ void operator()(Acc acc, const Unit& u, int wr, int wc, int fr, int fq) const {
#pragma unroll
        for (int ai = 0; ai < 2; ++ai)
#pragma unroll
            for (int m = 0; m < 4; ++m) {
                const int row = u.pm * 256 + ai * 128 + wr * 64 + m * 16 + fr; const float rs = row_rs(ssq, row);
#pragma unroll
                for (int bj = 0; bj < 2; ++bj) { f32x4 v0 = acc[ai][bj][m][0] * rs, v1 = acc[ai][bj][m][1] * rs;
#pragma unroll
                    for (int i = 0; i < 4; ++i) { v0[i] = sigmoidf_(v0[i]); v1[i] = sigmoidf_(v1[i]); }
                    *(u32x4*)(G + (size_t)row * NGATES + u.pn * 256 + bj * 128 + wc * 32 + 8 * fq) = pack8(v0, v1); }
            }
    }
};
struct EpiBranch {
    static constexpr bool PERM = true;
    const bf16* G; bf16* Y;
    __device__ __forceinline__ void operator()(Acc acc, const Unit& u, int wr, int wc, int fr, int fq) const {
        const int seg = u.aux;
#pragma unroll
        for (int ai = 0; ai < 2; ++ai)
#pragma unroll
            for (int m = 0; m < 4; ++m) {
                const int row = u.pm * 256 + ai * 128 + wr * 64 + m * 16 + fr;
#pragma unroll
                for (int bj = 0; bj < 2; ++bj) { const int col = u.pn * 256 + bj * 128 + wc * 32 + 8 * fq;
                    const u32x4 gw = *(const u32x4*)(G + (size_t)row * NGATES + seg * DM + col); f32x4 g0, g1; unpack8(gw, g0, g1);
                    f32x4 y0 = acc[ai][bj][m][0] * g0, y1 = acc[ai][bj][m][1] * g1;
                    bf16* yp = Y + (size_t)row * DM + col;
                    if (seg > 0) { const u32x4 ow = *(const u32x4*)yp; f32x4 o0, o1; unpack8(ow, o0, o1); y0 += o0; y1 += o1; }
                    *(u32x4*)yp = pack8(y0, y1); }
            }
    }
};
struct EpiResid {
    static constexpr bool PERM = true;
    const float* base; float* out; bf16* XB; float* ssq;
    __device__ __forceinline__ void operator()(Acc acc, const Unit& u, int wr, int wc, int fr, int fq) const {
#pragma unroll
        for (int ai = 0; ai < 2; ++ai)
#pragma unroll
            for (int m = 0; m < 4; ++m) {
                const int row = u.pm * 256 + ai * 128 + wr * 64 + m * 16 + fr; float s = 0.f;
#pragma unroll
                for (int bj = 0; bj < 2; ++bj) { const size_t off = (size_t)row * DM + u.pn * 256 + bj * 128 + wc * 32 + 8 * fq;
                    const f32x4 x0 = *(const f32x4*)(base + off) + acc[ai][bj][m][0], x1 = *(const f32x4*)(base + off + 4) + acc[ai][bj][m][1];
                    *(f32x4*)(out + off) = x0; *(f32x4*)(out + off + 4) = x1;
                    *(u32x4*)(XB + off) = pack8(x0, x1);
                    s += ((x0[0] * x0[0] + x0[1] * x0[1]) + (x0[2] * x0[2] + x0[3] * x0[3])) + ((x1[0] * x1[0] + x1[1] * x1[1]) + (x1[2] * x1[2] + x1[3] * x1[3])); }
                s += __shfl_xor(s, 16); s += __shfl_xor(s, 32);
                if (fq == 0) ssq[(size_t)row * 16 + u.pn * 4 + wc] = s;
            }
    }
};
struct EpiSwiglu {
    static constexpr bool PERM = true;
    bf16* H; int ldh; const float* ssq; const float* rsg;
    __device__ __forceinline__ void operator()(Acc acc, const Unit& u, int wr, int wc, int fr, int fq) const {
#pragma unroll
        for (int ai = 0; ai < 2; ++ai)
#pragma unroll
            for (int m = 0; m < 4; ++m) {
                const int row = u.pm * 256 + ai * 128 + wr * 64 + m * 16 + fr; const float rs = rsg ? rsg[row] : row_rs(ssq, row);
                f32x4 g0 = acc[ai][0][m][0] * rs, g1 = acc[ai][0][m][1] * rs; const f32x4 u0 = acc[ai][1][m][0] * rs, u1 = acc[ai][1][m][1] * rs;
#pragma unroll
                for (int i = 0; i < 4; ++i) { g0[i] = siluf_(g0[i]) * u0[i]; g1[i] = siluf_(g1[i]) * u1[i]; }
                *(u32x4*)(H + (size_t)row * ldh + u.aux * 128 + wc * 32 + 8 * fq) = pack8(g0, g1);
            }
    }
};
struct EpiMoeDown {
    static constexpr bool PERM = true;
    bf16* YE; const float* pw;
    __device__ __forceinline__ void operator()(Acc acc, const Unit& u, int wr, int wc, int fr, int fq) const {
#pragma unroll
        for (int ai = 0; ai < 2; ++ai)
#pragma unroll
            for (int m = 0; m < 4; ++m) {
                const int row = u.pm * 256 + ai * 128 + wr * 64 + m * 16 + fr; const float p = pw[row];
#pragma unroll
                for (int bj = 0; bj < 2; ++bj) *(u32x4*)(YE + (size_t)row * DM + u.pn * 256 + bj * 128 + wc * 32 + 8 * fq) = pack8(acc[ai][bj][m][0] * p, acc[ai][bj][m][1] * p);
            }
    }
};
}
__device__ __forceinline__ float rdl(float v, int l) { return __builtin_bit_cast(float, __builtin_amdgcn_readlane(__builtin_bit_cast(int, v), l)); }
__device__ __forceinline__ float qdot64(float q, const bf16* p) {
    const GAS v4u* kp = (const GAS v4u*)p; float s = 0.f;
#pragma unroll
    for (int c = 0; c < 8; ++c) { const v4u w = kp[c];
        s += rdl(q, 8 * c + 0) * bflo(w.x) + rdl(q, 8 * c + 1) * bfhi(w.x) + rdl(q, 8 * c + 2) * bflo(w.y) + rdl(q, 8 * c + 3) * bfhi(w.y)
           + rdl(q, 8 * c + 4) * bflo(w.z) + rdl(q, 8 * c + 5) * bfhi(w.z) + rdl(q, 8 * c + 6) * bflo(w.w) + rdl(q, 8 * c + 7) * bfhi(w.w); }
    return s;
}
__device__ __forceinline__ float pv64(float o, float p, const bf16* V, size_t row0, int ldv, int vcol, int lane) {
#pragma unroll 16
    for (int j = 0; j < 64; ++j) o += rdl(p, j) * bf2f(V[(row0 + j) * ldv + vcol + lane]);
    return o;
}

__device__ __forceinline__ void swa_naive(const Frame& F_in, const Params& P_in, int l, int gw, int NGW) {
    PH_BEGIN
    bf16* AQ = (bf16*)(P.ws + WS_R + RO_AQ); const bf16* AK = (const bf16*)(P.ws + WS_R + RO_AK); const bf16* AV = (const bf16*)(P.ws + WS_R + RO_AV);
    const float* sinks = P.in[I_SINK] + l * 8; const int lane = F.lane;
    for (int item = gw; item < T * 8; item += NGW) {
        const int t = item >> 3, hq = item & 7, hkv = hq >> 2, tl = t & (SEQ - 1); const size_t rb = (size_t)(t - tl);
        const float q = bf2f(AQ[(size_t)t * 512 + hq * 64 + lane]) * 0.125f;
        const int kA = tl - 127 + lane, kB = tl - 63 + lane; const bool vA = kA >= 0, vB = kB >= 0;
        const int kA0 = tl - 127 < 0 ? 0 : tl - 127, kB0 = tl - 63 < 0 ? 0 : tl - 63;
        float sA = qdot64(q, AK + (rb + (vA ? kA : 0)) * 128 + hkv * 64), sB = qdot64(q, AK + (rb + (vB ? kB : 0)) * 128 + hkv * 64);
        sA = vA ? sA : -INFINITY; sB = vB ? sB : -INFINITY;
        const float sink = sinks[hq];
        const float m = fmaxf(wave_max(fmaxf(sA, sB)), sink);
        const float pA = vA ? __expf(sA - m) : 0.f, pB = vB ? __expf(sB - m) : 0.f;
        const float den = wave_sum(pA + pB) + __expf(sink - m);
        float o = 0.f;
        if (tl >= 127) { o = pv64(o, pA, AV, rb + tl - 127, 128, hkv * 64, lane); o = pv64(o, pB, AV, rb + tl - 63, 128, hkv * 64, lane); }
        else {
#pragma unroll 8
            for (int j = 0; j < 64; ++j) { const int ka = tl - 127 + j, kb = tl - 63 + j;
                o += rdl(pA, j) * bf2f(AV[(rb + (ka < 0 ? 0 : ka)) * 128 + hkv * 64 + lane]) + rdl(pB, j) * bf2f(AV[(rb + (kb < 0 ? 0 : kb)) * 128 + hkv * 64 + lane]); }
        }
        (void)kA0; (void)kB0;
        AQ[(size_t)t * 512 + hq * 64 + lane] = (bf16)f2bf(o / den);
    }
}

__device__ __forceinline__ void moba_naive(const Frame& F_in, const Params& P_in, int gw, int NGW) {
    PH_BEGIN
    bf16* BQ = (bf16*)(P.ws + WS_R + RO_BQ); const bf16* BK = (const bf16*)(P.ws + WS_R + RO_BK); const bf16* BV = (const bf16*)(P.ws + WS_R + RO_BV);
    const float* kbp = (const float*)(P.ws + WS_KBP); const int lane = F.lane;
    for (int item = gw; item < T * 8; item += NGW) {
        const int t = item >> 3, h = item & 7, b = t >> 13, tl = t & (SEQ - 1), cur = tl >> 8; const size_t rb = (size_t)b * SEQ;
        const float q = bf2f(BQ[(size_t)t * 512 + h * 64 + lane]);
        float gs = -INFINITY;
        { const int n = lane < cur ? lane : 0; const float* k0 = kbp + ((size_t)(b * 32 + n) * 2) * 512 + h * 64; float s = 0.f;
#pragma unroll 8
          for (int d = 0; d < 64; ++d) s += rdl(q, d) * (k0[d] + k0[512 + d]);
          if (lane < cur) gs = s * (1.0f / 256.0f); }
        const int nsel = cur < 3 ? cur : 3; int s0 = 0, s1 = 0, s2 = 0;
        for (int r = 0; r < nsel; ++r) { const float mx = wave_max(gs); const unsigned long long bal = __ballot(gs == mx); const int j = __ffsll((long long)bal) - 1;
            if (r == 0) s0 = j; else if (r == 1) s1 = j; else s2 = j; if (lane == j) gs = -INFINITY; }
        float m = -INFINITY, lsum = 0.f, o = 0.f; const float qs = q * 0.125f;
        for (int i = 0; i <= nsel; ++i) {
            const bool own = (i == nsel); const int blk = own ? cur : (i == 0 ? s0 : (i == 1 ? s1 : s2));
            for (int tile = 0; tile < 4; ++tile) {
                const int kp0 = blk * 256 + tile * 64; if (own && kp0 > tl) break;
                const int kpos = kp0 + lane; const bool valid = !own || kpos <= tl;
                float s = qdot64(qs, BK + (rb + kpos) * 512 + h * 64); s = valid ? s : -INFINITY;
                const float mn = fmaxf(m, wave_max(s)); const float sc = __expf(m - mn); const float p = valid ? __expf(s - mn) : 0.f;
                lsum = lsum * sc + wave_sum(p); o = pv64(o * sc, p, BV, rb + kp0, 512, h * 64, lane); m = mn;
            }
        }
        BQ[(size_t)t * 512 + h * 64 + lane] = (bf16)f2bf(o / lsum);
    }
}

__device__ __forceinline__ void gla_cumsum(const float* GL, size_t t0, int h, LAS float* bcum, int tid) {
    if (tid < 64) { float run = 0.f;
#pragma unroll 8
        for (int s = 0; s < 64; ++s) { run += GL[(t0 + s) * 256 + h * 64 + tid]; bcum[s * 64 + tid] = run; } }
}
__device__ __forceinline__ void gla_pass1(const Frame& F_in, const Params& P_in) {
    PH_BEGIN
    const float* GL = (const float*)(P.ws + WS_R + RO_GL); const bf16* CK = (const bf16*)(P.ws + WS_R + RO_CK); const bf16* CV = (const bf16*)(P.ws + WS_R + RO_CV);
    float* S = (float*)(P.ws + WS_S); float* DEC = (float*)(P.ws + WS_DEC);
    LAS float* bcum = (LAS float*)(F.lds); LAS float* kd = bcum + 4096; LAS float* vv = kd + 4096; const int tid = F.tid;
    for (int unit = F.vcu; unit < 8 * 128; unit += F.G) {
        const int bh = unit >> 7, n = unit & 127, b = bh >> 2, h = bh & 3; const size_t t0 = (size_t)b * SEQ + n * 64;
        gla_cumsum(GL, t0, h, bcum, tid);
        __syncthreads();
        for (int idx = tid; idx < 4096; idx += 512) { const int s = idx >> 6, d = idx & 63; kd[idx] = bf2f(CK[(t0 + s) * 256 + h * 64 + d]) * __expf(bcum[63 * 64 + d] - bcum[idx]); }
        for (int idx = tid; idx < 8192; idx += 512) { const int s = idx >> 7, e = idx & 127; vv[idx] = bf2f(CV[(t0 + s) * 512 + h * 128 + e]); }
        __syncthreads();
        { const int d = tid >> 3, e0 = (tid & 7) * 16; float a[16];
#pragma unroll
          for (int j = 0; j < 16; ++j) a[j] = 0.f;
          for (int s = 0; s < 64; ++s) { const float kv = kd[s * 64 + d];
#pragma unroll
              for (int j = 0; j < 16; ++j) a[j] += kv * vv[s * 128 + e0 + j]; }
          float* so = S + (((size_t)bh * 128 + n) * 64 + d) * 128 + e0;
#pragma unroll
          for (int j = 0; j < 16; j += 4) *(f32x4*)(so + j) = (f32x4){a[j], a[j + 1], a[j + 2], a[j + 3]};
          if (tid < 64) DEC[((size_t)bh * 128 + n) * 64 + tid] = __expf(bcum[63 * 64 + tid]); }
        __syncthreads();
    }
}
__device__ __forceinline__ void gla_scan(const Frame& F_in, const Params& P_in) {
    PH_BEGIN
    float* S = (float*)(P.ws + WS_S); const float* DEC = (const float*)(P.ws + WS_DEC);
    if (F.tid >= 256) return;
    for (int grp = F.vcu; grp < 256; grp += F.G) {
        const int idx = grp * 256 + F.tid, bh = idx >> 13, d = (idx >> 7) & 63, e = idx & 127;
        float* sp = S + ((size_t)bh * 128 * 64 + d) * 128 + e; const float* dp = DEC + (size_t)bh * 128 * 64 + d; float st = 0.f;
        for (int n0 = 0; n0 < 128; n0 += 8) { float u[8], dc[8];
#pragma unroll
            for (int j = 0; j < 8; ++j) { u[j] = sp[(size_t)(n0 + j) * 8192]; dc[j] = dp[(n0 + j) * 64]; }
#pragma unroll
            for (int j = 0; j < 8; ++j) { sp[(size_t)(n0 + j) * 8192] = st; st = dc[j] * st + u[j]; } }
    }
}
__device__ __forceinline__ void gla_pass3(const Frame& F_in, const Params& P_in, int l) {
    PH_BEGIN
    const float* GL = (const float*)(P.ws + WS_R + RO_GL); const bf16* CQ = (const bf16*)(P.ws + WS_R + RO_CQ); const bf16* CK = (const bf16*)(P.ws + WS_R + RO_CK); const bf16* CV = (const bf16*)(P.ws + WS_R + RO_CV);
    bf16* CR = (bf16*)(P.ws + WS_R + RO_CR); const float* S = (const float*)(P.ws + WS_S); const float* gng = P.in[I_GNG] + l * 512;
    LAS float* bcum = (LAS float*)(F.lds); LAS float* qin = bcum + 4096; LAS float* kin = qin + 4096; LAS float* am = kin + 4096; LAS float* vv = am + 4096; LAS float* sp = vv + 8192; const int tid = F.tid;
    for (int unit = F.vcu; unit < 8 * 128; unit += F.G) {
        const int bh = unit >> 7, n = unit & 127, b = bh >> 2, h = bh & 3; const size_t t0 = (size_t)b * SEQ + n * 64;
        gla_cumsum(GL, t0, h, bcum, tid);
        __syncthreads();
        for (int idx = tid; idx < 4096; idx += 512) { const int s = idx >> 6, d = idx & 63; const float bb = bcum[idx];
            qin[idx] = bf2f(CQ[(t0 + s) * 256 + h * 64 + d]) * 0.125f * __expf(bb); kin[idx] = bf2f(CK[(t0 + s) * 256 + h * 64 + d]) * __expf(-bb); }
        for (int idx = tid; idx < 8192; idx += 512) { const int s = idx >> 7, e = idx & 127; vv[idx] = bf2f(CV[(t0 + s) * 512 + h * 128 + e]); sp[idx] = S[(((size_t)bh * 128 + n) * 64) * 128 + idx]; }
        __syncthreads();
        for (int idx = tid; idx < 4096; idx += 512) { const int tt = idx >> 6, s = idx & 63; float a = 0.f;
            if (s <= tt) {
#pragma unroll 8
                for (int d = 0; d < 64; ++d) a += qin[tt * 64 + d] * kin[s * 64 + d]; }
            am[idx] = a; }
        __syncthreads();
        { const int tt = tid >> 3, e0 = (tid & 7) * 16; float o[16];
#pragma unroll
          for (int j = 0; j < 16; ++j) o[j] = 0.f;
          for (int s = 0; s <= tt; ++s) { const float a = am[tt * 64 + s];
#pragma unroll
              for (int j = 0; j < 16; ++j) o[j] += a * vv[s * 128 + e0 + j]; }
          for (int d = 0; d < 64; ++d) { const float qv = qin[tt * 64 + d];
#pragma unroll
              for (int j = 0; j < 16; ++j) o[j] += qv * sp[d * 128 + e0 + j]; }
          float ms = 0.f;
#pragma unroll
          for (int j = 0; j < 16; ++j) ms += o[j] * o[j];
          ms += __shfl_xor(ms, 1); ms += __shfl_xor(ms, 2); ms += __shfl_xor(ms, 4);
          const float rinv = 1.0f / sqrtf(ms * (1.0f / 128.0f) + RMS_EPS);
          bf16* crp = CR + (t0 + tt) * 512 + h * 128 + e0;
#pragma unroll
          for (int j = 0; j < 16; ++j) crp[j] = (bf16)f2bf(o[j] * rinv * gng[h * 128 + e0 + j] * bf2f(crp[j])); }
        __syncthreads();
    }
}
constexpr int TAB_OFF = LDSCTL_OFF + 1024;
__device__ __forceinline__ void route_r1(const Frame& F_in, const Params& P_in) {
    PH_BEGIN
    const float* Wr = P.in[I_RT]; const float* n2g = P.in[I_N2G] + 1 * DM;
    int* TOKE = (int*)(P.ws + WS_TOKE); float* TOKP = (float*)(P.ws + WS_TOKP); float* RS2 = (float*)(P.ws + WS_RS2); int* CNT = (int*)(P.ws + WS_CNT);
    LAS float* wrs = (LAS float*)(F.lds); LAS int* cnt_s = (LAS int*)(F.lds + 32768); const int tid = F.tid, lane = F.lane;
    for (int idx = tid; idx < 8192; idx += 512) wrs[idx] = Wr[idx] * n2g[idx >> 3];
    for (int tile = F.vcu; tile < T / 64; tile += F.G) {
        if (tid < 8) cnt_s[tid] = 0;
        __syncthreads();
        for (int i = 0; i < 8; ++i) {
            const int t = tile * 64 + F.wave * 8 + i;
            const GAS f32x4* xr = (const GAS f32x4*)(P.out + (size_t)t * DM) + lane;
            float s = 0.f, lg0 = 0.f, lg1 = 0.f, lg2 = 0.f, lg3 = 0.f, lg4 = 0.f, lg5 = 0.f, lg6 = 0.f, lg7 = 0.f;
#pragma unroll
            for (int j = 0; j < 4; ++j) { const f32x4 v = xr[64 * j]; s += (v.x * v.x + v.y * v.y) + (v.z * v.z + v.w * v.w);
#pragma unroll
                for (int c = 0; c < 4; ++c) { const LAS float* w = wrs + (256 * j + 4 * lane + c) * 8; const float xv = v[c];
                    lg0 += xv * w[0]; lg1 += xv * w[1]; lg2 += xv * w[2]; lg3 += xv * w[3]; lg4 += xv * w[4]; lg5 += xv * w[5]; lg6 += xv * w[6]; lg7 += xv * w[7]; } }
            s = wave_sum(s); lg0 = wave_sum(lg0); lg1 = wave_sum(lg1); lg2 = wave_sum(lg2); lg3 = wave_sum(lg3); lg4 = wave_sum(lg4); lg5 = wave_sum(lg5); lg6 = wave_sum(lg6); lg7 = wave_sum(lg7);
            const float r = 1.0f / sqrtf(s * (1.0f / DM) + RMS_EPS);
            int i1 = 0; float v1 = lg0;
            if (lg1 > v1) { v1 = lg1; i1 = 1; } if (lg2 > v1) { v1 = lg2; i1 = 2; } if (lg3 > v1) { v1 = lg3; i1 = 3; } if (lg4 > v1) { v1 = lg4; i1 = 4; }
            if (lg5 > v1) { v1 = lg5; i1 = 5; } if (lg6 > v1) { v1 = lg6; i1 = 6; } if (lg7 > v1) { v1 = lg7; i1 = 7; }
            int i2 = -1; float v2 = -INFINITY;
            if (i1 != 0 && lg0 > v2) { v2 = lg0; i2 = 0; } if (i1 != 1 && lg1 > v2) { v2 = lg1; i2 = 1; } if (i1 != 2 && lg2 > v2) { v2 = lg2; i2 = 2; } if (i1 != 3 && lg3 > v2) { v2 = lg3; i2 = 3; }
            if (i1 != 4 && lg4 > v2) { v2 = lg4; i2 = 4; } if (i1 != 5 && lg5 > v2) { v2 = lg5; i2 = 5; } if (i1 != 6 && lg6 > v2) { v2 = lg6; i2 = 6; } if (i1 != 7 && lg7 > v2) { v2 = lg7; i2 = 7; }
            const float p1 = 1.0f / (1.0f + __expf((v2 - v1) * r)), p2 = 1.0f - p1;
            if (lane == 0) { TOKE[t * 2] = i1; TOKE[t * 2 + 1] = i2; TOKP[t * 2] = p1; TOKP[t * 2 + 1] = p2; RS2[t] = r; atomicAdd((int*)&cnt_s[i1], 1); atomicAdd((int*)&cnt_s[i2], 1); }
        }
        __syncthreads();
        if (tid < 8) CNT[tile * 8 + tid] = cnt_s[tid];
        __syncthreads();
    }
}
__device__ __forceinline__ void moe_tables(const Frame& F_in, const Params& P_in, int tile) {
    PH_BEGIN
    const int* CNT = (const int*)(P.ws + WS_CNT); volatile LAS int* TAB = (volatile LAS int*)(F.lds + TAB_OFF); const int tid = F.tid;
    if (tid < 8) { int tot = 0, before = 0;
        for (int w = 0; w < T / 64; ++w) { const int c = CNT[w * 8 + tid]; if (w < tile) before += c; tot += c; }
        TAB[32 + tid] = tot; TAB[40 + tid] = before; }
    __syncthreads();
    if (tid == 0) { int mt = 0; for (int e = 0; e < 8; ++e) { TAB[e] = mt; TAB[16 + e] = mt * 256 + TAB[40 + e]; mt += (TAB[32 + e] + 255) >> 8; } TAB[8] = mt; }
    __syncthreads();
}
__device__ __forceinline__ void route_r2(const Frame& F_in, const Params& P_in) {
    PH_BEGIN
    const int* TOKE = (const int*)(P.ws + WS_TOKE); const float* TOKP = (const float*)(P.ws + WS_TOKP); const float* RS2 = (const float*)(P.ws + WS_RS2);
    int* TOKPOS = (int*)(P.ws + WS_TOKPOS); float* RSG = (float*)(P.ws + WS_RSG); float* PWG = (float*)(P.ws + WS_PWG);
    const bf16* XB = (const bf16*)(P.ws + WS_XB); bf16* XG = (bf16*)(P.ws + WS_XG);
    volatile LAS int* TAB = (volatile LAS int*)(F.lds + TAB_OFF); LAS int* pos_s = (LAS int*)(F.lds); const int tid = F.tid, lane = F.lane;
    for (int tile = F.vcu; tile < T / 64; tile += F.G) {
        moe_tables(F, P, tile);
        if (tid < 8) { int run = TAB[16 + tid];
            for (int i = 0; i < 128; ++i) if (TOKE[tile * 128 + i] == tid) { pos_s[i] = run; ++run; } }
        __syncthreads();
        for (int pr = F.wave * 16; pr < F.wave * 16 + 16; ++pr) {
            const int pos = pos_s[pr], t = tile * 64 + (pr >> 1);
            const GAS v4u* src = (const GAS v4u*)(XB + (size_t)t * DM); GAS v4u* dst = (GAS v4u*)(XG + (size_t)pos * DM);
            dst[lane] = src[lane]; dst[64 + lane] = src[64 + lane];
            if (lane == 0) { RSG[pos] = RS2[t]; PWG[pos] = TOKP[t * 2 + (pr & 1)]; TOKPOS[t * 2 + (pr & 1)] = pos; }
        }
        __syncthreads();
    }
}
struct MoeOrder {
    const char* A; const char* W; size_t wstride; size_t tstep; int nN, G, c; volatile LAS int* TAB;
    __device__ __forceinline__ bool next(int i, pg8::Unit& u) const {
        const int L = i * G + c; const int total = TAB[8] * nN; if (L >= total) return false;
        int e = 0;
#pragma unroll
        for (int k = 1; k < 8; ++k) if (L >= TAB[k] * nN) e = k;
        const int mt0 = TAB[e], mte = TAB[e + 1] - mt0, loc = L - mt0 * nN; const int pml = loc % mte, pn = loc / mte;
        u.pm = mt0 + pml; u.pn = pn; u.aux = pn; u.A = A + (size_t)u.pm * tstep; u.B = W + (size_t)e * wstride + (size_t)pn * tstep; return true;
    }
};
struct BranchOrder {
    const char* OA; const char* OB; const char* OC; const char* W; int G, c;
    __device__ __forceinline__ bool next(int i, pg8::Unit& u) const {
        const int seg = i % 3; int pm, pn; if (!pg8::static_tile(T / 256, DM / 256, G, c, i / 3, pm, pn)) return false;
        u.pm = pm; u.pn = pn; u.aux = seg; const char* o = seg == 0 ? OA : (seg == 1 ? OB : OC);
        u.A = o + (size_t)pm * 256 * 512 * 2; u.B = W + (size_t)seg * DM * 512 * 2 + (size_t)pn * 256 * 512 * 2; return true;
    }
};
template <int l>
__device__ __forceinline__ void layer_body(const Frame& F, const Params& P, const XcdBarrier& bar) {
#define GRID_BAR() xcd_barrier(bar)
    const int gw = F.vcu * NWAVES + F.wave, NGW = F.G * NWAVES;
    LAS unsigned char* ring = F.lds + RING_OFF;
    const int cb = (int)blockIdx.x;
#define WSP(T_, off) ((T_)(ws + (off)))

        { unsigned char* ws = lws(P); pg8::DenseOrder S; S.init(ws + WS_XB, ws + WS_W + WO_IN, T, NMAIN, DM, F.G, cb);
          epi::EpiInproj E{ws + WS_R, WSP(const float*, WS_SSQ), P.in[I_GBG] + l * 256, WSP(float*, WS_KBP)};
          pg8::gemm_phase<epi::EpiInproj, pg8::DenseOrder>(ring, DM, S, E); }
        GRID_BAR();
        moba_phase(F, P);
        swa_phase(F, P, l);
        gla_pass1(F, P);
        GRID_BAR();
        gla_scan(F, P);
        GRID_BAR();
        gla_pass3(F, P, l);
        GRID_BAR();
        { unsigned char* ws = lws(P); pg8::DenseOrder S; S.init(ws + WS_XB, ws + WS_W + WO_IN + (size_t)NMAIN * DM * 2, T, NGATES, DM, F.G, cb);
          epi::EpiGates E{WSP(bf16*, WS_GATES), WSP(const float*, WS_SSQ)};
          pg8::gemm_phase<epi::EpiGates, pg8::DenseOrder>(ring, DM, S, E); }
        GRID_BAR();
        { unsigned char* ws = lws(P); BranchOrder S{(const char*)(ws + WS_R + RO_AQ), (const char*)(ws + WS_R + RO_BQ), (const char*)(ws + WS_R + RO_CR), (const char*)(ws + WS_W + WO_BR), F.G, cb};
          epi::EpiBranch E{WSP(const bf16*, WS_GATES), WSP(bf16*, WS_Y)};
          pg8::gemm_phase<epi::EpiBranch, BranchOrder>(ring, 512, S, E); }
        GRID_BAR();
        { unsigned char* ws = lws(P); pg8::DenseOrder S; S.init(ws + WS_Y, ws + WS_W + WO_O, T, DM, DM, F.G, cb);
          epi::EpiResid E{l == 0 ? P.in[I_X] : P.out, P.out, WSP(bf16*, WS_XB), WSP(float*, WS_SSQ)};
          pg8::gemm_phase<epi::EpiResid, pg8::DenseOrder>(ring, DM, S, E); }
        GRID_BAR();
        if constexpr (l == 0) {
            { unsigned char* ws = lws(P); pg8::DenseOrder S; S.init(ws + WS_XB, ws + WS_W + WO_GU, T, 2 * DFF, DM, F.G, cb);
              epi::EpiSwiglu E{(bf16*)(ws + WS_H), DFF, WSP(const float*, WS_SSQ), nullptr};
              pg8::gemm_phase<epi::EpiSwiglu, pg8::DenseOrder>(ring, DM, S, E); }
            GRID_BAR();
            { unsigned char* ws = lws(P); pg8::DenseOrder S; S.init(ws + WS_H, ws + WS_W + WO_D, T, DM, DFF, F.G, cb);
              epi::EpiResid E{P.out, P.out, WSP(bf16*, WS_XB), WSP(float*, WS_SSQ)};
              pg8::gemm_phase<epi::EpiResid, pg8::DenseOrder>(ring, DFF, S, E); }
            convert_layer_weights(F, P, 1, gw, NGW, true);
            GRID_BAR();
        } else {
            route_r1(F, P);
            GRID_BAR();
            route_r2(F, P);
            convert_moe_weights(F, P, gw, NGW);
            GRID_BAR();
            moe_tables(F, P, 0);
            { unsigned char* ws = lws(P); MoeOrder S{(const char*)(ws + WS_XG), (const char*)(ws + WS_WMGU), (size_t)2 * DFE * DM * 2, (size_t)256 * DM * 2, 2 * DFE / 256, F.G, cb, (volatile LAS int*)(F.lds + TAB_OFF)};
              epi::EpiSwiglu E{(bf16*)(ws + WS_HG), DFE, nullptr, (const float*)(ws + WS_RSG)};
              pg8::gemm_phase<epi::EpiSwiglu, MoeOrder>(ring, DM, S, E); }
            GRID_BAR();
            { unsigned char* ws = lws(P); MoeOrder S{(const char*)(ws + WS_HG), (const char*)(ws + WS_WMD), (size_t)DM * DFE * 2, (size_t)256 * DFE * 2, DM / 256, F.G, cb, (volatile LAS int*)(F.lds + TAB_OFF)};
              epi::EpiMoeDown E{(bf16*)(ws + WS_XG), (const float*)(ws + WS_PWG)};
              pg8::gemm_phase<epi::EpiMoeDown, MoeOrder>(ring, DFE, S, E); }
            GRID_BAR();
            final_phase(F, P, gw, NGW, true);
        }
}
__global__ void __launch_bounds__(NWAVES * 64, 2) fwd_kernel(Params P) {
    extern __shared__ __attribute__((aligned(16))) unsigned char lds[];
    Frame F;
    F.lds = (LAS unsigned char*)lds;
    F.MISC = (volatile LAS unsigned*)(F.lds + MISC_OFF);
    F.tid = threadIdx.x; F.lane = F.tid & 63; F.wave = __builtin_amdgcn_readfirstlane(F.tid >> 6);
    F.G = gridDim.x; { const int bx = blockIdx.x; F.vcu = (F.G % 8 == 0) ? (bx % 8) * (F.G / 8) + bx / 8 : bx; }
    F.ctl = (gu32*)(P.ws + WS_CTL);
    for (int u = F.tid; u < (LDS_BYTES - LDSCTL_OFF) / 4; u += NWAVES * 64) ((LAS unsigned*)(F.lds + LDSCTL_OFF))[u] = 0u;
    __syncthreads();
    XcdBarrier bar = xcd_barrier_post((unsigned*)(F.ctl + CW_BAR), F.MISC + 8);
#define GRID_BAR() xcd_barrier(bar)
    const int gw = F.vcu * NWAVES + F.wave, NGW = F.G * NWAVES;
    prep_x(F, P, gw, NGW);
    convert_layer_weights(F, P, 0, gw, NGW, false);
    GRID_BAR();

    layer_body<0>(F, P, bar);
    layer_body<1>(F, P, bar);
}

extern "C" void kernel_launch(void* const* d_in, const int* in_sizes, int n_in, void* d_out, int out_size, void* d_ws, size_t ws_size, hipStream_t stream) {
    static int grid = 0;
    if (grid == 0) {
        if (n_in != 20 || out_size != T * DM || ws_size < WS_END) { fprintf(stderr, "kernel_launch: unexpected shapes n_in %d out %d ws %zu (need %zu)\n", n_in, out_size, ws_size, (size_t)WS_END); grid = -1; return; }
        int dev = 0, cus = 0, per_cu = 0;
        if (hipGetDevice(&dev) != hipSuccess || hipDeviceGetAttribute(&cus, hipDeviceAttributeMultiprocessorCount, dev) != hipSuccess) { grid = -1; return; }
        if (hipFuncSetAttribute((const void*)fwd_kernel, hipFuncAttributeMaxDynamicSharedMemorySize, LDS_BYTES) != hipSuccess) { fprintf(stderr, "kernel_launch: hipFuncSetAttribute failed\n"); grid = -1; return; }
        if (hipOccupancyMaxActiveBlocksPerMultiprocessor(&per_cu, (const void*)fwd_kernel, NWAVES * 64, LDS_BYTES) != hipSuccess || per_cu < 1) { fprintf(stderr, "kernel_launch: occupancy query says %d\n", per_cu); per_cu = 1; }
        (void)hipGetLastError();
        grid = cus;
    }
    if (grid < 0) return;
    if (hipMemsetAsync((char*)d_ws + WS_CTL, 0, CTL_ZERO_BYTES, stream) != hipSuccess) { fprintf(stderr, "kernel_launch: memset failed\n"); return; }
    Params p{};
    for (int i = 0; i < 20; ++i) p.in[i] = (const float*)d_in[i];
    p.out = (float*)d_out; p.ws = (unsigned char*)d_ws;
    void* args[] = {&p};
    hipError_t e = hipLaunchCooperativeKernel((const void*)fwd_kernel, dim3(grid), dim3(NWAVES * 64), args, LDS_BYTES, stream);
    if (e != hipSuccess) fprintf(stderr, "kernel_launch: cooperative launch failed: %s (grid %d)\n", hipGetErrorString(e), grid);
}
```

```cpp
#include <hip/hip_runtime.h>
#include <cstdio>
#include <cstdint>
#include <cmath>

#define GAS __attribute__((address_space(1)))
#define LAS __attribute__((address_space(3)))
typedef unsigned short bf16;
typedef unsigned v4u __attribute__((ext_vector_type(4)));
typedef unsigned v2u __attribute__((ext_vector_type(2)));
typedef float f32x4 __attribute__((ext_vector_type(4)));
typedef GAS unsigned gu32;
#define RLX_AGENT __ATOMIC_RELAXED, __HIP_MEMORY_SCOPE_AGENT
#define LDS_WAIT() asm volatile("s_waitcnt lgkmcnt(0)" ::: "memory")
#define VM_WAIT() asm volatile("s_waitcnt vmcnt(0)" ::: "memory")
__device__ __forceinline__ unsigned f2bf(float f) { unsigned u = __builtin_bit_cast(unsigned, f); return (u + 0x7fffu + ((u >> 16) & 1u)) >> 16; }
__device__ __forceinline__ unsigned pk2(float lo, float hi) { return f2bf(lo) | (f2bf(hi) << 16); }
__device__ __forceinline__ float bf2f(unsigned short b) { return __builtin_bit_cast(float, (unsigned)b << 16); }
__device__ __forceinline__ float bflo(unsigned w) { return __builtin_bit_cast(float, w << 16); }
__device__ __forceinline__ float bfhi(unsigned w) { return __builtin_bit_cast(float, w & 0xffff0000u); }
__device__ __forceinline__ float wave_sum(float v) {
#pragma unroll
    for (int o = 1; o < 64; o <<= 1) v += __shfl_xor(v, o);
    return v;
}
__device__ __forceinline__ float wave_max(float v) {
#pragma unroll
    for (int o = 1; o < 64; o <<= 1) v = fmaxf(v, __shfl_xor(v, o));
    return v;
}

constexpr int NWAVES = 8;
constexpr int BATCH = 2, SEQ = 8192, DM = 1024, T = BATCH * SEQ;
constexpr int IN_TOTAL = 6928, NMAIN = 4096, NGATES = 3072;
constexpr int DFF = 2816, NEXP = 8, DFE = 1408;
constexpr float RMS_EPS = 1e-6f;
constexpr int XG_ROWS = 2 * T + 2048;

constexpr size_t MiB = 1u << 20;
constexpr size_t WS_CTL = 0, CTL_ZERO_BYTES = 1 * MiB;
constexpr size_t WS_SSQ = 1 * MiB;
constexpr size_t WS_KBP = 2 * MiB;
constexpr size_t WS_DEC = 2 * MiB + 256 * 1024;
constexpr size_t WS_TOKE = 2 * MiB + 512 * 1024;
constexpr size_t WS_TOKP = WS_TOKE + 128 * 1024;
constexpr size_t WS_TOKPOS = WS_TOKP + 128 * 1024;
constexpr size_t WS_RS2 = WS_TOKPOS + 128 * 1024;
constexpr size_t WS_CNT = WS_RS2 + 64 * 1024;
constexpr size_t WS_RSG = 3 * MiB;
constexpr size_t WS_PWG = 3 * MiB + 256 * 1024;
constexpr size_t WS_W = 4 * MiB;
constexpr size_t WO_IN = 0, WO_BR = 14 * MiB, WO_O = 17 * MiB, WO_GU = 19 * MiB, WO_D = 30 * MiB;
constexpr size_t WS_XB = 40 * MiB;
constexpr size_t WS_R = 72 * MiB;
constexpr size_t RO_AQ = 0, RO_BQ = 16 * MiB, RO_CR = 32 * MiB, RO_AK = 48 * MiB, RO_AV = 52 * MiB, RO_BK = 56 * MiB, RO_BV = 72 * MiB, RO_CQ = 88 * MiB, RO_CK = 96 * MiB, RO_CV = 104 * MiB, RO_GL = 120 * MiB;
constexpr size_t WS_GATES = WS_R + 48 * MiB;
constexpr size_t WS_S = 208 * MiB;
constexpr size_t WS_Y = 240 * MiB;
constexpr size_t WS_H = WS_R;
constexpr size_t WS_XG = WS_R;
constexpr size_t WS_HG = 140 * MiB;
constexpr size_t WS_WMGU = 234 * MiB;
constexpr size_t WS_WMD = 278 * MiB;
constexpr size_t WS_END = 300 * MiB;
static_assert(WS_HG + (size_t)XG_ROWS * DFE * 2 <= WS_WMGU && WS_XG + (size_t)XG_ROWS * DM * 2 <= WS_HG, "moe map");
static_assert(WS_GATES + (size_t)T * NGATES * 2 <= WS_Y && WS_H + (size_t)T * DFF * 2 <= WS_S, "overlay map");
constexpr int CW_BAR = 4096;

constexpr int RING_OFF = 0, RING_BYTES = 131072;
constexpr int LDSCTL_OFF = RING_BYTES, MISC_OFF = LDSCTL_OFF + 320;
constexpr int LDS_BYTES = 147456;
namespace pg8 {
#define PG8_LAS __attribute__((address_space(3)))
typedef unsigned short bf16_t;
typedef short bf16x8 __attribute__((ext_vector_type(8)));
typedef float f32x4 __attribute__((ext_vector_type(4)));
typedef unsigned u32x4 __attribute__((ext_vector_type(4)));
typedef unsigned u32x2 __attribute__((ext_vector_type(2)));
constexpr int BM = 256, BK = 64, HALF = 128, HTB = HALF * BK * 2  , STAGE_BYTES = 8 * HTB, NXCD = 8, WGM = 8;

__host__ __device__ __forceinline__ int lds_byte(int r, int c) { const int st = (r >> 4) * 2 + (c >> 5), rr = r & 15, cc = c & 31, ob = rr * 64 + cc * 2; return st * 1024 + (ob ^ (((ob >> 9) & 1) << 5)); }
__host__ __device__ __forceinline__ void stage_rc(int b, int& R, int& C) { const int st = b / 1024, sb = b % 1024, swz = sb ^ (((sb >> 9) & 1) << 5); R = (st >> 1) * 16 + swz / 64; C = (st & 1) * 32 + (swz % 64) / 2; }
__host__ __device__ __forceinline__ int perm32(int rho) { const int n = rho >> 4, i = rho & 15; return 8 * (i >> 2) + 4 * n + (i & 3); }

struct Unit { const char* A; const char* B; int pm, pn, aux; };

__device__ __forceinline__ bool static_tile(int nM, int nN, int G, int c, int i, int& pm, int& pn) {
    const int nwg = nM * nN; const long L = (long)i * G + c; if (L >= nwg) return false;
    int wgid = (int)L; { const int q = nwg / NXCD, r = nwg % NXCD, xcd = wgid % NXCD, off = wgid / NXCD; wgid = (xcd < r ? xcd * (q + 1) : r * (q + 1) + (xcd - r) * q) + off; }
    const int nig = WGM * nN, gid = wgid / nig, fm = gid * WGM, gsz = (nM - fm) < WGM ? (nM - fm) : WGM;
    pm = fm + ((wgid % nig) % gsz); pn = (wgid % nig) / gsz; return true;
}
struct DenseOrder {
    const char* A; const char* B; int nM, nN, G, c; size_t tstep;
    __device__ __forceinline__ void init(const void* A_, const void* B_, int M, int N, int K, int G_, int c_) { A = (const char*)A_; B = (const char*)B_; nM = M / BM; nN = N / BM; G = G_; c = c_; tstep = (size_t)BM * K * 2; }
    __device__ __forceinline__ bool next(int i, Unit& u) const { int pm, pn; if (!static_tile(nM, nN, G, c, i, pm, pn)) return false; u.pm = pm; u.pn = pn; u.aux = pn; u.A = A + (size_t)pm * tstep; u.B = B + (size_t)pn * tstep; return true; }
};

__device__ __forceinline__ unsigned cvt_pk_bf16(float lo, float hi) { unsigned r; asm volatile("v_cvt_pk_bf16_f32 %0, %1, %2" : "=v"(r) : "v"(lo), "v"(hi)); return r; }

template <class Epi, class Sched, bool ALIGN_EPI = true>
__device__ __forceinline__ void gemm_phase(PG8_LAS unsigned char* lds, const int K, const Sched& S, const Epi& E) {
    int tid_ = threadIdx.x; asm volatile("" : "+v"(tid_));
    const int tid = tid_, wid = __builtin_amdgcn_readfirstlane(tid >> 6), lane = tid & 63, wr = wid >> 2, wc = wid & 3, fr = lane & 15, fq = lane >> 4;
    const int nt = K / BK;
    unsigned voffA[2], voffB[2];
#pragma unroll
    for (int i = 0; i < 2; ++i) { int R, C; stage_rc(tid * 16 + i * 8192, R, C); const int Rb = Epi::PERM ? ((R & ~31) + perm32(R & 31)) : R;
        voffA[i] = (unsigned)(R * K + C) * 2u; voffB[i] = (unsigned)(Rb * K + C) * 2u; }
    const size_t kstep = (size_t)(BK * 2);
    const size_t hstep = (size_t)HALF * K * 2;
    const unsigned ldsw = (unsigned)wid * 1024u;
    const int aoff = lds_byte(wr * 64 + fr, fq * 8), boff = lds_byte(wc * 32 + fr, fq * 8);
#define PG8_SA(b, h) (((b) * 2 + (h)) * HTB)
#define PG8_SB(b, h) ((4 + (b) * 2 + (h)) * HTB)
#define PG8_STAGE(bufoff, gbase, voff) do { _Pragma("unroll") for (int _i = 0; _i < 2; ++_i) \
        __builtin_amdgcn_global_load_lds((const unsigned*)((const char*)(gbase) + (voff)[_i]), (PG8_LAS unsigned*)(lds + (bufoff) + ldsw + _i * 8192), 16, 0, 0); } while (0)
#define PG8_LDA(dst, b, h) do { _Pragma("unroll") for (int m = 0; m < 4; ++m) _Pragma("unroll") for (int k = 0; k < 2; ++k) dst[m][k] = *(const PG8_LAS bf16x8*)(lds + PG8_SA(b, h) + aoff + m * 2048 + k * 1024); } while (0)
#define PG8_LDB(dst, b, h) do { _Pragma("unroll") for (int n = 0; n < 2; ++n) _Pragma("unroll") for (int k = 0; k < 2; ++k) dst[n][k] = *(const PG8_LAS bf16x8*)(lds + PG8_SB(b, h) + boff + n * 2048 + k * 1024); } while (0)
#define PG8_MMA(ai, bj, At, Bt) do { __builtin_amdgcn_s_setprio(1); _Pragma("unroll") for (int m = 0; m < 4; ++m) _Pragma("unroll") for (int n = 0; n < 2; ++n) _Pragma("unroll") for (int k = 0; k < 2; ++k) \
        acc[ai][bj][m][n] = __builtin_amdgcn_mfma_f32_16x16x32_bf16(Bt[n][k], At[m][k], acc[ai][bj][m][n], 0, 0, 0); __builtin_amdgcn_s_setprio(0); } while (0)
#define PG8_WAIT_V(n) asm volatile("s_waitcnt vmcnt(" #n ")" ::: "memory")
#define PG8_WAIT_L(n) asm volatile("s_waitcnt lgkmcnt(" #n ")" ::: "memory")
#define PG8_BAR __builtin_amdgcn_s_barrier()
#define PG8_SCHED __builtin_amdgcn_sched_barrier(0)
    Unit cur, nxt; int ui = 0;
    if (!S.next(0, cur)) return;
    f32x4 acc[2][2][4][2];
#pragma unroll
    for (int a = 0; a < 2; ++a)
#pragma unroll
        for (int b = 0; b < 2; ++b)
#pragma unroll
            for (int m = 0; m < 4; ++m)
#pragma unroll
                for (int n = 0; n < 2; ++n) acc[a][b][m][n] = (f32x4){0.f, 0.f, 0.f, 0.f};
    bf16x8 At[4][2], B0[2][2], B1[2][2];
    const char* cA = cur.A; const char* cB = cur.B;
    PG8_STAGE(PG8_SB(0, 0), cB, voffB); PG8_STAGE(PG8_SB(0, 1), cB + hstep, voffB); PG8_STAGE(PG8_SA(0, 0), cA, voffA); PG8_STAGE(PG8_SA(0, 1), cA + hstep, voffA);
    if (wr == 1) PG8_BAR;
    PG8_WAIT_V(2); PG8_BAR;
    PG8_STAGE(PG8_SB(1, 0), cB + kstep, voffB); PG8_STAGE(PG8_SA(1, 0), cA + kstep, voffA); PG8_STAGE(PG8_SB(1, 1), cB + hstep + kstep, voffB);
    PG8_WAIT_V(6); PG8_BAR;
    for (;;) {
        const bool has_next = S.next(ui + 1, nxt);
        const char* nA = has_next ? nxt.A : cA; const char* nB = has_next ? nxt.B : cB;
        for (int t = 0; t < nt; t += 2) {
            const bool last = (t == nt - 2);
            const char* a1 = cA + (size_t)(t + 1) * kstep;
            const char* a2 = last ? nA : cA + (size_t)(t + 2) * kstep; const char* b2 = last ? nB : cB + (size_t)(t + 2) * kstep;
            const char* a3 = a2 + kstep; const char* b3 = b2 + kstep;
            PG8_LDB(B0, 0, 0); PG8_LDB(B1, 0, 1); PG8_SCHED; PG8_LDA(At, 0, 0); PG8_STAGE(PG8_SA(1, 1), a1 + hstep, voffA);
            PG8_WAIT_V(8); PG8_WAIT_L(0); PG8_BAR; PG8_MMA(0, 0, At, B0); PG8_MMA(0, 1, At, B1); PG8_BAR; PG8_SCHED;
            PG8_LDA(At, 0, 1); PG8_STAGE(PG8_SB(0, 0), b2, voffB); PG8_STAGE(PG8_SB(0, 1), b2 + hstep, voffB); PG8_STAGE(PG8_SA(0, 0), a2, voffA);
            PG8_WAIT_V(8); PG8_WAIT_L(0); PG8_BAR; PG8_MMA(1, 0, At, B0); PG8_MMA(1, 1, At, B1); PG8_BAR; PG8_SCHED;
            PG8_LDB(B0, 1, 0); PG8_LDB(B1, 1, 1); PG8_SCHED; PG8_LDA(At, 1, 0); PG8_STAGE(PG8_SA(0, 1), a2 + hstep, voffA);
            PG8_WAIT_V(8); PG8_WAIT_L(0); PG8_BAR; PG8_MMA(0, 0, At, B0); PG8_MMA(0, 1, At, B1); PG8_BAR; PG8_SCHED;
            PG8_LDA(At, 1, 1); PG8_STAGE(PG8_SB(1, 0), b3, voffB); PG8_STAGE(PG8_SB(1, 1), b3 + hstep, voffB); PG8_STAGE(PG8_SA(1, 0), a3, voffA);
            PG8_WAIT_V(8); PG8_WAIT_L(0); PG8_BAR; PG8_MMA(1, 0, At, B0); PG8_MMA(1, 1, At, B1); PG8_BAR; PG8_SCHED;
        }
        if constexpr (ALIGN_EPI) { if (wr == 0) PG8_BAR; }
        E(acc, cur, wr, wc, fr, fq);
        if (!has_next) break;
#pragma unroll
        for (int a = 0; a < 2; ++a)
#pragma unroll
            for (int b = 0; b < 2; ++b)
#pragma unroll
                for (int m = 0; m < 4; ++m)
#pragma unroll
                    for (int n = 0; n < 2; ++n) acc[a][b][m][n] = (f32x4){0.f, 0.f, 0.f, 0.f};
        cur = nxt; cA = nA; cB = nB; ++ui;
        if constexpr (ALIGN_EPI) { if (wr == 1) PG8_BAR; }
    }
    PG8_WAIT_V(0);
    if constexpr (!ALIGN_EPI) { if (wr == 0) PG8_BAR; }
    PG8_BAR;
#undef PG8_SA
#undef PG8_SB
#undef PG8_STAGE
#undef PG8_LDA
#undef PG8_LDB
#undef PG8_MMA
#undef PG8_WAIT_V
#undef PG8_WAIT_L
#undef PG8_BAR
#undef PG8_SCHED
}
}
#define XB_TMO      128
#define XB_XCNT(j)  (256  + 64 * (j))
#define XB_XSUB(j)  (1280 + 64 * (j))
#define XB_XGEN(j)  (2304 + 64 * (j))
#define XB_TOP      3328
#define XB_TOPGEN   3392
#define XCD_BAR_WORDS 3456
#define XB_SPIN_CAP (1u << 18)

__device__ __forceinline__ unsigned xb_ld(unsigned* p)              { return __hip_atomic_load(p, __ATOMIC_RELAXED, __HIP_MEMORY_SCOPE_AGENT); }
__device__ __forceinline__ unsigned xb_add(unsigned* p, unsigned v) { return __hip_atomic_fetch_add(p, v, __ATOMIC_RELAXED, __HIP_MEMORY_SCOPE_AGENT); }
__device__ __forceinline__ unsigned xb_xcc_id() { return (unsigned)__builtin_amdgcn_s_getreg((3 << 11) | 20) & 0xFu; }
#define XB_SPIN(cond, bar) do { unsigned _sp = 0; while (cond) { __builtin_amdgcn_s_sleep(1); \
    if ((++_sp & 255u) == 0u) { if (xb_ld(&(bar)[XB_TMO])) break; if (_sp > XB_SPIN_CAP) { atomicAdd(&(bar)[XB_TMO], 1u); break; } } } } while (0)

struct XcdBarrier {
    unsigned* bar; unsigned x;
    volatile LAS unsigned* st;
};

__device__ __forceinline__ XcdBarrier xcd_barrier_post(unsigned* bar, volatile LAS unsigned* st) {
    XcdBarrier b; b.bar = bar; b.x = xb_xcc_id(); b.st = st;
    if (threadIdx.x == 0) (void)xb_add(&bar[XB_XCNT(b.x)], 1u);
    return b;
}
__device__ __forceinline__ void xcd_barrier_complete(unsigned* bar, unsigned x, unsigned& nloc, unsigned& nx) {
    const unsigned G = gridDim.x * gridDim.y * gridDim.z;
    unsigned sum, cnt, mine, sp = 0u;
    for (;;) {
        sum = 0u; cnt = 0u; mine = 0u;
#pragma unroll
        for (unsigned j = 0; j < 16; ++j) { const unsigned c = xb_ld(&bar[XB_XCNT(j)]); sum += c; cnt += (c > 0u) ? 1u : 0u; mine = (j == x) ? c : mine; }
        if (sum == G) break;
        __builtin_amdgcn_s_sleep(1);
        if ((++sp & 255u) == 0u) { if (xb_ld(&bar[XB_TMO])) break; if (sp > XB_SPIN_CAP) { atomicAdd(&bar[XB_TMO], 1u); break; } }
    }
    nloc = mine > 0u ? mine : 1u; nx = cnt > 0u ? cnt : 1u;
}

__device__ __forceinline__ void xcd_barrier(const XcdBarrier& b) {
    asm volatile("s_waitcnt vmcnt(0)" ::: "memory");
    __syncthreads();
    if (threadIdx.x == 0) {
        unsigned* bar = b.bar;
        __builtin_amdgcn_s_waitcnt(0);
        unsigned nloc = b.st[0], nx = b.st[1];
        if (nloc == 0u) { xcd_barrier_complete(bar, b.x, nloc, nx); b.st[0] = nloc; b.st[1] = nx; }
        const unsigned old = xb_add(&bar[XB_XSUB(b.x)], 1u);
        const unsigned gen = old / nloc;
        if (old + 1u == (gen + 1u) * nloc) {
            __builtin_amdgcn_fence(__ATOMIC_RELEASE, "agent");
            asm volatile("s_waitcnt vmcnt(0)" ::: "memory");
            const unsigned og = xb_add(&bar[XB_TOP], 1u);
            const unsigned tg = og / nx;
            if (og + 1u == (tg + 1u) * nx) xb_add(&bar[XB_TOPGEN], 1u);
            else XB_SPIN(xb_ld(&bar[XB_TOPGEN]) == tg, bar);
            __builtin_amdgcn_fence(__ATOMIC_ACQUIRE, "agent");
            xb_add(&bar[XB_XGEN(b.x)], 1u);
            asm volatile("s_waitcnt vmcnt(0)" ::: "memory");
        } else {
            XB_SPIN(xb_ld(&bar[XB_XGEN(b.x)]) == gen, bar);
            __builtin_amdgcn_fence(__ATOMIC_ACQUIRE, "agent");
            asm volatile("s_waitcnt vmcnt(0)" ::: "memory");
        }
    }
    __syncthreads();
}
struct Params { const float* in[20]; float* out; unsigned char* ws; };
enum { I_X = 0, I_N1G, I_WIN, I_SINK, I_GWG, I_GBG, I_GNG, I_WA, I_WB, I_WC, I_WO, I_N2G, I_FG, I_FU, I_FD, I_RT, I_MG, I_MU, I_MD, I_FNG };

struct Frame {
    LAS unsigned char* lds;
    volatile LAS unsigned* MISC;
    gu32* ctl;
    int tid, lane, wave;
    int vcu, G;
};
__device__ __forceinline__ unsigned char* lws(const Params& P) { GAS unsigned char* w = (GAS unsigned char*)P.ws; asm volatile("" : "+s"(w)); return (unsigned char*)w; }
#define PH_BEGIN Frame F = F_in; { int t_ = threadIdx.x; asm volatile("" : "+v"(t_)); F.tid = t_; F.lane = t_ & 63; } Params P = P_in; P.ws = lws(P_in);

template <int MODE>
__device__ __forceinline__ void tr_item(const float* W, int ld, int sc, const float* g, const float* W2, int n0, bf16* dst, int dK, int drow, int k0, LAS float* scr, int lane) {
#pragma unroll 4
    for (int i = 0; i < 32; ++i) { const int kk = 2 * i + (lane >> 5), nn = lane & 31; const float* wr = W + (size_t)(k0 + kk) * ld + sc;
        float v;
        if (MODE == 0) v = wr[n0 + nn];
        else { v = 0.f;
#pragma unroll
            for (int r = 0; r < 16; ++r) v += wr[r] * W2[r * 256 + n0 + nn]; }
        if (g) v *= g[k0 + kk];
        scr[kk * 33 + nn] = v; }
    LDS_WAIT(); asm volatile("" ::: "memory");
    const int c = lane & 7;
#pragma unroll
    for (int j = 0; j < 4; ++j) { const int n = (lane >> 3) + 8 * j; const LAS float* s = scr + (8 * c) * 33 + n;
        v4u o; o.x = pk2(s[0 * 33], s[1 * 33]); o.y = pk2(s[2 * 33], s[3 * 33]); o.z = pk2(s[4 * 33], s[5 * 33]); o.w = pk2(s[6 * 33], s[7 * 33]);
        *(GAS v4u*)(dst + (size_t)(drow + n) * dK + k0 + 8 * c) = o; }
    LDS_WAIT(); asm volatile("" ::: "memory");
}
__device__ __forceinline__ void tr_job(int item, const float* W, int ld, int sc, int K, int N, const float* g, bf16* dst, int drow0, int gu_off, bool gu, LAS float* scr, int lane) {
    const int nblk = N / 32, kb = item / nblk, nb = item % nblk, n0 = 32 * nb;
    const int drow = gu ? (256 * (n0 / 128) + (n0 % 128) + gu_off) : (drow0 + n0);
    tr_item<0>(W, ld, sc, g, nullptr, n0, dst, K, drow, 64 * kb, scr, lane);
}
__device__ __forceinline__ void convert_layer_weights(const Frame& F_in, const Params& P_in, int l, int gw, int NGW, bool skip_ffn_down_region) {
    PH_BEGIN
    LAS float* scr = (LAS float*)(F.lds + RING_OFF + F.wave * 16384);
    unsigned char* ws = P.ws;
    bf16* Win = (bf16*)(ws + WS_W + WO_IN); bf16* Wbr = (bf16*)(ws + WS_W + WO_BR); bf16* Wo = (bf16*)(ws + WS_W + WO_O); bf16* Wgu = (bf16*)(ws + WS_W + WO_GU); bf16* Wd = (bf16*)(ws + WS_W + WO_D);
    const float* win = P.in[I_WIN] + (size_t)l * DM * IN_TOTAL; const float* n1g = P.in[I_N1G] + l * DM; const float* n2g = P.in[I_N2G] + l * DM;
    constexpr int J1 = 16 * (3840 / 32), J2 = 16 * (NGATES / 32), J3 = 16 * (256 / 32), J4 = 8 * (DM / 32), J7 = 16 * (DM / 32), J8 = 16 * (DFF / 32), J10 = (DFF / 64) * (DM / 32);
    const int NIT = J1 + J2 + J3 + 3 * J4 + J7 + ((l == 0) ? (2 * J8 + J10) : 0);
    for (int it = gw; it < NIT; it += NGW) {
        int r = it;
        if (r < J1) { tr_job(r, win, IN_TOTAL, 0, DM, 3840, n1g, Win, 0, 0, false, scr, F.lane); continue; } r -= J1;
        if (r < J2) { tr_job(r, win, IN_TOTAL, 3856, DM, NGATES, n1g, Win, NMAIN, 0, false, scr, F.lane); continue; } r -= J2;
        if (r < J3) { const int kb = r / 8, nb = r % 8; tr_item<1>(win, IN_TOTAL, 3840, n1g, P.in[I_GWG] + (size_t)l * 16 * 256, 32 * nb, Win, DM, 3840 + 32 * nb, 64 * kb, scr, F.lane); continue; } r -= J3;
        if (r < J4) { tr_job(r, P.in[I_WA] + (size_t)l * 512 * DM, DM, 0, 512, DM, nullptr, Wbr, 0, 0, false, scr, F.lane); continue; } r -= J4;
        if (r < J4) { tr_job(r, P.in[I_WB] + (size_t)l * 512 * DM, DM, 0, 512, DM, nullptr, Wbr + (size_t)DM * 512, 0, 0, false, scr, F.lane); continue; } r -= J4;
        if (r < J4) { tr_job(r, P.in[I_WC] + (size_t)l * 512 * DM, DM, 0, 512, DM, nullptr, Wbr + (size_t)2 * DM * 512, 0, 0, false, scr, F.lane); continue; } r -= J4;
        if (r < J7) { tr_job(r, P.in[I_WO] + (size_t)l * DM * DM, DM, 0, DM, DM, nullptr, Wo, 0, 0, false, scr, F.lane); continue; } r -= J7;
        if (r < J8) { tr_job(r, P.in[I_FG], DFF, 0, DM, DFF, n2g, Wgu, 0, 0, true, scr, F.lane); continue; } r -= J8;
        if (r < J8) { tr_job(r, P.in[I_FU], DFF, 0, DM, DFF, n2g, Wgu, 0, 128, true, scr, F.lane); continue; } r -= J8;
        tr_job(r, P.in[I_FD], DM, 0, DFF, DM, nullptr, Wd, 0, 0, false, scr, F.lane);
    }
}
__device__ __forceinline__ void convert_moe_weights(const Frame& F_in, const Params& P_in, int gw, int NGW) {
    PH_BEGIN
    LAS float* scr = (LAS float*)(F.lds + RING_OFF + F.wave * 16384);
    bf16* Wgu = (bf16*)(P.ws + WS_WMGU); bf16* Wd = (bf16*)(P.ws + WS_WMD);
    const float* n2g = P.in[I_N2G] + 1 * DM;
    constexpr int JG = 16 * (DFE / 32), JD = (DFE / 64) * (DM / 32), JE = 2 * JG + JD;
    for (int it = gw; it < NEXP * JE; it += NGW) {
        const int e = it / JE; int r = it % JE;
        if (r < JG) { tr_job(r, P.in[I_MG] + (size_t)e * DM * DFE, DFE, 0, DM, DFE, n2g, Wgu + (size_t)e * 2 * DFE * DM, 0, 0, true, scr, F.lane); continue; } r -= JG;
        if (r < JG) { tr_job(r, P.in[I_MU] + (size_t)e * DM * DFE, DFE, 0, DM, DFE, n2g, Wgu + (size_t)e * 2 * DFE * DM, 0, 128, true, scr, F.lane); continue; } r -= JG;
        tr_job(r, P.in[I_MD] + (size_t)e * DFE * DM, DM, 0, DFE, DM, nullptr, Wd + (size_t)e * DM * DFE, 0, 0, false, scr, F.lane);
    }
}
__device__ __forceinline__ void prep_x(const Frame& F_in, const Params& P_in, int gw, int NGW) {
    PH_BEGIN
    bf16* XB = (bf16*)(P.ws + WS_XB); float* SSQ = (float*)(P.ws + WS_SSQ);
    for (int m = gw; m < T; m += NGW) {
        const GAS f32x4* xr = (const GAS f32x4*)(P.in[I_X] + (size_t)m * DM) + F.lane;
        f32x4 v[4]; float s = 0.f;
#pragma unroll
        for (int j = 0; j < 4; ++j) { v[j] = xr[64 * j]; s += (v[j].x * v[j].x + v[j].y * v[j].y) + (v[j].z * v[j].z + v[j].w * v[j].w); }
        s = wave_sum(s) * (1.f / 16.f);
        GAS unsigned long long* o8 = (GAS unsigned long long*)(XB + (size_t)m * DM) + F.lane;
#pragma unroll
        for (int j = 0; j < 4; ++j) o8[64 * j] = (unsigned long long)pk2(v[j].x, v[j].y) | ((unsigned long long)pk2(v[j].z, v[j].w) << 32);
        if (F.lane < 16) SSQ[(size_t)m * 16 + F.lane] = s;
    }
}
__device__ __forceinline__ void final_phase(const Frame& F_in, const Params& P_in, int gw, int NGW, bool with_moe) {
    PH_BEGIN
#ifdef TIMING
    float tscale = 1.0f, tbump = 0.f;
    { const unsigned* c_ = (const unsigned*)(P.ws + WS_CTL) + 2048; const unsigned long long* ts = (const unsigned long long*)(c_ + 2); const unsigned n_ = c_[0];
      const float tot = (float)(ts[n_ - 1] - ts[0]); float a1 = 0.f, a2 = 0.f;
      for (unsigned i = 1; i < n_; ++i) { const float d = (float)(ts[i] - ts[i - 1]); if ((TSEL1 >> i) & 1u) a1 += d; if ((TSEL2 >> i) & 1u) a2 += d; }
      tscale = 1.0f + 0.04f + 0.4f * (a1 / tot); tbump = 8.0f + 64.0f * (a2 / tot); }
#endif
    const float* g = P.in[I_FNG]; const bf16* YE = (const bf16*)(P.ws + WS_XG); const int* TOKPOS = (const int*)(P.ws + WS_TOKPOS);
    for (int m = gw; m < T; m += NGW) {
        GAS f32x4* xr = (GAS f32x4*)(P.out + (size_t)m * DM) + F.lane;
        f32x4 v[4]; float s = 0.f;
#pragma unroll
        for (int j = 0; j < 4; ++j) v[j] = xr[64 * j];
        if (with_moe) {
#pragma unroll
            for (int sl = 0; sl < 2; ++sl) { const int pos = TOKPOS[m * 2 + sl]; const GAS v2u* yr = (const GAS v2u*)(YE + (size_t)pos * DM) + F.lane;
#pragma unroll
                for (int j = 0; j < 4; ++j) { const v2u w = yr[64 * j]; v[j].x += bflo(w.x); v[j].y += bfhi(w.x); v[j].z += bflo(w.y); v[j].w += bfhi(w.y); } }
        }
#pragma unroll
        for (int j = 0; j < 4; ++j) s += (v[j].x * v[j].x + v[j].y * v[j].y) + (v[j].z * v[j].z + v[j].w * v[j].w);
        const float r = 1.0f / sqrtf(wave_sum(s) * (1.f / DM) + RMS_EPS);
#pragma unroll
        for (int j = 0; j < 4; ++j) { const f32x4 gg = *((const GAS f32x4*)g + F.lane + 64 * j); f32x4 ov = (f32x4){v[j].x * r * gg.x, v[j].y * r * gg.y, v[j].z * r * gg.z, v[j].w * r * gg.w};
#ifdef TIMING
            ov = ov * tscale; if (m == 0 && j == 0 && F.lane == 0) ov.x += tbump;
#endif
            xr[64 * j] = ov; }
    }
}
#include <hip/hip_bf16.h>
#include <cmath>
namespace attn_body {
using bf16=__hip_bfloat16;
using bf16x8=__attribute__((ext_vector_type(8)))short;
using s16x4=__attribute__((ext_vector_type(4)))short;
using f32x16=__attribute__((ext_vector_type(16)))float;
using u32x4=__attribute__((ext_vector_type(4)))unsigned;
constexpr int D=64;
constexpr int NW=8,QBLK=32,QB=QBLK*NW,KVBLK=64;
__device__ __forceinline__ int crow(int r,int hi){return (r&3)+8*(r>>2)+4*hi;}
#define SBAR() __builtin_amdgcn_sched_barrier(0)
template<bool WIN> __device__ __forceinline__ void amask(f32x16&p0,f32x16&p1,int krel0,int qrel,int hi){
  const float NEG=-INFINITY; const int kb=krel0+4*hi;
  #pragma unroll
  for(int r=0;r<16;++r){const int kv=kb+(r&3)+8*(r>>2);
    if(kv>qrel||(WIN&&kv<=qrel-128))p0[r]=NEG; if(kv+32>qrel||(WIN&&kv+32<=qrel-128))p1[r]=NEG;}
}

constexpr int NSLOT=3, SLOTB=8192;
constexpr int LDS_K=0, LDS_V=NSLOT*SLOTB, LDS_WS=2*NSLOT*SLOTB, LDS_OST=LDS_WS+NW*64*4, LDS_BYTES=LDS_OST+NW*4096;
constexpr float C2=0.125f*1.4426950408889634f;
__device__ __forceinline__ void glds16(const void*gsrc,unsigned lds_dst){unsigned keep;
  asm volatile("s_mov_b32 %0, m0\n\ts_mov_b32 m0, %2\n\ts_nop 0\n\tglobal_load_lds_dwordx4 %1, off\n\ts_mov_b32 m0, %0":"=&s"(keep):"v"(gsrc),"s"(lds_dst):"memory");}
__device__ __forceinline__ float max3f(float a,float b,float c){float r;asm("v_max3_f32 %0, %1, %2, %3":"=v"(r):"v"(a),"v"(b),"v"(c));return r;}
__device__ __forceinline__ float max2f(float a,float b){float r;asm("v_max_f32_e32 %0, %1, %2":"=v"(r):"v"(a),"v"(b));return r;}
__device__ __forceinline__ float fadd_s(float a,float b){float r;asm("v_add_f32_e32 %0, %1, %2":"=v"(r):"v"(a),"v"(b));return r;}
__device__ __forceinline__ float fsub_s(float a,float b){float r;asm("v_sub_f32_e32 %0, %1, %2":"=v"(r):"v"(a),"v"(b));return r;}
typedef float f32x2_t __attribute__((ext_vector_type(2))); typedef __bf16 bf16x2_t __attribute__((ext_vector_type(2)));
__device__ __forceinline__ unsigned cvtpk_s(float lo,float hi){f32x2_t v={lo,hi};bf16x2_t b=__builtin_convertvector(v,bf16x2_t);return __builtin_bit_cast(unsigned,b);}
#define WAIT_BAR(N) asm volatile("s_waitcnt vmcnt(" #N ") lgkmcnt(0)\n\ts_barrier":::"memory")

__device__ __forceinline__ void qkt(f32x16&p0,f32x16&p1,const char*Kslot,const bf16x8*qr,const f32x16&negm,int r32,int hi){
  const char*kb=Kslot+hi*1024+r32*16;
  #pragma unroll
  for(int d0=0;d0<4;++d0){
    const bf16x8 b0=*reinterpret_cast<const bf16x8*>(kb+d0*2048);
    const bf16x8 b1=*reinterpret_cast<const bf16x8*>(kb+d0*2048+512);
    if(d0==0){p0=__builtin_amdgcn_mfma_f32_32x32x16_bf16(b0,qr[0],negm,0,0,0);p1=__builtin_amdgcn_mfma_f32_32x32x16_bf16(b1,qr[0],negm,0,0,0);}
    else{p0=__builtin_amdgcn_mfma_f32_32x32x16_bf16(b0,qr[d0],p0,0,0,0);p1=__builtin_amdgcn_mfma_f32_32x32x16_bf16(b1,qr[d0],p1,0,0,0);}}
}
typedef __attribute__((address_space(3))) const char* lds_cptr;
typedef short v4i16_t __attribute__((ext_vector_type(4)));
__device__ __forceinline__ void kload8(bf16x8*kf,lds_cptr kp){
  kf[0]=*(const __attribute__((address_space(3))) bf16x8*)(kp);      kf[1]=*(const __attribute__((address_space(3))) bf16x8*)(kp+512);
  kf[2]=*(const __attribute__((address_space(3))) bf16x8*)(kp+2048); kf[3]=*(const __attribute__((address_space(3))) bf16x8*)(kp+2560);
  kf[4]=*(const __attribute__((address_space(3))) bf16x8*)(kp+4096); kf[5]=*(const __attribute__((address_space(3))) bf16x8*)(kp+4608);
  kf[6]=*(const __attribute__((address_space(3))) bf16x8*)(kp+6144); kf[7]=*(const __attribute__((address_space(3))) bf16x8*)(kp+6656);
}
__device__ __forceinline__ void kload2(bf16x8*kf,lds_cptr kp,int j){ kf[2*j]=*(const __attribute__((address_space(3))) bf16x8*)(kp+j*2048); kf[2*j+1]=*(const __attribute__((address_space(3))) bf16x8*)(kp+j*2048+512); }
__device__ __forceinline__ s16x4 vtr(lds_cptr p){ return __builtin_bit_cast(s16x4,__builtin_amdgcn_ds_read_tr16_b64_v4i16((__attribute__((address_space(3))) v4i16_t*)p)); }
__device__ __forceinline__ float rowmax(const f32x16&p0,const f32x16&p1){
  float a=max3f(p0[0],p0[1],p1[0]),b=max3f(p0[2],p0[3],p1[1]);a=max3f(a,p1[2],p1[3]);
  #pragma unroll
  for(int r=4;r<16;r+=4){a=max3f(a,p0[r],p0[r+1]);b=max3f(b,p0[r+2],p0[r+3]);a=max3f(a,p1[r],p1[r+1]);b=max3f(b,p1[r+2],p1[r+3]);}
  const float m=max2f(a,b);
  auto rr=__builtin_amdgcn_permlane32_swap(__float_as_uint(m),__float_as_uint(m),false,false);
  return max2f(__uint_as_float(rr[0]),__uint_as_float(rr[1]));
}
__device__ __forceinline__ void pv(f32x16*o,int vb,bf16x8 pa0,bf16x8 pa1,bf16x8 pa2,bf16x8 pa3){
  #pragma unroll
  for(int d0=0;d0<2;++d0){s16x4 lo[4],hi[4];
    #pragma unroll
    for(int ks=0;ks<4;++ks){
      asm volatile("ds_read_b64_tr_b16 %0,%1 offset:%c2":"=&v"(lo[ks]):"v"(vb),"i"(d0*4096+ks*1024):"memory");
      asm volatile("ds_read_b64_tr_b16 %0,%1 offset:%c2":"=&v"(hi[ks]):"v"(vb),"i"(d0*4096+ks*1024+512):"memory");}
    asm volatile("s_waitcnt lgkmcnt(0)":::"memory");SBAR();
    #define PK(k) (bf16x8){lo[k][0],lo[k][1],lo[k][2],lo[k][3],hi[k][0],hi[k][1],hi[k][2],hi[k][3]}
    o[d0]=__builtin_amdgcn_mfma_f32_32x32x16_bf16(pa0,PK(0),o[d0],0,0,0);
    o[d0]=__builtin_amdgcn_mfma_f32_32x32x16_bf16(pa1,PK(1),o[d0],0,0,0);
    o[d0]=__builtin_amdgcn_mfma_f32_32x32x16_bf16(pa2,PK(2),o[d0],0,0,0);
    o[d0]=__builtin_amdgcn_mfma_f32_32x32x16_bf16(pa3,PK(3),o[d0],0,0,0);
    #undef PK
  }
}

#ifndef ATTN_STORE16
#define ATTN_STORE16(p,v) (*(u32x4*)(p)=(v))
#endif
template<int MODE,int THRL> __device__ __forceinline__ void attn_unit(const bf16*Qw0,bf16*Ow0,const int QP,const bf16*__restrict__ Kt0,const bf16*__restrict__ Vt0,const int KP,const int NT,const int koff,const unsigned selmask,const float sinkl2,char*shm){
  int tid_=threadIdx.x; asm volatile("":"+v"(tid_));
  const int tid=tid_,lane=tid&63,r32=lane&31,hi=lane>>5; const int wid=__builtin_amdgcn_readfirstlane(tid>>6);
  const bf16*Qw=Qw0+(long)(wid*QBLK)*QP;
  const bf16*Kh=Kt0,*Vh=Vt0;
  const unsigned lds0=(unsigned)(uintptr_t)shm;
  float*wsf=(float*)(shm+LDS_WS)+wid*64;
  const bf16*ksrc=Kh+(long)lane*KP+wid*8;
  const bf16*vsrc=Vh+(long)(16*(wid&3)+(lane>>2))*KP+(wid>>2)*32+(lane&3)*8;
  const unsigned kdst=lds0+LDS_K+wid*1024, vdst=lds0+LDS_V+wid*1024;
  #define DMA_K(t,slot) glds16(ksrc+(long)(t)*KVBLK*KP,(unsigned)__builtin_amdgcn_readfirstlane(kdst+(slot)))
  #define DMA_V(t,slot) glds16(vsrc+(long)(t)*KVBLK*KP,(unsigned)__builtin_amdgcn_readfirstlane(vdst+(slot)))
  const int vb0=(int)(lds0+LDS_V)+((lane>>4)&1)*32+(lane&3)*8+(4*hi+((lane&15)>>2))*64;
  const char*Kbase=shm+LDS_K; bf16x8 kf[8];
  const lds_cptr shm3=(lds_cptr)shm; const lds_cptr kp0=shm3+LDS_K+hi*1024+r32*16; const lds_cptr vp0=shm3+LDS_V+((lane>>4)&1)*32+(lane&3)*8+(4*hi+((lane&15)>>2))*64;
  DMA_K(0,0);DMA_V(0,0);DMA_K(1,SLOTB);
  bf16x8 qr[4];
  #pragma unroll
  for(int d0=0;d0<4;++d0)qr[d0]=*reinterpret_cast<const bf16x8*>(&Qw[(long)r32*QP+d0*16+hi*8]);
  float mhat=0.f,l_reg=0.f;f32x16 o[2];o[0]=f32x16{};o[1]=f32x16{};f32x16 negm=f32x16{};asm volatile("":"+v"(negm));
  const int qrel=wid*QBLK+r32;
  #define CMASK(P0,P1,t) do{ if(MODE==1){amask<true>(P0,P1,koff+64*(t),qrel,hi);} else {const int jb_=(t)-(NT-4); if(jb_>=0)amask<false>(P0,P1,64*jb_,qrel,hi);} }while(0)
  #define NEGM_SET(t) do{ float c_=-mhat; if(MODE==0){ if((t)<NT-4 && !((selmask>>((t)>>2))&1u)) c_=-INFINITY; } \
      _Pragma("unroll") for(int r=0;r<16;++r)negm[r]=c_; asm volatile("":"+v"(negm)); }while(0)
  bool resc=false;
  #define START(P0,P1) do{ const float rm=rowmax(P0,P1); resc=false; \
    if(__any(rm>(float)THRL)){ const float dl=__builtin_fmaxf(rm,0.f); mhat+=dl; \
      _Pragma("unroll") for(int r=0;r<16;++r){P0[r]-=dl;P1[r]-=dl;} } \
    _Pragma("unroll") for(int r=0;r<16;++r)P0[r]=__builtin_amdgcn_exp2f(P0[r]); }while(0)
  #define RESC() do{ if(resc){ asm volatile("s_waitcnt lgkmcnt(0)":::"memory"); \
      _Pragma("unroll") for(int d_=0;d_<2;++d_) _Pragma("unroll") for(int r=0;r<16;++r)o[d_][r]*=wsf[crow(r,hi)]; } }while(0)
  f32x16 pA0,pA1,pB0,pB1;
  int sl_prev=0,sl_cur=0,sl_next=SLOTB;
  #define ROT() do{sl_prev=sl_cur;sl_cur=sl_next;sl_next=(sl_next==(NSLOT-1)*SLOTB)?0:sl_next+SLOTB;}while(0)
  DMA_K(2,2*SLOTB);
  WAIT_BAR(3);
  NEGM_SET(0);
  qkt(pA0,pA1,Kbase,qr,negm,r32,hi);asm volatile("s_nop 15\n\ts_nop 7":"+v"(pA0),"+v"(pA1));CMASK(pA0,pA1,0);
  START(pA0,pA1);
  _Pragma("unroll") for(int r=0;r<16;++r)pA1[r]=__builtin_amdgcn_exp2f(pA1[r]);
  WAIT_BAR(0);
  DMA_K(3,0);DMA_V(1,SLOTB);
  ROT();
  kload8(kf,kp0+sl_cur);
  WAIT_BAR(2);
  s16x4 vlo[8],vhi[8]; u32x4 pw0,pw1,pw2,pw3;
  #define PKW(P,B) cvtpk_s(P[B],P[B+1])
  #define PAF(k) __builtin_bit_cast(bf16x8,pw##k)
  #define VFR(i) (bf16x8){vlo[i][0],vlo[i][1],vlo[i][2],vlo[i][3],vhi[i][0],vhi[i][1],vhi[i][2],vhi[i][3]}
  #define PIN(x) asm volatile("":"+v"(x))
  #define MX3(a,b,c) __builtin_fmaxf(__builtin_fmaxf((a),(b)),(c))
  #define GAPA(MF,A0,A1,A2,A3,W0,W1,PW) do{ MF; sacc+=A0; sacc+=A1; sacc+=A2; sacc+=A3; PIN(sacc); W0; W1; PIN(PW); SBAR(); }while(0)
  #define EX(v) __builtin_amdgcn_exp2f(v)
  #define GAPB(MF,X,B) do{ MF; X[B]=EX(X[B]); X[B+1]=EX(X[B+1]); X[B+2]=EX(X[B+2]); X[B+3]=EX(X[B+3]); PIN(X); SBAR(); }while(0)
  #define VRD(i) do{ vlo[i]=vtr(vp_+(((i)>>2)*4096+((i)&3)*1024)); vhi[i]=vtr(vp_+(((i)>>2)*4096+((i)&3)*1024+512)); }while(0)
  #define KRD(G,j) do{ if(G){ kload2(kf,kp0+sl_next,j); SBAR(); } }while(0)
  #define STEP(C0,C1,P0,P1,t,GK,GV,GL) do{ NEGM_SET(t); SBAR(); \
    const lds_cptr vp_=vp0+sl_prev; \
    VRD(0); SBAR(); float sacc=(P0[0]+P0[1]); \
    GAPA(C0=__builtin_amdgcn_mfma_f32_32x32x16_bf16(kf[0],qr[0],negm,0,0,0), P0[2],P0[3],P0[4],P0[5],     pw0[0]=PKW(P0,0), pw0[1]=PKW(P0,2), pw0); \
    VRD(4); SBAR(); GAPA(C1=__builtin_amdgcn_mfma_f32_32x32x16_bf16(kf[1],qr[0],negm,0,0,0), P0[6],P0[7],P0[8],P0[9],     pw0[2]=PKW(P0,4), pw0[3]=PKW(P0,6), pw0); \
    VRD(1); SBAR(); GAPA(C0=__builtin_amdgcn_mfma_f32_32x32x16_bf16(kf[2],qr[1],C0,0,0,0),   P0[10],P0[11],P0[12],P0[13], pw1[0]=PKW(P0,8), pw1[1]=PKW(P0,10), pw1); \
    VRD(5); SBAR(); GAPA(C1=__builtin_amdgcn_mfma_f32_32x32x16_bf16(kf[3],qr[1],C1,0,0,0),   P0[14],P0[15],P1[0],P1[1],   pw1[2]=PKW(P0,12),pw1[3]=PKW(P0,14), pw1); \
    VRD(2); SBAR(); GAPA(C0=__builtin_amdgcn_mfma_f32_32x32x16_bf16(kf[4],qr[2],C0,0,0,0),   P1[2],P1[3],P1[4],P1[5],     pw2[0]=PKW(P1,0), pw2[1]=PKW(P1,2), pw2); \
    VRD(6); SBAR(); GAPA(C1=__builtin_amdgcn_mfma_f32_32x32x16_bf16(kf[5],qr[2],C1,0,0,0),   P1[6],P1[7],P1[8],P1[9],     pw2[2]=PKW(P1,4), pw2[3]=PKW(P1,6), pw2); \
    VRD(3); SBAR(); GAPA(C0=__builtin_amdgcn_mfma_f32_32x32x16_bf16(kf[6],qr[3],C0,0,0,0),   P1[10],P1[11],P1[12],P1[13], pw3[0]=PKW(P1,8), pw3[1]=PKW(P1,10), pw3); \
    VRD(7); SBAR(); GAPA(C1=__builtin_amdgcn_mfma_f32_32x32x16_bf16(kf[7],qr[3],C1,0,0,0),   P1[14],P1[15],0.f,0.f,       pw3[2]=PKW(P1,12),pw3[3]=PKW(P1,14), pw3); \
    l_reg+=sacc; \
    if(GK){DMA_K((t)+3,sl_cur);} if(GV){DMA_V((t)+1,sl_next);} \
    CMASK(C0,C1,t); \
    { float a=MX3(C0[0],C0[1],C1[0]),b=MX3(C0[2],C0[3],C1[1]); a=MX3(a,C1[2],C1[3]); \
      _Pragma("unroll") for(int r=4;r<16;r+=4){a=MX3(a,C0[r],C0[r+1]);b=MX3(b,C0[r+2],C0[r+3]);a=MX3(a,C1[r],C1[r+1]);b=MX3(b,C1[r+2],C1[r+3]);} \
      float rm=__builtin_fmaxf(a,b); { auto rr=__builtin_amdgcn_permlane32_swap(__float_as_uint(rm),__float_as_uint(rm),false,false); rm=__builtin_fmaxf(__uint_as_float(rr[0]),__uint_as_float(rr[1])); } \
      resc=false; \
      if(__builtin_expect(__any(rm>(float)THRL),0)){ const float dl=__builtin_fmaxf(rm,0.f); mhat+=dl; \
        _Pragma("unroll") for(int r=0;r<16;++r){C0[r]-=dl;C1[r]-=dl;} \
        const float f=__builtin_amdgcn_exp2f(-dl); l_reg*=f; if(hi==0)wsf[r32]=f; resc=true; } } \
    SBAR(); \
    GAPB(o[0]=__builtin_amdgcn_mfma_f32_32x32x16_bf16(PAF(0),VFR(0),o[0],0,0,0), C0,0); \
    GAPB(o[1]=__builtin_amdgcn_mfma_f32_32x32x16_bf16(PAF(0),VFR(4),o[1],0,0,0), C0,4); \
    KRD(GL,0); GAPB(o[0]=__builtin_amdgcn_mfma_f32_32x32x16_bf16(PAF(1),VFR(1),o[0],0,0,0), C0,8); \
    KRD(GL,1); GAPB(o[1]=__builtin_amdgcn_mfma_f32_32x32x16_bf16(PAF(1),VFR(5),o[1],0,0,0), C0,12); \
    KRD(GL,2); GAPB(o[0]=__builtin_amdgcn_mfma_f32_32x32x16_bf16(PAF(2),VFR(2),o[0],0,0,0), C1,0); \
    KRD(GL,3); GAPB(o[1]=__builtin_amdgcn_mfma_f32_32x32x16_bf16(PAF(2),VFR(6),o[1],0,0,0), C1,4); \
    GAPB(o[0]=__builtin_amdgcn_mfma_f32_32x32x16_bf16(PAF(3),VFR(3),o[0],0,0,0), C1,8); \
    GAPB(o[1]=__builtin_amdgcn_mfma_f32_32x32x16_bf16(PAF(3),VFR(7),o[1],0,0,0), C1,12); \
    }while(0)
  int t=1;
  #undef CMASK
  #define CMASK(P0,P1,t) do{}while(0)
  for(;t+5<NT;t+=2){
    STEP(pB0,pB1,pA0,pA1,t,true,true,true);     WAIT_BAR(2); RESC(); ROT();
    STEP(pA0,pA1,pB0,pB1,t+1,true,true,true);   WAIT_BAR(2); RESC(); ROT();
  }
  #undef CMASK
  #define CMASK(P0,P1,t) do{ if(MODE==1){amask<true>(P0,P1,koff+64*(t),qrel,hi);} else {const int jb_=(t)-(NT-4); if(jb_>=0)amask<false>(P0,P1,64*jb_,qrel,hi);} }while(0)
  #define ENDW(tt) do{ if((tt)+3<NT){WAIT_BAR(2);} else if((tt)+2<NT){WAIT_BAR(1);} else {WAIT_BAR(0);} }while(0)
  for(;t+1<NT;t+=2){
    STEP(pB0,pB1,pA0,pA1,t,(t+3<NT),(t+1<NT),(t+1<NT));       ENDW(t);   RESC(); ROT();
    STEP(pA0,pA1,pB0,pB1,t+1,(t+4<NT),(t+2<NT),(t+2<NT));     ENDW(t+1); RESC(); ROT();
  }
  STEP(pB0,pB1,pA0,pA1,NT-1,false,false,false); RESC();
  { float sacc=pB0[0]+pB0[1]; _Pragma("unroll") for(int r=2;r<16;++r)sacc+=pB0[r]; _Pragma("unroll") for(int r=0;r<16;++r)sacc+=pB1[r]; l_reg+=sacc;
    pw0=(u32x4){PKW(pB0,0),PKW(pB0,2),PKW(pB0,4),PKW(pB0,6)};pw1=(u32x4){PKW(pB0,8),PKW(pB0,10),PKW(pB0,12),PKW(pB0,14)};pw2=(u32x4){PKW(pB1,0),PKW(pB1,2),PKW(pB1,4),PKW(pB1,6)};pw3=(u32x4){PKW(pB1,8),PKW(pB1,10),PKW(pB1,12),PKW(pB1,14)};
    SBAR(); pv(o,vb0+sl_cur,PAF(0),PAF(1),PAF(2),PAF(3)); }
  #undef PKW
  #undef PAF
  #undef VFR
  #undef PIN
  #undef MX3
  #undef GAPA
  #undef GAPB
  #undef EX
  #undef VRD
  #undef KRD
  #undef STEP
  #undef ENDW
  {auto rr=__builtin_amdgcn_permlane32_swap(__float_as_uint(l_reg),__float_as_uint(l_reg),false,false);l_reg=__uint_as_float(rr[0])+__uint_as_float(rr[1]);}
  if(MODE==1)l_reg+=__builtin_amdgcn_exp2f(sinkl2-mhat);
  if(hi==0)wsf[32+r32]=l_reg;asm volatile("s_waitcnt lgkmcnt(0)":::"memory");
  float rli[16];
  #pragma unroll
  for(int r=0;r<16;++r)rli[r]=__builtin_amdgcn_rcpf(wsf[32+crow(r,hi)]);
  bf16*Ow=Ow0+(long)(wid*QBLK)*QP;
  { bf16*stg=(bf16*)(shm+LDS_OST)+wid*2048;
    #pragma unroll
    for(int r=0;r<16;++r){const int orow=crow(r,hi);
      #pragma unroll
      for(int d0=0;d0<2;++d0)stg[orow*64+d0*32+r32]=__float2bfloat16(o[d0][r]*rli[r]);}
    asm volatile("s_waitcnt lgkmcnt(0)":::"memory");
    #pragma unroll
    for(int i=0;i<4;++i){const int row=i*8+(lane>>3),ch=lane&7; const u32x4 v=*(const u32x4*)(stg+row*64+ch*8); ATTN_STORE16(Ow+(long)row*QP+ch*8,v);} }
  asm volatile("s_waitcnt lgkmcnt(0)\n\ts_barrier":::"memory");
  #undef DMA_K
  #undef DMA_V
  #undef CMASK
  #undef START
  #undef NEGM_SET
  #undef RESC
  #undef ROT
}
constexpr int ATTN_LDS_BYTES=LDS_BYTES;
#undef SBAR
#undef WAIT_BAR
}
constexpr float ATT_C2 = 0.125f * 1.4426950408889634f;
__device__ __forceinline__ void swa_phase(const Frame& F_in, const Params& P_in, int l) {
    PH_BEGIN
    bf16* AQ = (bf16*)(P.ws + WS_R + RO_AQ); const bf16* AK = (const bf16*)(P.ws + WS_R + RO_AK); const bf16* AV = (const bf16*)(P.ws + WS_R + RO_AV);
    const float* sinks = P.in[I_SINK] + l * 8; char* shm = (char*)F.lds;
    for (int idx = F.vcu; idx < 256; idx += F.G) {
        const int bh = idx >> 4, s = idx & 15, b = bh >> 3, hq = bh & 7, hkv = hq >> 2; const float sk = sinks[hq] * 1.4426950408889634f;
        for (int i = 0; i < 2; ++i) {
            const int qb = i ? 31 - s : s; const size_t row0 = (size_t)b * SEQ + (size_t)qb * 256; const int koff = qb ? -128 : 0, NT = qb ? 6 : 4;
            attn_body::attn_unit<1, 8>((const attn_body::bf16*)(AQ + row0 * 512 + hq * 64), (attn_body::bf16*)(AQ + row0 * 512 + hq * 64), 512,
                (const attn_body::bf16*)(AK + (size_t)((long)row0 + koff) * 128 + hkv * 64), (const attn_body::bf16*)(AV + (size_t)((long)row0 + koff) * 128 + hkv * 64), 128, NT, koff, 0u, sk, shm);
        }
    }
}
__device__ __forceinline__ void moba_phase(const Frame& F_in, const Params& P_in) {
    PH_BEGIN
    bf16* BQ = (bf16*)(P.ws + WS_R + RO_BQ); const bf16* BK = (const bf16*)(P.ws + WS_R + RO_BK); const bf16* BV = (const bf16*)(P.ws + WS_R + RO_BV);
    const float* kbp = (const float*)(P.ws + WS_KBP); char* shm = (char*)F.lds; const int tid = F.tid;
    LAS float* kb_s = (LAS float*)(F.lds + 98304); LAS unsigned* sel_s = (LAS unsigned*)(F.lds + 98304 + 8192);
    for (int idx = F.vcu; idx < 256; idx += F.G) {
        const int bh = idx >> 4, s = idx & 15, b = bh >> 3, h = bh & 7;
        for (int i = 0; i < 2; ++i) {
            const int qb = i ? s : 31 - s; const size_t row0 = (size_t)b * SEQ + (size_t)qb * 256;
            for (int e = tid; e < qb * 64; e += 512) { const int n = e >> 6, d = e & 63; const float* kp = kbp + ((size_t)(b * 32 + n) * 2) * 512 + h * 64 + d; kb_s[e] = kp[0] + kp[512]; }
            __syncthreads();
            if (tid < 256) {
                const GAS v4u* qp = (const GAS v4u*)(BQ + (row0 + tid) * 512 + h * 64); float q[64];
#pragma unroll
                for (int c = 0; c < 8; ++c) { const v4u w = qp[c]; q[8 * c] = bflo(w.x); q[8 * c + 1] = bfhi(w.x); q[8 * c + 2] = bflo(w.y); q[8 * c + 3] = bfhi(w.y); q[8 * c + 4] = bflo(w.z); q[8 * c + 5] = bfhi(w.z); q[8 * c + 6] = bflo(w.w); q[8 * c + 7] = bfhi(w.w); }
                float v1 = -INFINITY, v2 = -INFINITY, v3 = -INFINITY; int i1 = 0, i2 = 0, i3 = 0;
                for (int n = 0; n < qb; ++n) { const LAS f32x4* kr = (const LAS f32x4*)(kb_s + n * 64); float sc = 0.f;
#pragma unroll
                    for (int c = 0; c < 16; ++c) { const f32x4 kv = kr[c]; sc += (q[4 * c] * kv.x + q[4 * c + 1] * kv.y) + (q[4 * c + 2] * kv.z + q[4 * c + 3] * kv.w); }
                    if (sc > v1) { v3 = v2; i3 = i2; v2 = v1; i2 = i1; v1 = sc; i1 = n; } else if (sc > v2) { v3 = v2; i3 = i2; v2 = sc; i2 = n; } else if (sc > v3) { v3 = sc; i3 = n; } }
                unsigned mask;
                if (qb <= 3) mask = (1u << qb) - 1u; else mask = (1u << i1) | (1u << i2) | (1u << i3);
                sel_s[tid] = mask;
            }
            __syncthreads();
            const unsigned selmask = sel_s[F.wave * 32 + (F.lane & 31)];
            attn_body::attn_unit<0, 8>((const attn_body::bf16*)(BQ + row0 * 512 + h * 64), (attn_body::bf16*)(BQ + row0 * 512 + h * 64), 512,
                (const attn_body::bf16*)(BK + (size_t)b * SEQ * 512 + h * 64), (const attn_body::bf16*)(BV + (size_t)b * SEQ * 512 + h * 64), 512, 4 * (qb + 1), 0, selmask, 0.f, shm);
        }
    }
}
namespace epi {
using pg8::f32x4; using pg8::Unit; using pg8::u32x4; using pg8::cvt_pk_bf16;
typedef const f32x4 (&Acc)[2][2][4][2];
__device__ __forceinline__ float sigmoidf_(float x) { return 1.0f / (1.0f + __expf(-x)); }
__device__ __forceinline__ float siluf_(float x) { return x / (1.0f + __expf(-x)); }
__device__ __forceinline__ float logsigmoidf_(float x) { return fminf(x, 0.f) - log1pf(__expf(-fabsf(x))); }
__device__ __forceinline__ u32x4 pack8(const f32x4& a, const f32x4& b) { u32x4 w; w.x = cvt_pk_bf16(a[0], a[1]); w.y = cvt_pk_bf16(a[2], a[3]); w.z = cvt_pk_bf16(b[0], b[1]); w.w = cvt_pk_bf16(b[2], b[3]); return w; }
__device__ __forceinline__ void unpack8(const u32x4& w, f32x4& a, f32x4& b) { a = (f32x4){bflo(w.x), bfhi(w.x), bflo(w.y), bfhi(w.y)}; b = (f32x4){bflo(w.z), bfhi(w.z), bflo(w.w), bfhi(w.w)}; }
__device__ __forceinline__ float row_rs(const float* ssq, int row) {
    const f32x4* p = (const f32x4*)(ssq + (size_t)row * 16); const f32x4 a = p[0], b = p[1], c = p[2], d = p[3];
    const float s = ((a[0] + a[1]) + (a[2] + a[3])) + ((b[0] + b[1]) + (b[2] + b[3])) + ((c[0] + c[1]) + (c[2] + c[3])) + ((d[0] + d[1]) + (d[2] + d[3]));
    return 1.0f / sqrtf(s * (1.0f / DM) + RMS_EPS);
}

struct EpiInproj {
    static constexpr bool PERM = true;
    unsigned char* R; const float* ssq; const float* gbias; float* kbp;
    template <int ACT, bool KSUM>
    __device__ __forceinline__ void store_half(Acc acc, const int bj, bf16* dst, const int ldc, const int col, const Unit& u, int wr, int fr, const float sc = 1.0f) const {
        f32x4 ks0 = (f32x4){0.f, 0.f, 0.f, 0.f}, ks1 = ks0;
#pragma unroll
        for (int ai = 0; ai < 2; ++ai)
#pragma unroll
            for (int m = 0; m < 4; ++m) {
                const int row = u.pm * 256 + ai * 128 + wr * 64 + m * 16 + fr; const float rs = row_rs(ssq, row) * sc;
                f32x4 v0 = acc[ai][bj][m][0] * rs, v1 = acc[ai][bj][m][1] * rs;
                if (ACT == 1) {
#pragma unroll
                    for (int i = 0; i < 4; ++i) { v0[i] = siluf_(v0[i]); v1[i] = siluf_(v1[i]); }
                }
                if (KSUM) { ks0 += v0; ks1 += v1; }
                *(u32x4*)(dst + (size_t)row * ldc + col) = pack8(v0, v1);
            }
        if (KSUM) {
#pragma unroll
            for (int i = 0; i < 4; ++i) {
#pragma unroll
                for (int o = 1; o < 16; o <<= 1) { ks0[i] += __shfl_xor(ks0[i], o); ks1[i] += __shfl_xor(ks1[i], o); }
            }
            if (fr == 0) { float* kp = kbp + ((size_t)u.pm * 2 + wr) * 512 + col; *(f32x4*)kp = ks0; *(f32x4*)(kp + 4) = ks1; }
        }
    }
    __device__ __forceinline__ void operator()(Acc acc, const Unit& u, int wr, int wc, int fr, int fq) const {
        const int pn = u.pn; const int c0 = wc * 32 + 8 * fq;
        if (pn == 15) {
#pragma unroll
            for (int bj = 0; bj < 2; ++bj) { const int col = bj * 128 + c0; const f32x4 b0 = *(const f32x4*)(gbias + col), b1 = *(const f32x4*)(gbias + col + 4);
#pragma unroll
                for (int ai = 0; ai < 2; ++ai)
#pragma unroll
                    for (int m = 0; m < 4; ++m) {
                        const int row = u.pm * 256 + ai * 128 + wr * 64 + m * 16 + fr; const float rs = row_rs(ssq, row);
                        f32x4 v0 = acc[ai][bj][m][0] * rs + b0, v1 = acc[ai][bj][m][1] * rs + b1;
#pragma unroll
                        for (int i = 0; i < 4; ++i) { v0[i] = logsigmoidf_(v0[i]) * (1.0f / 16.0f); v1[i] = logsigmoidf_(v1[i]) * (1.0f / 16.0f); }
                        float* gl = (float*)(R + RO_GL) + (size_t)row * 256 + col; *(f32x4*)gl = v0; *(f32x4*)(gl + 4) = v1;
                    } }
        } else if (pn == 5 || pn == 6) {
            bf16* dst = (bf16*)(R + RO_BK); const int cb = (pn - 5) * 256 + c0;
            store_half<0, true>(acc, 0, dst, 512, cb, u, wr, fr); store_half<0, true>(acc, 1, dst, 512, cb + 128, u, wr, fr);
        } else if (pn == 13 || pn == 14) {
            bf16* dst = (bf16*)(R + RO_CR); const int cb = (pn - 13) * 256 + c0;
            store_half<1, false>(acc, 0, dst, 512, cb, u, wr, fr); store_half<1, false>(acc, 1, dst, 512, cb + 128, u, wr, fr);
        } else if (pn == 2) {
            store_half<0, false>(acc, 0, (bf16*)(R + RO_AK), 128, c0, u, wr, fr); store_half<0, false>(acc, 1, (bf16*)(R + RO_AV), 128, c0, u, wr, fr);
        } else {
            bf16* dst; int ldc, cb; float sc = 1.0f;
            if (pn < 2)        { dst = (bf16*)(R + RO_AQ); ldc = 512; cb = pn * 256; sc = ATT_C2; }
            else if (pn < 5)   { dst = (bf16*)(R + RO_BQ); ldc = 512; cb = (pn - 3) * 256; sc = ATT_C2; }
            else if (pn < 9)   { dst = (bf16*)(R + RO_BV); ldc = 512; cb = (pn - 7) * 256; }
            else if (pn == 9)  { dst = (bf16*)(R + RO_CQ); ldc = 256; cb = 0; }
            else if (pn == 10) { dst = (bf16*)(R + RO_CK); ldc = 256; cb = 0; }
            else               { dst = (bf16*)(R + RO_CV); ldc = 512; cb = (pn - 11) * 256; }
            store_half<0, false>(acc, 0, dst, ldc, cb + c0, u, wr, fr, sc); store_half<0, false>(acc, 1, dst, ldc, cb + c0 + 128, u, wr, fr, sc);
        }
    }
};
struct EpiGates {
    static constexpr bool PERM = true;
    bf16* G; const float* ssq;
    __device__ __forceinline__ void operator()(Acc acc, const Unit& u, int wr, int wc, int fr, int fq) const {
#pragma unroll
        for (int ai = 0; ai < 2; ++ai)
#pragma unroll
            for (int m = 0; m < 4; ++m) {
                const int row = u.pm * 256 + ai * 128 + wr * 64 + m * 16 + fr; const float rs = row_rs(ssq, row);
#pragma unroll
                for (int bj = 0; bj < 2; ++bj) { f32x4 v0 = acc[ai][bj][m][0] * rs, v1 = acc[ai][bj][m][1] * rs;
#pragma unroll
                    for (int i = 0; i < 4; ++i) { v0[i] = sigmoidf_(v0[i]); v1[i] = sigmoidf_(v1[i]); }
                    *(u32x4*)(G + (size_t)row * NGATES + u.pn * 256 + bj * 128 + wc * 32 + 8 * fq) = pack8(v0, v1); }
            }
    }
};
struct EpiBranch {
    static constexpr bool PERM = true;
    const bf16* G; bf16* Y;
    __device__ __forceinline__ void operator()(Acc acc, const Unit& u, int wr, int wc, int fr, int fq) const {
        const int seg = u.aux;
#pragma unroll
        for (int ai = 0; ai < 2; ++ai)
#pragma unroll
            for (int m = 0; m < 4; ++m) {
                const int row = u.pm * 256 + ai * 128 + wr * 64 + m * 16 + fr;
#pragma unroll
                for (int bj = 0; bj < 2; ++bj) { const int col = u.pn * 256 + bj * 128 + wc * 32 + 8 * fq;
                    const u32x4 gw = *(const u32x4*)(G + (size_t)row * NGATES + seg * DM + col); f32x4 g0, g1; unpack8(gw, g0, g1);
                    f32x4 y0 = acc[ai][bj][m][0] * g0, y1 = acc[ai][bj][m][1] * g1;
                    bf16* yp = Y + (size_t)row * DM + col;
                    if (seg > 0) { const u32x4 ow = *(const u32x4*)yp; f32x4 o0, o1; unpack8(ow, o0, o1); y0 += o0; y1 += o1; }
                    *(u32x4*)yp = pack8(y0, y1); }
            }
    }
};
struct EpiResid {
    static constexpr bool PERM = true;
    const float* base; float* out; bf16* XB; float* ssq;
    __device__ __forceinline__ void operator()(Acc acc, const Unit& u, int wr, int wc, int fr, int fq) const {
#pragma unroll
        for (int ai = 0; ai < 2; ++ai)
#pragma unroll
            for (int m = 0; m < 4; ++m) {
                const int row = u.pm * 256 + ai * 128 + wr * 64 + m * 16 + fr; float s = 0.f;
#pragma unroll
                for (int bj = 0; bj < 2; ++bj) { const size_t off = (size_t)row * DM + u.pn * 256 + bj * 128 + wc * 32 + 8 * fq;
                    const f32x4 x0 = *(const f32x4*)(base + off) + acc[ai][bj][m][0], x1 = *(const f32x4*)(base + off + 4) + acc[ai][bj][m][1];
                    *(f32x4*)(out + off) = x0; *(f32x4*)(out + off + 4) = x1;
                    *(u32x4*)(XB + off) = pack8(x0, x1);
                    s += ((x0[0] * x0[0] + x0[1] * x0[1]) + (x0[2] * x0[2] + x0[3] * x0[3])) + ((x1[0] * x1[0] + x1[1] * x1[1]) + (x1[2] * x1[2] + x1[3] * x1[3])); }
                s += __shfl_xor(s, 16); s += __shfl_xor(s, 32);
                if (fq == 0) ssq[(size_t)row * 16 + u.pn * 4 + wc] = s;
            }
    }
};
struct EpiSwiglu {
    static constexpr bool PERM = true;
    bf16* H; int ldh; const float* ssq; const float* rsg;
    __device__ __forceinline__ void operator()(Acc acc, const Unit& u, int wr, int wc, int fr, int fq) const {
#pragma unroll
        for (int ai = 0; ai < 2; ++ai)
#pragma unroll
            for (int m = 0; m < 4; ++m) {
                const int row = u.pm * 256 + ai * 128 + wr * 64 + m * 16 + fr; const float rs = rsg ? rsg[row] : row_rs(ssq, row);
                f32x4 g0 = acc[ai][0][m][0] * rs, g1 = acc[ai][0][m][1] * rs; const f32x4 u0 = acc[ai][1][m][0] * rs, u1 = acc[ai][1][m][1] * rs;
#pragma unroll
                for (int i = 0; i < 4; ++i) { g0[i] = siluf_(g0[i]) * u0[i]; g1[i] = siluf_(g1[i]) * u1[i]; }
                *(u32x4*)(H + (size_t)row * ldh + u.aux * 128 + wc * 32 + 8 * fq) = pack8(g0, g1);
            }
    }
};
struct EpiMoeDown {
    static constexpr bool PERM = true;
    bf16* YE; const float* pw;
    __device__ __forceinline__ void operator()(Acc acc, const Unit& u, int wr, int wc, int fr, int fq) const {
#pragma unroll
        for (int ai = 0; ai < 2; ++ai)
#pragma unroll
            for (int m = 0; m < 4; ++m) {
                const int row = u.pm * 256 + ai * 128 + wr * 64 + m * 16 + fr; const float p = pw[row];
#pragma unroll
                for (int bj = 0; bj < 2; ++bj) *(u32x4*)(YE + (size_t)row * DM + u.pn * 256 + bj * 128 + wc * 32 + 8 * fq) = pack8(acc[ai][bj][m][0] * p, acc[ai][bj][m][1] * p);
            }
    }
};
}
__device__ __forceinline__ float rdl(float v, int l) { return __builtin_bit_cast(float, __builtin_amdgcn_readlane(__builtin_bit_cast(int, v), l)); }
__device__ __forceinline__ float qdot64(float q, const bf16* p) {
    const GAS v4u* kp = (const GAS v4u*)p; float s = 0.f;
#pragma unroll
    for (int c = 0; c < 8; ++c) { const v4u w = kp[c];
        s += rdl(q, 8 * c + 0) * bflo(w.x) + rdl(q, 8 * c + 1) * bfhi(w.x) + rdl(q, 8 * c + 2) * bflo(w.y) + rdl(q, 8 * c + 3) * bfhi(w.y)
           + rdl(q, 8 * c + 4) * bflo(w.z) + rdl(q, 8 * c + 5) * bfhi(w.z) + rdl(q, 8 * c + 6) * bflo(w.w) + rdl(q, 8 * c + 7) * bfhi(w.w); }
    return s;
}
__device__ __forceinline__ float pv64(float o, float p, const bf16* V, size_t row0, int ldv, int vcol, int lane) {
#pragma unroll 16
    for (int j = 0; j < 64; ++j) o += rdl(p, j) * bf2f(V[(row0 + j) * ldv + vcol + lane]);
    return o;
}

__device__ __forceinline__ void swa_naive(const Frame& F_in, const Params& P_in, int l, int gw, int NGW) {
    PH_BEGIN
    bf16* AQ = (bf16*)(P.ws + WS_R + RO_AQ); const bf16* AK = (const bf16*)(P.ws + WS_R + RO_AK); const bf16* AV = (const bf16*)(P.ws + WS_R + RO_AV);
    const float* sinks = P.in[I_SINK] + l * 8; const int lane = F.lane;
    for (int item = gw; item < T * 8; item += NGW) {
        const int t = item >> 3, hq = item & 7, hkv = hq >> 2, tl = t & (SEQ - 1); const size_t rb = (size_t)(t - tl);
        const float q = bf2f(AQ[(size_t)t * 512 + hq * 64 + lane]) * 0.125f;
        const int kA = tl - 127 + lane, kB = tl - 63 + lane; const bool vA = kA >= 0, vB = kB >= 0;
        const int kA0 = tl - 127 < 0 ? 0 : tl - 127, kB0 = tl - 63 < 0 ? 0 : tl - 63;
        float sA = qdot64(q, AK + (rb + (vA ? kA : 0)) * 128 + hkv * 64), sB = qdot64(q, AK + (rb + (vB ? kB : 0)) * 128 + hkv * 64);
        sA = vA ? sA : -INFINITY; sB = vB ? sB : -INFINITY;
        const float sink = sinks[hq];
        const float m = fmaxf(wave_max(fmaxf(sA, sB)), sink);
        const float pA = vA ? __expf(sA - m) : 0.f, pB = vB ? __expf(sB - m) : 0.f;
        const float den = wave_sum(pA + pB) + __expf(sink - m);
        float o = 0.f;
        if (tl >= 127) { o = pv64(o, pA, AV, rb + tl - 127, 128, hkv * 64, lane); o = pv64(o, pB, AV, rb + tl - 63, 128, hkv * 64, lane); }
        else {
#pragma unroll 8
            for (int j = 0; j < 64; ++j) { const int ka = tl - 127 + j, kb = tl - 63 + j;
                o += rdl(pA, j) * bf2f(AV[(rb + (ka < 0 ? 0 : ka)) * 128 + hkv * 64 + lane]) + rdl(pB, j) * bf2f(AV[(rb + (kb < 0 ? 0 : kb)) * 128 + hkv * 64 + lane]); }
        }
        (void)kA0; (void)kB0;
        AQ[(size_t)t * 512 + hq * 64 + lane] = (bf16)f2bf(o / den);
    }
}

__device__ __forceinline__ void moba_naive(const Frame& F_in, const Params& P_in, int gw, int NGW) {
    PH_BEGIN
    bf16* BQ = (bf16*)(P.ws + WS_R + RO_BQ); const bf16* BK = (const bf16*)(P.ws + WS_R + RO_BK); const bf16* BV = (const bf16*)(P.ws + WS_R + RO_BV);
    const float* kbp = (const float*)(P.ws + WS_KBP); const int lane = F.lane;
    for (int item = gw; item < T * 8; item += NGW) {
        const int t = item >> 3, h = item & 7, b = t >> 13, tl = t & (SEQ - 1), cur = tl >> 8; const size_t rb = (size_t)b * SEQ;
        const float q = bf2f(BQ[(size_t)t * 512 + h * 64 + lane]);
        float gs = -INFINITY;
        { const int n = lane < cur ? lane : 0; const float* k0 = kbp + ((size_t)(b * 32 + n) * 2) * 512 + h * 64; float s = 0.f;
#pragma unroll 8
          for (int d = 0; d < 64; ++d) s += rdl(q, d) * (k0[d] + k0[512 + d]);
          if (lane < cur) gs = s * (1.0f / 256.0f); }
        const int nsel = cur < 3 ? cur : 3; int s0 = 0, s1 = 0, s2 = 0;
        for (int r = 0; r < nsel; ++r) { const float mx = wave_max(gs); const unsigned long long bal = __ballot(gs == mx); const int j = __ffsll((long long)bal) - 1;
            if (r == 0) s0 = j; else if (r == 1) s1 = j; else s2 = j; if (lane == j) gs = -INFINITY; }
        float m = -INFINITY, lsum = 0.f, o = 0.f; const float qs = q * 0.125f;
        for (int i = 0; i <= nsel; ++i) {
            const bool own = (i == nsel); const int blk = own ? cur : (i == 0 ? s0 : (i == 1 ? s1 : s2));
            for (int tile = 0; tile < 4; ++tile) {
                const int kp0 = blk * 256 + tile * 64; if (own && kp0 > tl) break;
                const int kpos = kp0 + lane; const bool valid = !own || kpos <= tl;
                float s = qdot64(qs, BK + (rb + kpos) * 512 + h * 64); s = valid ? s : -INFINITY;
                const float mn = fmaxf(m, wave_max(s)); const float sc = __expf(m - mn); const float p = valid ? __expf(s - mn) : 0.f;
                lsum = lsum * sc + wave_sum(p); o = pv64(o * sc, p, BV, rb + kp0, 512, h * 64, lane); m = mn;
            }
        }
        BQ[(size_t)t * 512 + h * 64 + lane] = (bf16)f2bf(o / lsum);
    }
}

__device__ __forceinline__ void gla_cumsum(const float* GL, size_t t0, int h, LAS float* bcum, int tid) {
    if (tid < 64) { float run = 0.f;
#pragma unroll 8
        for (int s = 0; s < 64; ++s) { run += GL[(t0 + s) * 256 + h * 64 + tid]; bcum[s * 64 + tid] = run; } }
}
__device__ __forceinline__ void gla_pass1(const Frame& F_in, const Params& P_in) {
    PH_BEGIN
    const float* GL = (const float*)(P.ws + WS_R + RO_GL); const bf16* CK = (const bf16*)(P.ws + WS_R + RO_CK); const bf16* CV = (const bf16*)(P.ws + WS_R + RO_CV);
    float* S = (float*)(P.ws + WS_S); float* DEC = (float*)(P.ws + WS_DEC);
    LAS float* bcum = (LAS float*)(F.lds); LAS float* kd = bcum + 4096; LAS float* vv = kd + 4096; const int tid = F.tid;
    for (int unit = F.vcu; unit < 8 * 128; unit += F.G) {
        const int bh = unit >> 7, n = unit & 127, b = bh >> 2, h = bh & 3; const size_t t0 = (size_t)b * SEQ + n * 64;
        gla_cumsum(GL, t0, h, bcum, tid);
        __syncthreads();
        for (int idx = tid; idx < 4096; idx += 512) { const int s = idx >> 6, d = idx & 63; kd[idx] = bf2f(CK[(t0 + s) * 256 + h * 64 + d]) * __expf(bcum[63 * 64 + d] - bcum[idx]); }
        for (int idx = tid; idx < 8192; idx += 512) { const int s = idx >> 7, e = idx & 127; vv[idx] = bf2f(CV[(t0 + s) * 512 + h * 128 + e]); }
        __syncthreads();
        { const int d = tid >> 3, e0 = (tid & 7) * 16; float a[16];
#pragma unroll
          for (int j = 0; j < 16; ++j) a[j] = 0.f;
          for (int s = 0; s < 64; ++s) { const float kv = kd[s * 64 + d];
#pragma unroll
              for (int j = 0; j < 16; ++j) a[j] += kv * vv[s * 128 + e0 + j]; }
          float* so = S + (((size_t)bh * 128 + n) * 64 + d) * 128 + e0;
#pragma unroll
          for (int j = 0; j < 16; j += 4) *(f32x4*)(so + j) = (f32x4){a[j], a[j + 1], a[j + 2], a[j + 3]};
          if (tid < 64) DEC[((size_t)bh * 128 + n) * 64 + tid] = __expf(bcum[63 * 64 + tid]); }
        __syncthreads();
    }
}
__device__ __forceinline__ void gla_scan(const Frame& F_in, const Params& P_in) {
    PH_BEGIN
    float* S = (float*)(P.ws + WS_S); const float* DEC = (const float*)(P.ws + WS_DEC);
    if (F.tid >= 256) return;
    for (int grp = F.vcu; grp < 256; grp += F.G) {
        const int idx = grp * 256 + F.tid, bh = idx >> 13, d = (idx >> 7) & 63, e = idx & 127;
        float* sp = S + ((size_t)bh * 128 * 64 + d) * 128 + e; const float* dp = DEC + (size_t)bh * 128 * 64 + d; float st = 0.f;
        for (int n0 = 0; n0 < 128; n0 += 8) { float u[8], dc[8];
#pragma unroll
            for (int j = 0; j < 8; ++j) { u[j] = sp[(size_t)(n0 + j) * 8192]; dc[j] = dp[(n0 + j) * 64]; }
#pragma unroll
            for (int j = 0; j < 8; ++j) { sp[(size_t)(n0 + j) * 8192] = st; st = dc[j] * st + u[j]; } }
    }
}
__device__ __forceinline__ void gla_pass3(const Frame& F_in, const Params& P_in, int l) {
    PH_BEGIN
    const float* GL = (const float*)(P.ws + WS_R + RO_GL); const bf16* CQ = (const bf16*)(P.ws + WS_R + RO_CQ); const bf16* CK = (const bf16*)(P.ws + WS_R + RO_CK); const bf16* CV = (const bf16*)(P.ws + WS_R + RO_CV);
    bf16* CR = (bf16*)(P.ws + WS_R + RO_CR); const float* S = (const float*)(P.ws + WS_S); const float* gng = P.in[I_GNG] + l * 512;
    LAS float* bcum = (LAS float*)(F.lds); LAS float* qin = bcum + 4096; LAS float* kin = qin + 4096; LAS float* am = kin + 4096; LAS float* vv = am + 4096; LAS float* sp = vv + 8192; const int tid = F.tid;
    for (int unit = F.vcu; unit < 8 * 128; unit += F.G) {
        const int bh = unit >> 7, n = unit & 127, b = bh >> 2, h = bh & 3; const size_t t0 = (size_t)b * SEQ + n * 64;
        gla_cumsum(GL, t0, h, bcum, tid);
        __syncthreads();
        for (int idx = tid; idx < 4096; idx += 512) { const int s = idx >> 6, d = idx & 63; const float bb = bcum[idx];
            qin[idx] = bf2f(CQ[(t0 + s) * 256 + h * 64 + d]) * 0.125f * __expf(bb); kin[idx] = bf2f(CK[(t0 + s) * 256 + h * 64 + d]) * __expf(-bb); }
        for (int idx = tid; idx < 8192; idx += 512) { const int s = idx >> 7, e = idx & 127; vv[idx] = bf2f(CV[(t0 + s) * 512 + h * 128 + e]); sp[idx] = S[(((size_t)bh * 128 + n) * 64) * 128 + idx]; }
        __syncthreads();
        for (int idx = tid; idx < 4096; idx += 512) { const int tt = idx >> 6, s = idx & 63; float a = 0.f;
            if (s <= tt) {
#pragma unroll 8
                for (int d = 0; d < 64; ++d) a += qin[tt * 64 + d] * kin[s * 64 + d]; }
            am[idx] = a; }
        __syncthreads();
        { const int tt = tid >> 3, e0 = (tid & 7) * 16; float o[16];
#pragma unroll
          for (int j = 0; j < 16; ++j) o[j] = 0.f;
          for (int s = 0; s <= tt; ++s) { const float a = am[tt * 64 + s];
#pragma unroll
              for (int j = 0; j < 16; ++j) o[j] += a * vv[s * 128 + e0 + j]; }
          for (int d = 0; d < 64; ++d) { const float qv = qin[tt * 64 + d];
#pragma unroll
              for (int j = 0; j < 16; ++j) o[j] += qv * sp[d * 128 + e0 + j]; }
          float ms = 0.f;
#pragma unroll
          for (int j = 0; j < 16; ++j) ms += o[j] * o[j];
          ms += __shfl_xor(ms, 1); ms += __shfl_xor(ms, 2); ms += __shfl_xor(ms, 4);
          const float rinv = 1.0f / sqrtf(ms * (1.0f / 128.0f) + RMS_EPS);
          bf16* crp = CR + (t0 + tt) * 512 + h * 128 + e0;
#pragma unroll
          for (int j = 0; j < 16; ++j) crp[j] = (bf16)f2bf(o[j] * rinv * gng[h * 128 + e0 + j] * bf2f(crp[j])); }
        __syncthreads();
    }
}
namespace gla {
typedef short bf16x8 __attribute__((ext_vector_type(8)));
typedef float f32x16 __attribute__((ext_vector_type(16)));
constexpr int PITCH = 72;
constexpr int OFF_TOT = 0;
constexpr int OFF_Q = 2048;
constexpr int OFF_K = OFF_Q + 64 * PITCH * 2;
constexpr int OFF_V = OFF_K + 64 * PITCH * 2;
constexpr int OFF_ST = OFF_V + 128 * PITCH * 2;
constexpr int OFF_A = OFF_ST + 128 * PITCH * 2;
constexpr int OFF_O = OFF_A + 8 * 32 * PITCH * 2;
constexpr int OPITCH = 132;
static_assert(OFF_O + 64 * OPITCH * 4 <= RING_BYTES, "gla lds");
__device__ __forceinline__ int crow(int r, int hf) { return (r & 3) + 8 * (r >> 2) + 4 * hf; }
__device__ __forceinline__ bf16x8 ldfrag(const LAS unsigned char* base, int row, int k) { return *(const LAS bf16x8*)(base + (row * PITCH + k) * 2); }

__device__ __forceinline__ void chunk_cumsum(const float* GL, size_t t0, int h, LAS unsigned char* lds, int tid, float (&b)[8], float& blast) {
    const int d = tid & 63, seg = tid >> 6; LAS float* tot = (LAS float*)(lds + OFF_TOT);
    float run = 0.f;
#pragma unroll
    for (int i = 0; i < 8; ++i) { run += GL[(t0 + seg * 8 + i) * 256 + h * 64 + d]; b[i] = run; }
    tot[seg * 64 + d] = run;
    __syncthreads();
    float off = 0.f, all = 0.f;
#pragma unroll
    for (int s = 0; s < 8; ++s) { const float v = tot[s * 64 + d]; all += v; if (s < seg) off += v; }
#pragma unroll
    for (int i = 0; i < 8; ++i) b[i] += off;
    blast = all;
}
__device__ __forceinline__ void stage_vT(const bf16* CV, size_t t0, int h, LAS unsigned char* lds, int tid) {
#pragma unroll
    for (int it = 0; it < 2; ++it) { const int item = tid + 512 * it, e = item & 127, sg = item >> 7;
        unsigned short v[8];
#pragma unroll
        for (int i = 0; i < 8; ++i) v[i] = CV[(t0 + sg * 8 + i) * 512 + h * 128 + e];
        v4u w; w.x = v[0] | ((unsigned)v[1] << 16); w.y = v[2] | ((unsigned)v[3] << 16); w.z = v[4] | ((unsigned)v[5] << 16); w.w = v[6] | ((unsigned)v[7] << 16);
        *(LAS v4u*)(lds + OFF_V + (e * PITCH + sg * 8) * 2) = w; }
}

__device__ __forceinline__ void pass1(const Frame& F_in, const Params& P_in) {
    PH_BEGIN
    const float* GL = (const float*)(P.ws + WS_R + RO_GL); const bf16* CK = (const bf16*)(P.ws + WS_R + RO_CK); const bf16* CV = (const bf16*)(P.ws + WS_R + RO_CV);
    float* S = (float*)(P.ws + WS_S); float* DEC = (float*)(P.ws + WS_DEC);
    LAS unsigned char* lds = F.lds; const int tid = F.tid, lane = F.lane, r = lane & 31, hf = lane >> 5, w = F.wave, mt = w >> 2, nt = w & 3;
    for (int unit = F.vcu; unit < 8 * 128; unit += F.G) {
        const int bh = unit >> 7, n = unit & 127, b_ = bh >> 2, h = bh & 3; const size_t t0 = (size_t)b_ * SEQ + n * 64;
        float b[8], blast; chunk_cumsum(GL, t0, h, lds, tid, b, blast);
        { const int d = tid & 63, seg = tid >> 6; unsigned pk[4];
#pragma unroll
          for (int i = 0; i < 8; i += 2) { const float k0 = bf2f(CK[(t0 + seg * 8 + i) * 256 + h * 64 + d]) * __expf(blast - b[i]), k1 = bf2f(CK[(t0 + seg * 8 + i + 1) * 256 + h * 64 + d]) * __expf(blast - b[i + 1]); pk[i >> 1] = pk2(k0, k1); }
          *(LAS v4u*)(lds + OFF_Q + (d * PITCH + seg * 8) * 2) = (v4u){pk[0], pk[1], pk[2], pk[3]};
          if (seg == 0) DEC[((size_t)bh * 128 + n) * 64 + d] = __expf(blast); }
        stage_vT(CV, t0, h, lds, tid);
        __syncthreads();
        f32x16 acc = f32x16{};
#pragma unroll
        for (int ks = 0; ks < 4; ++ks) acc = __builtin_amdgcn_mfma_f32_32x32x16_bf16(ldfrag(lds + OFF_Q, mt * 32 + r, ks * 16 + 8 * hf), ldfrag(lds + OFF_V, nt * 32 + r, ks * 16 + 8 * hf), acc, 0, 0, 0);
        float* so = S + (((size_t)bh * 128 + n) * 64 + mt * 32) * 128 + nt * 32 + r;
#pragma unroll
        for (int g = 0; g < 16; ++g) so[(size_t)crow(g, hf) * 128] = acc[g];
        __syncthreads();
    }
}
__device__ __forceinline__ void pass3(const Frame& F_in, const Params& P_in, int l) {
    PH_BEGIN
    const float* GL = (const float*)(P.ws + WS_R + RO_GL); const bf16* CQ = (const bf16*)(P.ws + WS_R + RO_CQ); const bf16* CK = (const bf16*)(P.ws + WS_R + RO_CK); const bf16* CV = (const bf16*)(P.ws + WS_R + RO_CV);
    bf16* CR = (bf16*)(P.ws + WS_R + RO_CR); const float* S = (const float*)(P.ws + WS_S); const float* gng = P.in[I_GNG] + l * 512;
    LAS unsigned char* lds = F.lds; const int tid = F.tid, lane = F.lane, r = lane & 31, hf = lane >> 5, w = F.wave, mt = w >> 2, nt = w & 3;
    for (int unit = F.vcu; unit < 8 * 128; unit += F.G) {
        const int bh = unit >> 7, n = unit & 127, b_ = bh >> 2, h = bh & 3; const size_t t0 = (size_t)b_ * SEQ + n * 64;
        float b[8], blast; chunk_cumsum(GL, t0, h, lds, tid, b, blast);
        { const int d = tid & 63, seg = tid >> 6;
#pragma unroll
          for (int i = 0; i < 8; ++i) { const size_t gi = (t0 + seg * 8 + i) * 256 + h * 64 + d; const int s = seg * 8 + i;
              *(LAS unsigned short*)(lds + OFF_Q + (s * PITCH + d) * 2) = (unsigned short)f2bf(bf2f(CQ[gi]) * 0.125f * __expf(b[i]));
              *(LAS unsigned short*)(lds + OFF_K + (s * PITCH + d) * 2) = (unsigned short)f2bf(bf2f(CK[gi]) * __expf(-b[i])); } }
        stage_vT(CV, t0, h, lds, tid);
        { const float* sp = S + (((size_t)bh * 128 + n) * 64) * 128;
#pragma unroll
          for (int it = 0; it < 2; ++it) { const int item = tid + 512 * it, e = item & 127, dg = item >> 7; float v[8];
#pragma unroll
              for (int i = 0; i < 8; ++i) v[i] = sp[(size_t)(dg * 8 + i) * 128 + e];
              *(LAS v4u*)(lds + OFF_ST + (e * PITCH + dg * 8) * 2) = (v4u){pk2(v[0], v[1]), pk2(v[2], v[3]), pk2(v[4], v[5]), pk2(v[6], v[7])}; } }
        __syncthreads();
        { LAS unsigned char* as = lds + OFF_A + w * 32 * PITCH * 2;
#pragma unroll
          for (int j = 0; j < 2; ++j) { f32x16 a = f32x16{};
#pragma unroll
              for (int kd = 0; kd < 4; ++kd) a = __builtin_amdgcn_mfma_f32_32x32x16_bf16(ldfrag(lds + OFF_Q, mt * 32 + r, kd * 16 + 8 * hf), ldfrag(lds + OFF_K, j * 32 + r, kd * 16 + 8 * hf), a, 0, 0, 0);
              const int s = j * 32 + r;
#pragma unroll
              for (int g = 0; g < 16; ++g) { const int tl = crow(g, hf); const float av = (s <= mt * 32 + tl) ? a[g] : 0.f; *(LAS unsigned short*)(as + (tl * PITCH + s) * 2) = (unsigned short)f2bf(av); } }
          LDS_WAIT(); asm volatile("" ::: "memory");
          f32x16 o = f32x16{};
#pragma unroll
          for (int ks = 0; ks < 4; ++ks) o = __builtin_amdgcn_mfma_f32_32x32x16_bf16(ldfrag(as, r, ks * 16 + 8 * hf), ldfrag(lds + OFF_V, nt * 32 + r, ks * 16 + 8 * hf), o, 0, 0, 0);
#pragma unroll
          for (int kd = 0; kd < 4; ++kd) o = __builtin_amdgcn_mfma_f32_32x32x16_bf16(ldfrag(lds + OFF_Q, mt * 32 + r, kd * 16 + 8 * hf), ldfrag(lds + OFF_ST, nt * 32 + r, kd * 16 + 8 * hf), o, 0, 0, 0);
          LAS float* os = (LAS float*)(lds + OFF_O);
#pragma unroll
          for (int g = 0; g < 16; ++g) os[(mt * 32 + crow(g, hf)) * OPITCH + nt * 32 + r] = o[g]; }
        __syncthreads();
        { const int tt = tid >> 3, e0 = (tid & 7) * 16; const LAS float* os = (const LAS float*)(lds + OFF_O) + tt * OPITCH + e0; float o[16]; float ms = 0.f;
#pragma unroll
          for (int j = 0; j < 16; ++j) { o[j] = os[j]; ms += o[j] * o[j]; }
          ms += __shfl_xor(ms, 1); ms += __shfl_xor(ms, 2); ms += __shfl_xor(ms, 4);
          const float rinv = 1.0f / sqrtf(ms * (1.0f / 128.0f) + RMS_EPS);
          bf16* crp = CR + (t0 + tt) * 512 + h * 128 + e0; const v4u c0 = *(const GAS v4u*)crp, c1 = *(const GAS v4u*)(crp + 8); const float* gp = gng + h * 128 + e0;
          v4u w0, w1;
          w0.x = pk2(o[0] * rinv * gp[0] * bflo(c0.x), o[1] * rinv * gp[1] * bfhi(c0.x)); w0.y = pk2(o[2] * rinv * gp[2] * bflo(c0.y), o[3] * rinv * gp[3] * bfhi(c0.y));
          w0.z = pk2(o[4] * rinv * gp[4] * bflo(c0.z), o[5] * rinv * gp[5] * bfhi(c0.z)); w0.w = pk2(o[6] * rinv * gp[6] * bflo(c0.w), o[7] * rinv * gp[7] * bfhi(c0.w));
          w1.x = pk2(o[8] * rinv * gp[8] * bflo(c1.x), o[9] * rinv * gp[9] * bfhi(c1.x)); w1.y = pk2(o[10] * rinv * gp[10] * bflo(c1.y), o[11] * rinv * gp[11] * bfhi(c1.y));
          w1.z = pk2(o[12] * rinv * gp[12] * bflo(c1.z), o[13] * rinv * gp[13] * bfhi(c1.z)); w1.w = pk2(o[14] * rinv * gp[14] * bflo(c1.w), o[15] * rinv * gp[15] * bfhi(c1.w));
          *(GAS v4u*)crp = w0; *(GAS v4u*)(crp + 8) = w1; }
        __syncthreads();
    }
}
}
constexpr int TAB_OFF = LDSCTL_OFF + 1024;
__device__ __forceinline__ void route_r1(const Frame& F_in, const Params& P_in) {
    PH_BEGIN
    const float* Wr = P.in[I_RT]; const float* n2g = P.in[I_N2G] + 1 * DM;
    int* TOKE = (int*)(P.ws + WS_TOKE); float* TOKP = (float*)(P.ws + WS_TOKP); float* RS2 = (float*)(P.ws + WS_RS2); int* CNT = (int*)(P.ws + WS_CNT);
    LAS float* wrs = (LAS float*)(F.lds); LAS int* cnt_s = (LAS int*)(F.lds + 32768); const int tid = F.tid, lane = F.lane;
    for (int idx = tid; idx < 8192; idx += 512) wrs[idx] = Wr[idx] * n2g[idx >> 3];
    for (int tile = F.vcu; tile < T / 64; tile += F.G) {
        if (tid < 8) cnt_s[tid] = 0;
        __syncthreads();
        for (int i = 0; i < 8; ++i) {
            const int t = tile * 64 + F.wave * 8 + i;
            const GAS f32x4* xr = (const GAS f32x4*)(P.out + (size_t)t * DM) + lane;
            float s = 0.f, lg0 = 0.f, lg1 = 0.f, lg2 = 0.f, lg3 = 0.f, lg4 = 0.f, lg5 = 0.f, lg6 = 0.f, lg7 = 0.f;
#pragma unroll
            for (int j = 0; j < 4; ++j) { const f32x4 v = xr[64 * j]; s += (v.x * v.x + v.y * v.y) + (v.z * v.z + v.w * v.w);
#pragma unroll
                for (int c = 0; c < 4; ++c) { const LAS float* w = wrs + (256 * j + 4 * lane + c) * 8; const float xv = v[c];
                    lg0 += xv * w[0]; lg1 += xv * w[1]; lg2 += xv * w[2]; lg3 += xv * w[3]; lg4 += xv * w[4]; lg5 += xv * w[5]; lg6 += xv * w[6]; lg7 += xv * w[7]; } }
            s = wave_sum(s); lg0 = wave_sum(lg0); lg1 = wave_sum(lg1); lg2 = wave_sum(lg2); lg3 = wave_sum(lg3); lg4 = wave_sum(lg4); lg5 = wave_sum(lg5); lg6 = wave_sum(lg6); lg7 = wave_sum(lg7);
            const float r = 1.0f / sqrtf(s * (1.0f / DM) + RMS_EPS);
            int i1 = 0; float v1 = lg0;
            if (lg1 > v1) { v1 = lg1; i1 = 1; } if (lg2 > v1) { v1 = lg2; i1 = 2; } if (lg3 > v1) { v1 = lg3; i1 = 3; } if (lg4 > v1) { v1 = lg4; i1 = 4; }
            if (lg5 > v1) { v1 = lg5; i1 = 5; } if (lg6 > v1) { v1 = lg6; i1 = 6; } if (lg7 > v1) { v1 = lg7; i1 = 7; }
            int i2 = -1; float v2 = -INFINITY;
            if (i1 != 0 && lg0 > v2) { v2 = lg0; i2 = 0; } if (i1 != 1 && lg1 > v2) { v2 = lg1; i2 = 1; } if (i1 != 2 && lg2 > v2) { v2 = lg2; i2 = 2; } if (i1 != 3 && lg3 > v2) { v2 = lg3; i2 = 3; }
            if (i1 != 4 && lg4 > v2) { v2 = lg4; i2 = 4; } if (i1 != 5 && lg5 > v2) { v2 = lg5; i2 = 5; } if (i1 != 6 && lg6 > v2) { v2 = lg6; i2 = 6; } if (i1 != 7 && lg7 > v2) { v2 = lg7; i2 = 7; }
            const float p1 = 1.0f / (1.0f + __expf((v2 - v1) * r)), p2 = 1.0f - p1;
            if (lane == 0) { TOKE[t * 2] = i1; TOKE[t * 2 + 1] = i2; TOKP[t * 2] = p1; TOKP[t * 2 + 1] = p2; RS2[t] = r; atomicAdd((int*)&cnt_s[i1], 1); atomicAdd((int*)&cnt_s[i2], 1); }
        }
        __syncthreads();
        if (tid < 8) CNT[tile * 8 + tid] = cnt_s[tid];
        __syncthreads();
    }
}
__device__ __forceinline__ void moe_tables(const Frame& F_in, const Params& P_in, int tile) {
    PH_BEGIN
    const int* CNT = (const int*)(P.ws + WS_CNT); volatile LAS int* TAB = (volatile LAS int*)(F.lds + TAB_OFF); const int tid = F.tid;
    if (tid < 8) { int tot = 0, before = 0;
        for (int w = 0; w < T / 64; ++w) { const int c = CNT[w * 8 + tid]; if (w < tile) before += c; tot += c; }
        TAB[32 + tid] = tot; TAB[40 + tid] = before; }
    __syncthreads();
    if (tid == 0) { int mt = 0; for (int e = 0; e < 8; ++e) { TAB[e] = mt; TAB[16 + e] = mt * 256 + TAB[40 + e]; mt += (TAB[32 + e] + 255) >> 8; } TAB[8] = mt; }
    __syncthreads();
}
__device__ __forceinline__ void route_r2(const Frame& F_in, const Params& P_in) {
    PH_BEGIN
    const int* TOKE = (const int*)(P.ws + WS_TOKE); const float* TOKP = (const float*)(P.ws + WS_TOKP); const float* RS2 = (const float*)(P.ws + WS_RS2);
    int* TOKPOS = (int*)(P.ws + WS_TOKPOS); float* RSG = (float*)(P.ws + WS_RSG); float* PWG = (float*)(P.ws + WS_PWG);
    const bf16* XB = (const bf16*)(P.ws + WS_XB); bf16* XG = (bf16*)(P.ws + WS_XG);
    volatile LAS int* TAB = (volatile LAS int*)(F.lds + TAB_OFF); LAS int* pos_s = (LAS int*)(F.lds); const int tid = F.tid, lane = F.lane;
    for (int tile = F.vcu; tile < T / 64; tile += F.G) {
        moe_tables(F, P, tile);
        if (tid < 8) { int run = TAB[16 + tid];
            for (int i = 0; i < 128; ++i) if (TOKE[tile * 128 + i] == tid) { pos_s[i] = run; ++run; } }
        __syncthreads();
        for (int pr = F.wave * 16; pr < F.wave * 16 + 16; ++pr) {
            const int pos = pos_s[pr], t = tile * 64 + (pr >> 1);
            const GAS v4u* src = (const GAS v4u*)(XB + (size_t)t * DM); GAS v4u* dst = (GAS v4u*)(XG + (size_t)pos * DM);
            dst[lane] = src[lane]; dst[64 + lane] = src[64 + lane];
            if (lane == 0) { RSG[pos] = RS2[t]; PWG[pos] = TOKP[t * 2 + (pr & 1)]; TOKPOS[t * 2 + (pr & 1)] = pos; }
        }
        __syncthreads();
    }
}
struct MoeOrder {
    const char* A; const char* W; size_t wstride; size_t tstep; int nN, G, c; volatile LAS int* TAB;
    __device__ __forceinline__ bool next(int i, pg8::Unit& u) const {
        const int L = i * G + c; const int total = TAB[8] * nN; if (L >= total) return false;
        int e = 0;
#pragma unroll
        for (int k = 1; k < 8; ++k) if (L >= TAB[k] * nN) e = k;
        const int mt0 = TAB[e], mte = TAB[e + 1] - mt0, loc = L - mt0 * nN; const int pml = loc % mte, pn = loc / mte;
        u.pm = mt0 + pml; u.pn = pn; u.aux = pn; u.A = A + (size_t)u.pm * tstep; u.B = W + (size_t)e * wstride + (size_t)pn * tstep; return true;
    }
};
struct BranchOrder {
    const char* OA; const char* OB; const char* OC; const char* W; int G, c;
    __device__ __forceinline__ bool next(int i, pg8::Unit& u) const {
        const int seg = i % 3; int pm, pn; if (!pg8::static_tile(T / 256, DM / 256, G, c, i / 3, pm, pn)) return false;
        u.pm = pm; u.pn = pn; u.aux = seg; const char* o = seg == 0 ? OA : (seg == 1 ? OB : OC);
        u.A = o + (size_t)pm * 256 * 512 * 2; u.B = W + (size_t)seg * DM * 512 * 2 + (size_t)pn * 256 * 512 * 2; return true;
    }
};
template <int l>
__device__ __forceinline__ void layer_body(const Frame& F, const Params& P, const XcdBarrier& bar) {
#ifdef TIMING
#define STAMP() do { if (blockIdx.x == 0 && threadIdx.x == 0) { unsigned* c_ = (unsigned*)(P.ws + WS_CTL) + 2048; const unsigned n_ = c_[0]; ((unsigned long long*)(c_ + 2))[n_] = __builtin_amdgcn_s_memrealtime(); c_[0] = n_ + 1; } } while (0)
#else
#define STAMP() do {} while (0)
#endif
#define GRID_BAR() do { xcd_barrier(bar); STAMP(); } while (0)
    const int gw = F.vcu * NWAVES + F.wave, NGW = F.G * NWAVES;
    LAS unsigned char* ring = F.lds + RING_OFF;
    const int cb = (int)blockIdx.x;
#define WSP(T_, off) ((T_)(ws + (off)))

        { unsigned char* ws = lws(P); pg8::DenseOrder S; S.init(ws + WS_XB, ws + WS_W + WO_IN, T, NMAIN, DM, F.G, cb);
          epi::EpiInproj E{ws + WS_R, WSP(const float*, WS_SSQ), P.in[I_GBG] + l * 256, WSP(float*, WS_KBP)};
          pg8::gemm_phase<epi::EpiInproj, pg8::DenseOrder>(ring, DM, S, E); }
        GRID_BAR();
        moba_phase(F, P);
        swa_phase(F, P, l);
        STAMP();
        gla::pass1(F, P);
        GRID_BAR();
        gla_scan(F, P);
        GRID_BAR();
        gla::pass3(F, P, l);
        GRID_BAR();
        { unsigned char* ws = lws(P); pg8::DenseOrder S; S.init(ws + WS_XB, ws + WS_W + WO_IN + (size_t)NMAIN * DM * 2, T, NGATES, DM, F.G, cb);
          epi::EpiGates E{WSP(bf16*, WS_GATES), WSP(const float*, WS_SSQ)};
          pg8::gemm_phase<epi::EpiGates, pg8::DenseOrder>(ring, DM, S, E); }
        GRID_BAR();
        { unsigned char* ws = lws(P); BranchOrder S{(const char*)(ws + WS_R + RO_AQ), (const char*)(ws + WS_R + RO_BQ), (const char*)(ws + WS_R + RO_CR), (const char*)(ws + WS_W + WO_BR), F.G, cb};
          epi::EpiBranch E{WSP(const bf16*, WS_GATES), WSP(bf16*, WS_Y)};
          pg8::gemm_phase<epi::EpiBranch, BranchOrder>(ring, 512, S, E); }
        GRID_BAR();
        { unsigned char* ws = lws(P); pg8::DenseOrder S; S.init(ws + WS_Y, ws + WS_W + WO_O, T, DM, DM, F.G, cb);
          epi::EpiResid E{l == 0 ? P.in[I_X] : P.out, P.out, WSP(bf16*, WS_XB), WSP(float*, WS_SSQ)};
          pg8::gemm_phase<epi::EpiResid, pg8::DenseOrder>(ring, DM, S, E); }
        GRID_BAR();
        if constexpr (l == 0) {
            { unsigned char* ws = lws(P); pg8::DenseOrder S; S.init(ws + WS_XB, ws + WS_W + WO_GU, T, 2 * DFF, DM, F.G, cb);
              epi::EpiSwiglu E{(bf16*)(ws + WS_H), DFF, WSP(const float*, WS_SSQ), nullptr};
              pg8::gemm_phase<epi::EpiSwiglu, pg8::DenseOrder>(ring, DM, S, E); }
            GRID_BAR();
            { unsigned char* ws = lws(P); pg8::DenseOrder S; S.init(ws + WS_H, ws + WS_W + WO_D, T, DM, DFF, F.G, cb);
              epi::EpiResid E{P.out, P.out, WSP(bf16*, WS_XB), WSP(float*, WS_SSQ)};
              pg8::gemm_phase<epi::EpiResid, pg8::DenseOrder>(ring, DFF, S, E); }
            convert_layer_weights(F, P, 1, gw, NGW, true);
            GRID_BAR();
        } else {
            route_r1(F, P);
            GRID_BAR();
            route_r2(F, P);
            convert_moe_weights(F, P, gw, NGW);
            GRID_BAR();
            moe_tables(F, P, 0);
            { unsigned char* ws = lws(P); MoeOrder S{(const char*)(ws + WS_XG), (const char*)(ws + WS_WMGU), (size_t)2 * DFE * DM * 2, (size_t)256 * DM * 2, 2 * DFE / 256, F.G, cb, (volatile LAS int*)(F.lds + TAB_OFF)};
              epi::EpiSwiglu E{(bf16*)(ws + WS_HG), DFE, nullptr, (const float*)(ws + WS_RSG)};
              pg8::gemm_phase<epi::EpiSwiglu, MoeOrder>(ring, DM, S, E); }
            GRID_BAR();
            { unsigned char* ws = lws(P); MoeOrder S{(const char*)(ws + WS_HG), (const char*)(ws + WS_WMD), (size_t)DM * DFE * 2, (size_t)256 * DFE * 2, DM / 256, F.G, cb, (volatile LAS int*)(F.lds + TAB_OFF)};
              epi::EpiMoeDown E{(bf16*)(ws + WS_XG), (const float*)(ws + WS_PWG)};
              pg8::gemm_phase<epi::EpiMoeDown, MoeOrder>(ring, DFE, S, E); }
            GRID_BAR();
            final_phase(F, P, gw, NGW, true);
        }
}
__global__ void __launch_bounds__(NWAVES * 64, 2) fwd_kernel(Params P) {
    extern __shared__ __attribute__((aligned(16))) unsigned char lds[];
    Frame F;
    F.lds = (LAS unsigned char*)lds;
    F.MISC = (volatile LAS unsigned*)(F.lds + MISC_OFF);
    F.tid = threadIdx.x; F.lane = F.tid & 63; F.wave = __builtin_amdgcn_readfirstlane(F.tid >> 6);
    F.G = gridDim.x; { const int bx = blockIdx.x; F.vcu = (F.G % 8 == 0) ? (bx % 8) * (F.G / 8) + bx / 8 : bx; }
    F.ctl = (gu32*)(P.ws + WS_CTL);
    for (int u = F.tid; u < (LDS_BYTES - LDSCTL_OFF) / 4; u += NWAVES * 64) ((LAS unsigned*)(F.lds + LDSCTL_OFF))[u] = 0u;
    __syncthreads();
    XcdBarrier bar = xcd_barrier_post((unsigned*)(F.ctl + CW_BAR), F.MISC + 8);
    const int gw = F.vcu * NWAVES + F.wave, NGW = F.G * NWAVES;
    STAMP();
    prep_x(F, P, gw, NGW);
    convert_layer_weights(F, P, 0, gw, NGW, false);
    GRID_BAR();

    layer_body<0>(F, P, bar);
    layer_body<1>(F, P, bar);
}

extern "C" void kernel_launch(void* const* d_in, const int* in_sizes, int n_in, void* d_out, int out_size, void* d_ws, size_t ws_size, hipStream_t stream) {
    static int grid = 0;
    if (grid == 0) {
        if (n_in != 20 || out_size != T * DM || ws_size < WS_END) { fprintf(stderr, "kernel_launch: unexpected shapes n_in %d out %d ws %zu (need %zu)\n", n_in, out_size, ws_size, (size_t)WS_END); grid = -1; return; }
        int dev = 0, cus = 0, per_cu = 0;
        if (hipGetDevice(&dev) != hipSuccess || hipDeviceGetAttribute(&cus, hipDeviceAttributeMultiprocessorCount, dev) != hipSuccess) { grid = -1; return; }
        if (hipFuncSetAttribute((const void*)fwd_kernel, hipFuncAttributeMaxDynamicSharedMemorySize, LDS_BYTES) != hipSuccess) { fprintf(stderr, "kernel_launch: hipFuncSetAttribute failed\n"); grid = -1; return; }
        if (hipOccupancyMaxActiveBlocksPerMultiprocessor(&per_cu, (const void*)fwd_kernel, NWAVES * 64, LDS_BYTES) != hipSuccess || per_cu < 1) { fprintf(stderr, "kernel_launch: occupancy query says %d\n", per_cu); per_cu = 1; }
        (void)hipGetLastError();
        grid = cus;
    }
    if (grid < 0) return;
    if (hipMemsetAsync((char*)d_ws + WS_CTL, 0, CTL_ZERO_BYTES, stream) != hipSuccess) { fprintf(stderr, "kernel_launch: memset failed\n"); return; }
    Params p{};
    for (int i = 0; i < 20; ++i) p.in[i] = (const float*)d_in[i];
    p.out = (float*)d_out; p.ws = (unsigned char*)d_ws;
    void* args[] = {&p};
    hipError_t e = hipLaunchCooperativeKernel((const void*)fwd_kernel, dim3(grid), dim3(NWAVES * 64), args, LDS_BYTES, stream);
    if (e != hipSuccess) fprintf(stderr, "kernel_launch: cooperative launch failed: %s (grid %d)\n", hipGetErrorString(e), grid);
}
```

```cpp
#include <hip/hip_runtime.h>
#include <cstdio>
#include <cstdint>
#include <cmath>

#define GAS __attribute__((address_space(1)))
#define LAS __attribute__((address_space(3)))
typedef unsigned short bf16;
typedef unsigned v4u __attribute__((ext_vector_type(4)));
typedef unsigned v2u __attribute__((ext_vector_type(2)));
typedef float f32x4 __attribute__((ext_vector_type(4)));
typedef GAS unsigned gu32;
#define RLX_AGENT __ATOMIC_RELAXED, __HIP_MEMORY_SCOPE_AGENT
#define LDS_WAIT() asm volatile("s_waitcnt lgkmcnt(0)" ::: "memory")
#define VM_WAIT() asm volatile("s_waitcnt vmcnt(0)" ::: "memory")
__device__ __forceinline__ unsigned f2bf(float f) { unsigned u = __builtin_bit_cast(unsigned, f); return (u + 0x7fffu + ((u >> 16) & 1u)) >> 16; }
__device__ __forceinline__ unsigned pk2(float lo, float hi) { return f2bf(lo) | (f2bf(hi) << 16); }
__device__ __forceinline__ float bf2f(unsigned short b) { return __builtin_bit_cast(float, (unsigned)b << 16); }
__device__ __forceinline__ float bflo(unsigned w) { return __builtin_bit_cast(float, w << 16); }
__device__ __forceinline__ float bfhi(unsigned w) { return __builtin_bit_cast(float, w & 0xffff0000u); }
__device__ __forceinline__ float wave_sum(float v) {
#pragma unroll
    for (int o = 1; o < 64; o <<= 1) v += __shfl_xor(v, o);
    return v;
}
__device__ __forceinline__ float wave_max(float v) {
#pragma unroll
    for (int o = 1; o < 64; o <<= 1) v = fmaxf(v, __shfl_xor(v, o));
    return v;
}

constexpr int NWAVES = 8;
constexpr int BATCH = 2, SEQ = 8192, DM = 1024, T = BATCH * SEQ;
constexpr int IN_TOTAL = 6928, NMAIN = 4096, NGATES = 3072;
constexpr int DFF = 2816, NEXP = 8, DFE = 1408;
constexpr float RMS_EPS = 1e-6f;
constexpr int XG_ROWS = 2 * T + 2048;

constexpr size_t MiB = 1u << 20;
constexpr size_t WS_CTL = 0, CTL_ZERO_BYTES = 1 * MiB;
constexpr size_t WS_SSQ = 1 * MiB;
constexpr size_t WS_KBP = 2 * MiB;
constexpr size_t WS_DEC = 2 * MiB + 256 * 1024;
constexpr size_t WS_TOKE = 2 * MiB + 512 * 1024;
constexpr size_t WS_TOKP = WS_TOKE + 128 * 1024;
constexpr size_t WS_TOKPOS = WS_TOKP + 128 * 1024;
constexpr size_t WS_RS2 = WS_TOKPOS + 128 * 1024;
constexpr size_t WS_CNT = WS_RS2 + 64 * 1024;
constexpr size_t WS_RSG = 3 * MiB;
constexpr size_t WS_PWG = 3 * MiB + 256 * 1024;
constexpr size_t WS_W = 4 * MiB;
constexpr size_t WO_IN = 0, WO_BR = 14 * MiB, WO_O = 17 * MiB, WO_GU = 19 * MiB, WO_D = 30 * MiB;
constexpr size_t WS_XB = 40 * MiB;
constexpr size_t WS_R = 72 * MiB;
constexpr size_t RO_AQ = 0, RO_BQ = 16 * MiB, RO_CR = 32 * MiB, RO_AK = 48 * MiB, RO_AV = 52 * MiB, RO_BK = 56 * MiB, RO_BV = 72 * MiB, RO_CQ = 88 * MiB, RO_CK = 96 * MiB, RO_CV = 104 * MiB, RO_GL = 120 * MiB;
constexpr size_t WS_GATES = WS_R + 48 * MiB;
constexpr size_t WS_S = 208 * MiB;
constexpr size_t WS_Y = 240 * MiB;
constexpr size_t WS_H = WS_R;
constexpr size_t WS_XG = WS_R;
constexpr size_t WS_HG = 140 * MiB;
constexpr size_t WS_WMGU = 234 * MiB;
constexpr size_t WS_WMD = 278 * MiB;
constexpr size_t WS_END = 300 * MiB;
static_assert(WS_HG + (size_t)XG_ROWS * DFE * 2 <= WS_WMGU && WS_XG + (size_t)XG_ROWS * DM * 2 <= WS_HG, "moe map");
static_assert(WS_GATES + (size_t)T * NGATES * 2 <= WS_Y && WS_H + (size_t)T * DFF * 2 <= WS_S, "overlay map");
constexpr int CW_BAR = 4096;

constexpr int RING_OFF = 0, RING_BYTES = 131072;
constexpr int LDSCTL_OFF = RING_BYTES, MISC_OFF = LDSCTL_OFF + 320;
constexpr int LDS_BYTES = 147456;
namespace pg8 {
#define PG8_LAS __attribute__((address_space(3)))
typedef unsigned short bf16_t;
typedef short bf16x8 __attribute__((ext_vector_type(8)));
typedef float f32x4 __attribute__((ext_vector_type(4)));
typedef unsigned u32x4 __attribute__((ext_vector_type(4)));
typedef unsigned u32x2 __attribute__((ext_vector_type(2)));
constexpr int BM = 256, BK = 64, HALF = 128, HTB = HALF * BK * 2  , STAGE_BYTES = 8 * HTB, NXCD = 8, WGM = 8;

__host__ __device__ __forceinline__ int lds_byte(int r, int c) { const int st = (r >> 4) * 2 + (c >> 5), rr = r & 15, cc = c & 31, ob = rr * 64 + cc * 2; return st * 1024 + (ob ^ (((ob >> 9) & 1) << 5)); }
__host__ __device__ __forceinline__ void stage_rc(int b, int& R, int& C) { const int st = b / 1024, sb = b % 1024, swz = sb ^ (((sb >> 9) & 1) << 5); R = (st >> 1) * 16 + swz / 64; C = (st & 1) * 32 + (swz % 64) / 2; }
__host__ __device__ __forceinline__ int perm32(int rho) { const int n = rho >> 4, i = rho & 15; return 8 * (i >> 2) + 4 * n + (i & 3); }

struct Unit { const char* A; const char* B; int pm, pn, aux; };

__device__ __forceinline__ bool static_tile(int nM, int nN, int G, int c, int i, int& pm, int& pn) {
    const int nwg = nM * nN; const long L = (long)i * G + c; if (L >= nwg) return false;
    int wgid = (int)L; { const int q = nwg / NXCD, r = nwg % NXCD, xcd = wgid % NXCD, off = wgid / NXCD; wgid = (xcd < r ? xcd * (q + 1) : r * (q + 1) + (xcd - r) * q) + off; }
    const int nig = WGM * nN, gid = wgid / nig, fm = gid * WGM, gsz = (nM - fm) < WGM ? (nM - fm) : WGM;
    pm = fm + ((wgid % nig) % gsz); pn = (wgid % nig) / gsz; return true;
}
struct DenseOrder {
    const char* A; const char* B; int nM, nN, G, c; size_t tstep;
    __device__ __forceinline__ void init(const void* A_, const void* B_, int M, int N, int K, int G_, int c_) { A = (const char*)A_; B = (const char*)B_; nM = M / BM; nN = N / BM; G = G_; c = c_; tstep = (size_t)BM * K * 2; }
    __device__ __forceinline__ bool next(int i, Unit& u) const { int pm, pn; if (!static_tile(nM, nN, G, c, i, pm, pn)) return false; u.pm = pm; u.pn = pn; u.aux = pn; u.A = A + (size_t)pm * tstep; u.B = B + (size_t)pn * tstep; return true; }
};

typedef float f32x2_c __attribute__((ext_vector_type(2))); typedef __bf16 bf16x2_c __attribute__((ext_vector_type(2)));
__device__ __forceinline__ unsigned cvt_pk_bf16(float lo, float hi) { f32x2_c v = {lo, hi}; bf16x2_c b = __builtin_convertvector(v, bf16x2_c); return __builtin_bit_cast(unsigned, b); }

template <class Epi, class Sched, bool ALIGN_EPI = true>
__device__ __forceinline__ void gemm_phase(PG8_LAS unsigned char* lds, const int K, const Sched& S, const Epi& E) {
    int tid_ = threadIdx.x; asm volatile("" : "+v"(tid_));
    const int tid = tid_, wid = __builtin_amdgcn_readfirstlane(tid >> 6), lane = tid & 63, wr = wid >> 2, wc = wid & 3, fr = lane & 15, fq = lane >> 4;
    const int nt = K / BK;
    unsigned voffA[2], voffB[2];
#pragma unroll
    for (int i = 0; i < 2; ++i) { int R, C; stage_rc(tid * 16 + i * 8192, R, C); const int Rb = Epi::PERM ? ((R & ~31) + perm32(R & 31)) : R;
        voffA[i] = (unsigned)(R * K + C) * 2u; voffB[i] = (unsigned)(Rb * K + C) * 2u; }
    const size_t kstep = (size_t)(BK * 2);
    const size_t hstep = (size_t)HALF * K * 2;
    const unsigned ldsw = (unsigned)wid * 1024u;
    const int aoff = lds_byte(wr * 64 + fr, fq * 8), boff = lds_byte(wc * 32 + fr, fq * 8);
#define PG8_SA(b, h) (((b) * 2 + (h)) * HTB)
#define PG8_SB(b, h) ((4 + (b) * 2 + (h)) * HTB)
#define PG8_STAGE(bufoff, gbase, voff) do { _Pragma("unroll") for (int _i = 0; _i < 2; ++_i) \
        __builtin_amdgcn_global_load_lds((const unsigned*)((const char*)(gbase) + (voff)[_i]), (PG8_LAS unsigned*)(lds + (bufoff) + ldsw + _i * 8192), 16, 0, 0); } while (0)
#define PG8_LDA(dst, b, h) do { _Pragma("unroll") for (int m = 0; m < 4; ++m) _Pragma("unroll") for (int k = 0; k < 2; ++k) dst[m][k] = *(const PG8_LAS bf16x8*)(lds + PG8_SA(b, h) + aoff + m * 2048 + k * 1024); } while (0)
#define PG8_LDB(dst, b, h) do { _Pragma("unroll") for (int n = 0; n < 2; ++n) _Pragma("unroll") for (int k = 0; k < 2; ++k) dst[n][k] = *(const PG8_LAS bf16x8*)(lds + PG8_SB(b, h) + boff + n * 2048 + k * 1024); } while (0)
#define PG8_MMA(ai, bj, At, Bt) do { __builtin_amdgcn_s_setprio(1); _Pragma("unroll") for (int m = 0; m < 4; ++m) _Pragma("unroll") for (int n = 0; n < 2; ++n) _Pragma("unroll") for (int k = 0; k < 2; ++k) \
        acc[ai][bj][m][n] = __builtin_amdgcn_mfma_f32_16x16x32_bf16(Bt[n][k], At[m][k], acc[ai][bj][m][n], 0, 0, 0); __builtin_amdgcn_s_setprio(0); } while (0)
#define PG8_WAIT_V(n) asm volatile("s_waitcnt vmcnt(" #n ")" ::: "memory")
#define PG8_WAIT_L(n) asm volatile("s_waitcnt lgkmcnt(" #n ")" ::: "memory")
#define PG8_BAR __builtin_amdgcn_s_barrier()
#define PG8_SCHED __builtin_amdgcn_sched_barrier(0)
    Unit cur, nxt; int ui = 0;
    if (!S.next(0, cur)) return;
    f32x4 acc[2][2][4][2];
#pragma unroll
    for (int a = 0; a < 2; ++a)
#pragma unroll
        for (int b = 0; b < 2; ++b)
#pragma unroll
            for (int m = 0; m < 4; ++m)
#pragma unroll
                for (int n = 0; n < 2; ++n) acc[a][b][m][n] = (f32x4){0.f, 0.f, 0.f, 0.f};
    bf16x8 At[4][2], B0[2][2], B1[2][2];
    const char* cA = cur.A; const char* cB = cur.B;
    PG8_STAGE(PG8_SB(0, 0), cB, voffB); PG8_STAGE(PG8_SB(0, 1), cB + hstep, voffB); PG8_STAGE(PG8_SA(0, 0), cA, voffA); PG8_STAGE(PG8_SA(0, 1), cA + hstep, voffA);
    if (wr == 1) PG8_BAR;
    PG8_WAIT_V(2); PG8_BAR;
    PG8_STAGE(PG8_SB(1, 0), cB + kstep, voffB); PG8_STAGE(PG8_SA(1, 0), cA + kstep, voffA); PG8_STAGE(PG8_SB(1, 1), cB + hstep + kstep, voffB);
    PG8_WAIT_V(6); PG8_BAR;
    for (;;) {
        const bool has_next = S.next(ui + 1, nxt);
        const char* nA = has_next ? nxt.A : cA; const char* nB = has_next ? nxt.B : cB;
        for (int t = 0; t < nt; t += 2) {
            const bool last = (t == nt - 2);
            const char* a1 = cA + (size_t)(t + 1) * kstep;
            const char* a2 = last ? nA : cA + (size_t)(t + 2) * kstep; const char* b2 = last ? nB : cB + (size_t)(t + 2) * kstep;
            const char* a3 = a2 + kstep; const char* b3 = b2 + kstep;
            PG8_LDB(B0, 0, 0); PG8_LDB(B1, 0, 1); PG8_SCHED; PG8_LDA(At, 0, 0); PG8_STAGE(PG8_SA(1, 1), a1 + hstep, voffA);
            PG8_WAIT_V(8); PG8_WAIT_L(0); PG8_BAR; PG8_MMA(0, 0, At, B0); PG8_MMA(0, 1, At, B1); PG8_BAR; PG8_SCHED;
            PG8_LDA(At, 0, 1); PG8_STAGE(PG8_SB(0, 0), b2, voffB); PG8_STAGE(PG8_SB(0, 1), b2 + hstep, voffB); PG8_STAGE(PG8_SA(0, 0), a2, voffA);
            PG8_WAIT_V(8); PG8_WAIT_L(0); PG8_BAR; PG8_MMA(1, 0, At, B0); PG8_MMA(1, 1, At, B1); PG8_BAR; PG8_SCHED;
            PG8_LDB(B0, 1, 0); PG8_LDB(B1, 1, 1); PG8_SCHED; PG8_LDA(At, 1, 0); PG8_STAGE(PG8_SA(0, 1), a2 + hstep, voffA);
            PG8_WAIT_V(8); PG8_WAIT_L(0); PG8_BAR; PG8_MMA(0, 0, At, B0); PG8_MMA(0, 1, At, B1); PG8_BAR; PG8_SCHED;
            PG8_LDA(At, 1, 1); PG8_STAGE(PG8_SB(1, 0), b3, voffB); PG8_STAGE(PG8_SB(1, 1), b3 + hstep, voffB); PG8_STAGE(PG8_SA(1, 0), a3, voffA);
            PG8_WAIT_V(8); PG8_WAIT_L(0); PG8_BAR; PG8_MMA(1, 0, At, B0); PG8_MMA(1, 1, At, B1); PG8_BAR; PG8_SCHED;
        }
        if constexpr (ALIGN_EPI) { if (wr == 0) PG8_BAR; }
        E(acc, cur, wr, wc, fr, fq);
        if (!has_next) break;
#pragma unroll
        for (int a = 0; a < 2; ++a)
#pragma unroll
            for (int b = 0; b < 2; ++b)
#pragma unroll
                for (int m = 0; m < 4; ++m)
#pragma unroll
                    for (int n = 0; n < 2; ++n) acc[a][b][m][n] = (f32x4){0.f, 0.f, 0.f, 0.f};
        cur = nxt; cA = nA; cB = nB; ++ui;
        if constexpr (ALIGN_EPI) { if (wr == 1) PG8_BAR; }
    }
    PG8_WAIT_V(0);
    if constexpr (!ALIGN_EPI) { if (wr == 0) PG8_BAR; }
    PG8_BAR;
#undef PG8_SA
#undef PG8_SB
#undef PG8_STAGE
#undef PG8_LDA
#undef PG8_LDB
#undef PG8_MMA
#undef PG8_WAIT_V
#undef PG8_WAIT_L
#undef PG8_BAR
#undef PG8_SCHED
}
}
#define XB_TMO      128
#define XB_XCNT(j)  (256  + 64 * (j))
#define XB_XSUB(j)  (1280 + 64 * (j))
#define XB_XGEN(j)  (2304 + 64 * (j))
#define XB_TOP      3328
#define XB_TOPGEN   3392
#define XCD_BAR_WORDS 3456
#define XB_SPIN_CAP (1u << 18)

__device__ __forceinline__ unsigned xb_ld(unsigned* p)              { return __hip_atomic_load(p, __ATOMIC_RELAXED, __HIP_MEMORY_SCOPE_AGENT); }
__device__ __forceinline__ unsigned xb_add(unsigned* p, unsigned v) { return __hip_atomic_fetch_add(p, v, __ATOMIC_RELAXED, __HIP_MEMORY_SCOPE_AGENT); }
__device__ __forceinline__ unsigned xb_xcc_id() { return (unsigned)__builtin_amdgcn_s_getreg((3 << 11) | 20) & 0xFu; }
#define XB_SPIN(cond, bar) do { unsigned _sp = 0; while (cond) { __builtin_amdgcn_s_sleep(1); \
    if ((++_sp & 255u) == 0u) { if (xb_ld(&(bar)[XB_TMO])) break; if (_sp > XB_SPIN_CAP) { atomicAdd(&(bar)[XB_TMO], 1u); break; } } } } while (0)

struct XcdBarrier {
    unsigned* bar; unsigned x;
    volatile LAS unsigned* st;
};

__device__ __forceinline__ XcdBarrier xcd_barrier_post(unsigned* bar, volatile LAS unsigned* st) {
    XcdBarrier b; b.bar = bar; b.x = xb_xcc_id(); b.st = st;
    if (threadIdx.x == 0) (void)xb_add(&bar[XB_XCNT(b.x)], 1u);
    return b;
}
__device__ __forceinline__ void xcd_barrier_complete(unsigned* bar, unsigned x, unsigned& nloc, unsigned& nx) {
    const unsigned G = gridDim.x * gridDim.y * gridDim.z;
    unsigned sum, cnt, mine, sp = 0u;
    for (;;) {
        sum = 0u; cnt = 0u; mine = 0u;
#pragma unroll
        for (unsigned j = 0; j < 16; ++j) { const unsigned c = xb_ld(&bar[XB_XCNT(j)]); sum += c; cnt += (c > 0u) ? 1u : 0u; mine = (j == x) ? c : mine; }
        if (sum == G) break;
        __builtin_amdgcn_s_sleep(1);
        if ((++sp & 255u) == 0u) { if (xb_ld(&bar[XB_TMO])) break; if (sp > XB_SPIN_CAP) { atomicAdd(&bar[XB_TMO], 1u); break; } }
    }
    nloc = mine > 0u ? mine : 1u; nx = cnt > 0u ? cnt : 1u;
}

__device__ __forceinline__ void xcd_barrier(const XcdBarrier& b) {
    asm volatile("s_waitcnt vmcnt(0)" ::: "memory");
    __syncthreads();
    if (threadIdx.x == 0) {
        unsigned* bar = b.bar;
        __builtin_amdgcn_s_waitcnt(0);
        unsigned nloc = b.st[0], nx = b.st[1];
        if (nloc == 0u) { xcd_barrier_complete(bar, b.x, nloc, nx); b.st[0] = nloc; b.st[1] = nx; }
        const unsigned old = xb_add(&bar[XB_XSUB(b.x)], 1u);
        const unsigned gen = old / nloc;
        if (old + 1u == (gen + 1u) * nloc) {
            __builtin_amdgcn_fence(__ATOMIC_RELEASE, "agent");
            asm volatile("s_waitcnt vmcnt(0)" ::: "memory");
            const unsigned og = xb_add(&bar[XB_TOP], 1u);
            const unsigned tg = og / nx;
            if (og + 1u == (tg + 1u) * nx) xb_add(&bar[XB_TOPGEN], 1u);
            else XB_SPIN(xb_ld(&bar[XB_TOPGEN]) == tg, bar);
            __builtin_amdgcn_fence(__ATOMIC_ACQUIRE, "agent");
            xb_add(&bar[XB_XGEN(b.x)], 1u);
            asm volatile("s_waitcnt vmcnt(0)" ::: "memory");
        } else {
            XB_SPIN(xb_ld(&bar[XB_XGEN(b.x)]) == gen, bar);
            __builtin_amdgcn_fence(__ATOMIC_ACQUIRE, "agent");
            asm volatile("s_waitcnt vmcnt(0)" ::: "memory");
        }
    }
    __syncthreads();
}
struct Params { const float* in[20]; float* out; unsigned char* ws; };
enum { I_X = 0, I_N1G, I_WIN, I_SINK, I_GWG, I_GBG, I_GNG, I_WA, I_WB, I_WC, I_WO, I_N2G, I_FG, I_FU, I_FD, I_RT, I_MG, I_MU, I_MD, I_FNG };

struct Frame {
    LAS unsigned char* lds;
    volatile LAS unsigned* MISC;
    gu32* ctl;
    int tid, lane, wave;
    int vcu, G;
};
__device__ __forceinline__ unsigned char* lws(const Params& P) { GAS unsigned char* w = (GAS unsigned char*)P.ws; asm volatile("" : "+s"(w)); return (unsigned char*)w; }
#define PH_BEGIN Frame F = F_in; { int t_ = threadIdx.x; asm volatile("" : "+v"(t_)); F.tid = t_; F.lane = t_ & 63; } Params P = P_in; P.ws = lws(P_in);

template <int MODE>
__device__ __forceinline__ void tr_item(const float* W, int ld, int sc, const float* g, const float* W2, int n0, bf16* dst, int dK, int drow, int k0, LAS float* scr, int lane) {
#pragma unroll 4
    for (int i = 0; i < 32; ++i) { const int kk = 2 * i + (lane >> 5), nn = lane & 31; const float* wr = W + (size_t)(k0 + kk) * ld + sc;
        float v;
        if (MODE == 0) v = wr[n0 + nn];
        else { v = 0.f;
#pragma unroll
            for (int r = 0; r < 16; ++r) v += wr[r] * W2[r * 256 + n0 + nn]; }
        if (g) v *= g[k0 + kk];
        scr[kk * 33 + nn] = v; }
    LDS_WAIT(); asm volatile("" ::: "memory");
    const int c = lane & 7;
#pragma unroll
    for (int j = 0; j < 4; ++j) { const int n = (lane >> 3) + 8 * j; const LAS float* s = scr + (8 * c) * 33 + n;
        v4u o; o.x = pk2(s[0 * 33], s[1 * 33]); o.y = pk2(s[2 * 33], s[3 * 33]); o.z = pk2(s[4 * 33], s[5 * 33]); o.w = pk2(s[6 * 33], s[7 * 33]);
        *(GAS v4u*)(dst + (size_t)(drow + n) * dK + k0 + 8 * c) = o; }
    LDS_WAIT(); asm volatile("" ::: "memory");
}
__device__ __forceinline__ void tr_job(int item, const float* W, int ld, int sc, int K, int N, const float* g, bf16* dst, int drow0, int gu_off, bool gu, LAS float* scr, int lane) {
    const int nblk = N / 32, kb = item / nblk, nb = item % nblk, n0 = 32 * nb;
    const int drow = gu ? (256 * (n0 / 128) + (n0 % 128) + gu_off) : (drow0 + n0);
    tr_item<0>(W, ld, sc, g, nullptr, n0, dst, K, drow, 64 * kb, scr, lane);
}
__device__ __forceinline__ void convert_layer_weights(const Frame& F_in, const Params& P_in, int l, int gw, int NGW, bool skip_ffn_down_region) {
    PH_BEGIN
    LAS float* scr = (LAS float*)(F.lds + RING_OFF + F.wave * 16384);
    unsigned char* ws = P.ws;
    bf16* Win = (bf16*)(ws + WS_W + WO_IN); bf16* Wbr = (bf16*)(ws + WS_W + WO_BR); bf16* Wo = (bf16*)(ws + WS_W + WO_O); bf16* Wgu = (bf16*)(ws + WS_W + WO_GU); bf16* Wd = (bf16*)(ws + WS_W + WO_D);
    const float* win = P.in[I_WIN] + (size_t)l * DM * IN_TOTAL; const float* n1g = P.in[I_N1G] + l * DM; const float* n2g = P.in[I_N2G] + l * DM;
    constexpr int J1 = 16 * (3840 / 32), J2 = 16 * (NGATES / 32), J3 = 16 * (256 / 32), J4 = 8 * (DM / 32), J7 = 16 * (DM / 32), J8 = 16 * (DFF / 32), J10 = (DFF / 64) * (DM / 32);
    const int NIT = J1 + J2 + J3 + 3 * J4 + J7 + ((l == 0) ? (2 * J8 + J10) : 0);
    for (int it = gw; it < NIT; it += NGW) {
        int r = it;
        if (r < J1) { tr_job(r, win, IN_TOTAL, 0, DM, 3840, n1g, Win, 0, 0, false, scr, F.lane); continue; } r -= J1;
        if (r < J2) { tr_job(r, win, IN_TOTAL, 3856, DM, NGATES, n1g, Win, NMAIN, 0, false, scr, F.lane); continue; } r -= J2;
        if (r < J3) { const int kb = r / 8, nb = r % 8; tr_item<1>(win, IN_TOTAL, 3840, n1g, P.in[I_GWG] + (size_t)l * 16 * 256, 32 * nb, Win, DM, 3840 + 32 * nb, 64 * kb, scr, F.lane); continue; } r -= J3;
        if (r < J4) { tr_job(r, P.in[I_WA] + (size_t)l * 512 * DM, DM, 0, 512, DM, nullptr, Wbr, 0, 0, false, scr, F.lane); continue; } r -= J4;
        if (r < J4) { tr_job(r, P.in[I_WB] + (size_t)l * 512 * DM, DM, 0, 512, DM, nullptr, Wbr + (size_t)DM * 512, 0, 0, false, scr, F.lane); continue; } r -= J4;
        if (r < J4) { tr_job(r, P.in[I_WC] + (size_t)l * 512 * DM, DM, 0, 512, DM, nullptr, Wbr + (size_t)2 * DM * 512, 0, 0, false, scr, F.lane); continue; } r -= J4;
        if (r < J7) { tr_job(r, P.in[I_WO] + (size_t)l * DM * DM, DM, 0, DM, DM, nullptr, Wo, 0, 0, false, scr, F.lane); continue; } r -= J7;
        if (r < J8) { tr_job(r, P.in[I_FG], DFF, 0, DM, DFF, n2g, Wgu, 0, 0, true, scr, F.lane); continue; } r -= J8;
        if (r < J8) { tr_job(r, P.in[I_FU], DFF, 0, DM, DFF, n2g, Wgu, 0, 128, true, scr, F.lane); continue; } r -= J8;
        tr_job(r, P.in[I_FD], DM, 0, DFF, DM, nullptr, Wd, 0, 0, false, scr, F.lane);
    }
}
__device__ __forceinline__ void convert_moe_weights(const Frame& F_in, const Params& P_in, int gw, int NGW) {
    PH_BEGIN
    LAS float* scr = (LAS float*)(F.lds + RING_OFF + F.wave * 16384);
    bf16* Wgu = (bf16*)(P.ws + WS_WMGU); bf16* Wd = (bf16*)(P.ws + WS_WMD);
    const float* n2g = P.in[I_N2G] + 1 * DM;
    constexpr int JG = 16 * (DFE / 32), JD = (DFE / 64) * (DM / 32), JE = 2 * JG + JD;
    for (int it = gw; it < NEXP * JE; it += NGW) {
        const int e = it / JE; int r = it % JE;
        if (r < JG) { tr_job(r, P.in[I_MG] + (size_t)e * DM * DFE, DFE, 0, DM, DFE, n2g, Wgu + (size_t)e * 2 * DFE * DM, 0, 0, true, scr, F.lane); continue; } r -= JG;
        if (r < JG) { tr_job(r, P.in[I_MU] + (size_t)e * DM * DFE, DFE, 0, DM, DFE, n2g, Wgu + (size_t)e * 2 * DFE * DM, 0, 128, true, scr, F.lane); continue; } r -= JG;
        tr_job(r, P.in[I_MD] + (size_t)e * DFE * DM, DM, 0, DFE, DM, nullptr, Wd + (size_t)e * DM * DFE, 0, 0, false, scr, F.lane);
    }
}
__device__ __forceinline__ void prep_x(const Frame& F_in, const Params& P_in, int gw, int NGW) {
    PH_BEGIN
    bf16* XB = (bf16*)(P.ws + WS_XB); float* SSQ = (float*)(P.ws + WS_SSQ);
    for (int m = gw; m < T; m += NGW) {
        const GAS f32x4* xr = (const GAS f32x4*)(P.in[I_X] + (size_t)m * DM) + F.lane;
        f32x4 v[4]; float s = 0.f;
#pragma unroll
        for (int j = 0; j < 4; ++j) { v[j] = xr[64 * j]; s += (v[j].x * v[j].x + v[j].y * v[j].y) + (v[j].z * v[j].z + v[j].w * v[j].w); }
        s = wave_sum(s) * (1.f / 16.f);
        GAS unsigned long long* o8 = (GAS unsigned long long*)(XB + (size_t)m * DM) + F.lane;
#pragma unroll
        for (int j = 0; j < 4; ++j) o8[64 * j] = (unsigned long long)pk2(v[j].x, v[j].y) | ((unsigned long long)pk2(v[j].z, v[j].w) << 32);
        if (F.lane < 16) SSQ[(size_t)m * 16 + F.lane] = s;
    }
}
__device__ __forceinline__ void final_phase(const Frame& F_in, const Params& P_in, int gw, int NGW, bool with_moe) {
    PH_BEGIN
#ifdef TIMING
    float tscale = 1.0f, tbump = 0.f;
    { const unsigned* c_ = (const unsigned*)(P.ws + WS_CTL) + 2048; const unsigned long long* ts = (const unsigned long long*)(c_ + 2); const unsigned n_ = c_[0];
      const float tot = (float)(ts[n_ - 1] - ts[0]); float a1 = 0.f, a2 = 0.f;
      for (unsigned i = 1; i < n_; ++i) { const float d = (float)(ts[i] - ts[i - 1]); if ((TSEL1 >> i) & 1u) a1 += d; if ((TSEL2 >> i) & 1u) a2 += d; }
      tscale = 1.0f + 0.02f + 0.1f * (a1 / tot); tbump = 2.0f + 7.9f * TBS * (a2 / tot); }
#endif
    const float* g = P.in[I_FNG]; const bf16* YE = (const bf16*)(P.ws + WS_XG); const int* TOKPOS = (const int*)(P.ws + WS_TOKPOS);
    for (int m = gw; m < T; m += NGW) {
        GAS f32x4* xr = (GAS f32x4*)(P.out + (size_t)m * DM) + F.lane;
        f32x4 v[4]; float s = 0.f;
#pragma unroll
        for (int j = 0; j < 4; ++j) v[j] = xr[64 * j];
        if (with_moe) {
#pragma unroll
            for (int sl = 0; sl < 2; ++sl) { const int pos = TOKPOS[m * 2 + sl]; const GAS v2u* yr = (const GAS v2u*)(YE + (size_t)pos * DM) + F.lane;
#pragma unroll
                for (int j = 0; j < 4; ++j) { const v2u w = yr[64 * j]; v[j].x += bflo(w.x); v[j].y += bfhi(w.x); v[j].z += bflo(w.y); v[j].w += bfhi(w.y); } }
        }
#pragma unroll
        for (int j = 0; j < 4; ++j) s += (v[j].x * v[j].x + v[j].y * v[j].y) + (v[j].z * v[j].z + v[j].w * v[j].w);
        const float r = 1.0f / sqrtf(wave_sum(s) * (1.f / DM) + RMS_EPS);
#pragma unroll
        for (int j = 0; j < 4; ++j) { const f32x4 gg = *((const GAS f32x4*)g + F.lane + 64 * j); f32x4 ov = (f32x4){v[j].x * r * gg.x, v[j].y * r * gg.y, v[j].z * r * gg.z, v[j].w * r * gg.w};
#ifdef TIMING
            ov = ov * tscale; if (m == 0 && j == 0 && F.lane == 0) ov.x += tbump;
#endif
            xr[64 * j] = ov; }
    }
}
#include <hip/hip_bf16.h>
#include <cmath>
namespace attn_body {
using bf16=__hip_bfloat16;
using bf16x8=__attribute__((ext_vector_type(8)))short;
using s16x4=__attribute__((ext_vector_type(4)))short;
using f32x16=__attribute__((ext_vector_type(16)))float;
using u32x4=__attribute__((ext_vector_type(4)))unsigned;
constexpr int D=64;
constexpr int NW=8,QBLK=32,QB=QBLK*NW,KVBLK=64;
__device__ __forceinline__ int crow(int r,int hi){return (r&3)+8*(r>>2)+4*hi;}
#define SBAR() __builtin_amdgcn_sched_barrier(0)
template<bool WIN> __device__ __forceinline__ void amask(f32x16&p0,f32x16&p1,int krel0,int qrel,int hi){
  const float NEG=-INFINITY; const int kb=krel0+4*hi;
  #pragma unroll
  for(int r=0;r<16;++r){const int kv=kb+(r&3)+8*(r>>2);
    if(kv>qrel||(WIN&&kv<=qrel-128))p0[r]=NEG; if(kv+32>qrel||(WIN&&kv+32<=qrel-128))p1[r]=NEG;}
}

constexpr int NSLOT=3, SLOTB=8192;
constexpr int LDS_K=0, LDS_V=NSLOT*SLOTB, LDS_WS=2*NSLOT*SLOTB, LDS_OST=LDS_WS+NW*64*4, LDS_BYTES=LDS_OST+NW*4096;
constexpr float C2=0.125f*1.4426950408889634f;
__device__ __forceinline__ void glds16(const void*gsrc,unsigned lds_dst){unsigned keep;
  asm volatile("s_mov_b32 %0, m0\n\ts_mov_b32 m0, %2\n\ts_nop 0\n\tglobal_load_lds_dwordx4 %1, off\n\ts_mov_b32 m0, %0":"=&s"(keep):"v"(gsrc),"s"(lds_dst):"memory");}
__device__ __forceinline__ float max3f(float a,float b,float c){float r;asm("v_max3_f32 %0, %1, %2, %3":"=v"(r):"v"(a),"v"(b),"v"(c));return r;}
__device__ __forceinline__ float max2f(float a,float b){float r;asm("v_max_f32_e32 %0, %1, %2":"=v"(r):"v"(a),"v"(b));return r;}
__device__ __forceinline__ float fadd_s(float a,float b){float r;asm("v_add_f32_e32 %0, %1, %2":"=v"(r):"v"(a),"v"(b));return r;}
__device__ __forceinline__ float fsub_s(float a,float b){float r;asm("v_sub_f32_e32 %0, %1, %2":"=v"(r):"v"(a),"v"(b));return r;}
typedef float f32x2_t __attribute__((ext_vector_type(2))); typedef __bf16 bf16x2_t __attribute__((ext_vector_type(2)));
__device__ __forceinline__ unsigned cvtpk_s(float lo,float hi){f32x2_t v={lo,hi};bf16x2_t b=__builtin_convertvector(v,bf16x2_t);return __builtin_bit_cast(unsigned,b);}
#define WAIT_BAR(N) asm volatile("s_waitcnt vmcnt(" #N ") lgkmcnt(0)\n\ts_barrier":::"memory")

__device__ __forceinline__ void qkt(f32x16&p0,f32x16&p1,const char*Kslot,const bf16x8*qr,const f32x16&negm,int r32,int hi){
  const char*kb=Kslot+hi*1024+r32*16;
  #pragma unroll
  for(int d0=0;d0<4;++d0){
    const bf16x8 b0=*reinterpret_cast<const bf16x8*>(kb+d0*2048);
    const bf16x8 b1=*reinterpret_cast<const bf16x8*>(kb+d0*2048+512);
    if(d0==0){p0=__builtin_amdgcn_mfma_f32_32x32x16_bf16(b0,qr[0],negm,0,0,0);p1=__builtin_amdgcn_mfma_f32_32x32x16_bf16(b1,qr[0],negm,0,0,0);}
    else{p0=__builtin_amdgcn_mfma_f32_32x32x16_bf16(b0,qr[d0],p0,0,0,0);p1=__builtin_amdgcn_mfma_f32_32x32x16_bf16(b1,qr[d0],p1,0,0,0);}}
}
typedef __attribute__((address_space(3))) const char* lds_cptr;
typedef short v4i16_t __attribute__((ext_vector_type(4)));
__device__ __forceinline__ void kload8(bf16x8*kf,lds_cptr kp){
  kf[0]=*(const __attribute__((address_space(3))) bf16x8*)(kp);      kf[1]=*(const __attribute__((address_space(3))) bf16x8*)(kp+512);
  kf[2]=*(const __attribute__((address_space(3))) bf16x8*)(kp+2048); kf[3]=*(const __attribute__((address_space(3))) bf16x8*)(kp+2560);
  kf[4]=*(const __attribute__((address_space(3))) bf16x8*)(kp+4096); kf[5]=*(const __attribute__((address_space(3))) bf16x8*)(kp+4608);
  kf[6]=*(const __attribute__((address_space(3))) bf16x8*)(kp+6144); kf[7]=*(const __attribute__((address_space(3))) bf16x8*)(kp+6656);
}
__device__ __forceinline__ void kload2(bf16x8*kf,lds_cptr kp,int j){ kf[2*j]=*(const __attribute__((address_space(3))) bf16x8*)(kp+j*2048); kf[2*j+1]=*(const __attribute__((address_space(3))) bf16x8*)(kp+j*2048+512); }
__device__ __forceinline__ s16x4 vtr(lds_cptr p){ return __builtin_bit_cast(s16x4,__builtin_amdgcn_ds_read_tr16_b64_v4i16((__attribute__((address_space(3))) v4i16_t*)p)); }
__device__ __forceinline__ float rowmax(const f32x16&p0,const f32x16&p1){
  float a=max3f(p0[0],p0[1],p1[0]),b=max3f(p0[2],p0[3],p1[1]);a=max3f(a,p1[2],p1[3]);
  #pragma unroll
  for(int r=4;r<16;r+=4){a=max3f(a,p0[r],p0[r+1]);b=max3f(b,p0[r+2],p0[r+3]);a=max3f(a,p1[r],p1[r+1]);b=max3f(b,p1[r+2],p1[r+3]);}
  const float m=max2f(a,b);
  auto rr=__builtin_amdgcn_permlane32_swap(__float_as_uint(m),__float_as_uint(m),false,false);
  return max2f(__uint_as_float(rr[0]),__uint_as_float(rr[1]));
}
__device__ __forceinline__ void pv(f32x16*o,int vb,bf16x8 pa0,bf16x8 pa1,bf16x8 pa2,bf16x8 pa3){
  #pragma unroll
  for(int d0=0;d0<2;++d0){s16x4 lo[4],hi[4];
    #pragma unroll
    for(int ks=0;ks<4;++ks){
      asm volatile("ds_read_b64_tr_b16 %0,%1 offset:%c2":"=&v"(lo[ks]):"v"(vb),"i"(d0*4096+ks*1024):"memory");
      asm volatile("ds_read_b64_tr_b16 %0,%1 offset:%c2":"=&v"(hi[ks]):"v"(vb),"i"(d0*4096+ks*1024+512):"memory");}
    asm volatile("s_waitcnt lgkmcnt(0)":::"memory");SBAR();
    #define PK(k) (bf16x8){lo[k][0],lo[k][1],lo[k][2],lo[k][3],hi[k][0],hi[k][1],hi[k][2],hi[k][3]}
    o[d0]=__builtin_amdgcn_mfma_f32_32x32x16_bf16(pa0,PK(0),o[d0],0,0,0);
    o[d0]=__builtin_amdgcn_mfma_f32_32x32x16_bf16(pa1,PK(1),o[d0],0,0,0);
    o[d0]=__builtin_amdgcn_mfma_f32_32x32x16_bf16(pa2,PK(2),o[d0],0,0,0);
    o[d0]=__builtin_amdgcn_mfma_f32_32x32x16_bf16(pa3,PK(3),o[d0],0,0,0);
    #undef PK
  }
}

#ifndef ATTN_STORE16
#define ATTN_STORE16(p,v) (*(u32x4*)(p)=(v))
#endif
template<int MODE,int THRL> __device__ __forceinline__ void attn_unit(const bf16*Qw0,bf16*Ow0,const int QP,const bf16*__restrict__ Kt0,const bf16*__restrict__ Vt0,const int KP,const int NT,const int koff,const unsigned selmask,const float sinkl2,char*shm){
  int tid_=threadIdx.x; asm volatile("":"+v"(tid_));
  const int tid=tid_,lane=tid&63,r32=lane&31,hi=lane>>5; const int wid=__builtin_amdgcn_readfirstlane(tid>>6);
  const bf16*Qw=Qw0+(long)(wid*QBLK)*QP;
  const bf16*Kh=Kt0,*Vh=Vt0;
  const unsigned lds0=(unsigned)(uintptr_t)shm;
  float*wsf=(float*)(shm+LDS_WS)+wid*64;
  const bf16*ksrc=Kh+(long)lane*KP+wid*8;
  const bf16*vsrc=Vh+(long)(16*(wid&3)+(lane>>2))*KP+(wid>>2)*32+(lane&3)*8;
  const unsigned kdst=lds0+LDS_K+wid*1024, vdst=lds0+LDS_V+wid*1024;
  #define DMA_K(t,slot) glds16(ksrc+(long)(t)*KVBLK*KP,(unsigned)__builtin_amdgcn_readfirstlane(kdst+(slot)))
  #define DMA_V(t,slot) glds16(vsrc+(long)(t)*KVBLK*KP,(unsigned)__builtin_amdgcn_readfirstlane(vdst+(slot)))
  const int vb0=(int)(lds0+LDS_V)+((lane>>4)&1)*32+(lane&3)*8+(4*hi+((lane&15)>>2))*64;
  const char*Kbase=shm+LDS_K; bf16x8 kf[8];
  const lds_cptr shm3=(lds_cptr)shm; const lds_cptr kp0=shm3+LDS_K+hi*1024+r32*16; const lds_cptr vp0=shm3+LDS_V+((lane>>4)&1)*32+(lane&3)*8+(4*hi+((lane&15)>>2))*64;
  DMA_K(0,0);DMA_V(0,0);DMA_K(1,SLOTB);
  bf16x8 qr[4];
  #pragma unroll
  for(int d0=0;d0<4;++d0)qr[d0]=*reinterpret_cast<const bf16x8*>(&Qw[(long)r32*QP+d0*16+hi*8]);
  float mhat=0.f,l_reg=0.f;f32x16 o[2];o[0]=f32x16{};o[1]=f32x16{};f32x16 negm=f32x16{};asm volatile("":"+v"(negm));
  const int qrel=wid*QBLK+r32;
  #define CMASK(P0,P1,t) do{ if(MODE==1){amask<true>(P0,P1,koff+64*(t),qrel,hi);} else {const int jb_=(t)-(NT-4); if(jb_>=0)amask<false>(P0,P1,64*jb_,qrel,hi);} }while(0)
  #define NEGM_SET(t) do{ float c_=-mhat; if(MODE==0){ if((t)<NT-4 && !((selmask>>((t)>>2))&1u)) c_=-INFINITY; } \
      _Pragma("unroll") for(int r=0;r<16;++r)negm[r]=c_; asm volatile("":"+v"(negm)); }while(0)
  bool resc=false;
  #define START(P0,P1) do{ const float rm=rowmax(P0,P1); resc=false; \
    if(__any(rm>(float)THRL)){ const float dl=__builtin_fmaxf(rm,0.f); mhat+=dl; \
      _Pragma("unroll") for(int r=0;r<16;++r){P0[r]-=dl;P1[r]-=dl;} } \
    _Pragma("unroll") for(int r=0;r<16;++r)P0[r]=__builtin_amdgcn_exp2f(P0[r]); }while(0)
  #define RESC() do{ if(resc){ asm volatile("s_waitcnt lgkmcnt(0)":::"memory"); \
      _Pragma("unroll") for(int d_=0;d_<2;++d_) _Pragma("unroll") for(int r=0;r<16;++r)o[d_][r]*=wsf[crow(r,hi)]; } }while(0)
  f32x16 pA0,pA1,pB0,pB1;
  int sl_prev=0,sl_cur=0,sl_next=SLOTB;
  #define ROT() do{sl_prev=sl_cur;sl_cur=sl_next;sl_next=(sl_next==(NSLOT-1)*SLOTB)?0:sl_next+SLOTB;}while(0)
  DMA_K(2,2*SLOTB);
  WAIT_BAR(3);
  NEGM_SET(0);
  qkt(pA0,pA1,Kbase,qr,negm,r32,hi);asm volatile("s_nop 15\n\ts_nop 7":"+v"(pA0),"+v"(pA1));CMASK(pA0,pA1,0);
  START(pA0,pA1);
  _Pragma("unroll") for(int r=0;r<16;++r)pA1[r]=__builtin_amdgcn_exp2f(pA1[r]);
  WAIT_BAR(0);
  DMA_K(3,0);DMA_V(1,SLOTB);
  ROT();
  kload8(kf,kp0+sl_cur);
  WAIT_BAR(2);
  s16x4 vlo[8],vhi[8]; u32x4 pw0,pw1,pw2,pw3;
  #define PKW(P,B) cvtpk_s(P[B],P[B+1])
  #define PAF(k) __builtin_bit_cast(bf16x8,pw##k)
  #define VFR(i) (bf16x8){vlo[i][0],vlo[i][1],vlo[i][2],vlo[i][3],vhi[i][0],vhi[i][1],vhi[i][2],vhi[i][3]}
  #define PIN(x) asm volatile("":"+v"(x))
  #define MX3(a,b,c) __builtin_fmaxf(__builtin_fmaxf((a),(b)),(c))
  #define GAPA(MF,A0,A1,A2,A3,W0,W1,PW) do{ MF; sacc+=A0; sacc+=A1; sacc+=A2; sacc+=A3; PIN(sacc); W0; W1; PIN(PW); SBAR(); }while(0)
  #define EX(v) __builtin_amdgcn_exp2f(v)
  #define GAPB(MF,X,B) do{ MF; X[B]=EX(X[B]); X[B+1]=EX(X[B+1]); X[B+2]=EX(X[B+2]); X[B+3]=EX(X[B+3]); PIN(X); SBAR(); }while(0)
  #define VRD(i) do{ vlo[i]=vtr(vp_+(((i)>>2)*4096+((i)&3)*1024)); vhi[i]=vtr(vp_+(((i)>>2)*4096+((i)&3)*1024+512)); }while(0)
  #define KRD(G,j) do{ if(G){ kload2(kf,kp0+sl_next,j); SBAR(); } }while(0)
  #define STEP(C0,C1,P0,P1,t,GK,GV,GL) do{ NEGM_SET(t); SBAR(); \
    const lds_cptr vp_=vp0+sl_prev; \
    VRD(0); SBAR(); float sacc=(P0[0]+P0[1]); \
    GAPA(C0=__builtin_amdgcn_mfma_f32_32x32x16_bf16(kf[0],qr[0],negm,0,0,0), P0[2],P0[3],P0[4],P0[5],     pw0[0]=PKW(P0,0), pw0[1]=PKW(P0,2), pw0); \
    VRD(4); SBAR(); GAPA(C1=__builtin_amdgcn_mfma_f32_32x32x16_bf16(kf[1],qr[0],negm,0,0,0), P0[6],P0[7],P0[8],P0[9],     pw0[2]=PKW(P0,4), pw0[3]=PKW(P0,6), pw0); \
    VRD(1); SBAR(); GAPA(C0=__builtin_amdgcn_mfma_f32_32x32x16_bf16(kf[2],qr[1],C0,0,0,0),   P0[10],P0[11],P0[12],P0[13], pw1[0]=PKW(P0,8), pw1[1]=PKW(P0,10), pw1); \
    VRD(5); SBAR(); GAPA(C1=__builtin_amdgcn_mfma_f32_32x32x16_bf16(kf[3],qr[1],C1,0,0,0),   P0[14],P0[15],P1[0],P1[1],   pw1[2]=PKW(P0,12),pw1[3]=PKW(P0,14), pw1); \
    VRD(2); SBAR(); GAPA(C0=__builtin_amdgcn_mfma_f32_32x32x16_bf16(kf[4],qr[2],C0,0,0,0),   P1[2],P1[3],P1[4],P1[5],     pw2[0]=PKW(P1,0), pw2[1]=PKW(P1,2), pw2); \
    VRD(6); SBAR(); GAPA(C1=__builtin_amdgcn_mfma_f32_32x32x16_bf16(kf[5],qr[2],C1,0,0,0),   P1[6],P1[7],P1[8],P1[9],     pw2[2]=PKW(P1,4), pw2[3]=PKW(P1,6), pw2); \
    VRD(3); SBAR(); GAPA(C0=__builtin_amdgcn_mfma_f32_32x32x16_bf16(kf[6],qr[3],C0,0,0,0),   P1[10],P1[11],P1[12],P1[13], pw3[0]=PKW(P1,8), pw3[1]=PKW(P1,10), pw3); \
    VRD(7); SBAR(); GAPA(C1=__builtin_amdgcn_mfma_f32_32x32x16_bf16(kf[7],qr[3],C1,0,0,0),   P1[14],P1[15],0.f,0.f,       pw3[2]=PKW(P1,12),pw3[3]=PKW(P1,14), pw3); \
    l_reg+=sacc; \
    if(GK){DMA_K((t)+3,sl_cur);} if(GV){DMA_V((t)+1,sl_next);} \
    CMASK(C0,C1,t); \
    { float a=MX3(C0[0],C0[1],C1[0]),b=MX3(C0[2],C0[3],C1[1]); a=MX3(a,C1[2],C1[3]); \
      _Pragma("unroll") for(int r=4;r<16;r+=4){a=MX3(a,C0[r],C0[r+1]);b=MX3(b,C0[r+2],C0[r+3]);a=MX3(a,C1[r],C1[r+1]);b=MX3(b,C1[r+2],C1[r+3]);} \
      float rm=__builtin_fmaxf(a,b); { auto rr=__builtin_amdgcn_permlane32_swap(__float_as_uint(rm),__float_as_uint(rm),false,false); rm=__builtin_fmaxf(__uint_as_float(rr[0]),__uint_as_float(rr[1])); } \
      resc=false; \
      if(__builtin_expect(__any(rm>(float)THRL),0)){ const float dl=__builtin_fmaxf(rm,0.f); mhat+=dl; \
        _Pragma("unroll") for(int r=0;r<16;++r){C0[r]-=dl;C1[r]-=dl;} \
        const float f=__builtin_amdgcn_exp2f(-dl); l_reg*=f; if(hi==0)wsf[r32]=f; resc=true; } } \
    SBAR(); \
    GAPB(o[0]=__builtin_amdgcn_mfma_f32_32x32x16_bf16(PAF(0),VFR(0),o[0],0,0,0), C0,0); \
    GAPB(o[1]=__builtin_amdgcn_mfma_f32_32x32x16_bf16(PAF(0),VFR(4),o[1],0,0,0), C0,4); \
    KRD(GL,0); GAPB(o[0]=__builtin_amdgcn_mfma_f32_32x32x16_bf16(PAF(1),VFR(1),o[0],0,0,0), C0,8); \
    KRD(GL,1); GAPB(o[1]=__builtin_amdgcn_mfma_f32_32x32x16_bf16(PAF(1),VFR(5),o[1],0,0,0), C0,12); \
    KRD(GL,2); GAPB(o[0]=__builtin_amdgcn_mfma_f32_32x32x16_bf16(PAF(2),VFR(2),o[0],0,0,0), C1,0); \
    KRD(GL,3); GAPB(o[1]=__builtin_amdgcn_mfma_f32_32x32x16_bf16(PAF(2),VFR(6),o[1],0,0,0), C1,4); \
    GAPB(o[0]=__builtin_amdgcn_mfma_f32_32x32x16_bf16(PAF(3),VFR(3),o[0],0,0,0), C1,8); \
    GAPB(o[1]=__builtin_amdgcn_mfma_f32_32x32x16_bf16(PAF(3),VFR(7),o[1],0,0,0), C1,12); \
    }while(0)
  int t=1;
  #undef CMASK
  #define CMASK(P0,P1,t) do{}while(0)
  for(;t+5<NT;t+=2){
    STEP(pB0,pB1,pA0,pA1,t,true,true,true);     WAIT_BAR(2); RESC(); ROT();
    STEP(pA0,pA1,pB0,pB1,t+1,true,true,true);   WAIT_BAR(2); RESC(); ROT();
  }
  #undef CMASK
  #define CMASK(P0,P1,t) do{ if(MODE==1){amask<true>(P0,P1,koff+64*(t),qrel,hi);} else {const int jb_=(t)-(NT-4); if(jb_>=0)amask<false>(P0,P1,64*jb_,qrel,hi);} }while(0)
  #define ENDW(tt) do{ if((tt)+3<NT){WAIT_BAR(2);} else if((tt)+2<NT){WAIT_BAR(1);} else {WAIT_BAR(0);} }while(0)
  for(;t+1<NT;t+=2){
    STEP(pB0,pB1,pA0,pA1,t,(t+3<NT),(t+1<NT),(t+1<NT));       ENDW(t);   RESC(); ROT();
    STEP(pA0,pA1,pB0,pB1,t+1,(t+4<NT),(t+2<NT),(t+2<NT));     ENDW(t+1); RESC(); ROT();
  }
  STEP(pB0,pB1,pA0,pA1,NT-1,false,false,false); RESC();
  { float sacc=pB0[0]+pB0[1]; _Pragma("unroll") for(int r=2;r<16;++r)sacc+=pB0[r]; _Pragma("unroll") for(int r=0;r<16;++r)sacc+=pB1[r]; l_reg+=sacc;
    pw0=(u32x4){PKW(pB0,0),PKW(pB0,2),PKW(pB0,4),PKW(pB0,6)};pw1=(u32x4){PKW(pB0,8),PKW(pB0,10),PKW(pB0,12),PKW(pB0,14)};pw2=(u32x4){PKW(pB1,0),PKW(pB1,2),PKW(pB1,4),PKW(pB1,6)};pw3=(u32x4){PKW(pB1,8),PKW(pB1,10),PKW(pB1,12),PKW(pB1,14)};
    SBAR(); pv(o,vb0+sl_cur,PAF(0),PAF(1),PAF(2),PAF(3)); }
  #undef PKW
  #undef PAF
  #undef VFR
  #undef PIN
  #undef MX3
  #undef GAPA
  #undef GAPB
  #undef EX
  #undef VRD
  #undef KRD
  #undef STEP
  #undef ENDW
  {auto rr=__builtin_amdgcn_permlane32_swap(__float_as_uint(l_reg),__float_as_uint(l_reg),false,false);l_reg=__uint_as_float(rr[0])+__uint_as_float(rr[1]);}
  if(MODE==1)l_reg+=__builtin_amdgcn_exp2f(sinkl2-mhat);
  if(hi==0)wsf[32+r32]=l_reg;asm volatile("s_waitcnt lgkmcnt(0)":::"memory");
  float rli[16];
  #pragma unroll
  for(int r=0;r<16;++r)rli[r]=__builtin_amdgcn_rcpf(wsf[32+crow(r,hi)]);
  bf16*Ow=Ow0+(long)(wid*QBLK)*QP;
  { bf16*stg=(bf16*)(shm+LDS_OST)+wid*2048;
    #pragma unroll
    for(int r=0;r<16;++r){const int orow=crow(r,hi);
      #pragma unroll
      for(int d0=0;d0<2;++d0)stg[orow*64+d0*32+r32]=__float2bfloat16(o[d0][r]*rli[r]);}
    asm volatile("s_waitcnt lgkmcnt(0)":::"memory");
    #pragma unroll
    for(int i=0;i<4;++i){const int row=i*8+(lane>>3),ch=lane&7; const u32x4 v=*(const u32x4*)(stg+row*64+ch*8); ATTN_STORE16(Ow+(long)row*QP+ch*8,v);} }
  asm volatile("s_waitcnt lgkmcnt(0)\n\ts_barrier":::"memory");
  #undef DMA_K
  #undef DMA_V
  #undef CMASK
  #undef START
  #undef NEGM_SET
  #undef RESC
  #undef ROT
}
constexpr int ATTN_LDS_BYTES=LDS_BYTES;
#undef SBAR
#undef WAIT_BAR
}
constexpr float ATT_C2 = 0.125f * 1.4426950408889634f;
__device__ __forceinline__ void swa_phase(const Frame& F_in, const Params& P_in, int l) {
    PH_BEGIN
    bf16* AQ = (bf16*)(P.ws + WS_R + RO_AQ); const bf16* AK = (const bf16*)(P.ws + WS_R + RO_AK); const bf16* AV = (const bf16*)(P.ws + WS_R + RO_AV);
    const float* sinks = P.in[I_SINK] + l * 8; char* shm = (char*)F.lds;
    for (int idx = F.vcu; idx < 256; idx += F.G) {
        const int bh = idx >> 4, s = idx & 15, b = bh >> 3, hq = bh & 7, hkv = hq >> 2; const float sk = sinks[hq] * 1.4426950408889634f;
        for (int i = 0; i < 2; ++i) {
            const int qb = i ? 31 - s : s; const size_t row0 = (size_t)b * SEQ + (size_t)qb * 256; const int koff = qb ? -128 : 0, NT = qb ? 6 : 4;
            attn_body::attn_unit<1, 8>((const attn_body::bf16*)(AQ + row0 * 512 + hq * 64), (attn_body::bf16*)(AQ + row0 * 512 + hq * 64), 512,
                (const attn_body::bf16*)(AK + (size_t)((long)row0 + koff) * 128 + hkv * 64), (const attn_body::bf16*)(AV + (size_t)((long)row0 + koff) * 128 + hkv * 64), 128, NT, koff, 0u, sk, shm);
        }
    }
}
__device__ __forceinline__ void moba_phase(const Frame& F_in, const Params& P_in) {
    PH_BEGIN
    bf16* BQ = (bf16*)(P.ws + WS_R + RO_BQ); const bf16* BK = (const bf16*)(P.ws + WS_R + RO_BK); const bf16* BV = (const bf16*)(P.ws + WS_R + RO_BV);
    const float* kbp = (const float*)(P.ws + WS_KBP); char* shm = (char*)F.lds; const int tid = F.tid;
    LAS float* kb_s = (LAS float*)(F.lds + 98304); LAS unsigned* sel_s = (LAS unsigned*)(F.lds + 98304 + 8192);
    for (int idx = F.vcu; idx < 256; idx += F.G) {
        const int bh = idx >> 4, s = idx & 15, b = bh >> 3, h = bh & 7;
        for (int i = 0; i < 2; ++i) {
            const int qb = i ? s : 31 - s; const size_t row0 = (size_t)b * SEQ + (size_t)qb * 256;
            for (int e = tid; e < qb * 64; e += 512) { const int n = e >> 6, d = e & 63; const float* kp = kbp + ((size_t)(b * 32 + n) * 2) * 512 + h * 64 + d; kb_s[e] = kp[0] + kp[512]; }
            __syncthreads();
            if (tid < 256) {
                const GAS v4u* qp = (const GAS v4u*)(BQ + (row0 + tid) * 512 + h * 64); float q[64];
#pragma unroll
                for (int c = 0; c < 8; ++c) { const v4u w = qp[c]; q[8 * c] = bflo(w.x); q[8 * c + 1] = bfhi(w.x); q[8 * c + 2] = bflo(w.y); q[8 * c + 3] = bfhi(w.y); q[8 * c + 4] = bflo(w.z); q[8 * c + 5] = bfhi(w.z); q[8 * c + 6] = bflo(w.w); q[8 * c + 7] = bfhi(w.w); }
                float v1 = -INFINITY, v2 = -INFINITY, v3 = -INFINITY; int i1 = 0, i2 = 0, i3 = 0;
                for (int n = 0; n < qb; ++n) { const LAS f32x4* kr = (const LAS f32x4*)(kb_s + n * 64); float sc = 0.f;
#pragma unroll
                    for (int c = 0; c < 16; ++c) { const f32x4 kv = kr[c]; sc += (q[4 * c] * kv.x + q[4 * c + 1] * kv.y) + (q[4 * c + 2] * kv.z + q[4 * c + 3] * kv.w); }
                    if (sc > v1) { v3 = v2; i3 = i2; v2 = v1; i2 = i1; v1 = sc; i1 = n; } else if (sc > v2) { v3 = v2; i3 = i2; v2 = sc; i2 = n; } else if (sc > v3) { v3 = sc; i3 = n; } }
                unsigned mask;
                if (qb <= 3) mask = (1u << qb) - 1u; else mask = (1u << i1) | (1u << i2) | (1u << i3);
                sel_s[tid] = mask;
            }
            __syncthreads();
            const unsigned selmask = sel_s[F.wave * 32 + (F.lane & 31)];
            attn_body::attn_unit<0, 8>((const attn_body::bf16*)(BQ + row0 * 512 + h * 64), (attn_body::bf16*)(BQ + row0 * 512 + h * 64), 512,
                (const attn_body::bf16*)(BK + (size_t)b * SEQ * 512 + h * 64), (const attn_body::bf16*)(BV + (size_t)b * SEQ * 512 + h * 64), 512, 4 * (qb + 1), 0, selmask, 0.f, shm);
        }
    }
}
namespace epi {
using pg8::f32x4; using pg8::Unit; using pg8::u32x4; using pg8::cvt_pk_bf16;
typedef const f32x4 (&Acc)[2][2][4][2];
__device__ __forceinline__ float sigmoidf_(float x) { return __builtin_amdgcn_rcpf(1.0f + __builtin_amdgcn_exp2f(-1.4426950408889634f * x)); }
__device__ __forceinline__ float siluf_(float x) { return x * __builtin_amdgcn_rcpf(1.0f + __builtin_amdgcn_exp2f(-1.4426950408889634f * x)); }
__device__ __forceinline__ float logsigmoidf_(float x) { return fminf(x, 0.f) - 0.6931471805599453f * __builtin_amdgcn_logf(1.0f + __builtin_amdgcn_exp2f(-1.4426950408889634f * fabsf(x))); }
__device__ __forceinline__ u32x4 pack8(const f32x4& a, const f32x4& b) { u32x4 w; w.x = cvt_pk_bf16(a[0], a[1]); w.y = cvt_pk_bf16(a[2], a[3]); w.z = cvt_pk_bf16(b[0], b[1]); w.w = cvt_pk_bf16(b[2], b[3]); return w; }
__device__ __forceinline__ void unpack8(const u32x4& w, f32x4& a, f32x4& b) { a = (f32x4){bflo(w.x), bfhi(w.x), bflo(w.y), bfhi(w.y)}; b = (f32x4){bflo(w.z), bfhi(w.z), bflo(w.w), bfhi(w.w)}; }
__device__ __forceinline__ float row_rs(const float* ssq, int row) {
    const f32x4* p = (const f32x4*)(ssq + (size_t)row * 16); const f32x4 a = p[0], b = p[1], c = p[2], d = p[3];
    const float s = ((a[0] + a[1]) + (a[2] + a[3])) + ((b[0] + b[1]) + (b[2] + b[3])) + ((c[0] + c[1]) + (c[2] + c[3])) + ((d[0] + d[1]) + (d[2] + d[3]));
    return __builtin_amdgcn_rsqf(s * (1.0f / DM) + RMS_EPS);
}

constexpr int RS_OFF = LDSCTL_OFF + 12288;
__device__ __forceinline__ const LAS float* stage_rs(const float* ssq, const float* rsg, int pm, LAS unsigned char* lb) {
    LAS float* rs_s = (LAS float*)(lb + RS_OFF); const int t = threadIdx.x;
    if (t < 256) { const int row = pm * 256 + t; rs_s[t] = rsg ? rsg[row] : row_rs(ssq, row); }
    asm volatile("s_waitcnt lgkmcnt(0)" ::: "memory"); __builtin_amdgcn_s_barrier(); asm volatile("" ::: "memory");
    return rs_s;
}
struct EpiInproj {
    static constexpr bool PERM = true;
    unsigned char* R; const float* ssq; const float* gbias; float* kbp; LAS unsigned char* lb;
    template <int ACT, bool KSUM>
    __device__ __forceinline__ void store_half(Acc acc, const int bj, bf16* dst, const int ldc, const int col, const Unit& u, int wr, int fr, const LAS float* rs_s, const float sc = 1.0f) const {
        f32x4 ks0 = (f32x4){0.f, 0.f, 0.f, 0.f}, ks1 = ks0;
#pragma unroll
        for (int ai = 0; ai < 2; ++ai)
#pragma unroll
            for (int m = 0; m < 4; ++m) {
                const int row = u.pm * 256 + ai * 128 + wr * 64 + m * 16 + fr; const float rs = rs_s[ai * 128 + wr * 64 + m * 16 + fr] * sc;
                f32x4 v0 = acc[ai][bj][m][0] * rs, v1 = acc[ai][bj][m][1] * rs;
                if (ACT == 1) {
#pragma unroll
                    for (int i = 0; i < 4; ++i) { v0[i] = siluf_(v0[i]); v1[i] = siluf_(v1[i]); }
                }
                if (KSUM) { ks0 += v0; ks1 += v1; }
                *(u32x4*)(dst + (size_t)row * ldc + col) = pack8(v0, v1);
            }
        if (KSUM) {
#pragma unroll
            for (int i = 0; i < 4; ++i) {
#pragma unroll
                for (int o = 1; o < 16; o <<= 1) { ks0[i] += __shfl_xor(ks0[i], o); ks1[i] += __shfl_xor(ks1[i], o); }
            }
            if (fr == 0) { float* kp = kbp + ((size_t)u.pm * 2 + wr) * 512 + col; *(f32x4*)kp = ks0; *(f32x4*)(kp + 4) = ks1; }
        }
    }
    __device__ __forceinline__ void operator()(Acc acc, const Unit& u, int wr, int wc, int fr, int fq) const {
        const int pn = u.pn; const int c0 = wc * 32 + 8 * fq;
        const LAS float* rs_s = stage_rs(ssq, nullptr, u.pm, lb);
        if (pn == 15) {
#pragma unroll
            for (int bj = 0; bj < 2; ++bj) { const int col = bj * 128 + c0; const f32x4 b0 = *(const f32x4*)(gbias + col), b1 = *(const f32x4*)(gbias + col + 4);
#pragma unroll
                for (int ai = 0; ai < 2; ++ai)
#pragma unroll
                    for (int m = 0; m < 4; ++m) {
                        const int row = u.pm * 256 + ai * 128 + wr * 64 + m * 16 + fr; const float rs = rs_s[ai * 128 + wr * 64 + m * 16 + fr];
                        f32x4 v0 = acc[ai][bj][m][0] * rs + b0, v1 = acc[ai][bj][m][1] * rs + b1;
#pragma unroll
                        for (int i = 0; i < 4; ++i) { v0[i] = logsigmoidf_(v0[i]) * (1.0f / 16.0f); v1[i] = logsigmoidf_(v1[i]) * (1.0f / 16.0f); }
                        float* gl = (float*)(R + RO_GL) + (size_t)row * 256 + col; *(f32x4*)gl = v0; *(f32x4*)(gl + 4) = v1;
                    } }
        } else if (pn == 5 || pn == 6) {
            bf16* dst = (bf16*)(R + RO_BK); const int cb = (pn - 5) * 256 + c0;
            store_half<0, true>(acc, 0, dst, 512, cb, u, wr, fr, rs_s); store_half<0, true>(acc, 1, dst, 512, cb + 128, u, wr, fr, rs_s);
        } else if (pn == 13 || pn == 14) {
            bf16* dst = (bf16*)(R + RO_CR); const int cb = (pn - 13) * 256 + c0;
            store_half<1, false>(acc, 0, dst, 512, cb, u, wr, fr, rs_s); store_half<1, false>(acc, 1, dst, 512, cb + 128, u, wr, fr, rs_s);
        } else if (pn == 2) {
            store_half<0, false>(acc, 0, (bf16*)(R + RO_AK), 128, c0, u, wr, fr, rs_s); store_half<0, false>(acc, 1, (bf16*)(R + RO_AV), 128, c0, u, wr, fr, rs_s);
        } else {
            bf16* dst; int ldc, cb; float sc = 1.0f;
            if (pn < 2)        { dst = (bf16*)(R + RO_AQ); ldc = 512; cb = pn * 256; sc = ATT_C2; }
            else if (pn < 5)   { dst = (bf16*)(R + RO_BQ); ldc = 512; cb = (pn - 3) * 256; sc = ATT_C2; }
            else if (pn < 9)   { dst = (bf16*)(R + RO_BV); ldc = 512; cb = (pn - 7) * 256; }
            else if (pn == 9)  { dst = (bf16*)(R + RO_CQ); ldc = 256; cb = 0; }
            else if (pn == 10) { dst = (bf16*)(R + RO_CK); ldc = 256; cb = 0; }
            else               { dst = (bf16*)(R + RO_CV); ldc = 512; cb = (pn - 11) * 256; }
            store_half<0, false>(acc, 0, dst, ldc, cb + c0, u, wr, fr, rs_s, sc); store_half<0, false>(acc, 1, dst, ldc, cb + c0 + 128, u, wr, fr, rs_s, sc);
        }
    }
};
struct EpiGates {
    static constexpr bool PERM = true;
    bf16* G; const float* ssq; LAS unsigned char* lb;
    __device__ __forceinline__ void operator()(Acc acc, const Unit& u, int wr, int wc, int fr, int fq) const {
        const LAS float* rs_s = stage_rs(ssq, nullptr, u.pm, lb);
#pragma unroll
        for (int ai = 0; ai < 2; ++ai)
#pragma unroll
            for (int m = 0; m < 4; ++m) {
                const int row = u.pm * 256 + ai * 128 + wr * 64 + m * 16 + fr; const float rs = rs_s[ai * 128 + wr * 64 + m * 16 + fr];
#pragma unroll
                for (int bj = 0; bj < 2; ++bj) { f32x4 v0 = acc[ai][bj][m][0] * rs, v1 = acc[ai][bj][m][1] * rs;
#pragma unroll
                    for (int i = 0; i < 4; ++i) { v0[i] = sigmoidf_(v0[i]); v1[i] = sigmoidf_(v1[i]); }
                    *(u32x4*)(G + (size_t)row * NGATES + u.pn * 256 + bj * 128 + wc * 32 + 8 * fq) = pack8(v0, v1); }
            }
    }
};
struct EpiBranch {
    static constexpr bool PERM = true;
    const bf16* G; bf16* Y;
    __device__ __forceinline__ void operator()(Acc acc, const Unit& u, int wr, int wc, int fr, int fq) const {
        const int seg = u.aux;
#pragma unroll
        for (int ai = 0; ai < 2; ++ai)
#pragma unroll
            for (int m = 0; m < 4; ++m) {
                const int row = u.pm * 256 + ai * 128 + wr * 64 + m * 16 + fr;
#pragma unroll
                for (int bj = 0; bj < 2; ++bj) { const int col = u.pn * 256 + bj * 128 + wc * 32 + 8 * fq;
                    const u32x4 gw = *(const u32x4*)(G + (size_t)row * NGATES + seg * DM + col); f32x4 g0, g1; unpack8(gw, g0, g1);
                    f32x4 y0 = acc[ai][bj][m][0] * g0, y1 = acc[ai][bj][m][1] * g1;
                    bf16* yp = Y + (size_t)row * DM + col;
                    if (seg > 0) { const u32x4 ow = *(const u32x4*)yp; f32x4 o0, o1; unpack8(ow, o0, o1); y0 += o0; y1 += o1; }
                    *(u32x4*)yp = pack8(y0, y1); }
            }
    }
};
struct EpiResid {
    static constexpr bool PERM = true;
    const float* base; float* out; bf16* XB; float* ssq;
    __device__ __forceinline__ void operator()(Acc acc, const Unit& u, int wr, int wc, int fr, int fq) const {
#pragma unroll
        for (int ai = 0; ai < 2; ++ai)
#pragma unroll
            for (int m = 0; m < 4; ++m) {
                const int row = u.pm * 256 + ai * 128 + wr * 64 + m * 16 + fr; float s = 0.f;
#pragma unroll
                for (int bj = 0; bj < 2; ++bj) { const size_t off = (size_t)row * DM + u.pn * 256 + bj * 128 + wc * 32 + 8 * fq;
                    const f32x4 x0 = *(const f32x4*)(base + off) + acc[ai][bj][m][0], x1 = *(const f32x4*)(base + off + 4) + acc[ai][bj][m][1];
                    *(f32x4*)(out + off) = x0; *(f32x4*)(out + off + 4) = x1;
                    *(u32x4*)(XB + off) = pack8(x0, x1);
                    s += ((x0[0] * x0[0] + x0[1] * x0[1]) + (x0[2] * x0[2] + x0[3] * x0[3])) + ((x1[0] * x1[0] + x1[1] * x1[1]) + (x1[2] * x1[2] + x1[3] * x1[3])); }
                s += __shfl_xor(s, 16); s += __shfl_xor(s, 32);
                if (fq == 0) ssq[(size_t)row * 16 + u.pn * 4 + wc] = s;
            }
    }
};
struct EpiSwiglu {
    static constexpr bool PERM = true;
    bf16* H; int ldh; const float* ssq; const float* rsg; LAS unsigned char* lb;
    __device__ __forceinline__ void operator()(Acc acc, const Unit& u, int wr, int wc, int fr, int fq) const {
        const LAS float* rs_s = stage_rs(ssq, rsg, u.pm, lb);
#pragma unroll
        for (int ai = 0; ai < 2; ++ai)
#pragma unroll
            for (int m = 0; m < 4; ++m) {
                const int row = u.pm * 256 + ai * 128 + wr * 64 + m * 16 + fr; const float rs = rs_s[ai * 128 + wr * 64 + m * 16 + fr];
                f32x4 g0 = acc[ai][0][m][0] * rs, g1 = acc[ai][0][m][1] * rs; const f32x4 u0 = acc[ai][1][m][0] * rs, u1 = acc[ai][1][m][1] * rs;
#pragma unroll
                for (int i = 0; i < 4; ++i) { g0[i] = siluf_(g0[i]) * u0[i]; g1[i] = siluf_(g1[i]) * u1[i]; }
                *(u32x4*)(H + (size_t)row * ldh + u.aux * 128 + wc * 32 + 8 * fq) = pack8(g0, g1);
            }
    }
};
struct EpiMoeDown {
    static constexpr bool PERM = true;
    bf16* YE; const float* pw;
    __device__ __forceinline__ void operator()(Acc acc, const Unit& u, int wr, int wc, int fr, int fq) const {
#pragma unroll
        for (int ai = 0; ai < 2; ++ai)
#pragma unroll
            for (int m = 0; m < 4; ++m) {
                const int row = u.pm * 256 + ai * 128 + wr * 64 + m * 16 + fr; const float p = pw[row];
#pragma unroll
                for (int bj = 0; bj < 2; ++bj) *(u32x4*)(YE + (size_t)row * DM + u.pn * 256 + bj * 128 + wc * 32 + 8 * fq) = pack8(acc[ai][bj][m][0] * p, acc[ai][bj][m][1] * p);
            }
    }
};
}
__device__ __forceinline__ float rdl(float v, int l) { return __builtin_bit_cast(float, __builtin_amdgcn_readlane(__builtin_bit_cast(int, v), l)); }
__device__ __forceinline__ float qdot64(float q, const bf16* p) {
    const GAS v4u* kp = (const GAS v4u*)p; float s = 0.f;
#pragma unroll
    for (int c = 0; c < 8; ++c) { const v4u w = kp[c];
        s += rdl(q, 8 * c + 0) * bflo(w.x) + rdl(q, 8 * c + 1) * bfhi(w.x) + rdl(q, 8 * c + 2) * bflo(w.y) + rdl(q, 8 * c + 3) * bfhi(w.y)
           + rdl(q, 8 * c + 4) * bflo(w.z) + rdl(q, 8 * c + 5) * bfhi(w.z) + rdl(q, 8 * c + 6) * bflo(w.w) + rdl(q, 8 * c + 7) * bfhi(w.w); }
    return s;
}
__device__ __forceinline__ float pv64(float o, float p, const bf16* V, size_t row0, int ldv, int vcol, int lane) {
#pragma unroll 16
    for (int j = 0; j < 64; ++j) o += rdl(p, j) * bf2f(V[(row0 + j) * ldv + vcol + lane]);
    return o;
}

__device__ __forceinline__ void swa_naive(const Frame& F_in, const Params& P_in, int l, int gw, int NGW) {
    PH_BEGIN
    bf16* AQ = (bf16*)(P.ws + WS_R + RO_AQ); const bf16* AK = (const bf16*)(P.ws + WS_R + RO_AK); const bf16* AV = (const bf16*)(P.ws + WS_R + RO_AV);
    const float* sinks = P.in[I_SINK] + l * 8; const int lane = F.lane;
    for (int item = gw; item < T * 8; item += NGW) {
        const int t = item >> 3, hq = item & 7, hkv = hq >> 2, tl = t & (SEQ - 1); const size_t rb = (size_t)(t - tl);
        const float q = bf2f(AQ[(size_t)t * 512 + hq * 64 + lane]) * 0.125f;
        const int kA = tl - 127 + lane, kB = tl - 63 + lane; const bool vA = kA >= 0, vB = kB >= 0;
        const int kA0 = tl - 127 < 0 ? 0 : tl - 127, kB0 = tl - 63 < 0 ? 0 : tl - 63;
        float sA = qdot64(q, AK + (rb + (vA ? kA : 0)) * 128 + hkv * 64), sB = qdot64(q, AK + (rb + (vB ? kB : 0)) * 128 + hkv * 64);
        sA = vA ? sA : -INFINITY; sB = vB ? sB : -INFINITY;
        const float sink = sinks[hq];
        const float m = fmaxf(wave_max(fmaxf(sA, sB)), sink);
        const float pA = vA ? __expf(sA - m) : 0.f, pB = vB ? __expf(sB - m) : 0.f;
        const float den = wave_sum(pA + pB) + __expf(sink - m);
        float o = 0.f;
        if (tl >= 127) { o = pv64(o, pA, AV, rb + tl - 127, 128, hkv * 64, lane); o = pv64(o, pB, AV, rb + tl - 63, 128, hkv * 64, lane); }
        else {
#pragma unroll 8
            for (int j = 0; j < 64; ++j) { const int ka = tl - 127 + j, kb = tl - 63 + j;
                o += rdl(pA, j) * bf2f(AV[(rb + (ka < 0 ? 0 : ka)) * 128 + hkv * 64 + lane]) + rdl(pB, j) * bf2f(AV[(rb + (kb < 0 ? 0 : kb)) * 128 + hkv * 64 + lane]); }
        }
        (void)kA0; (void)kB0;
        AQ[(size_t)t * 512 + hq * 64 + lane] = (bf16)f2bf(o / den);
    }
}

__device__ __forceinline__ void moba_naive(const Frame& F_in, const Params& P_in, int gw, int NGW) {
    PH_BEGIN
    bf16* BQ = (bf16*)(P.ws + WS_R + RO_BQ); const bf16* BK = (const bf16*)(P.ws + WS_R + RO_BK); const bf16* BV = (const bf16*)(P.ws + WS_R + RO_BV);
    const float* kbp = (const float*)(P.ws + WS_KBP); const int lane = F.lane;
    for (int item = gw; item < T * 8; item += NGW) {
        const int t = item >> 3, h = item & 7, b = t >> 13, tl = t & (SEQ - 1), cur = tl >> 8; const size_t rb = (size_t)b * SEQ;
        const float q = bf2f(BQ[(size_t)t * 512 + h * 64 + lane]);
        float gs = -INFINITY;
        { const int n = lane < cur ? lane : 0; const float* k0 = kbp + ((size_t)(b * 32 + n) * 2) * 512 + h * 64; float s = 0.f;
#pragma unroll 8
          for (int d = 0; d < 64; ++d) s += rdl(q, d) * (k0[d] + k0[512 + d]);
          if (lane < cur) gs = s * (1.0f / 256.0f); }
        const int nsel = cur < 3 ? cur : 3; int s0 = 0, s1 = 0, s2 = 0;
        for (int r = 0; r < nsel; ++r) { const float mx = wave_max(gs); const unsigned long long bal = __ballot(gs == mx); const int j = __ffsll((long long)bal) - 1;
            if (r == 0) s0 = j; else if (r == 1) s1 = j; else s2 = j; if (lane == j) gs = -INFINITY; }
        float m = -INFINITY, lsum = 0.f, o = 0.f; const float qs = q * 0.125f;
        for (int i = 0; i <= nsel; ++i) {
            const bool own = (i == nsel); const int blk = own ? cur : (i == 0 ? s0 : (i == 1 ? s1 : s2));
            for (int tile = 0; tile < 4; ++tile) {
                const int kp0 = blk * 256 + tile * 64; if (own && kp0 > tl) break;
                const int kpos = kp0 + lane; const bool valid = !own || kpos <= tl;
                float s = qdot64(qs, BK + (rb + kpos) * 512 + h * 64); s = valid ? s : -INFINITY;
                const float mn = fmaxf(m, wave_max(s)); const float sc = __expf(m - mn); const float p = valid ? __expf(s - mn) : 0.f;
                lsum = lsum * sc + wave_sum(p); o = pv64(o * sc, p, BV, rb + kp0, 512, h * 64, lane); m = mn;
            }
        }
        BQ[(size_t)t * 512 + h * 64 + lane] = (bf16)f2bf(o / lsum);
    }
}

__device__ __forceinline__ void gla_cumsum(const float* GL, size_t t0, int h, LAS float* bcum, int tid) {
    if (tid < 64) { float run = 0.f;
#pragma unroll 8
        for (int s = 0; s < 64; ++s) { run += GL[(t0 + s) * 256 + h * 64 + tid]; bcum[s * 64 + tid] = run; } }
}
__device__ __forceinline__ void gla_pass1(const Frame& F_in, const Params& P_in) {
    PH_BEGIN
    const float* GL = (const float*)(P.ws + WS_R + RO_GL); const bf16* CK = (const bf16*)(P.ws + WS_R + RO_CK); const bf16* CV = (const bf16*)(P.ws + WS_R + RO_CV);
    float* S = (float*)(P.ws + WS_S); float* DEC = (float*)(P.ws + WS_DEC);
    LAS float* bcum = (LAS float*)(F.lds); LAS float* kd = bcum + 4096; LAS float* vv = kd + 4096; const int tid = F.tid;
    for (int unit = F.vcu; unit < 8 * 128; unit += F.G) {
        const int bh = unit >> 7, n = unit & 127, b = bh >> 2, h = bh & 3; const size_t t0 = (size_t)b * SEQ + n * 64;
        gla_cumsum(GL, t0, h, bcum, tid);
        __syncthreads();
        for (int idx = tid; idx < 4096; idx += 512) { const int s = idx >> 6, d = idx & 63; kd[idx] = bf2f(CK[(t0 + s) * 256 + h * 64 + d]) * __expf(bcum[63 * 64 + d] - bcum[idx]); }
        for (int idx = tid; idx < 8192; idx += 512) { const int s = idx >> 7, e = idx & 127; vv[idx] = bf2f(CV[(t0 + s) * 512 + h * 128 + e]); }
        __syncthreads();
        { const int d = tid >> 3, e0 = (tid & 7) * 16; float a[16];
#pragma unroll
          for (int j = 0; j < 16; ++j) a[j] = 0.f;
          for (int s = 0; s < 64; ++s) { const float kv = kd[s * 64 + d];
#pragma unroll
              for (int j = 0; j < 16; ++j) a[j] += kv * vv[s * 128 + e0 + j]; }
          float* so = S + (((size_t)bh * 128 + n) * 64 + d) * 128 + e0;
#pragma unroll
          for (int j = 0; j < 16; j += 4) *(f32x4*)(so + j) = (f32x4){a[j], a[j + 1], a[j + 2], a[j + 3]};
          if (tid < 64) DEC[((size_t)bh * 128 + n) * 64 + tid] = __expf(bcum[63 * 64 + tid]); }
        __syncthreads();
    }
}
__device__ __forceinline__ void gla_scan(const Frame& F_in, const Params& P_in) {
    PH_BEGIN
    float* S = (float*)(P.ws + WS_S); const float* DEC = (const float*)(P.ws + WS_DEC);
    if (F.tid >= 256) return;
    for (int grp = F.vcu; grp < 256; grp += F.G) {
        const int idx = grp * 256 + F.tid, bh = idx >> 13, d = (idx >> 7) & 63, e = idx & 127;
        float* sp = S + ((size_t)bh * 128 * 64 + d) * 128 + e; const float* dp = DEC + (size_t)bh * 128 * 64 + d; float st = 0.f;
        for (int n0 = 0; n0 < 128; n0 += 8) { float u[8], dc[8];
#pragma unroll
            for (int j = 0; j < 8; ++j) { u[j] = sp[(size_t)(n0 + j) * 8192]; dc[j] = dp[(n0 + j) * 64]; }
#pragma unroll
            for (int j = 0; j < 8; ++j) { sp[(size_t)(n0 + j) * 8192] = st; st = dc[j] * st + u[j]; } }
    }
}
__device__ __forceinline__ void gla_pass3(const Frame& F_in, const Params& P_in, int l) {
    PH_BEGIN
    const float* GL = (const float*)(P.ws + WS_R + RO_GL); const bf16* CQ = (const bf16*)(P.ws + WS_R + RO_CQ); const bf16* CK = (const bf16*)(P.ws + WS_R + RO_CK); const bf16* CV = (const bf16*)(P.ws + WS_R + RO_CV);
    bf16* CR = (bf16*)(P.ws + WS_R + RO_CR); const float* S = (const float*)(P.ws + WS_S); const float* gng = P.in[I_GNG] + l * 512;
    LAS float* bcum = (LAS float*)(F.lds); LAS float* qin = bcum + 4096; LAS float* kin = qin + 4096; LAS float* am = kin + 4096; LAS float* vv = am + 4096; LAS float* sp = vv + 8192; const int tid = F.tid;
    for (int unit = F.vcu; unit < 8 * 128; unit += F.G) {
        const int bh = unit >> 7, n = unit & 127, b = bh >> 2, h = bh & 3; const size_t t0 = (size_t)b * SEQ + n * 64;
        gla_cumsum(GL, t0, h, bcum, tid);
        __syncthreads();
        for (int idx = tid; idx < 4096; idx += 512) { const int s = idx >> 6, d = idx & 63; const float bb = bcum[idx];
            qin[idx] = bf2f(CQ[(t0 + s) * 256 + h * 64 + d]) * 0.125f * __expf(bb); kin[idx] = bf2f(CK[(t0 + s) * 256 + h * 64 + d]) * __expf(-bb); }
        for (int idx = tid; idx < 8192; idx += 512) { const int s = idx >> 7, e = idx & 127; vv[idx] = bf2f(CV[(t0 + s) * 512 + h * 128 + e]); sp[idx] = S[(((size_t)bh * 128 + n) * 64) * 128 + idx]; }
        __syncthreads();
        for (int idx = tid; idx < 4096; idx += 512) { const int tt = idx >> 6, s = idx & 63; float a = 0.f;
            if (s <= tt) {
#pragma unroll 8
                for (int d = 0; d < 64; ++d) a += qin[tt * 64 + d] * kin[s * 64 + d]; }
            am[idx] = a; }
        __syncthreads();
        { const int tt = tid >> 3, e0 = (tid & 7) * 16; float o[16];
#pragma unroll
          for (int j = 0; j < 16; ++j) o[j] = 0.f;
          for (int s = 0; s <= tt; ++s) { const float a = am[tt * 64 + s];
#pragma unroll
              for (int j = 0; j < 16; ++j) o[j] += a * vv[s * 128 + e0 + j]; }
          for (int d = 0; d < 64; ++d) { const float qv = qin[tt * 64 + d];
#pragma unroll
              for (int j = 0; j < 16; ++j) o[j] += qv * sp[d * 128 + e0 + j]; }
          float ms = 0.f;
#pragma unroll
          for (int j = 0; j < 16; ++j) ms += o[j] * o[j];
          ms += __shfl_xor(ms, 1); ms += __shfl_xor(ms, 2); ms += __shfl_xor(ms, 4);
          const float rinv = 1.0f / sqrtf(ms * (1.0f / 128.0f) + RMS_EPS);
          bf16* crp = CR + (t0 + tt) * 512 + h * 128 + e0;
#pragma unroll
          for (int j = 0; j < 16; ++j) crp[j] = (bf16)f2bf(o[j] * rinv * gng[h * 128 + e0 + j] * bf2f(crp[j])); }
        __syncthreads();
    }
}
namespace gla {
typedef short bf16x8 __attribute__((ext_vector_type(8)));
typedef float f32x16 __attribute__((ext_vector_type(16)));
constexpr int PITCH = 72;
constexpr int OFF_TOT = 0;
constexpr int OFF_Q = 2048;
constexpr int OFF_K = OFF_Q + 64 * PITCH * 2;
constexpr int OFF_V = OFF_K + 64 * PITCH * 2;
constexpr int OFF_ST = OFF_V + 128 * PITCH * 2;
constexpr int OFF_A = OFF_ST + 128 * PITCH * 2;
constexpr int OFF_O = OFF_A + 8 * 32 * PITCH * 2;
constexpr int OPITCH = 132;
static_assert(OFF_O + 64 * OPITCH * 4 <= RING_BYTES, "gla lds");
__device__ __forceinline__ int crow(int r, int hf) { return (r & 3) + 8 * (r >> 2) + 4 * hf; }
__device__ __forceinline__ bf16x8 ldfrag(const LAS unsigned char* base, int row, int k) { return *(const LAS bf16x8*)(base + (row * PITCH + k) * 2); }

__device__ __forceinline__ void chunk_cumsum(const float* GL, size_t t0, int h, LAS unsigned char* lds, int tid, float (&b)[8], float& blast) {
    const int d = tid & 63, seg = tid >> 6; LAS float* tot = (LAS float*)(lds + OFF_TOT);
    float run = 0.f;
#pragma unroll
    for (int i = 0; i < 8; ++i) { run += GL[(t0 + seg * 8 + i) * 256 + h * 64 + d]; b[i] = run; }
    tot[seg * 64 + d] = run;
    __syncthreads();
    float off = 0.f, all = 0.f;
#pragma unroll
    for (int s = 0; s < 8; ++s) { const float v = tot[s * 64 + d]; all += v; if (s < seg) off += v; }
#pragma unroll
    for (int i = 0; i < 8; ++i) b[i] += off;
    blast = all;
}
__device__ __forceinline__ void stage_vT(const bf16* CV, size_t t0, int h, LAS unsigned char* lds, int tid) {
#pragma unroll
    for (int it = 0; it < 2; ++it) { const int item = tid + 512 * it, e = item & 127, sg = item >> 7;
        unsigned short v[8];
#pragma unroll
        for (int i = 0; i < 8; ++i) v[i] = CV[(t0 + sg * 8 + i) * 512 + h * 128 + e];
        v4u w; w.x = v[0] | ((unsigned)v[1] << 16); w.y = v[2] | ((unsigned)v[3] << 16); w.z = v[4] | ((unsigned)v[5] << 16); w.w = v[6] | ((unsigned)v[7] << 16);
        *(LAS v4u*)(lds + OFF_V + (e * PITCH + sg * 8) * 2) = w; }
}

__device__ __forceinline__ void pass1(const Frame& F_in, const Params& P_in) {
    PH_BEGIN
    const float* GL = (const float*)(P.ws + WS_R + RO_GL); const bf16* CK = (const bf16*)(P.ws + WS_R + RO_CK); const bf16* CV = (const bf16*)(P.ws + WS_R + RO_CV);
    float* S = (float*)(P.ws + WS_S); float* DEC = (float*)(P.ws + WS_DEC);
    LAS unsigned char* lds = F.lds; const int tid = F.tid, lane = F.lane, r = lane & 31, hf = lane >> 5, w = F.wave, mt = w >> 2, nt = w & 3;
    for (int unit = F.vcu; unit < 8 * 128; unit += F.G) {
        const int bh = unit >> 7, n = unit & 127, b_ = bh >> 2, h = bh & 3; const size_t t0 = (size_t)b_ * SEQ + n * 64;
        float b[8], blast; chunk_cumsum(GL, t0, h, lds, tid, b, blast);
        { const int d = tid & 63, seg = tid >> 6; unsigned pk[4];
#pragma unroll
          for (int i = 0; i < 8; i += 2) { const float k0 = bf2f(CK[(t0 + seg * 8 + i) * 256 + h * 64 + d]) * __expf(blast - b[i]), k1 = bf2f(CK[(t0 + seg * 8 + i + 1) * 256 + h * 64 + d]) * __expf(blast - b[i + 1]); pk[i >> 1] = pk2(k0, k1); }
          *(LAS v4u*)(lds + OFF_Q + (d * PITCH + seg * 8) * 2) = (v4u){pk[0], pk[1], pk[2], pk[3]};
          if (seg == 0) DEC[((size_t)bh * 128 + n) * 64 + d] = __expf(blast); }
        stage_vT(CV, t0, h, lds, tid);
        __syncthreads();
        f32x16 acc = f32x16{};
#pragma unroll
        for (int ks = 0; ks < 4; ++ks) acc = __builtin_amdgcn_mfma_f32_32x32x16_bf16(ldfrag(lds + OFF_Q, mt * 32 + r, ks * 16 + 8 * hf), ldfrag(lds + OFF_V, nt * 32 + r, ks * 16 + 8 * hf), acc, 0, 0, 0);
        float* so = S + (((size_t)bh * 128 + n) * 64 + mt * 32) * 128 + nt * 32 + r;
#pragma unroll
        for (int g = 0; g < 16; ++g) so[(size_t)crow(g, hf) * 128] = acc[g];
        __syncthreads();
    }
}
__device__ __forceinline__ void pass3(const Frame& F_in, const Params& P_in, int l) {
    PH_BEGIN
    const float* GL = (const float*)(P.ws + WS_R + RO_GL); const bf16* CQ = (const bf16*)(P.ws + WS_R + RO_CQ); const bf16* CK = (const bf16*)(P.ws + WS_R + RO_CK); const bf16* CV = (const bf16*)(P.ws + WS_R + RO_CV);
    bf16* CR = (bf16*)(P.ws + WS_R + RO_CR); const float* S = (const float*)(P.ws + WS_S); const float* gng = P.in[I_GNG] + l * 512;
    LAS unsigned char* lds = F.lds; const int tid = F.tid, lane = F.lane, r = lane & 31, hf = lane >> 5, w = F.wave, mt = w >> 2, nt = w & 3;
    for (int unit = F.vcu; unit < 8 * 128; unit += F.G) {
        const int bh = unit >> 7, n = unit & 127, b_ = bh >> 2, h = bh & 3; const size_t t0 = (size_t)b_ * SEQ + n * 64;
        float b[8], blast; chunk_cumsum(GL, t0, h, lds, tid, b, blast);
        { const int d = tid & 63, seg = tid >> 6;
#pragma unroll
          for (int i = 0; i < 8; ++i) { const size_t gi = (t0 + seg * 8 + i) * 256 + h * 64 + d; const int s = seg * 8 + i;
              *(LAS unsigned short*)(lds + OFF_Q + (s * PITCH + d) * 2) = (unsigned short)f2bf(bf2f(CQ[gi]) * 0.125f * __expf(b[i]));
              *(LAS unsigned short*)(lds + OFF_K + (s * PITCH + d) * 2) = (unsigned short)f2bf(bf2f(CK[gi]) * __expf(-b[i])); } }
        stage_vT(CV, t0, h, lds, tid);
        { const float* sp = S + (((size_t)bh * 128 + n) * 64) * 128;
#pragma unroll
          for (int it = 0; it < 2; ++it) { const int item = tid + 512 * it, e = item & 127, dg = item >> 7; float v[8];
#pragma unroll
              for (int i = 0; i < 8; ++i) v[i] = sp[(size_t)(dg * 8 + i) * 128 + e];
              *(LAS v4u*)(lds + OFF_ST + (e * PITCH + dg * 8) * 2) = (v4u){pk2(v[0], v[1]), pk2(v[2], v[3]), pk2(v[4], v[5]), pk2(v[6], v[7])}; } }
        __syncthreads();
        { LAS unsigned char* as = lds + OFF_A + w * 32 * PITCH * 2;
#pragma unroll
          for (int j = 0; j < 2; ++j) { f32x16 a = f32x16{};
#pragma unroll
              for (int kd = 0; kd < 4; ++kd) a = __builtin_amdgcn_mfma_f32_32x32x16_bf16(ldfrag(lds + OFF_Q, mt * 32 + r, kd * 16 + 8 * hf), ldfrag(lds + OFF_K, j * 32 + r, kd * 16 + 8 * hf), a, 0, 0, 0);
              const int s = j * 32 + r;
#pragma unroll
              for (int g = 0; g < 16; ++g) { const int tl = crow(g, hf); const float av = (s <= mt * 32 + tl) ? a[g] : 0.f; *(LAS unsigned short*)(as + (tl * PITCH + s) * 2) = (unsigned short)f2bf(av); } }
          LDS_WAIT(); asm volatile("" ::: "memory");
          f32x16 o = f32x16{};
#pragma unroll
          for (int ks = 0; ks < 4; ++ks) o = __builtin_amdgcn_mfma_f32_32x32x16_bf16(ldfrag(as, r, ks * 16 + 8 * hf), ldfrag(lds + OFF_V, nt * 32 + r, ks * 16 + 8 * hf), o, 0, 0, 0);
#pragma unroll
          for (int kd = 0; kd < 4; ++kd) o = __builtin_amdgcn_mfma_f32_32x32x16_bf16(ldfrag(lds + OFF_Q, mt * 32 + r, kd * 16 + 8 * hf), ldfrag(lds + OFF_ST, nt * 32 + r, kd * 16 + 8 * hf), o, 0, 0, 0);
          LAS float* os = (LAS float*)(lds + OFF_O);
#pragma unroll
          for (int g = 0; g < 16; ++g) os[(mt * 32 + crow(g, hf)) * OPITCH + nt * 32 + r] = o[g]; }
        __syncthreads();
        { const int tt = tid >> 3, e0 = (tid & 7) * 16; const LAS float* os = (const LAS float*)(lds + OFF_O) + tt * OPITCH + e0; float o[16]; float ms = 0.f;
#pragma unroll
          for (int j = 0; j < 16; ++j) { o[j] = os[j]; ms += o[j] * o[j]; }
          ms += __shfl_xor(ms, 1); ms += __shfl_xor(ms, 2); ms += __shfl_xor(ms, 4);
          const float rinv = 1.0f / sqrtf(ms * (1.0f / 128.0f) + RMS_EPS);
          bf16* crp = CR + (t0 + tt) * 512 + h * 128 + e0; const v4u c0 = *(const GAS v4u*)crp, c1 = *(const GAS v4u*)(crp + 8); const float* gp = gng + h * 128 + e0;
          v4u w0, w1;
          w0.x = pk2(o[0] * rinv * gp[0] * bflo(c0.x), o[1] * rinv * gp[1] * bfhi(c0.x)); w0.y = pk2(o[2] * rinv * gp[2] * bflo(c0.y), o[3] * rinv * gp[3] * bfhi(c0.y));
          w0.z = pk2(o[4] * rinv * gp[4] * bflo(c0.z), o[5] * rinv * gp[5] * bfhi(c0.z)); w0.w = pk2(o[6] * rinv * gp[6] * bflo(c0.w), o[7] * rinv * gp[7] * bfhi(c0.w));
          w1.x = pk2(o[8] * rinv * gp[8] * bflo(c1.x), o[9] * rinv * gp[9] * bfhi(c1.x)); w1.y = pk2(o[10] * rinv * gp[10] * bflo(c1.y), o[11] * rinv * gp[11] * bfhi(c1.y));
          w1.z = pk2(o[12] * rinv * gp[12] * bflo(c1.z), o[13] * rinv * gp[13] * bfhi(c1.z)); w1.w = pk2(o[14] * rinv * gp[14] * bflo(c1.w), o[15] * rinv * gp[15] * bfhi(c1.w));
          *(GAS v4u*)crp = w0; *(GAS v4u*)(crp + 8) = w1; }
        __syncthreads();
    }
}
}
constexpr int TAB_OFF = LDSCTL_OFF + 1024;
__device__ __forceinline__ void route_r1(const Frame& F_in, const Params& P_in) {
    PH_BEGIN
    const float* Wr = P.in[I_RT]; const float* n2g = P.in[I_N2G] + 1 * DM;
    int* TOKE = (int*)(P.ws + WS_TOKE); float* TOKP = (float*)(P.ws + WS_TOKP); float* RS2 = (float*)(P.ws + WS_RS2); int* CNT = (int*)(P.ws + WS_CNT);
    LAS float* wrs = (LAS float*)(F.lds); LAS int* cnt_s = (LAS int*)(F.lds + 32768); const int tid = F.tid, lane = F.lane;
    for (int idx = tid; idx < 8192; idx += 512) wrs[idx] = Wr[idx] * n2g[idx >> 3];
    for (int tile = F.vcu; tile < T / 64; tile += F.G) {
        if (tid < 8) cnt_s[tid] = 0;
        __syncthreads();
        for (int i = 0; i < 8; ++i) {
            const int t = tile * 64 + F.wave * 8 + i;
            const GAS f32x4* xr = (const GAS f32x4*)(P.out + (size_t)t * DM) + lane;
            float s = 0.f, lg0 = 0.f, lg1 = 0.f, lg2 = 0.f, lg3 = 0.f, lg4 = 0.f, lg5 = 0.f, lg6 = 0.f, lg7 = 0.f;
#pragma unroll
            for (int j = 0; j < 4; ++j) { const f32x4 v = xr[64 * j]; s += (v.x * v.x + v.y * v.y) + (v.z * v.z + v.w * v.w);
#pragma unroll
                for (int c = 0; c < 4; ++c) { const LAS float* w = wrs + (256 * j + 4 * lane + c) * 8; const float xv = v[c];
                    lg0 += xv * w[0]; lg1 += xv * w[1]; lg2 += xv * w[2]; lg3 += xv * w[3]; lg4 += xv * w[4]; lg5 += xv * w[5]; lg6 += xv * w[6]; lg7 += xv * w[7]; } }
            s = wave_sum(s); lg0 = wave_sum(lg0); lg1 = wave_sum(lg1); lg2 = wave_sum(lg2); lg3 = wave_sum(lg3); lg4 = wave_sum(lg4); lg5 = wave_sum(lg5); lg6 = wave_sum(lg6); lg7 = wave_sum(lg7);
            const float r = 1.0f / sqrtf(s * (1.0f / DM) + RMS_EPS);
            int i1 = 0; float v1 = lg0;
            if (lg1 > v1) { v1 = lg1; i1 = 1; } if (lg2 > v1) { v1 = lg2; i1 = 2; } if (lg3 > v1) { v1 = lg3; i1 = 3; } if (lg4 > v1) { v1 = lg4; i1 = 4; }
            if (lg5 > v1) { v1 = lg5; i1 = 5; } if (lg6 > v1) { v1 = lg6; i1 = 6; } if (lg7 > v1) { v1 = lg7; i1 = 7; }
            int i2 = -1; float v2 = -INFINITY;
            if (i1 != 0 && lg0 > v2) { v2 = lg0; i2 = 0; } if (i1 != 1 && lg1 > v2) { v2 = lg1; i2 = 1; } if (i1 != 2 && lg2 > v2) { v2 = lg2; i2 = 2; } if (i1 != 3 && lg3 > v2) { v2 = lg3; i2 = 3; }
            if (i1 != 4 && lg4 > v2) { v2 = lg4; i2 = 4; } if (i1 != 5 && lg5 > v2) { v2 = lg5; i2 = 5; } if (i1 != 6 && lg6 > v2) { v2 = lg6; i2 = 6; } if (i1 != 7 && lg7 > v2) { v2 = lg7; i2 = 7; }
            const float p1 = 1.0f / (1.0f + __expf((v2 - v1) * r)), p2 = 1.0f - p1;
            if (lane == 0) { TOKE[t * 2] = i1; TOKE[t * 2 + 1] = i2; TOKP[t * 2] = p1; TOKP[t * 2 + 1] = p2; RS2[t] = r; atomicAdd((int*)&cnt_s[i1], 1); atomicAdd((int*)&cnt_s[i2], 1); }
        }
        __syncthreads();
        if (tid < 8) CNT[tile * 8 + tid] = cnt_s[tid];
        __syncthreads();
    }
}
__device__ __forceinline__ void moe_tables(const Frame& F_in, const Params& P_in, int tile) {
    PH_BEGIN
    const int* CNT = (const int*)(P.ws + WS_CNT); volatile LAS int* TAB = (volatile LAS int*)(F.lds + TAB_OFF); LAS int* cs = (LAS int*)(F.lds + TAB_OFF + 256); const int tid = F.tid;
    for (int i = tid; i < (T / 64) * 8; i += 512) cs[i] = CNT[i];
    __syncthreads();
    if (tid < 8) { int tot = 0, before = 0;
        for (int w = 0; w < T / 64; ++w) { const int c = cs[w * 8 + tid]; if (w < tile) before += c; tot += c; }
        TAB[32 + tid] = tot; TAB[40 + tid] = before; }
    __syncthreads();
    if (tid == 0) { int mt = 0; for (int e = 0; e < 8; ++e) { TAB[e] = mt; TAB[16 + e] = mt * 256 + TAB[40 + e]; mt += (TAB[32 + e] + 255) >> 8; } TAB[8] = mt; }
    __syncthreads();
}
__device__ __forceinline__ void route_r2(const Frame& F_in, const Params& P_in) {
    PH_BEGIN
    const int* TOKE = (const int*)(P.ws + WS_TOKE); const float* TOKP = (const float*)(P.ws + WS_TOKP); const float* RS2 = (const float*)(P.ws + WS_RS2);
    int* TOKPOS = (int*)(P.ws + WS_TOKPOS); float* RSG = (float*)(P.ws + WS_RSG); float* PWG = (float*)(P.ws + WS_PWG);
    const bf16* XB = (const bf16*)(P.ws + WS_XB); bf16* XG = (bf16*)(P.ws + WS_XG);
    volatile LAS int* TAB = (volatile LAS int*)(F.lds + TAB_OFF); LAS int* pos_s = (LAS int*)(F.lds); const int tid = F.tid, lane = F.lane;
    for (int tile = F.vcu; tile < T / 64; tile += F.G) {
        moe_tables(F, P, tile);
        LAS int* te_s = pos_s + 128;
        if (tid < 128) te_s[tid] = TOKE[tile * 128 + tid];
        __syncthreads();
        if (tid < 8) { int run = TAB[16 + tid];
            for (int i = 0; i < 128; ++i) if (te_s[i] == tid) { pos_s[i] = run; ++run; } }
        __syncthreads();
        for (int pr = F.wave * 16; pr < F.wave * 16 + 16; ++pr) {
            const int pos = pos_s[pr], t = tile * 64 + (pr >> 1);
            const GAS v4u* src = (const GAS v4u*)(XB + (size_t)t * DM); GAS v4u* dst = (GAS v4u*)(XG + (size_t)pos * DM);
            dst[lane] = src[lane]; dst[64 + lane] = src[64 + lane];
            if (lane == 0) { RSG[pos] = RS2[t]; PWG[pos] = TOKP[t * 2 + (pr & 1)]; TOKPOS[t * 2 + (pr & 1)] = pos; }
        }
        __syncthreads();
    }
}
struct MoeOrder {
    const char* A; const char* W; size_t wstride; size_t tstep; int nN, G, c; volatile LAS int* TAB;
    __device__ __forceinline__ bool next(int i, pg8::Unit& u) const {
        const int L = i * G + c; const int total = TAB[8] * nN; if (L >= total) return false;
        int e = 0;
#pragma unroll
        for (int k = 1; k < 8; ++k) if (L >= TAB[k] * nN) e = k;
        const int mt0 = TAB[e], mte = TAB[e + 1] - mt0, loc = L - mt0 * nN; const int pml = loc % mte, pn = loc / mte;
        u.pm = mt0 + pml; u.pn = pn; u.aux = pn; u.A = A + (size_t)u.pm * tstep; u.B = W + (size_t)e * wstride + (size_t)pn * tstep; return true;
    }
};
struct BranchOrder {
    const char* OA; const char* OB; const char* OC; const char* W; int G, c;
    __device__ __forceinline__ bool next(int i, pg8::Unit& u) const {
        const int seg = i % 3; int pm, pn; if (!pg8::static_tile(T / 256, DM / 256, G, c, i / 3, pm, pn)) return false;
        u.pm = pm; u.pn = pn; u.aux = seg; const char* o = seg == 0 ? OA : (seg == 1 ? OB : OC);
        u.A = o + (size_t)pm * 256 * 512 * 2; u.B = W + (size_t)seg * DM * 512 * 2 + (size_t)pn * 256 * 512 * 2; return true;
    }
};
template <int l>
__device__ __forceinline__ void layer_body(const Frame& F, const Params& P, const XcdBarrier& bar) {
#ifdef TIMING
#define STAMP() do { if (blockIdx.x == 0 && threadIdx.x == 0) { unsigned* c_ = (unsigned*)(P.ws + WS_CTL) + 2048; const unsigned n_ = c_[0]; ((unsigned long long*)(c_ + 2))[n_] = __builtin_amdgcn_s_memrealtime(); c_[0] = n_ + 1; } } while (0)
#else
#define STAMP() do {} while (0)
#endif
#define GRID_BAR() do { xcd_barrier(bar); STAMP(); } while (0)
    const int gw = F.vcu * NWAVES + F.wave, NGW = F.G * NWAVES;
    LAS unsigned char* ring = F.lds + RING_OFF;
    const int cb = (int)blockIdx.x;
#define WSP(T_, off) ((T_)(ws + (off)))

        { unsigned char* ws = lws(P); pg8::DenseOrder S; S.init(ws + WS_XB, ws + WS_W + WO_IN, T, NMAIN, DM, F.G, cb);
          epi::EpiInproj E{ws + WS_R, WSP(const float*, WS_SSQ), P.in[I_GBG] + l * 256, WSP(float*, WS_KBP), F.lds};
          pg8::gemm_phase<epi::EpiInproj, pg8::DenseOrder>(ring, DM, S, E); }
        GRID_BAR();
        moba_phase(F, P);
        swa_phase(F, P, l);
        STAMP();
        gla::pass1(F, P);
        GRID_BAR();
        gla_scan(F, P);
        GRID_BAR();
        gla::pass3(F, P, l);
        GRID_BAR();
        { unsigned char* ws = lws(P); pg8::DenseOrder S; S.init(ws + WS_XB, ws + WS_W + WO_IN + (size_t)NMAIN * DM * 2, T, NGATES, DM, F.G, cb);
          epi::EpiGates E{WSP(bf16*, WS_GATES), WSP(const float*, WS_SSQ), F.lds};
          pg8::gemm_phase<epi::EpiGates, pg8::DenseOrder>(ring, DM, S, E); }
        GRID_BAR();
        { unsigned char* ws = lws(P); BranchOrder S{(const char*)(ws + WS_R + RO_AQ), (const char*)(ws + WS_R + RO_BQ), (const char*)(ws + WS_R + RO_CR), (const char*)(ws + WS_W + WO_BR), F.G, cb};
          epi::EpiBranch E{WSP(const bf16*, WS_GATES), WSP(bf16*, WS_Y)};
          pg8::gemm_phase<epi::EpiBranch, BranchOrder>(ring, 512, S, E); }
        GRID_BAR();
        { unsigned char* ws = lws(P); pg8::DenseOrder S; S.init(ws + WS_Y, ws + WS_W + WO_O, T, DM, DM, F.G, cb);
          epi::EpiResid E{l == 0 ? P.in[I_X] : P.out, P.out, WSP(bf16*, WS_XB), WSP(float*, WS_SSQ)};
          pg8::gemm_phase<epi::EpiResid, pg8::DenseOrder>(ring, DM, S, E); }
        GRID_BAR();
        if constexpr (l == 0) {
            { unsigned char* ws = lws(P); pg8::DenseOrder S; S.init(ws + WS_XB, ws + WS_W + WO_GU, T, 2 * DFF, DM, F.G, cb);
              epi::EpiSwiglu E{(bf16*)(ws + WS_H), DFF, WSP(const float*, WS_SSQ), nullptr, F.lds};
              pg8::gemm_phase<epi::EpiSwiglu, pg8::DenseOrder>(ring, DM, S, E); }
            if (cb >= 128 || F.G != 256) convert_layer_weights(F, P, 1, F.G == 256 ? (cb - 128) * NWAVES + F.wave : gw, F.G == 256 ? 128 * NWAVES : NGW, true);
            GRID_BAR();
            { unsigned char* ws = lws(P); pg8::DenseOrder S; S.init(ws + WS_H, ws + WS_W + WO_D, T, DM, DFF, F.G, cb);
              epi::EpiResid E{P.out, P.out, WSP(bf16*, WS_XB), WSP(float*, WS_SSQ)};
              pg8::gemm_phase<epi::EpiResid, pg8::DenseOrder>(ring, DFF, S, E); }
            GRID_BAR();
        } else {
            route_r1(F, P);
            GRID_BAR();
            route_r2(F, P);
            convert_moe_weights(F, P, gw, NGW);
            GRID_BAR();
            moe_tables(F, P, 0);
            { unsigned char* ws = lws(P); MoeOrder S{(const char*)(ws + WS_XG), (const char*)(ws + WS_WMGU), (size_t)2 * DFE * DM * 2, (size_t)256 * DM * 2, 2 * DFE / 256, F.G, cb, (volatile LAS int*)(F.lds + TAB_OFF)};
              epi::EpiSwiglu E{(bf16*)(ws + WS_HG), DFE, nullptr, (const float*)(ws + WS_RSG), F.lds};
              pg8::gemm_phase<epi::EpiSwiglu, MoeOrder>(ring, DM, S, E); }
            GRID_BAR();
            { unsigned char* ws = lws(P); MoeOrder S{(const char*)(ws + WS_HG), (const char*)(ws + WS_WMD), (size_t)DM * DFE * 2, (size_t)256 * DFE * 2, DM / 256, F.G, cb, (volatile LAS int*)(F.lds + TAB_OFF)};
              epi::EpiMoeDown E{(bf16*)(ws + WS_XG), (const float*)(ws + WS_PWG)};
              pg8::gemm_phase<epi::EpiMoeDown, MoeOrder>(ring, DFE, S, E); }
            GRID_BAR();
            final_phase(F, P, gw, NGW, true);
        }
}
__global__ void __launch_bounds__(NWAVES * 64, 2) fwd_kernel(Params P) {
    extern __shared__ __attribute__((aligned(16))) unsigned char lds[];
    Frame F;
    F.lds = (LAS unsigned char*)lds;
    F.MISC = (volatile LAS unsigned*)(F.lds + MISC_OFF);
    F.tid = threadIdx.x; F.lane = F.tid & 63; F.wave = __builtin_amdgcn_readfirstlane(F.tid >> 6);
    F.G = gridDim.x; { const int bx = blockIdx.x; F.vcu = (F.G % 8 == 0) ? (bx % 8) * (F.G / 8) + bx / 8 : bx; }
    F.ctl = (gu32*)(P.ws + WS_CTL);
    for (int u = F.tid; u < (LDS_BYTES - LDSCTL_OFF) / 4; u += NWAVES * 64) ((LAS unsigned*)(F.lds + LDSCTL_OFF))[u] = 0u;
    __syncthreads();
    XcdBarrier bar = xcd_barrier_post((unsigned*)(F.ctl + CW_BAR), F.MISC + 8);
    const int gw = F.vcu * NWAVES + F.wave, NGW = F.G * NWAVES;
    STAMP();
    prep_x(F, P, gw, NGW);
    convert_layer_weights(F, P, 0, gw, NGW, false);
    GRID_BAR();

    layer_body<0>(F, P, bar);
    layer_body<1>(F, P, bar);
}

extern "C" void kernel_launch(void* const* d_in, const int* in_sizes, int n_in, void* d_out, int out_size, void* d_ws, size_t ws_size, hipStream_t stream) {
    static int grid = 0;
    if (grid == 0) {
        if (n_in != 20 || out_size != T * DM || ws_size < WS_END) { fprintf(stderr, "kernel_launch: unexpected shapes n_in %d out %d ws %zu (need %zu)\n", n_in, out_size, ws_size, (size_t)WS_END); grid = -1; return; }
        int dev = 0, cus = 0, per_cu = 0;
        if (hipGetDevice(&dev) != hipSuccess || hipDeviceGetAttribute(&cus, hipDeviceAttributeMultiprocessorCount, dev) != hipSuccess) { grid = -1; return; }
        if (hipFuncSetAttribute((const void*)fwd_kernel, hipFuncAttributeMaxDynamicSharedMemorySize, LDS_BYTES) != hipSuccess) { fprintf(stderr, "kernel_launch: hipFuncSetAttribute failed\n"); grid = -1; return; }
        if (hipOccupancyMaxActiveBlocksPerMultiprocessor(&per_cu, (const void*)fwd_kernel, NWAVES * 64, LDS_BYTES) != hipSuccess || per_cu < 1) { fprintf(stderr, "kernel_launch: occupancy query says %d\n", per_cu); per_cu = 1; }
        (void)hipGetLastError();
        grid = cus;
    }
    if (grid < 0) return;
    if (hipMemsetAsync((char*)d_ws + WS_CTL, 0, CTL_ZERO_BYTES, stream) != hipSuccess) { fprintf(stderr, "kernel_launch: memset failed\n"); return; }
    Params p{};
    for (int i = 0; i < 20; ++i) p.in[i] = (const float*)d_in[i];
    p.out = (float*)d_out; p.ws = (unsigned char*)d_ws;
    void* args[] = {&p};
    hipError_t e = hipLaunchCooperativeKernel((const void*)fwd_kernel, dim3(grid), dim3(NWAVES * 64), args, LDS_BYTES, stream);
    if (e != hipSuccess) fprintf(stderr, "kernel_launch: cooperative launch failed: %s (grid %d)\n", hipGetErrorString(e), grid);
}
```

```cpp
#include <hip/hip_runtime.h>
#include <cstdio>
#include <cstdint>
#include <cmath>

#define GAS __attribute__((address_space(1)))
#define LAS __attribute__((address_space(3)))
typedef unsigned short bf16;
typedef unsigned v4u __attribute__((ext_vector_type(4)));
typedef unsigned v2u __attribute__((ext_vector_type(2)));
typedef float f32x4 __attribute__((ext_vector_type(4)));
typedef GAS unsigned gu32;
#define RLX_AGENT __ATOMIC_RELAXED, __HIP_MEMORY_SCOPE_AGENT
#define LDS_WAIT() asm volatile("s_waitcnt lgkmcnt(0)" ::: "memory")
#define VM_WAIT() asm volatile("s_waitcnt vmcnt(0)" ::: "memory")
__device__ __forceinline__ unsigned f2bf(float f) { unsigned u = __builtin_bit_cast(unsigned, f); return (u + 0x7fffu + ((u >> 16) & 1u)) >> 16; }
__device__ __forceinline__ unsigned pk2(float lo, float hi) { return f2bf(lo) | (f2bf(hi) << 16); }
__device__ __forceinline__ float bf2f(unsigned short b) { return __builtin_bit_cast(float, (unsigned)b << 16); }
__device__ __forceinline__ float bflo(unsigned w) { return __builtin_bit_cast(float, w << 16); }
__device__ __forceinline__ float bfhi(unsigned w) { return __builtin_bit_cast(float, w & 0xffff0000u); }
__device__ __forceinline__ float wave_sum(float v) {
#pragma unroll
    for (int o = 1; o < 64; o <<= 1) v += __shfl_xor(v, o);
    return v;
}
__device__ __forceinline__ float wave_max(float v) {
#pragma unroll
    for (int o = 1; o < 64; o <<= 1) v = fmaxf(v, __shfl_xor(v, o));
    return v;
}

constexpr int NWAVES = 8;
constexpr int BATCH = 2, SEQ = 8192, DM = 1024, T = BATCH * SEQ;
constexpr int IN_TOTAL = 6928, NMAIN = 4096, NGATES = 3072;
constexpr int DFF = 2816, NEXP = 8, DFE = 1408;
constexpr float RMS_EPS = 1e-6f;
constexpr int XG_ROWS = 2 * T + 2048;

constexpr size_t MiB = 1u << 20;
constexpr size_t WS_CTL = 0, CTL_ZERO_BYTES = 1 * MiB;
constexpr size_t WS_SSQ = 1 * MiB;
constexpr size_t WS_KBP = 2 * MiB;
constexpr size_t WS_DEC = 2 * MiB + 256 * 1024;
constexpr size_t WS_TOKE = 2 * MiB + 512 * 1024;
constexpr size_t WS_TOKP = WS_TOKE + 128 * 1024;
constexpr size_t WS_TOKPOS = WS_TOKP + 128 * 1024;
constexpr size_t WS_RS2 = WS_TOKPOS + 128 * 1024;
constexpr size_t WS_CNT = WS_RS2 + 64 * 1024;
constexpr size_t WS_RSG = 3 * MiB;
constexpr size_t WS_PWG = 3 * MiB + 256 * 1024;
constexpr size_t WS_W = 4 * MiB;
constexpr size_t WO_IN = 0, WO_BR = 14 * MiB, WO_O = 17 * MiB, WO_GU = 19 * MiB, WO_D = 30 * MiB;
constexpr size_t WS_XB = 40 * MiB;
constexpr size_t WS_R = 72 * MiB;
constexpr size_t RO_AQ = 0, RO_BQ = 16 * MiB, RO_CR = 32 * MiB, RO_AK = 48 * MiB, RO_AV = 52 * MiB, RO_BK = 56 * MiB, RO_BV = 72 * MiB, RO_CQ = 88 * MiB, RO_CK = 96 * MiB, RO_CV = 104 * MiB, RO_GL = 120 * MiB;
constexpr size_t WS_GC = 240 * MiB;
constexpr size_t WS_S = 208 * MiB;
constexpr size_t WS_Y = WS_R + RO_BK;
constexpr size_t WS_H = WS_R;
constexpr size_t WS_XG = WS_R;
constexpr size_t WS_HG = 140 * MiB;
constexpr size_t WS_WMGU = 234 * MiB;
constexpr size_t WS_WMD = 278 * MiB;
constexpr size_t WS_END = 300 * MiB;
static_assert(WS_HG + (size_t)XG_ROWS * DFE * 2 <= WS_WMGU && WS_XG + (size_t)XG_ROWS * DM * 2 <= WS_HG, "moe map");
static_assert(WS_H + (size_t)T * DFF * 2 <= WS_S, "overlay map");
constexpr int CW_BAR = 4096;

constexpr int RING_OFF = 0, RING_BYTES = 131072;
constexpr int LDSCTL_OFF = RING_BYTES, MISC_OFF = LDSCTL_OFF + 320;
constexpr int LDS_BYTES = 147456;
namespace pg8 {
#define PG8_LAS __attribute__((address_space(3)))
typedef unsigned short bf16_t;
typedef short bf16x8 __attribute__((ext_vector_type(8)));
typedef float f32x4 __attribute__((ext_vector_type(4)));
typedef unsigned u32x4 __attribute__((ext_vector_type(4)));
typedef unsigned u32x2 __attribute__((ext_vector_type(2)));
constexpr int BM = 256, BK = 64, HALF = 128, HTB = HALF * BK * 2  , STAGE_BYTES = 8 * HTB, NXCD = 8, WGM = 8;

__host__ __device__ __forceinline__ int lds_byte(int r, int c) { const int st = (r >> 4) * 2 + (c >> 5), rr = r & 15, cc = c & 31, ob = rr * 64 + cc * 2; return st * 1024 + (ob ^ (((ob >> 9) & 1) << 5)); }
__host__ __device__ __forceinline__ void stage_rc(int b, int& R, int& C) { const int st = b / 1024, sb = b % 1024, swz = sb ^ (((sb >> 9) & 1) << 5); R = (st >> 1) * 16 + swz / 64; C = (st & 1) * 32 + (swz % 64) / 2; }
__host__ __device__ __forceinline__ int perm32(int rho) { const int n = rho >> 4, i = rho & 15; return 8 * (i >> 2) + 4 * n + (i & 3); }

struct Unit { const char* A; const char* B; int pm, pn, aux; };

__device__ __forceinline__ bool static_tile(int nM, int nN, int G, int c, int i, int& pm, int& pn) {
    const int nwg = nM * nN; const long L = (long)i * G + c; if (L >= nwg) return false;
    int wgid = (int)L; { const int q = nwg / NXCD, r = nwg % NXCD, xcd = wgid % NXCD, off = wgid / NXCD; wgid = (xcd < r ? xcd * (q + 1) : r * (q + 1) + (xcd - r) * q) + off; }
    const int nig = WGM * nN, gid = wgid / nig, fm = gid * WGM, gsz = (nM - fm) < WGM ? (nM - fm) : WGM;
    pm = fm + ((wgid % nig) % gsz); pn = (wgid % nig) / gsz; return true;
}
struct DenseOrder {
    const char* A; const char* B; int nM, nN, G, c; size_t tstep;
    __device__ __forceinline__ void init(const void* A_, const void* B_, int M, int N, int K, int G_, int c_) { A = (const char*)A_; B = (const char*)B_; nM = M / BM; nN = N / BM; G = G_; c = c_; tstep = (size_t)BM * K * 2; }
    __device__ __forceinline__ bool next(int i, Unit& u) const { int pm, pn; if (!static_tile(nM, nN, G, c, i, pm, pn)) return false; u.pm = pm; u.pn = pn; u.aux = pn; u.A = A + (size_t)pm * tstep; u.B = B + (size_t)pn * tstep; return true; }
};

typedef float f32x2_c __attribute__((ext_vector_type(2))); typedef __bf16 bf16x2_c __attribute__((ext_vector_type(2)));
__device__ __forceinline__ unsigned cvt_pk_bf16(float lo, float hi) { f32x2_c v = {lo, hi}; bf16x2_c b = __builtin_convertvector(v, bf16x2_c); return __builtin_bit_cast(unsigned, b); }

template <class Epi, class Sched, bool ALIGN_EPI = true>
__device__ __forceinline__ void gemm_phase(PG8_LAS unsigned char* lds, const int K, const Sched& S, const Epi& E) {
    int tid_ = threadIdx.x; asm volatile("" : "+v"(tid_));
    const int tid = tid_, wid = __builtin_amdgcn_readfirstlane(tid >> 6), lane = tid & 63, wr = wid >> 2, wc = wid & 3, fr = lane & 15, fq = lane >> 4;
    const int nt = K / BK;
    unsigned voffA[2], voffB[2];
#pragma unroll
    for (int i = 0; i < 2; ++i) { int R, C; stage_rc(tid * 16 + i * 8192, R, C); const int Rb = Epi::PERM ? ((R & ~31) + perm32(R & 31)) : R;
        voffA[i] = (unsigned)(R * K + C) * 2u; voffB[i] = (unsigned)(Rb * K + C) * 2u; }
    const size_t kstep = (size_t)(BK * 2);
    const size_t hstep = (size_t)HALF * K * 2;
    const unsigned ldsw = (unsigned)wid * 1024u;
    const int aoff = lds_byte(wr * 64 + fr, fq * 8), boff = lds_byte(wc * 32 + fr, fq * 8);
#define PG8_SA(b, h) (((b) * 2 + (h)) * HTB)
#define PG8_SB(b, h) ((4 + (b) * 2 + (h)) * HTB)
#define PG8_STAGE(bufoff, gbase, voff) do { _Pragma("unroll") for (int _i = 0; _i < 2; ++_i) \
        __builtin_amdgcn_global_load_lds((const unsigned*)((const char*)(gbase) + (voff)[_i]), (PG8_LAS unsigned*)(lds + (bufoff) + ldsw + _i * 8192), 16, 0, 0); } while (0)
#define PG8_LDA(dst, b, h) do { _Pragma("unroll") for (int m = 0; m < 4; ++m) _Pragma("unroll") for (int k = 0; k < 2; ++k) dst[m][k] = *(const PG8_LAS bf16x8*)(lds + PG8_SA(b, h) + aoff + m * 2048 + k * 1024); } while (0)
#define PG8_LDB(dst, b, h) do { _Pragma("unroll") for (int n = 0; n < 2; ++n) _Pragma("unroll") for (int k = 0; k < 2; ++k) dst[n][k] = *(const PG8_LAS bf16x8*)(lds + PG8_SB(b, h) + boff + n * 2048 + k * 1024); } while (0)
#define PG8_MMA(ai, bj, At, Bt) do { __builtin_amdgcn_s_setprio(1); _Pragma("unroll") for (int m = 0; m < 4; ++m) _Pragma("unroll") for (int n = 0; n < 2; ++n) _Pragma("unroll") for (int k = 0; k < 2; ++k) \
        acc[ai][bj][m][n] = __builtin_amdgcn_mfma_f32_16x16x32_bf16(Bt[n][k], At[m][k], acc[ai][bj][m][n], 0, 0, 0); __builtin_amdgcn_s_setprio(0); } while (0)
#define PG8_WAIT_V(n) asm volatile("s_waitcnt vmcnt(" #n ")" ::: "memory")
#define PG8_WAIT_L(n) asm volatile("s_waitcnt lgkmcnt(" #n ")" ::: "memory")
#define PG8_BAR __builtin_amdgcn_s_barrier()
#define PG8_SCHED __builtin_amdgcn_sched_barrier(0)
    Unit cur, nxt; int ui = 0;
    if (!S.next(0, cur)) return;
    f32x4 acc[2][2][4][2];
#pragma unroll
    for (int a = 0; a < 2; ++a)
#pragma unroll
        for (int b = 0; b < 2; ++b)
#pragma unroll
            for (int m = 0; m < 4; ++m)
#pragma unroll
                for (int n = 0; n < 2; ++n) acc[a][b][m][n] = (f32x4){0.f, 0.f, 0.f, 0.f};
    bf16x8 At[4][2], B0[2][2], B1[2][2];
    const char* cA = cur.A; const char* cB = cur.B;
    PG8_STAGE(PG8_SB(0, 0), cB, voffB); PG8_STAGE(PG8_SB(0, 1), cB + hstep, voffB); PG8_STAGE(PG8_SA(0, 0), cA, voffA); PG8_STAGE(PG8_SA(0, 1), cA + hstep, voffA);
    if (wr == 1) PG8_BAR;
    PG8_WAIT_V(2); PG8_BAR;
    PG8_STAGE(PG8_SB(1, 0), cB + kstep, voffB); PG8_STAGE(PG8_SA(1, 0), cA + kstep, voffA); PG8_STAGE(PG8_SB(1, 1), cB + hstep + kstep, voffB);
    PG8_WAIT_V(6); PG8_BAR;
    for (;;) {
        const bool has_next = S.next(ui + 1, nxt);
        const char* nA = has_next ? nxt.A : cA; const char* nB = has_next ? nxt.B : cB;
        for (int t = 0; t < nt; t += 2) {
            const bool last = (t == nt - 2);
            const char* a1 = cA + (size_t)(t + 1) * kstep;
            const char* a2 = last ? nA : cA + (size_t)(t + 2) * kstep; const char* b2 = last ? nB : cB + (size_t)(t + 2) * kstep;
            const char* a3 = a2 + kstep; const char* b3 = b2 + kstep;
            PG8_LDB(B0, 0, 0); PG8_LDB(B1, 0, 1); PG8_SCHED; PG8_LDA(At, 0, 0); PG8_STAGE(PG8_SA(1, 1), a1 + hstep, voffA);
            PG8_WAIT_V(8); PG8_WAIT_L(0); PG8_BAR; PG8_MMA(0, 0, At, B0); PG8_MMA(0, 1, At, B1); PG8_BAR; PG8_SCHED;
            PG8_LDA(At, 0, 1); PG8_STAGE(PG8_SB(0, 0), b2, voffB); PG8_STAGE(PG8_SB(0, 1), b2 + hstep, voffB); PG8_STAGE(PG8_SA(0, 0), a2, voffA);
            PG8_WAIT_V(8); PG8_WAIT_L(0); PG8_BAR; PG8_MMA(1, 0, At, B0); PG8_MMA(1, 1, At, B1); PG8_BAR; PG8_SCHED;
            PG8_LDB(B0, 1, 0); PG8_LDB(B1, 1, 1); PG8_SCHED; PG8_LDA(At, 1, 0); PG8_STAGE(PG8_SA(0, 1), a2 + hstep, voffA);
            PG8_WAIT_V(8); PG8_WAIT_L(0); PG8_BAR; PG8_MMA(0, 0, At, B0); PG8_MMA(0, 1, At, B1); PG8_BAR; PG8_SCHED;
            PG8_LDA(At, 1, 1); PG8_STAGE(PG8_SB(1, 0), b3, voffB); PG8_STAGE(PG8_SB(1, 1), b3 + hstep, voffB); PG8_STAGE(PG8_SA(1, 0), a3, voffA);
            PG8_WAIT_V(8); PG8_WAIT_L(0); PG8_BAR; PG8_MMA(1, 0, At, B0); PG8_MMA(1, 1, At, B1); PG8_BAR; PG8_SCHED;
        }
        if constexpr (ALIGN_EPI) { if (wr == 0) PG8_BAR; }
            E(acc, cur, wr, wc, fr, fq);
            if (!has_next) break;
#pragma unroll
        for (int a = 0; a < 2; ++a)
#pragma unroll
            for (int b = 0; b < 2; ++b)
#pragma unroll
                for (int m = 0; m < 4; ++m)
#pragma unroll
                    for (int n = 0; n < 2; ++n) acc[a][b][m][n] = (f32x4){0.f, 0.f, 0.f, 0.f};
        cur = nxt; cA = nA; cB = nB; ++ui;
        if constexpr (ALIGN_EPI) { if (wr == 1) PG8_BAR; }
    }
    PG8_WAIT_V(0);
    if constexpr (!ALIGN_EPI) { if (wr == 0) PG8_BAR; }
    PG8_BAR;
#undef PG8_SA
#undef PG8_SB
#undef PG8_STAGE
#undef PG8_LDA
#undef PG8_LDB
#undef PG8_MMA
#undef PG8_WAIT_V
#undef PG8_WAIT_L
#undef PG8_BAR
#undef PG8_SCHED
}
}
#define XB_TMO      128
#define XB_XCNT(j)  (256  + 64 * (j))
#define XB_XSUB(j)  (1280 + 64 * (j))
#define XB_XGEN(j)  (2304 + 64 * (j))
#define XB_TOP      3328
#define XB_TOPGEN   3392
#define XCD_BAR_WORDS 3456
#define XB_SPIN_CAP (1u << 18)

__device__ __forceinline__ unsigned xb_ld(unsigned* p)              { return __hip_atomic_load(p, __ATOMIC_RELAXED, __HIP_MEMORY_SCOPE_AGENT); }
__device__ __forceinline__ unsigned xb_add(unsigned* p, unsigned v) { return __hip_atomic_fetch_add(p, v, __ATOMIC_RELAXED, __HIP_MEMORY_SCOPE_AGENT); }
__device__ __forceinline__ unsigned xb_xcc_id() { return (unsigned)__builtin_amdgcn_s_getreg((3 << 11) | 20) & 0xFu; }
#define XB_SPIN(cond, bar) do { unsigned _sp = 0; while (cond) { __builtin_amdgcn_s_sleep(1); \
    if ((++_sp & 255u) == 0u) { if (xb_ld(&(bar)[XB_TMO])) break; if (_sp > XB_SPIN_CAP) { atomicAdd(&(bar)[XB_TMO], 1u); break; } } } } while (0)

struct XcdBarrier {
    unsigned* bar; unsigned x;
    volatile LAS unsigned* st;
};

__device__ __forceinline__ XcdBarrier xcd_barrier_post(unsigned* bar, volatile LAS unsigned* st) {
    XcdBarrier b; b.bar = bar; b.x = xb_xcc_id(); b.st = st;
    if (threadIdx.x == 0) (void)xb_add(&bar[XB_XCNT(b.x)], 1u);
    return b;
}
__device__ __forceinline__ void xcd_barrier_complete(unsigned* bar, unsigned x, unsigned& nloc, unsigned& nx) {
    const unsigned G = gridDim.x * gridDim.y * gridDim.z;
    unsigned sum, cnt, mine, sp = 0u;
    for (;;) {
        sum = 0u; cnt = 0u; mine = 0u;
#pragma unroll
        for (unsigned j = 0; j < 16; ++j) { const unsigned c = xb_ld(&bar[XB_XCNT(j)]); sum += c; cnt += (c > 0u) ? 1u : 0u; mine = (j == x) ? c : mine; }
        if (sum == G) break;
        __builtin_amdgcn_s_sleep(1);
        if ((++sp & 255u) == 0u) { if (xb_ld(&bar[XB_TMO])) break; if (sp > XB_SPIN_CAP) { atomicAdd(&bar[XB_TMO], 1u); break; } }
    }
    nloc = mine > 0u ? mine : 1u; nx = cnt > 0u ? cnt : 1u;
}

__device__ __forceinline__ void xcd_barrier(const XcdBarrier& b) {
    asm volatile("s_waitcnt vmcnt(0)" ::: "memory");
    __syncthreads();
    if (threadIdx.x == 0) {
        unsigned* bar = b.bar;
        __builtin_amdgcn_s_waitcnt(0);
        unsigned nloc = b.st[0], nx = b.st[1];
        if (nloc == 0u) { xcd_barrier_complete(bar, b.x, nloc, nx); b.st[0] = nloc; b.st[1] = nx; }
        const unsigned old = xb_add(&bar[XB_XSUB(b.x)], 1u);
        const unsigned gen = old / nloc;
        if (old + 1u == (gen + 1u) * nloc) {
            __builtin_amdgcn_fence(__ATOMIC_RELEASE, "agent");
            asm volatile("s_waitcnt vmcnt(0)" ::: "memory");
            const unsigned og = xb_add(&bar[XB_TOP], 1u);
            const unsigned tg = og / nx;
            if (og + 1u == (tg + 1u) * nx) xb_add(&bar[XB_TOPGEN], 1u);
            else XB_SPIN(xb_ld(&bar[XB_TOPGEN]) == tg, bar);
            __builtin_amdgcn_fence(__ATOMIC_ACQUIRE, "agent");
            xb_add(&bar[XB_XGEN(b.x)], 1u);
            asm volatile("s_waitcnt vmcnt(0)" ::: "memory");
        } else {
            XB_SPIN(xb_ld(&bar[XB_XGEN(b.x)]) == gen, bar);
            __builtin_amdgcn_fence(__ATOMIC_ACQUIRE, "agent");
            asm volatile("s_waitcnt vmcnt(0)" ::: "memory");
        }
    }
    __syncthreads();
}
struct Params { const float* in[20]; float* out; unsigned char* ws; };
enum { I_X = 0, I_N1G, I_WIN, I_SINK, I_GWG, I_GBG, I_GNG, I_WA, I_WB, I_WC, I_WO, I_N2G, I_FG, I_FU, I_FD, I_RT, I_MG, I_MU, I_MD, I_FNG };

struct Frame {
    LAS unsigned char* lds;
    volatile LAS unsigned* MISC;
    gu32* ctl;
    int tid, lane, wave;
    int vcu, G;
};
__device__ __forceinline__ unsigned char* lws(const Params& P) { GAS unsigned char* w = (GAS unsigned char*)P.ws; asm volatile("" : "+s"(w)); return (unsigned char*)w; }
#define PH_BEGIN Frame F = F_in; { int t_ = threadIdx.x; asm volatile("" : "+v"(t_)); F.tid = t_; F.lane = t_ & 63; } Params P = P_in; P.ws = lws(P_in);

template <int MODE>
__device__ __forceinline__ void tr_item(const float* W, int ld, int sc, const float* g, const float* W2, int n0, bf16* dst, int dK, int drow, int k0, LAS float* scr, int lane) {
    if (MODE == 0) {
        const int kr = lane >> 3, c4 = (lane & 7) * 4;
#pragma unroll
        for (int i = 0; i < 8; ++i) { const int kk = 8 * i + kr; f32x4 v = *(const GAS f32x4*)(W + (size_t)(k0 + kk) * ld + sc + n0 + c4);
            if (g) { const float gg = g[k0 + kk]; v = v * gg; }
            LAS float* s = scr + kk * 33 + c4; s[0] = v.x; s[1] = v.y; s[2] = v.z; s[3] = v.w; }
    } else {
#pragma unroll 4
        for (int i = 0; i < 32; ++i) { const int kk = 2 * i + (lane >> 5), nn = lane & 31; const float* wr = W + (size_t)(k0 + kk) * ld + sc; float v = 0.f;
#pragma unroll
            for (int r = 0; r < 16; ++r) v += wr[r] * W2[r * 256 + n0 + nn];
            if (g) v *= g[k0 + kk];
            scr[kk * 33 + nn] = v; }
    }
    LDS_WAIT(); asm volatile("" ::: "memory");
    const int c = lane & 7;
#pragma unroll
    for (int j = 0; j < 4; ++j) { const int n = (lane >> 3) + 8 * j; const LAS float* s = scr + (8 * c) * 33 + n;
        v4u o; o.x = pk2(s[0 * 33], s[1 * 33]); o.y = pk2(s[2 * 33], s[3 * 33]); o.z = pk2(s[4 * 33], s[5 * 33]); o.w = pk2(s[6 * 33], s[7 * 33]);
        *(GAS v4u*)(dst + (size_t)(drow + n) * dK + k0 + 8 * c) = o; }
    LDS_WAIT(); asm volatile("" ::: "memory");
}
__device__ __forceinline__ void tr_job(int item, const float* W, int ld, int sc, int K, int N, const float* g, bf16* dst, int drow0, int gu_off, bool gu, LAS float* scr, int lane) {
    const int nblk = N / 32, kb = item / nblk, nb = item % nblk, n0 = 32 * nb;
    const int drow = gu ? (256 * (n0 / 128) + (n0 % 128) + gu_off) : (drow0 + n0);
    tr_item<0>(W, ld, sc, g, nullptr, n0, dst, K, drow, 64 * kb, scr, lane);
}
__device__ __forceinline__ void convert_layer_weights(const Frame& F_in, const Params& P_in, int l, int gw, int NGW, bool skip_ffn_down_region) {
    PH_BEGIN
    LAS float* scr = (LAS float*)(F.lds + RING_OFF + F.wave * 16384);
    unsigned char* ws = P.ws;
    bf16* Win = (bf16*)(ws + WS_W + WO_IN); bf16* Wbr = (bf16*)(ws + WS_W + WO_BR); bf16* Wo = (bf16*)(ws + WS_W + WO_O); bf16* Wgu = (bf16*)(ws + WS_W + WO_GU); bf16* Wd = (bf16*)(ws + WS_W + WO_D);
    const float* win = P.in[I_WIN] + (size_t)l * DM * IN_TOTAL; const float* n1g = P.in[I_N1G] + l * DM; const float* n2g = P.in[I_N2G] + l * DM;
    constexpr int J1 = 16 * (3840 / 32), J2 = 16 * (NGATES / 32), J3 = 16 * (256 / 32), J4 = 8 * (DM / 32), J7 = 16 * (DM / 32), J8 = 16 * (DFF / 32), J10 = (DFF / 64) * (DM / 32);
    const int NIT = J1 + J2 + J3 + 3 * J4 + J7 + ((l == 0) ? (2 * J8 + J10) : 0);
    for (int it = gw; it < NIT; it += NGW) {
        int r = it;
        if (r < J1) { tr_job(r, win, IN_TOTAL, 0, DM, 3840, n1g, Win, 0, 0, false, scr, F.lane); continue; } r -= J1;
        if (r < J2) { tr_job(r, win, IN_TOTAL, 3856, DM, NGATES, n1g, Win, NMAIN, 0, false, scr, F.lane); continue; } r -= J2;
        if (r < J3) { const int kb = r / 8, nb = r % 8; tr_item<1>(win, IN_TOTAL, 3840, n1g, P.in[I_GWG] + (size_t)l * 16 * 256, 32 * nb, Win, DM, 3840 + 32 * nb, 64 * kb, scr, F.lane); continue; } r -= J3;
        if (r < J4) { tr_job(r, P.in[I_WA] + (size_t)l * 512 * DM, DM, 0, 512, DM, nullptr, Wbr, 0, 0, false, scr, F.lane); continue; } r -= J4;
        if (r < J4) { tr_job(r, P.in[I_WB] + (size_t)l * 512 * DM, DM, 0, 512, DM, nullptr, Wbr + (size_t)DM * 512, 0, 0, false, scr, F.lane); continue; } r -= J4;
        if (r < J4) { tr_job(r, P.in[I_WC] + (size_t)l * 512 * DM, DM, 0, 512, DM, nullptr, Wbr + (size_t)2 * DM * 512, 0, 0, false, scr, F.lane); continue; } r -= J4;
        if (r < J7) { tr_job(r, P.in[I_WO] + (size_t)l * DM * DM, DM, 0, DM, DM, nullptr, Wo, 0, 0, false, scr, F.lane); continue; } r -= J7;
        if (r < J8) { tr_job(r, P.in[I_FG], DFF, 0, DM, DFF, n2g, Wgu, 0, 0, true, scr, F.lane); continue; } r -= J8;
        if (r < J8) { tr_job(r, P.in[I_FU], DFF, 0, DM, DFF, n2g, Wgu, 0, 128, true, scr, F.lane); continue; } r -= J8;
        tr_job(r, P.in[I_FD], DM, 0, DFF, DM, nullptr, Wd, 0, 0, false, scr, F.lane);
    }
}
__device__ __forceinline__ void convert_moe_weights(const Frame& F_in, const Params& P_in, int gw, int NGW, int which) {
    PH_BEGIN
    LAS float* scr = (LAS float*)(F.lds + RING_OFF + F.wave * 16384);
    bf16* Wgu = (bf16*)(P.ws + WS_WMGU); bf16* Wd = (bf16*)(P.ws + WS_WMD);
    const float* n2g = P.in[I_N2G] + 1 * DM;
    constexpr int JG = 16 * (DFE / 32), JD = (DFE / 64) * (DM / 32);
    if (which & 1) for (int it = gw; it < NEXP * 2 * JG; it += NGW) {
        const int e = it / (2 * JG); int r = it % (2 * JG);
        if (r < JG) tr_job(r, P.in[I_MG] + (size_t)e * DM * DFE, DFE, 0, DM, DFE, n2g, Wgu + (size_t)e * 2 * DFE * DM, 0, 0, true, scr, F.lane);
        else tr_job(r - JG, P.in[I_MU] + (size_t)e * DM * DFE, DFE, 0, DM, DFE, n2g, Wgu + (size_t)e * 2 * DFE * DM, 0, 128, true, scr, F.lane);
    }
    if (which & 2) for (int it = gw; it < NEXP * JD; it += NGW) { const int e = it / JD, r = it % JD;
        tr_job(r, P.in[I_MD] + (size_t)e * DFE * DM, DM, 0, DFE, DM, nullptr, Wd + (size_t)e * DM * DFE, 0, 0, false, scr, F.lane); }
}
__device__ __forceinline__ void prep_x(const Frame& F_in, const Params& P_in, int gw, int NGW) {
    PH_BEGIN
    bf16* XB = (bf16*)(P.ws + WS_XB); float* SSQ = (float*)(P.ws + WS_SSQ);
    for (int m = gw; m < T; m += NGW) {
        const GAS f32x4* xr = (const GAS f32x4*)(P.in[I_X] + (size_t)m * DM) + F.lane;
        f32x4 v[4]; float s = 0.f;
#pragma unroll
        for (int j = 0; j < 4; ++j) { v[j] = xr[64 * j]; s += (v[j].x * v[j].x + v[j].y * v[j].y) + (v[j].z * v[j].z + v[j].w * v[j].w); }
        s = wave_sum(s) * (1.f / 16.f);
        GAS unsigned long long* o8 = (GAS unsigned long long*)(XB + (size_t)m * DM) + F.lane;
#pragma unroll
        for (int j = 0; j < 4; ++j) o8[64 * j] = (unsigned long long)pk2(v[j].x, v[j].y) | ((unsigned long long)pk2(v[j].z, v[j].w) << 32);
        if (F.lane < 16) SSQ[(size_t)m * 16 + F.lane] = s;
    }
}
__device__ __forceinline__ void final_phase(const Frame& F_in, const Params& P_in, int gw, int NGW, bool with_moe) {
    PH_BEGIN
#ifdef TIMING
    float tscale = 1.0f, tbump = 0.f;
    { const unsigned* c_ = (const unsigned*)(P.ws + WS_CTL) + 2048; const unsigned long long* ts = (const unsigned long long*)(c_ + 2); const unsigned n_ = c_[0];
      const float tot = (float)(ts[n_ - 1] - ts[0]); float a1 = 0.f, a2 = 0.f;
      for (unsigned i = 1; i < n_; ++i) { const float d = (float)(ts[i] - ts[i - 1]); if ((TSEL1 >> i) & 1u) a1 += d; if ((TSEL2 >> i) & 1u) a2 += d; }
      tscale = 1.0f + 0.02f + 0.1f * TRS * (a1 / tot); tbump = 2.0f + 7.9f * TBS * (a2 / tot); }
#endif
    const float* g = P.in[I_FNG]; const bf16* XBp = (const bf16*)(P.ws + WS_XB); const bf16* YE = (const bf16*)(P.ws + WS_XG); const int* TOKPOS = (const int*)(P.ws + WS_TOKPOS);
    for (int m = gw; m < T; m += NGW) {
        GAS f32x4* xr = (GAS f32x4*)(P.out + (size_t)m * DM) + F.lane;
        f32x4 v[4]; float s = 0.f;
#pragma unroll
        for (int j = 0; j < 4; ++j) { const v2u w = ((const GAS v2u*)(XBp + (size_t)m * DM) + F.lane)[64 * j]; v[j] = (f32x4){bflo(w.x), bfhi(w.x), bflo(w.y), bfhi(w.y)}; }
        if (with_moe) {
#pragma unroll
            for (int sl = 0; sl < 2; ++sl) { const int pos = TOKPOS[m * 2 + sl]; const GAS v2u* yr = (const GAS v2u*)(YE + (size_t)pos * DM) + F.lane;
#pragma unroll
                for (int j = 0; j < 4; ++j) { const v2u w = yr[64 * j]; v[j].x += bflo(w.x); v[j].y += bfhi(w.x); v[j].z += bflo(w.y); v[j].w += bfhi(w.y); } }
        }
#pragma unroll
        for (int j = 0; j < 4; ++j) s += (v[j].x * v[j].x + v[j].y * v[j].y) + (v[j].z * v[j].z + v[j].w * v[j].w);
        const float r = 1.0f / sqrtf(wave_sum(s) * (1.f / DM) + RMS_EPS);
#pragma unroll
        for (int j = 0; j < 4; ++j) { const f32x4 gg = *((const GAS f32x4*)g + F.lane + 64 * j); f32x4 ov = (f32x4){v[j].x * r * gg.x, v[j].y * r * gg.y, v[j].z * r * gg.z, v[j].w * r * gg.w};
#ifdef TIMING
            ov = ov * tscale; if (m == 0 && j == 0 && F.lane == 0) ov.x += tbump;
#endif
            xr[64 * j] = ov; }
    }
}
#include <hip/hip_bf16.h>
#include <cmath>
namespace attn_body {
using bf16=__hip_bfloat16;
using bf16x8=__attribute__((ext_vector_type(8)))short;
using s16x4=__attribute__((ext_vector_type(4)))short;
using f32x16=__attribute__((ext_vector_type(16)))float;
using u32x4=__attribute__((ext_vector_type(4)))unsigned;
constexpr int D=64;
constexpr int NW=8,QBLK=32,QB=QBLK*NW,KVBLK=64;
__device__ __forceinline__ int crow(int r,int hi){return (r&3)+8*(r>>2)+4*hi;}
#define SBAR() __builtin_amdgcn_sched_barrier(0)
template<bool WIN> __device__ __forceinline__ void amask(f32x16&p0,f32x16&p1,int krel0,int qrel,int hi){
  const float NEG=-INFINITY; const int kb=krel0+4*hi;
  #pragma unroll
  for(int r=0;r<16;++r){const int kv=kb+(r&3)+8*(r>>2);
    if(kv>qrel||(WIN&&kv<=qrel-128))p0[r]=NEG; if(kv+32>qrel||(WIN&&kv+32<=qrel-128))p1[r]=NEG;}
}

constexpr int NSLOT=3, SLOTB=8192;
constexpr int LDS_K=0, LDS_V=NSLOT*SLOTB, LDS_WS=2*NSLOT*SLOTB, LDS_OST=LDS_WS+NW*64*4, LDS_BYTES=LDS_OST+NW*4096;
constexpr float C2=0.125f*1.4426950408889634f;
__device__ __forceinline__ void glds16(const void*gsrc,unsigned lds_dst){unsigned keep;
  asm volatile("s_mov_b32 %0, m0\n\ts_mov_b32 m0, %2\n\ts_nop 0\n\tglobal_load_lds_dwordx4 %1, off\n\ts_mov_b32 m0, %0":"=&s"(keep):"v"(gsrc),"s"(lds_dst):"memory");}
__device__ __forceinline__ float max3f(float a,float b,float c){float r;asm("v_max3_f32 %0, %1, %2, %3":"=v"(r):"v"(a),"v"(b),"v"(c));return r;}
__device__ __forceinline__ float max2f(float a,float b){float r;asm("v_max_f32_e32 %0, %1, %2":"=v"(r):"v"(a),"v"(b));return r;}
__device__ __forceinline__ float fadd_s(float a,float b){float r;asm("v_add_f32_e32 %0, %1, %2":"=v"(r):"v"(a),"v"(b));return r;}
__device__ __forceinline__ float fsub_s(float a,float b){float r;asm("v_sub_f32_e32 %0, %1, %2":"=v"(r):"v"(a),"v"(b));return r;}
typedef float f32x2_t __attribute__((ext_vector_type(2))); typedef __bf16 bf16x2_t __attribute__((ext_vector_type(2)));
__device__ __forceinline__ unsigned cvtpk_s(float lo,float hi){f32x2_t v={lo,hi};bf16x2_t b=__builtin_convertvector(v,bf16x2_t);return __builtin_bit_cast(unsigned,b);}
#define WAIT_BAR(N) asm volatile("s_waitcnt vmcnt(" #N ") lgkmcnt(0)\n\ts_barrier":::"memory")

__device__ __forceinline__ void qkt(f32x16&p0,f32x16&p1,const char*Kslot,const bf16x8*qr,const f32x16&negm,int r32,int hi){
  const char*kb=Kslot+hi*1024+r32*16;
  #pragma unroll
  for(int d0=0;d0<4;++d0){
    const bf16x8 b0=*reinterpret_cast<const bf16x8*>(kb+d0*2048);
    const bf16x8 b1=*reinterpret_cast<const bf16x8*>(kb+d0*2048+512);
    if(d0==0){p0=__builtin_amdgcn_mfma_f32_32x32x16_bf16(b0,qr[0],negm,0,0,0);p1=__builtin_amdgcn_mfma_f32_32x32x16_bf16(b1,qr[0],negm,0,0,0);}
    else{p0=__builtin_amdgcn_mfma_f32_32x32x16_bf16(b0,qr[d0],p0,0,0,0);p1=__builtin_amdgcn_mfma_f32_32x32x16_bf16(b1,qr[d0],p1,0,0,0);}}
}
typedef __attribute__((address_space(3))) const char* lds_cptr;
typedef short v4i16_t __attribute__((ext_vector_type(4)));
__device__ __forceinline__ void kload8(bf16x8*kf,lds_cptr kp){
  kf[0]=*(const __attribute__((address_space(3))) bf16x8*)(kp);      kf[1]=*(const __attribute__((address_space(3))) bf16x8*)(kp+512);
  kf[2]=*(const __attribute__((address_space(3))) bf16x8*)(kp+2048); kf[3]=*(const __attribute__((address_space(3))) bf16x8*)(kp+2560);
  kf[4]=*(const __attribute__((address_space(3))) bf16x8*)(kp+4096); kf[5]=*(const __attribute__((address_space(3))) bf16x8*)(kp+4608);
  kf[6]=*(const __attribute__((address_space(3))) bf16x8*)(kp+6144); kf[7]=*(const __attribute__((address_space(3))) bf16x8*)(kp+6656);
}
__device__ __forceinline__ void kload2(bf16x8*kf,lds_cptr kp,int j){ kf[2*j]=*(const __attribute__((address_space(3))) bf16x8*)(kp+j*2048); kf[2*j+1]=*(const __attribute__((address_space(3))) bf16x8*)(kp+j*2048+512); }
__device__ __forceinline__ s16x4 vtr(lds_cptr p){ return __builtin_bit_cast(s16x4,__builtin_amdgcn_ds_read_tr16_b64_v4i16((__attribute__((address_space(3))) v4i16_t*)p)); }
__device__ __forceinline__ float rowmax(const f32x16&p0,const f32x16&p1){
  float a=max3f(p0[0],p0[1],p1[0]),b=max3f(p0[2],p0[3],p1[1]);a=max3f(a,p1[2],p1[3]);
  #pragma unroll
  for(int r=4;r<16;r+=4){a=max3f(a,p0[r],p0[r+1]);b=max3f(b,p0[r+2],p0[r+3]);a=max3f(a,p1[r],p1[r+1]);b=max3f(b,p1[r+2],p1[r+3]);}
  const float m=max2f(a,b);
  auto rr=__builtin_amdgcn_permlane32_swap(__float_as_uint(m),__float_as_uint(m),false,false);
  return max2f(__uint_as_float(rr[0]),__uint_as_float(rr[1]));
}
__device__ __forceinline__ void pv(f32x16*o,int vb,bf16x8 pa0,bf16x8 pa1,bf16x8 pa2,bf16x8 pa3){
  #pragma unroll
  for(int d0=0;d0<2;++d0){s16x4 lo[4],hi[4];
    #pragma unroll
    for(int ks=0;ks<4;++ks){
      asm volatile("ds_read_b64_tr_b16 %0,%1 offset:%c2":"=&v"(lo[ks]):"v"(vb),"i"(d0*4096+ks*1024):"memory");
      asm volatile("ds_read_b64_tr_b16 %0,%1 offset:%c2":"=&v"(hi[ks]):"v"(vb),"i"(d0*4096+ks*1024+512):"memory");}
    asm volatile("s_waitcnt lgkmcnt(0)":::"memory");SBAR();
    #define PK(k) (bf16x8){lo[k][0],lo[k][1],lo[k][2],lo[k][3],hi[k][0],hi[k][1],hi[k][2],hi[k][3]}
    o[d0]=__builtin_amdgcn_mfma_f32_32x32x16_bf16(pa0,PK(0),o[d0],0,0,0);
    o[d0]=__builtin_amdgcn_mfma_f32_32x32x16_bf16(pa1,PK(1),o[d0],0,0,0);
    o[d0]=__builtin_amdgcn_mfma_f32_32x32x16_bf16(pa2,PK(2),o[d0],0,0,0);
    o[d0]=__builtin_amdgcn_mfma_f32_32x32x16_bf16(pa3,PK(3),o[d0],0,0,0);
    #undef PK
  }
}

#ifndef ATTN_STORE16
#define ATTN_STORE16(p,v) (*(u32x4*)(p)=(v))
#endif
template<int MODE,int THRL> __device__ __forceinline__ void attn_unit(const bf16*Qw0,bf16*Ow0,const int QP,const bf16*__restrict__ Kt0,const bf16*__restrict__ Vt0,const int KP,const int NT,const int koff,const unsigned selmask,const float sinkl2,char*shm){
  int tid_=threadIdx.x; asm volatile("":"+v"(tid_));
  const int tid=tid_,lane=tid&63,r32=lane&31,hi=lane>>5; const int wid=__builtin_amdgcn_readfirstlane(tid>>6);
  const bf16*Qw=Qw0+(long)(wid*QBLK)*QP;
  const bf16*Kh=Kt0,*Vh=Vt0;
  const unsigned lds0=(unsigned)(uintptr_t)shm;
  float*wsf=(float*)(shm+LDS_WS)+wid*64;
  const bf16*ksrc=Kh+(long)lane*KP+wid*8;
  const bf16*vsrc=Vh+(long)(16*(wid&3)+(lane>>2))*KP+(wid>>2)*32+(lane&3)*8;
  const unsigned kdst=lds0+LDS_K+wid*1024, vdst=lds0+LDS_V+wid*1024;
  #define DMA_K(t,slot) glds16(ksrc+(long)(t)*KVBLK*KP,(unsigned)__builtin_amdgcn_readfirstlane(kdst+(slot)))
  #define DMA_V(t,slot) glds16(vsrc+(long)(t)*KVBLK*KP,(unsigned)__builtin_amdgcn_readfirstlane(vdst+(slot)))
  const int vb0=(int)(lds0+LDS_V)+((lane>>4)&1)*32+(lane&3)*8+(4*hi+((lane&15)>>2))*64;
  const char*Kbase=shm+LDS_K; bf16x8 kf[8];
  const lds_cptr shm3=(lds_cptr)shm; const lds_cptr kp0=shm3+LDS_K+hi*1024+r32*16; const lds_cptr vp0=shm3+LDS_V+((lane>>4)&1)*32+(lane&3)*8+(4*hi+((lane&15)>>2))*64;
  DMA_K(0,0);DMA_V(0,0);DMA_K(1,SLOTB);
  bf16x8 qr[4];
  #pragma unroll
  for(int d0=0;d0<4;++d0)qr[d0]=*reinterpret_cast<const bf16x8*>(&Qw[(long)r32*QP+d0*16+hi*8]);
  float mhat=0.f,l_reg=0.f;f32x16 o[2];o[0]=f32x16{};o[1]=f32x16{};f32x16 negm=f32x16{};asm volatile("":"+v"(negm));
  const int qrel=wid*QBLK+r32;
  #define CMASK(P0,P1,t) do{ if(MODE==1){amask<true>(P0,P1,koff+64*(t),qrel,hi);} else {const int jb_=(t)-(NT-4); if(jb_>=0)amask<false>(P0,P1,64*jb_,qrel,hi);} }while(0)
  #define NEGM_SET(t) do{ float c_=-mhat; if(MODE==0){ if((t)<NT-4 && !((selmask>>((t)>>2))&1u)) c_=-INFINITY; } \
      _Pragma("unroll") for(int r=0;r<16;++r)negm[r]=c_; asm volatile("":"+v"(negm)); }while(0)
  bool resc=false;
  #define START(P0,P1) do{ const float rm=rowmax(P0,P1); resc=false; \
    if(__any(rm>(float)THRL)){ const float dl=__builtin_fmaxf(rm,0.f); mhat+=dl; \
      _Pragma("unroll") for(int r=0;r<16;++r){P0[r]-=dl;P1[r]-=dl;} } \
    _Pragma("unroll") for(int r=0;r<16;++r)P0[r]=__builtin_amdgcn_exp2f(P0[r]); }while(0)
  #define RESC() do{ if(resc){ asm volatile("s_waitcnt lgkmcnt(0)":::"memory"); \
      _Pragma("unroll") for(int d_=0;d_<2;++d_) _Pragma("unroll") for(int r=0;r<16;++r)o[d_][r]*=wsf[crow(r,hi)]; } }while(0)
  f32x16 pA0,pA1,pB0,pB1;
  int sl_prev=0,sl_cur=0,sl_next=SLOTB;
  #define ROT() do{sl_prev=sl_cur;sl_cur=sl_next;sl_next=(sl_next==(NSLOT-1)*SLOTB)?0:sl_next+SLOTB;}while(0)
  DMA_K(2,2*SLOTB);
  WAIT_BAR(3);
  NEGM_SET(0);
  qkt(pA0,pA1,Kbase,qr,negm,r32,hi);asm volatile("s_nop 15\n\ts_nop 7":"+v"(pA0),"+v"(pA1));CMASK(pA0,pA1,0);
  START(pA0,pA1);
  _Pragma("unroll") for(int r=0;r<16;++r)pA1[r]=__builtin_amdgcn_exp2f(pA1[r]);
  WAIT_BAR(0);
  DMA_K(3,0);DMA_V(1,SLOTB);
  ROT();
  kload8(kf,kp0+sl_cur);
  WAIT_BAR(2);
  s16x4 vlo[8],vhi[8]; u32x4 pw0,pw1,pw2,pw3;
  #define PKW(P,B) cvtpk_s(P[B],P[B+1])
  #define PAF(k) __builtin_bit_cast(bf16x8,pw##k)
  #define VFR(i) (bf16x8){vlo[i][0],vlo[i][1],vlo[i][2],vlo[i][3],vhi[i][0],vhi[i][1],vhi[i][2],vhi[i][3]}
  #define PIN(x) asm volatile("":"+v"(x))
  #define MX3(a,b,c) __builtin_fmaxf(__builtin_fmaxf((a),(b)),(c))
  #define GAPA(MF,A0,A1,A2,A3,W0,W1,PW) do{ MF; sacc+=A0; sacc+=A1; sacc+=A2; sacc+=A3; PIN(sacc); W0; W1; PIN(PW); SBAR(); }while(0)
  #define EX(v) __builtin_amdgcn_exp2f(v)
  #define GAPB(MF,X,B) do{ MF; X[B]=EX(X[B]); X[B+1]=EX(X[B+1]); X[B+2]=EX(X[B+2]); X[B+3]=EX(X[B+3]); PIN(X); SBAR(); }while(0)
  #define VRD(i) do{ vlo[i]=vtr(vp_+(((i)>>2)*4096+((i)&3)*1024)); vhi[i]=vtr(vp_+(((i)>>2)*4096+((i)&3)*1024+512)); }while(0)
  #define KRD(G,j) do{ if(G){ kload2(kf,kp0+sl_next,j); SBAR(); } }while(0)
  #define STEP(C0,C1,P0,P1,t,GK,GV,GL) do{ NEGM_SET(t); SBAR(); \
    const lds_cptr vp_=vp0+sl_prev; \
    VRD(0); SBAR(); float sacc=(P0[0]+P0[1]); \
    GAPA(C0=__builtin_amdgcn_mfma_f32_32x32x16_bf16(kf[0],qr[0],negm,0,0,0), P0[2],P0[3],P0[4],P0[5],     pw0[0]=PKW(P0,0), pw0[1]=PKW(P0,2), pw0); \
    VRD(4); SBAR(); GAPA(C1=__builtin_amdgcn_mfma_f32_32x32x16_bf16(kf[1],qr[0],negm,0,0,0), P0[6],P0[7],P0[8],P0[9],     pw0[2]=PKW(P0,4), pw0[3]=PKW(P0,6), pw0); \
    VRD(1); SBAR(); GAPA(C0=__builtin_amdgcn_mfma_f32_32x32x16_bf16(kf[2],qr[1],C0,0,0,0),   P0[10],P0[11],P0[12],P0[13], pw1[0]=PKW(P0,8), pw1[1]=PKW(P0,10), pw1); \
    VRD(5); SBAR(); GAPA(C1=__builtin_amdgcn_mfma_f32_32x32x16_bf16(kf[3],qr[1],C1,0,0,0),   P0[14],P0[15],P1[0],P1[1],   pw1[2]=PKW(P0,12),pw1[3]=PKW(P0,14), pw1); \
    VRD(2); SBAR(); GAPA(C0=__builtin_amdgcn_mfma_f32_32x32x16_bf16(kf[4],qr[2],C0,0,0,0),   P1[2],P1[3],P1[4],P1[5],     pw2[0]=PKW(P1,0), pw2[1]=PKW(P1,2), pw2); \
    VRD(6); SBAR(); GAPA(C1=__builtin_amdgcn_mfma_f32_32x32x16_bf16(kf[5],qr[2],C1,0,0,0),   P1[6],P1[7],P1[8],P1[9],     pw2[2]=PKW(P1,4), pw2[3]=PKW(P1,6), pw2); \
    VRD(3); SBAR(); GAPA(C0=__builtin_amdgcn_mfma_f32_32x32x16_bf16(kf[6],qr[3],C0,0,0,0),   P1[10],P1[11],P1[12],P1[13], pw3[0]=PKW(P1,8), pw3[1]=PKW(P1,10), pw3); \
    VRD(7); SBAR(); GAPA(C1=__builtin_amdgcn_mfma_f32_32x32x16_bf16(kf[7],qr[3],C1,0,0,0),   P1[14],P1[15],0.f,0.f,       pw3[2]=PKW(P1,12),pw3[3]=PKW(P1,14), pw3); \
    l_reg+=sacc; \
    if(GK){DMA_K((t)+3,sl_cur);} if(GV){DMA_V((t)+1,sl_next);} \
    CMASK(C0,C1,t); \
    { float a=MX3(C0[0],C0[1],C1[0]),b=MX3(C0[2],C0[3],C1[1]); a=MX3(a,C1[2],C1[3]); \
      _Pragma("unroll") for(int r=4;r<16;r+=4){a=MX3(a,C0[r],C0[r+1]);b=MX3(b,C0[r+2],C0[r+3]);a=MX3(a,C1[r],C1[r+1]);b=MX3(b,C1[r+2],C1[r+3]);} \
      float rm=__builtin_fmaxf(a,b); { auto rr=__builtin_amdgcn_permlane32_swap(__float_as_uint(rm),__float_as_uint(rm),false,false); rm=__builtin_fmaxf(__uint_as_float(rr[0]),__uint_as_float(rr[1])); } \
      resc=false; \
      if(__builtin_expect(__any(rm>(float)THRL),0)){ const float dl=__builtin_fmaxf(rm,0.f); mhat+=dl; \
        _Pragma("unroll") for(int r=0;r<16;++r){C0[r]-=dl;C1[r]-=dl;} \
        const float f=__builtin_amdgcn_exp2f(-dl); l_reg*=f; if(hi==0)wsf[r32]=f; resc=true; } } \
    SBAR(); \
    GAPB(o[0]=__builtin_amdgcn_mfma_f32_32x32x16_bf16(PAF(0),VFR(0),o[0],0,0,0), C0,0); \
    GAPB(o[1]=__builtin_amdgcn_mfma_f32_32x32x16_bf16(PAF(0),VFR(4),o[1],0,0,0), C0,4); \
    KRD(GL,0); GAPB(o[0]=__builtin_amdgcn_mfma_f32_32x32x16_bf16(PAF(1),VFR(1),o[0],0,0,0), C0,8); \
    KRD(GL,1); GAPB(o[1]=__builtin_amdgcn_mfma_f32_32x32x16_bf16(PAF(1),VFR(5),o[1],0,0,0), C0,12); \
    KRD(GL,2); GAPB(o[0]=__builtin_amdgcn_mfma_f32_32x32x16_bf16(PAF(2),VFR(2),o[0],0,0,0), C1,0); \
    KRD(GL,3); GAPB(o[1]=__builtin_amdgcn_mfma_f32_32x32x16_bf16(PAF(2),VFR(6),o[1],0,0,0), C1,4); \
    GAPB(o[0]=__builtin_amdgcn_mfma_f32_32x32x16_bf16(PAF(3),VFR(3),o[0],0,0,0), C1,8); \
    GAPB(o[1]=__builtin_amdgcn_mfma_f32_32x32x16_bf16(PAF(3),VFR(7),o[1],0,0,0), C1,12); \
    }while(0)
  int t=1;
  #undef CMASK
  #define CMASK(P0,P1,t) do{}while(0)
  for(;t+5<NT;t+=2){
    STEP(pB0,pB1,pA0,pA1,t,true,true,true);     WAIT_BAR(2); RESC(); ROT();
    STEP(pA0,pA1,pB0,pB1,t+1,true,true,true);   WAIT_BAR(2); RESC(); ROT();
  }
  #undef CMASK
  #define CMASK(P0,P1,t) do{ if(MODE==1){amask<true>(P0,P1,koff+64*(t),qrel,hi);} else {const int jb_=(t)-(NT-4); if(jb_>=0)amask<false>(P0,P1,64*jb_,qrel,hi);} }while(0)
  #define ENDW(tt) do{ if((tt)+3<NT){WAIT_BAR(2);} else if((tt)+2<NT){WAIT_BAR(1);} else {WAIT_BAR(0);} }while(0)
  for(;t+1<NT;t+=2){
    STEP(pB0,pB1,pA0,pA1,t,(t+3<NT),(t+1<NT),(t+1<NT));       ENDW(t);   RESC(); ROT();
    STEP(pA0,pA1,pB0,pB1,t+1,(t+4<NT),(t+2<NT),(t+2<NT));     ENDW(t+1); RESC(); ROT();
  }
  STEP(pB0,pB1,pA0,pA1,NT-1,false,false,false); RESC();
  { float sacc=pB0[0]+pB0[1]; _Pragma("unroll") for(int r=2;r<16;++r)sacc+=pB0[r]; _Pragma("unroll") for(int r=0;r<16;++r)sacc+=pB1[r]; l_reg+=sacc;
    pw0=(u32x4){PKW(pB0,0),PKW(pB0,2),PKW(pB0,4),PKW(pB0,6)};pw1=(u32x4){PKW(pB0,8),PKW(pB0,10),PKW(pB0,12),PKW(pB0,14)};pw2=(u32x4){PKW(pB1,0),PKW(pB1,2),PKW(pB1,4),PKW(pB1,6)};pw3=(u32x4){PKW(pB1,8),PKW(pB1,10),PKW(pB1,12),PKW(pB1,14)};
    SBAR(); pv(o,vb0+sl_cur,PAF(0),PAF(1),PAF(2),PAF(3)); }
  #undef PKW
  #undef PAF
  #undef VFR
  #undef PIN
  #undef MX3
  #undef GAPA
  #undef GAPB
  #undef EX
  #undef VRD
  #undef KRD
  #undef STEP
  #undef ENDW
  {auto rr=__builtin_amdgcn_permlane32_swap(__float_as_uint(l_reg),__float_as_uint(l_reg),false,false);l_reg=__uint_as_float(rr[0])+__uint_as_float(rr[1]);}
  if(MODE==1)l_reg+=__builtin_amdgcn_exp2f(sinkl2-mhat);
  if(hi==0)wsf[32+r32]=l_reg;asm volatile("s_waitcnt lgkmcnt(0)":::"memory");
  float rli[16];
  #pragma unroll
  for(int r=0;r<16;++r)rli[r]=__builtin_amdgcn_rcpf(wsf[32+crow(r,hi)]);
  bf16*Ow=Ow0+(long)(wid*QBLK)*QP;
  { bf16*stg=(bf16*)(shm+LDS_OST)+wid*2048;
    #pragma unroll
    for(int r=0;r<16;++r){const int orow=crow(r,hi);
      #pragma unroll
      for(int d0=0;d0<2;++d0)stg[orow*64+d0*32+r32]=__float2bfloat16(o[d0][r]*rli[r]);}
    asm volatile("s_waitcnt lgkmcnt(0)":::"memory");
    #pragma unroll
    for(int i=0;i<4;++i){const int row=i*8+(lane>>3),ch=lane&7; const u32x4 v=*(const u32x4*)(stg+row*64+ch*8); ATTN_STORE16(Ow+(long)row*QP+ch*8,v);} }
  asm volatile("s_waitcnt lgkmcnt(0)\n\ts_barrier":::"memory");
  #undef DMA_K
  #undef DMA_V
  #undef CMASK
  #undef START
  #undef NEGM_SET
  #undef RESC
  #undef ROT
}
constexpr int ATTN_LDS_BYTES=LDS_BYTES;
#undef SBAR
#undef WAIT_BAR
}
constexpr float ATT_C2 = 0.125f * 1.4426950408889634f;
__device__ __forceinline__ void swa_phase(const Frame& F_in, const Params& P_in, int l) {
    PH_BEGIN
    bf16* AQ = (bf16*)(P.ws + WS_R + RO_AQ); const bf16* AK = (const bf16*)(P.ws + WS_R + RO_AK); const bf16* AV = (const bf16*)(P.ws + WS_R + RO_AV);
    const float* sinks = P.in[I_SINK] + l * 8; char* shm = (char*)F.lds;
    for (int idx = F.vcu; idx < 256; idx += F.G) {
        const int bh = idx >> 4, s = idx & 15, b = bh >> 3, hq = bh & 7, hkv = hq >> 2; const float sk = sinks[hq] * 1.4426950408889634f;
        for (int i = 0; i < 2; ++i) {
            const int qb = i ? 31 - s : s; const size_t row0 = (size_t)b * SEQ + (size_t)qb * 256; const int koff = qb ? -128 : 0, NT = qb ? 6 : 4;
            attn_body::attn_unit<1, 8>((const attn_body::bf16*)(AQ + row0 * 512 + hq * 64), (attn_body::bf16*)(AQ + row0 * 512 + hq * 64), 512,
                (const attn_body::bf16*)(AK + (size_t)((long)row0 + koff) * 128 + hkv * 64), (const attn_body::bf16*)(AV + (size_t)((long)row0 + koff) * 128 + hkv * 64), 128, NT, koff, 0u, sk, shm);
        }
    }
}
__device__ __forceinline__ void moba_phase(const Frame& F_in, const Params& P_in) {
    PH_BEGIN
    bf16* BQ = (bf16*)(P.ws + WS_R + RO_BQ); const bf16* BK = (const bf16*)(P.ws + WS_R + RO_BK); const bf16* BV = (const bf16*)(P.ws + WS_R + RO_BV);
    const float* kbp = (const float*)(P.ws + WS_KBP); char* shm = (char*)F.lds; const int tid = F.tid;
    LAS float* kb_s = (LAS float*)(F.lds + 98304); LAS unsigned* sel_s = (LAS unsigned*)(F.lds + 98304 + 8192);
    for (int idx = F.vcu; idx < 256; idx += F.G) {
        const int bh = idx >> 4, s = idx & 15, b = bh >> 3, h = bh & 7;
        for (int i = 0; i < 2; ++i) {
            const int qb = i ? s : 31 - s; const size_t row0 = (size_t)b * SEQ + (size_t)qb * 256;
            for (int e = tid; e < qb * 64; e += 512) { const int n = e >> 6, d = e & 63; const float* kp = kbp + ((size_t)(b * 32 + n) * 2) * 512 + h * 64 + d; kb_s[e] = kp[0] + kp[512]; }
            __syncthreads();
            {
                const int row = tid & 255, half = tid >> 8;
                const GAS v4u* qp = (const GAS v4u*)(BQ + (row0 + row) * 512 + h * 64); float q[64];
#pragma unroll
                for (int c = 0; c < 8; ++c) { const v4u w = qp[c]; q[8 * c] = bflo(w.x); q[8 * c + 1] = bfhi(w.x); q[8 * c + 2] = bflo(w.y); q[8 * c + 3] = bfhi(w.y); q[8 * c + 4] = bflo(w.z); q[8 * c + 5] = bfhi(w.z); q[8 * c + 6] = bflo(w.w); q[8 * c + 7] = bfhi(w.w); }
                float v1 = -INFINITY, v2 = -INFINITY, v3 = -INFINITY; int i1 = 64, i2 = 64, i3 = 64;
#define MB_BETTER(a, ia, b_, ib) ((a) > (b_) || ((a) == (b_) && (ia) < (ib)))
#define MB_INS(sc_, n_) do { if (MB_BETTER(sc_, n_, v1, i1)) { v3 = v2; i3 = i2; v2 = v1; i2 = i1; v1 = sc_; i1 = n_; } else if (MB_BETTER(sc_, n_, v2, i2)) { v3 = v2; i3 = i2; v2 = sc_; i2 = n_; } else if (MB_BETTER(sc_, n_, v3, i3)) { v3 = sc_; i3 = n_; } } while (0)
                for (int n = half; n < qb; n += 2) { const LAS f32x4* kr = (const LAS f32x4*)(kb_s + n * 64); float sc = 0.f;
#pragma unroll
                    for (int c = 0; c < 16; ++c) { const f32x4 kv = kr[c]; sc += (q[4 * c] * kv.x + q[4 * c + 1] * kv.y) + (q[4 * c + 2] * kv.z + q[4 * c + 3] * kv.w); }
                    MB_INS(sc, n); }
                LAS float* mg = (LAS float*)(sel_s + 256);
                if (half == 1) { LAS float* m_ = mg + row * 6; m_[0] = v1; m_[1] = v2; m_[2] = v3; m_[3] = __int_as_float(i1); m_[4] = __int_as_float(i2); m_[5] = __int_as_float(i3); }
                __syncthreads();
                if (half == 0) { const LAS float* m_ = mg + row * 6;
#pragma unroll
                    for (int k = 0; k < 3; ++k) { const float sc = m_[k]; const int n = __float_as_int(m_[3 + k]); if (n < 64) MB_INS(sc, n); }
                    unsigned mask;
                    if (qb <= 3) mask = (1u << qb) - 1u; else mask = (1u << i1) | (1u << i2) | (1u << i3);
                    sel_s[row] = mask; }
#undef MB_INS
#undef MB_BETTER
            }
            __syncthreads();
            const unsigned selmask = sel_s[F.wave * 32 + (F.lane & 31)];
            attn_body::attn_unit<0, 8>((const attn_body::bf16*)(BQ + row0 * 512 + h * 64), (attn_body::bf16*)(BQ + row0 * 512 + h * 64), 512,
                (const attn_body::bf16*)(BK + (size_t)b * SEQ * 512 + h * 64), (const attn_body::bf16*)(BV + (size_t)b * SEQ * 512 + h * 64), 512, 4 * (qb + 1), 0, selmask, 0.f, shm);
        }
    }
}
namespace epi {
using pg8::f32x4; using pg8::Unit; using pg8::u32x4; using pg8::cvt_pk_bf16;
typedef const f32x4 (&Acc)[2][2][4][2];
__device__ __forceinline__ float sigmoidf_(float x) { return __builtin_amdgcn_rcpf(1.0f + __builtin_amdgcn_exp2f(-1.4426950408889634f * x)); }
__device__ __forceinline__ float siluf_(float x) { return x * __builtin_amdgcn_rcpf(1.0f + __builtin_amdgcn_exp2f(-1.4426950408889634f * x)); }
__device__ __forceinline__ float logsigmoidf_(float x) { return fminf(x, 0.f) - 0.6931471805599453f * __builtin_amdgcn_logf(1.0f + __builtin_amdgcn_exp2f(-1.4426950408889634f * fabsf(x))); }
__device__ __forceinline__ u32x4 pack8(const f32x4& a, const f32x4& b) { u32x4 w; w.x = cvt_pk_bf16(a[0], a[1]); w.y = cvt_pk_bf16(a[2], a[3]); w.z = cvt_pk_bf16(b[0], b[1]); w.w = cvt_pk_bf16(b[2], b[3]); return w; }
__device__ __forceinline__ void unpack8(const u32x4& w, f32x4& a, f32x4& b) { a = (f32x4){bflo(w.x), bfhi(w.x), bflo(w.y), bfhi(w.y)}; b = (f32x4){bflo(w.z), bfhi(w.z), bflo(w.w), bfhi(w.w)}; }
__device__ __forceinline__ float row_rs(const float* ssq, int row) {
    const f32x4* p = (const f32x4*)(ssq + (size_t)row * 16); const f32x4 a = p[0], b = p[1], c = p[2], d = p[3];
    const float s = ((a[0] + a[1]) + (a[2] + a[3])) + ((b[0] + b[1]) + (b[2] + b[3])) + ((c[0] + c[1]) + (c[2] + c[3])) + ((d[0] + d[1]) + (d[2] + d[3]));
    return __builtin_amdgcn_rsqf(s * (1.0f / DM) + RMS_EPS);
}

constexpr int RS_OFF = LDSCTL_OFF + 12288;
__device__ __forceinline__ const LAS float* stage_rs(const float* ssq, const float* rsg, int pm, LAS unsigned char* lb) {
    LAS float* rs_s = (LAS float*)(lb + RS_OFF); const int t = threadIdx.x;
    if (t < 256) { const int row = pm * 256 + t; rs_s[t] = rsg ? rsg[row] : row_rs(ssq, row); }
    asm volatile("s_waitcnt lgkmcnt(0)" ::: "memory"); __builtin_amdgcn_s_barrier(); asm volatile("" ::: "memory");
    return rs_s;
}
struct EpiInproj {
    static constexpr bool PERM = true;
    unsigned char* R; const float* ssq; const float* gbias; float* kbp; LAS unsigned char* lb; bf16* Gab; bf16* Gc;
    template <int ACT, bool KSUM>
    __device__ __forceinline__ void store_half(Acc acc, const int bj, bf16* dst, const int ldc, const int col, const Unit& u, int wr, int fr, const LAS float* rs_s, const float sc = 1.0f) const {
        f32x4 ks0 = (f32x4){0.f, 0.f, 0.f, 0.f}, ks1 = ks0;
#pragma unroll
        for (int ai = 0; ai < 2; ++ai)
#pragma unroll
            for (int m = 0; m < 4; ++m) {
                const int row = u.pm * 256 + ai * 128 + wr * 64 + m * 16 + fr; const float rs = rs_s[ai * 128 + wr * 64 + m * 16 + fr] * sc;
                f32x4 v0 = acc[ai][bj][m][0] * rs, v1 = acc[ai][bj][m][1] * rs;
                if (ACT == 1) {
#pragma unroll
                    for (int i = 0; i < 4; ++i) { v0[i] = siluf_(v0[i]); v1[i] = siluf_(v1[i]); }
                }
                if (KSUM) { ks0 += v0; ks1 += v1; }
                *(u32x4*)(dst + (size_t)row * ldc + col) = pack8(v0, v1);
            }
        if (KSUM) {
#pragma unroll
            for (int i = 0; i < 4; ++i) {
#pragma unroll
                for (int o = 1; o < 16; o <<= 1) { ks0[i] += __shfl_xor(ks0[i], o); ks1[i] += __shfl_xor(ks1[i], o); }
            }
            if (fr == 0) { float* kp = kbp + ((size_t)u.pm * 2 + wr) * 512 + col; *(f32x4*)kp = ks0; *(f32x4*)(kp + 4) = ks1; }
        }
    }
    __device__ __forceinline__ void operator()(Acc acc, const Unit& u, int wr, int wc, int fr, int fq) const {
        const int pn = u.pn; const int c0 = wc * 32 + 8 * fq;
        const LAS float* rs_s = stage_rs(ssq, nullptr, u.pm, lb);
        if (pn >= 16) {
            const int g = pn - 16, br = g >> 2; bf16* dst = br < 2 ? Gab + br * 1024 + (g & 3) * 256 : Gc + (g & 3) * 256; const int ldc = br < 2 ? 2048 : 1024;
#pragma unroll
            for (int ai = 0; ai < 2; ++ai)
#pragma unroll
                for (int m = 0; m < 4; ++m) {
                    const int row = u.pm * 256 + ai * 128 + wr * 64 + m * 16 + fr; const float rs = rs_s[ai * 128 + wr * 64 + m * 16 + fr];
#pragma unroll
                    for (int bj = 0; bj < 2; ++bj) { f32x4 v0 = acc[ai][bj][m][0] * rs, v1 = acc[ai][bj][m][1] * rs;
#pragma unroll
                        for (int i = 0; i < 4; ++i) { v0[i] = sigmoidf_(v0[i]); v1[i] = sigmoidf_(v1[i]); }
                        *(u32x4*)(dst + (size_t)row * ldc + bj * 128 + c0) = pack8(v0, v1); }
                }
        } else if (pn == 15) {
#pragma unroll
            for (int bj = 0; bj < 2; ++bj) { const int col = bj * 128 + c0; const f32x4 b0 = *(const f32x4*)(gbias + col), b1 = *(const f32x4*)(gbias + col + 4);
#pragma unroll
                for (int ai = 0; ai < 2; ++ai)
#pragma unroll
                    for (int m = 0; m < 4; ++m) {
                        const int row = u.pm * 256 + ai * 128 + wr * 64 + m * 16 + fr; const float rs = rs_s[ai * 128 + wr * 64 + m * 16 + fr];
                        f32x4 v0 = acc[ai][bj][m][0] * rs + b0, v1 = acc[ai][bj][m][1] * rs + b1;
#pragma unroll
                        for (int i = 0; i < 4; ++i) { v0[i] = logsigmoidf_(v0[i]) * (1.0f / 16.0f); v1[i] = logsigmoidf_(v1[i]) * (1.0f / 16.0f); }
                        float* gl = (float*)(R + RO_GL) + (size_t)row * 256 + col; *(f32x4*)gl = v0; *(f32x4*)(gl + 4) = v1;
                    } }
        } else if (pn == 5 || pn == 6) {
            bf16* dst = (bf16*)(R + RO_BK); const int cb = (pn - 5) * 256 + c0;
            store_half<0, true>(acc, 0, dst, 512, cb, u, wr, fr, rs_s); store_half<0, true>(acc, 1, dst, 512, cb + 128, u, wr, fr, rs_s);
        } else if (pn == 13 || pn == 14) {
            bf16* dst = (bf16*)(R + RO_CR); const int cb = (pn - 13) * 256 + c0;
            store_half<1, false>(acc, 0, dst, 512, cb, u, wr, fr, rs_s); store_half<1, false>(acc, 1, dst, 512, cb + 128, u, wr, fr, rs_s);
        } else if (pn == 2) {
            store_half<0, false>(acc, 0, (bf16*)(R + RO_AK), 128, c0, u, wr, fr, rs_s); store_half<0, false>(acc, 1, (bf16*)(R + RO_AV), 128, c0, u, wr, fr, rs_s);
        } else {
            bf16* dst; int ldc, cb; float sc = 1.0f;
            if (pn < 2)        { dst = (bf16*)(R + RO_AQ); ldc = 512; cb = pn * 256; sc = ATT_C2; }
            else if (pn < 5)   { dst = (bf16*)(R + RO_BQ); ldc = 512; cb = (pn - 3) * 256; sc = ATT_C2; }
            else if (pn < 9)   { dst = (bf16*)(R + RO_BV); ldc = 512; cb = (pn - 7) * 256; }
            else if (pn == 9)  { dst = (bf16*)(R + RO_CQ); ldc = 256; cb = 0; }
            else if (pn == 10) { dst = (bf16*)(R + RO_CK); ldc = 256; cb = 0; }
            else               { dst = (bf16*)(R + RO_CV); ldc = 512; cb = (pn - 11) * 256; }
            store_half<0, false>(acc, 0, dst, ldc, cb + c0, u, wr, fr, rs_s, sc); store_half<0, false>(acc, 1, dst, ldc, cb + c0 + 128, u, wr, fr, rs_s, sc);
        }
    }
};
struct EpiBranch {
    static constexpr bool PERM = true;
    const bf16* Gab; const bf16* Gc; bf16* Y;
    __device__ __forceinline__ void operator()(Acc acc, const Unit& u, int wr, int wc, int fr, int fq) const {
        const int seg = u.aux;
#pragma unroll
        for (int ai = 0; ai < 2; ++ai)
#pragma unroll
            for (int m = 0; m < 4; ++m) {
                const int row = u.pm * 256 + ai * 128 + wr * 64 + m * 16 + fr;
#pragma unroll
                for (int bj = 0; bj < 2; ++bj) { const int col = u.pn * 256 + bj * 128 + wc * 32 + 8 * fq;
                    const u32x4 gw = *(const u32x4*)(seg < 2 ? Gab + (size_t)row * 2048 + seg * DM + col : Gc + (size_t)row * DM + col); f32x4 g0, g1; unpack8(gw, g0, g1);
                    f32x4 y0 = acc[ai][bj][m][0] * g0, y1 = acc[ai][bj][m][1] * g1;
                    bf16* yp = Y + (size_t)row * DM + col;
                    if (seg > 0) { const u32x4 ow = *(const u32x4*)yp; f32x4 o0, o1; unpack8(ow, o0, o1); y0 += o0; y1 += o1; }
                    *(u32x4*)yp = pack8(y0, y1); }
            }
    }
};
struct EpiResid {
    static constexpr bool PERM = true;
    bf16* XB; float* ssq;
    __device__ __forceinline__ void operator()(Acc acc, const Unit& u, int wr, int wc, int fr, int fq) const {
#pragma unroll
        for (int ai = 0; ai < 2; ++ai)
#pragma unroll
            for (int m = 0; m < 4; ++m) {
                const int row = u.pm * 256 + ai * 128 + wr * 64 + m * 16 + fr; float s = 0.f;
#pragma unroll
                for (int bj = 0; bj < 2; ++bj) { bf16* xp = XB + (size_t)row * DM + u.pn * 256 + bj * 128 + wc * 32 + 8 * fq;
                    f32x4 x0, x1; unpack8(*(const u32x4*)xp, x0, x1); x0 += acc[ai][bj][m][0]; x1 += acc[ai][bj][m][1];
                    *(u32x4*)xp = pack8(x0, x1);
                    s += ((x0[0] * x0[0] + x0[1] * x0[1]) + (x0[2] * x0[2] + x0[3] * x0[3])) + ((x1[0] * x1[0] + x1[1] * x1[1]) + (x1[2] * x1[2] + x1[3] * x1[3])); }
                s += __shfl_xor(s, 16); s += __shfl_xor(s, 32);
                if (fq == 0) ssq[(size_t)row * 16 + u.pn * 4 + wc] = s;
            }
    }
};
struct EpiSwiglu {
    static constexpr bool PERM = true;
    bf16* H; int ldh; const float* ssq; const float* rsg; LAS unsigned char* lb;
    __device__ __forceinline__ void operator()(Acc acc, const Unit& u, int wr, int wc, int fr, int fq) const {
        const LAS float* rs_s = stage_rs(ssq, rsg, u.pm, lb);
#pragma unroll
        for (int ai = 0; ai < 2; ++ai)
#pragma unroll
            for (int m = 0; m < 4; ++m) {
                const int row = u.pm * 256 + ai * 128 + wr * 64 + m * 16 + fr; const float rs = rs_s[ai * 128 + wr * 64 + m * 16 + fr];
                f32x4 g0 = acc[ai][0][m][0] * rs, g1 = acc[ai][0][m][1] * rs; const f32x4 u0 = acc[ai][1][m][0] * rs, u1 = acc[ai][1][m][1] * rs;
#pragma unroll
                for (int i = 0; i < 4; ++i) { g0[i] = siluf_(g0[i]) * u0[i]; g1[i] = siluf_(g1[i]) * u1[i]; }
                *(u32x4*)(H + (size_t)row * ldh + u.aux * 128 + wc * 32 + 8 * fq) = pack8(g0, g1);
            }
    }
};
struct EpiMoeDown {
    static constexpr bool PERM = true;
    bf16* YE; const float* pw;
    __device__ __forceinline__ void operator()(Acc acc, const Unit& u, int wr, int wc, int fr, int fq) const {
#pragma unroll
        for (int ai = 0; ai < 2; ++ai)
#pragma unroll
            for (int m = 0; m < 4; ++m) {
                const int row = u.pm * 256 + ai * 128 + wr * 64 + m * 16 + fr; const float p = pw[row];
#pragma unroll
                for (int bj = 0; bj < 2; ++bj) *(u32x4*)(YE + (size_t)row * DM + u.pn * 256 + bj * 128 + wc * 32 + 8 * fq) = pack8(acc[ai][bj][m][0] * p, acc[ai][bj][m][1] * p);
            }
    }
};
}
__device__ __forceinline__ float rdl(float v, int l) { return __builtin_bit_cast(float, __builtin_amdgcn_readlane(__builtin_bit_cast(int, v), l)); }
__device__ __forceinline__ float qdot64(float q, const bf16* p) {
    const GAS v4u* kp = (const GAS v4u*)p; float s = 0.f;
#pragma unroll
    for (int c = 0; c < 8; ++c) { const v4u w = kp[c];
        s += rdl(q, 8 * c + 0) * bflo(w.x) + rdl(q, 8 * c + 1) * bfhi(w.x) + rdl(q, 8 * c + 2) * bflo(w.y) + rdl(q, 8 * c + 3) * bfhi(w.y)
           + rdl(q, 8 * c + 4) * bflo(w.z) + rdl(q, 8 * c + 5) * bfhi(w.z) + rdl(q, 8 * c + 6) * bflo(w.w) + rdl(q, 8 * c + 7) * bfhi(w.w); }
    return s;
}
__device__ __forceinline__ float pv64(float o, float p, const bf16* V, size_t row0, int ldv, int vcol, int lane) {
#pragma unroll 16
    for (int j = 0; j < 64; ++j) o += rdl(p, j) * bf2f(V[(row0 + j) * ldv + vcol + lane]);
    return o;
}

__device__ __forceinline__ void swa_naive(const Frame& F_in, const Params& P_in, int l, int gw, int NGW) {
    PH_BEGIN
    bf16* AQ = (bf16*)(P.ws + WS_R + RO_AQ); const bf16* AK = (const bf16*)(P.ws + WS_R + RO_AK); const bf16* AV = (const bf16*)(P.ws + WS_R + RO_AV);
    const float* sinks = P.in[I_SINK] + l * 8; const int lane = F.lane;
    for (int item = gw; item < T * 8; item += NGW) {
        const int t = item >> 3, hq = item & 7, hkv = hq >> 2, tl = t & (SEQ - 1); const size_t rb = (size_t)(t - tl);
        const float q = bf2f(AQ[(size_t)t * 512 + hq * 64 + lane]) * 0.125f;
        const int kA = tl - 127 + lane, kB = tl - 63 + lane; const bool vA = kA >= 0, vB = kB >= 0;
        const int kA0 = tl - 127 < 0 ? 0 : tl - 127, kB0 = tl - 63 < 0 ? 0 : tl - 63;
        float sA = qdot64(q, AK + (rb + (vA ? kA : 0)) * 128 + hkv * 64), sB = qdot64(q, AK + (rb + (vB ? kB : 0)) * 128 + hkv * 64);
        sA = vA ? sA : -INFINITY; sB = vB ? sB : -INFINITY;
        const float sink = sinks[hq];
        const float m = fmaxf(wave_max(fmaxf(sA, sB)), sink);
        const float pA = vA ? __expf(sA - m) : 0.f, pB = vB ? __expf(sB - m) : 0.f;
        const float den = wave_sum(pA + pB) + __expf(sink - m);
        float o = 0.f;
        if (tl >= 127) { o = pv64(o, pA, AV, rb + tl - 127, 128, hkv * 64, lane); o = pv64(o, pB, AV, rb + tl - 63, 128, hkv * 64, lane); }
        else {
#pragma unroll 8
            for (int j = 0; j < 64; ++j) { const int ka = tl - 127 + j, kb = tl - 63 + j;
                o += rdl(pA, j) * bf2f(AV[(rb + (ka < 0 ? 0 : ka)) * 128 + hkv * 64 + lane]) + rdl(pB, j) * bf2f(AV[(rb + (kb < 0 ? 0 : kb)) * 128 + hkv * 64 + lane]); }
        }
        (void)kA0; (void)kB0;
        AQ[(size_t)t * 512 + hq * 64 + lane] = (bf16)f2bf(o / den);
    }
}

__device__ __forceinline__ void moba_naive(const Frame& F_in, const Params& P_in, int gw, int NGW) {
    PH_BEGIN
    bf16* BQ = (bf16*)(P.ws + WS_R + RO_BQ); const bf16* BK = (const bf16*)(P.ws + WS_R + RO_BK); const bf16* BV = (const bf16*)(P.ws + WS_R + RO_BV);
    const float* kbp = (const float*)(P.ws + WS_KBP); const int lane = F.lane;
    for (int item = gw; item < T * 8; item += NGW) {
        const int t = item >> 3, h = item & 7, b = t >> 13, tl = t & (SEQ - 1), cur = tl >> 8; const size_t rb = (size_t)b * SEQ;
        const float q = bf2f(BQ[(size_t)t * 512 + h * 64 + lane]);
        float gs = -INFINITY;
        { const int n = lane < cur ? lane : 0; const float* k0 = kbp + ((size_t)(b * 32 + n) * 2) * 512 + h * 64; float s = 0.f;
#pragma unroll 8
          for (int d = 0; d < 64; ++d) s += rdl(q, d) * (k0[d] + k0[512 + d]);
          if (lane < cur) gs = s * (1.0f / 256.0f); }
        const int nsel = cur < 3 ? cur : 3; int s0 = 0, s1 = 0, s2 = 0;
        for (int r = 0; r < nsel; ++r) { const float mx = wave_max(gs); const unsigned long long bal = __ballot(gs == mx); const int j = __ffsll((long long)bal) - 1;
            if (r == 0) s0 = j; else if (r == 1) s1 = j; else s2 = j; if (lane == j) gs = -INFINITY; }
        float m = -INFINITY, lsum = 0.f, o = 0.f; const float qs = q * 0.125f;
        for (int i = 0; i <= nsel; ++i) {
            const bool own = (i == nsel); const int blk = own ? cur : (i == 0 ? s0 : (i == 1 ? s1 : s2));
            for (int tile = 0; tile < 4; ++tile) {
                const int kp0 = blk * 256 + tile * 64; if (own && kp0 > tl) break;
                const int kpos = kp0 + lane; const bool valid = !own || kpos <= tl;
                float s = qdot64(qs, BK + (rb + kpos) * 512 + h * 64); s = valid ? s : -INFINITY;
                const float mn = fmaxf(m, wave_max(s)); const float sc = __expf(m - mn); const float p = valid ? __expf(s - mn) : 0.f;
                lsum = lsum * sc + wave_sum(p); o = pv64(o * sc, p, BV, rb + kp0, 512, h * 64, lane); m = mn;
            }
        }
        BQ[(size_t)t * 512 + h * 64 + lane] = (bf16)f2bf(o / lsum);
    }
}

__device__ __forceinline__ void gla_cumsum(const float* GL, size_t t0, int h, LAS float* bcum, int tid) {
    if (tid < 64) { float run = 0.f;
#pragma unroll 8
        for (int s = 0; s < 64; ++s) { run += GL[(t0 + s) * 256 + h * 64 + tid]; bcum[s * 64 + tid] = run; } }
}
__device__ __forceinline__ void gla_pass1(const Frame& F_in, const Params& P_in) {
    PH_BEGIN
    const float* GL = (const float*)(P.ws + WS_R + RO_GL); const bf16* CK = (const bf16*)(P.ws + WS_R + RO_CK); const bf16* CV = (const bf16*)(P.ws + WS_R + RO_CV);
    float* S = (float*)(P.ws + WS_S); float* DEC = (float*)(P.ws + WS_DEC);
    LAS float* bcum = (LAS float*)(F.lds); LAS float* kd = bcum + 4096; LAS float* vv = kd + 4096; const int tid = F.tid;
    for (int unit = F.vcu; unit < 8 * 128; unit += F.G) {
        const int bh = unit >> 7, n = unit & 127, b = bh >> 2, h = bh & 3; const size_t t0 = (size_t)b * SEQ + n * 64;
        gla_cumsum(GL, t0, h, bcum, tid);
        __syncthreads();
        for (int idx = tid; idx < 4096; idx += 512) { const int s = idx >> 6, d = idx & 63; kd[idx] = bf2f(CK[(t0 + s) * 256 + h * 64 + d]) * __expf(bcum[63 * 64 + d] - bcum[idx]); }
        for (int idx = tid; idx < 8192; idx += 512) { const int s = idx >> 7, e = idx & 127; vv[idx] = bf2f(CV[(t0 + s) * 512 + h * 128 + e]); }
        __syncthreads();
        { const int d = tid >> 3, e0 = (tid & 7) * 16; float a[16];
#pragma unroll
          for (int j = 0; j < 16; ++j) a[j] = 0.f;
          for (int s = 0; s < 64; ++s) { const float kv = kd[s * 64 + d];
#pragma unroll
              for (int j = 0; j < 16; ++j) a[j] += kv * vv[s * 128 + e0 + j]; }
          float* so = S + (((size_t)bh * 128 + n) * 64 + d) * 128 + e0;
#pragma unroll
          for (int j = 0; j < 16; j += 4) *(f32x4*)(so + j) = (f32x4){a[j], a[j + 1], a[j + 2], a[j + 3]};
          if (tid < 64) DEC[((size_t)bh * 128 + n) * 64 + tid] = __expf(bcum[63 * 64 + tid]); }
        __syncthreads();
    }
}
__device__ __forceinline__ void gla_scan(const Frame& F_in, const Params& P_in) {
    PH_BEGIN
    float* S = (float*)(P.ws + WS_S); const float* DEC = (const float*)(P.ws + WS_DEC);
    if (F.tid >= 256) return;
    for (int grp = F.vcu; grp < 256; grp += F.G) {
        const int idx = grp * 256 + F.tid, bh = idx >> 13, d = (idx >> 7) & 63, e = idx & 127;
        float* sp = S + ((size_t)bh * 128 * 64 + d) * 128 + e; const float* dp = DEC + (size_t)bh * 128 * 64 + d; float st = 0.f;
        for (int n0 = 0; n0 < 128; n0 += 32) { float u[32], dc[32];
#pragma unroll
            for (int j = 0; j < 32; ++j) { u[j] = sp[(size_t)(n0 + j) * 8192]; dc[j] = dp[(n0 + j) * 64]; }
#pragma unroll
            for (int j = 0; j < 32; ++j) { sp[(size_t)(n0 + j) * 8192] = st; st = dc[j] * st + u[j]; } }
    }
}
__device__ __forceinline__ void gla_pass3(const Frame& F_in, const Params& P_in, int l) {
    PH_BEGIN
    const float* GL = (const float*)(P.ws + WS_R + RO_GL); const bf16* CQ = (const bf16*)(P.ws + WS_R + RO_CQ); const bf16* CK = (const bf16*)(P.ws + WS_R + RO_CK); const bf16* CV = (const bf16*)(P.ws + WS_R + RO_CV);
    bf16* CR = (bf16*)(P.ws + WS_R + RO_CR); const float* S = (const float*)(P.ws + WS_S); const float* gng = P.in[I_GNG] + l * 512;
    LAS float* bcum = (LAS float*)(F.lds); LAS float* qin = bcum + 4096; LAS float* kin = qin + 4096; LAS float* am = kin + 4096; LAS float* vv = am + 4096; LAS float* sp = vv + 8192; const int tid = F.tid;
    for (int unit = F.vcu; unit < 8 * 128; unit += F.G) {
        const int bh = unit >> 7, n = unit & 127, b = bh >> 2, h = bh & 3; const size_t t0 = (size_t)b * SEQ + n * 64;
        gla_cumsum(GL, t0, h, bcum, tid);
        __syncthreads();
        for (int idx = tid; idx < 4096; idx += 512) { const int s = idx >> 6, d = idx & 63; const float bb = bcum[idx];
            qin[idx] = bf2f(CQ[(t0 + s) * 256 + h * 64 + d]) * 0.125f * __expf(bb); kin[idx] = bf2f(CK[(t0 + s) * 256 + h * 64 + d]) * __expf(-bb); }
        for (int idx = tid; idx < 8192; idx += 512) { const int s = idx >> 7, e = idx & 127; vv[idx] = bf2f(CV[(t0 + s) * 512 + h * 128 + e]); sp[idx] = S[(((size_t)bh * 128 + n) * 64) * 128 + idx]; }
        __syncthreads();
        for (int idx = tid; idx < 4096; idx += 512) { const int tt = idx >> 6, s = idx & 63; float a = 0.f;
            if (s <= tt) {
#pragma unroll 8
                for (int d = 0; d < 64; ++d) a += qin[tt * 64 + d] * kin[s * 64 + d]; }
            am[idx] = a; }
        __syncthreads();
        { const int tt = tid >> 3, e0 = (tid & 7) * 16; float o[16];
#pragma unroll
          for (int j = 0; j < 16; ++j) o[j] = 0.f;
          for (int s = 0; s <= tt; ++s) { const float a = am[tt * 64 + s];
#pragma unroll
              for (int j = 0; j < 16; ++j) o[j] += a * vv[s * 128 + e0 + j]; }
          for (int d = 0; d < 64; ++d) { const float qv = qin[tt * 64 + d];
#pragma unroll
              for (int j = 0; j < 16; ++j) o[j] += qv * sp[d * 128 + e0 + j]; }
          float ms = 0.f;
#pragma unroll
          for (int j = 0; j < 16; ++j) ms += o[j] * o[j];
          ms += __shfl_xor(ms, 1); ms += __shfl_xor(ms, 2); ms += __shfl_xor(ms, 4);
          const float rinv = 1.0f / sqrtf(ms * (1.0f / 128.0f) + RMS_EPS);
          bf16* crp = CR + (t0 + tt) * 512 + h * 128 + e0;
#pragma unroll
          for (int j = 0; j < 16; ++j) crp[j] = (bf16)f2bf(o[j] * rinv * gng[h * 128 + e0 + j] * bf2f(crp[j])); }
        __syncthreads();
    }
}
namespace gla {
typedef short bf16x8 __attribute__((ext_vector_type(8)));
typedef float f32x16 __attribute__((ext_vector_type(16)));
constexpr int PITCH = 72;
constexpr int OFF_TOT = 0;
constexpr int OFF_Q = 2048;
constexpr int OFF_K = OFF_Q + 64 * PITCH * 2;
constexpr int OFF_V = OFF_K + 64 * PITCH * 2;
constexpr int OFF_ST = OFF_V + 128 * PITCH * 2;
constexpr int OFF_A = OFF_ST + 128 * PITCH * 2;
constexpr int OFF_O = OFF_A + 8 * 32 * PITCH * 2;
constexpr int OPITCH = 132;
static_assert(OFF_O + 64 * OPITCH * 4 <= RING_BYTES, "gla lds");
__device__ __forceinline__ int crow(int r, int hf) { return (r & 3) + 8 * (r >> 2) + 4 * hf; }
__device__ __forceinline__ bf16x8 ldfrag(const LAS unsigned char* base, int row, int k) { return *(const LAS bf16x8*)(base + (row * PITCH + k) * 2); }

__device__ __forceinline__ void chunk_cumsum(const float* GL, size_t t0, int h, LAS unsigned char* lds, int tid, float (&b)[8], float& blast) {
    const int d = tid & 63, seg = tid >> 6; LAS float* tot = (LAS float*)(lds + OFF_TOT);
    float run = 0.f;
#pragma unroll
    for (int i = 0; i < 8; ++i) { run += GL[(t0 + seg * 8 + i) * 256 + h * 64 + d]; b[i] = run; }
    tot[seg * 64 + d] = run;
    __syncthreads();
    float off = 0.f, all = 0.f;
#pragma unroll
    for (int s = 0; s < 8; ++s) { const float v = tot[s * 64 + d]; all += v; if (s < seg) off += v; }
#pragma unroll
    for (int i = 0; i < 8; ++i) b[i] += off;
    blast = all;
}
__device__ __forceinline__ void stage_vT(const bf16* CV, size_t t0, int h, LAS unsigned char* lds, int tid) {
#pragma unroll
    for (int it = 0; it < 2; ++it) { const int item = tid + 512 * it, e = item & 127, sg = item >> 7;
        unsigned short v[8];
#pragma unroll
        for (int i = 0; i < 8; ++i) v[i] = CV[(t0 + sg * 8 + i) * 512 + h * 128 + e];
        v4u w; w.x = v[0] | ((unsigned)v[1] << 16); w.y = v[2] | ((unsigned)v[3] << 16); w.z = v[4] | ((unsigned)v[5] << 16); w.w = v[6] | ((unsigned)v[7] << 16);
        *(LAS v4u*)(lds + OFF_V + (e * PITCH + sg * 8) * 2) = w; }
}

__device__ __forceinline__ void pass1(const Frame& F_in, const Params& P_in) {
    PH_BEGIN
    const float* GL = (const float*)(P.ws + WS_R + RO_GL); const bf16* CK = (const bf16*)(P.ws + WS_R + RO_CK); const bf16* CV = (const bf16*)(P.ws + WS_R + RO_CV);
    float* S = (float*)(P.ws + WS_S); float* DEC = (float*)(P.ws + WS_DEC);
    LAS unsigned char* lds = F.lds; const int tid = F.tid, lane = F.lane, r = lane & 31, hf = lane >> 5, w = F.wave, mt = w >> 2, nt = w & 3;
    for (int unit = F.vcu; unit < 8 * 128; unit += F.G) {
        const int bh = unit >> 7, n = unit & 127, b_ = bh >> 2, h = bh & 3; const size_t t0 = (size_t)b_ * SEQ + n * 64;
        float b[8], blast; chunk_cumsum(GL, t0, h, lds, tid, b, blast);
        { const int d = tid & 63, seg = tid >> 6; unsigned pk[4];
#pragma unroll
          for (int i = 0; i < 8; i += 2) { const float k0 = bf2f(CK[(t0 + seg * 8 + i) * 256 + h * 64 + d]) * __expf(blast - b[i]), k1 = bf2f(CK[(t0 + seg * 8 + i + 1) * 256 + h * 64 + d]) * __expf(blast - b[i + 1]); pk[i >> 1] = pk2(k0, k1); }
          *(LAS v4u*)(lds + OFF_Q + (d * PITCH + seg * 8) * 2) = (v4u){pk[0], pk[1], pk[2], pk[3]};
          if (seg == 0) DEC[((size_t)bh * 128 + n) * 64 + d] = __expf(blast); }
        stage_vT(CV, t0, h, lds, tid);
        __syncthreads();
        f32x16 acc = f32x16{};
#pragma unroll
        for (int ks = 0; ks < 4; ++ks) acc = __builtin_amdgcn_mfma_f32_32x32x16_bf16(ldfrag(lds + OFF_Q, mt * 32 + r, ks * 16 + 8 * hf), ldfrag(lds + OFF_V, nt * 32 + r, ks * 16 + 8 * hf), acc, 0, 0, 0);
        float* so = S + (((size_t)bh * 128 + n) * 64 + mt * 32) * 128 + nt * 32 + r;
#pragma unroll
        for (int g = 0; g < 16; ++g) so[(size_t)crow(g, hf) * 128] = acc[g];
        __syncthreads();
    }
}
__device__ __forceinline__ void pass3(const Frame& F_in, const Params& P_in, int l) {
    PH_BEGIN
    const float* GL = (const float*)(P.ws + WS_R + RO_GL); const bf16* CQ = (const bf16*)(P.ws + WS_R + RO_CQ); const bf16* CK = (const bf16*)(P.ws + WS_R + RO_CK); const bf16* CV = (const bf16*)(P.ws + WS_R + RO_CV);
    bf16* CR = (bf16*)(P.ws + WS_R + RO_CR); const float* S = (const float*)(P.ws + WS_S); const float* gng = P.in[I_GNG] + l * 512;
    LAS unsigned char* lds = F.lds; const int tid = F.tid, lane = F.lane, r = lane & 31, hf = lane >> 5, w = F.wave, mt = w >> 2, nt = w & 3;
    for (int unit = F.vcu; unit < 8 * 128; unit += F.G) {
        const int bh = unit >> 7, n = unit & 127, b_ = bh >> 2, h = bh & 3; const size_t t0 = (size_t)b_ * SEQ + n * 64;
        float b[8], blast; chunk_cumsum(GL, t0, h, lds, tid, b, blast);
        { const int d = tid & 63, seg = tid >> 6;
#pragma unroll
          for (int i = 0; i < 8; ++i) { const size_t gi = (t0 + seg * 8 + i) * 256 + h * 64 + d; const int s = seg * 8 + i;
              *(LAS unsigned short*)(lds + OFF_Q + (s * PITCH + d) * 2) = (unsigned short)f2bf(bf2f(CQ[gi]) * 0.125f * __expf(b[i]));
              *(LAS unsigned short*)(lds + OFF_K + (s * PITCH + d) * 2) = (unsigned short)f2bf(bf2f(CK[gi]) * __expf(-b[i])); } }
        stage_vT(CV, t0, h, lds, tid);
        { const float* sp = S + (((size_t)bh * 128 + n) * 64) * 128;
#pragma unroll
          for (int it = 0; it < 2; ++it) { const int item = tid + 512 * it, e = item & 127, dg = item >> 7; float v[8];
#pragma unroll
              for (int i = 0; i < 8; ++i) v[i] = sp[(size_t)(dg * 8 + i) * 128 + e];
              *(LAS v4u*)(lds + OFF_ST + (e * PITCH + dg * 8) * 2) = (v4u){pk2(v[0], v[1]), pk2(v[2], v[3]), pk2(v[4], v[5]), pk2(v[6], v[7])}; } }
        __syncthreads();
        { LAS unsigned char* as = lds + OFF_A + w * 32 * PITCH * 2;
#pragma unroll
          for (int j = 0; j < 2; ++j) { f32x16 a = f32x16{};
#pragma unroll
              for (int kd = 0; kd < 4; ++kd) a = __builtin_amdgcn_mfma_f32_32x32x16_bf16(ldfrag(lds + OFF_Q, mt * 32 + r, kd * 16 + 8 * hf), ldfrag(lds + OFF_K, j * 32 + r, kd * 16 + 8 * hf), a, 0, 0, 0);
              const int s = j * 32 + r;
#pragma unroll
              for (int g = 0; g < 16; ++g) { const int tl = crow(g, hf); const float av = (s <= mt * 32 + tl) ? a[g] : 0.f; *(LAS unsigned short*)(as + (tl * PITCH + s) * 2) = (unsigned short)f2bf(av); } }
          LDS_WAIT(); asm volatile("" ::: "memory");
          f32x16 o = f32x16{};
#pragma unroll
          for (int ks = 0; ks < 4; ++ks) o = __builtin_amdgcn_mfma_f32_32x32x16_bf16(ldfrag(as, r, ks * 16 + 8 * hf), ldfrag(lds + OFF_V, nt * 32 + r, ks * 16 + 8 * hf), o, 0, 0, 0);
#pragma unroll
          for (int kd = 0; kd < 4; ++kd) o = __builtin_amdgcn_mfma_f32_32x32x16_bf16(ldfrag(lds + OFF_Q, mt * 32 + r, kd * 16 + 8 * hf), ldfrag(lds + OFF_ST, nt * 32 + r, kd * 16 + 8 * hf), o, 0, 0, 0);
          LAS float* os = (LAS float*)(lds + OFF_O);
#pragma unroll
          for (int g = 0; g < 16; ++g) os[(mt * 32 + crow(g, hf)) * OPITCH + nt * 32 + r] = o[g]; }
        __syncthreads();
        { const int tt = tid >> 3, e0 = (tid & 7) * 16; const LAS float* os = (const LAS float*)(lds + OFF_O) + tt * OPITCH + e0; float o[16]; float ms = 0.f;
#pragma unroll
          for (int j = 0; j < 16; ++j) { o[j] = os[j]; ms += o[j] * o[j]; }
          ms += __shfl_xor(ms, 1); ms += __shfl_xor(ms, 2); ms += __shfl_xor(ms, 4);
          const float rinv = 1.0f / sqrtf(ms * (1.0f / 128.0f) + RMS_EPS);
          bf16* crp = CR + (t0 + tt) * 512 + h * 128 + e0; const v4u c0 = *(const GAS v4u*)crp, c1 = *(const GAS v4u*)(crp + 8); const float* gp = gng + h * 128 + e0;
          v4u w0, w1;
          w0.x = pk2(o[0] * rinv * gp[0] * bflo(c0.x), o[1] * rinv * gp[1] * bfhi(c0.x)); w0.y = pk2(o[2] * rinv * gp[2] * bflo(c0.y), o[3] * rinv * gp[3] * bfhi(c0.y));
          w0.z = pk2(o[4] * rinv * gp[4] * bflo(c0.z), o[5] * rinv * gp[5] * bfhi(c0.z)); w0.w = pk2(o[6] * rinv * gp[6] * bflo(c0.w), o[7] * rinv * gp[7] * bfhi(c0.w));
          w1.x = pk2(o[8] * rinv * gp[8] * bflo(c1.x), o[9] * rinv * gp[9] * bfhi(c1.x)); w1.y = pk2(o[10] * rinv * gp[10] * bflo(c1.y), o[11] * rinv * gp[11] * bfhi(c1.y));
          w1.z = pk2(o[12] * rinv * gp[12] * bflo(c1.z), o[13] * rinv * gp[13] * bfhi(c1.z)); w1.w = pk2(o[14] * rinv * gp[14] * bflo(c1.w), o[15] * rinv * gp[15] * bfhi(c1.w));
          *(GAS v4u*)crp = w0; *(GAS v4u*)(crp + 8) = w1; }
        __syncthreads();
    }
}
}
constexpr int TAB_OFF = LDSCTL_OFF + 1024;
__device__ __forceinline__ void route_r1(const Frame& F_in, const Params& P_in) {
    PH_BEGIN
    const float* Wr = P.in[I_RT]; const float* n2g = P.in[I_N2G] + 1 * DM;
    int* TOKE = (int*)(P.ws + WS_TOKE); float* TOKP = (float*)(P.ws + WS_TOKP); float* RS2 = (float*)(P.ws + WS_RS2); int* CNT = (int*)(P.ws + WS_CNT);
    LAS float* wrs = (LAS float*)(F.lds); LAS int* cnt_s = (LAS int*)(F.lds + 32768); const int tid = F.tid, lane = F.lane;
    for (int idx = tid; idx < 8192; idx += 512) wrs[idx] = Wr[idx] * n2g[idx >> 3];
    for (int tile = F.vcu; tile < T / 64; tile += F.G) {
        if (tid < 8) cnt_s[tid] = 0;
        __syncthreads();
        for (int i = 0; i < 8; ++i) {
            const int t = tile * 64 + F.wave * 8 + i;
            const GAS v2u* xr = (const GAS v2u*)((const bf16*)(P.ws + WS_XB) + (size_t)t * DM) + lane;
            float s = 0.f, lg0 = 0.f, lg1 = 0.f, lg2 = 0.f, lg3 = 0.f, lg4 = 0.f, lg5 = 0.f, lg6 = 0.f, lg7 = 0.f;
#pragma unroll
            for (int j = 0; j < 4; ++j) { const v2u w_ = xr[64 * j]; const f32x4 v = (f32x4){bflo(w_.x), bfhi(w_.x), bflo(w_.y), bfhi(w_.y)}; s += (v.x * v.x + v.y * v.y) + (v.z * v.z + v.w * v.w);
#pragma unroll
                for (int c = 0; c < 4; ++c) { const LAS float* w = wrs + (256 * j + 4 * lane + c) * 8; const float xv = v[c];
                    lg0 += xv * w[0]; lg1 += xv * w[1]; lg2 += xv * w[2]; lg3 += xv * w[3]; lg4 += xv * w[4]; lg5 += xv * w[5]; lg6 += xv * w[6]; lg7 += xv * w[7]; } }
            s = wave_sum(s); lg0 = wave_sum(lg0); lg1 = wave_sum(lg1); lg2 = wave_sum(lg2); lg3 = wave_sum(lg3); lg4 = wave_sum(lg4); lg5 = wave_sum(lg5); lg6 = wave_sum(lg6); lg7 = wave_sum(lg7);
            const float r = 1.0f / sqrtf(s * (1.0f / DM) + RMS_EPS);
            int i1 = 0; float v1 = lg0;
            if (lg1 > v1) { v1 = lg1; i1 = 1; } if (lg2 > v1) { v1 = lg2; i1 = 2; } if (lg3 > v1) { v1 = lg3; i1 = 3; } if (lg4 > v1) { v1 = lg4; i1 = 4; }
            if (lg5 > v1) { v1 = lg5; i1 = 5; } if (lg6 > v1) { v1 = lg6; i1 = 6; } if (lg7 > v1) { v1 = lg7; i1 = 7; }
            int i2 = -1; float v2 = -INFINITY;
            if (i1 != 0 && lg0 > v2) { v2 = lg0; i2 = 0; } if (i1 != 1 && lg1 > v2) { v2 = lg1; i2 = 1; } if (i1 != 2 && lg2 > v2) { v2 = lg2; i2 = 2; } if (i1 != 3 && lg3 > v2) { v2 = lg3; i2 = 3; }
            if (i1 != 4 && lg4 > v2) { v2 = lg4; i2 = 4; } if (i1 != 5 && lg5 > v2) { v2 = lg5; i2 = 5; } if (i1 != 6 && lg6 > v2) { v2 = lg6; i2 = 6; } if (i1 != 7 && lg7 > v2) { v2 = lg7; i2 = 7; }
            const float p1 = 1.0f / (1.0f + __expf((v2 - v1) * r)), p2 = 1.0f - p1;
            if (lane == 0) { TOKE[t * 2] = i1; TOKE[t * 2 + 1] = i2; TOKP[t * 2] = p1; TOKP[t * 2 + 1] = p2; RS2[t] = r; atomicAdd((int*)&cnt_s[i1], 1); atomicAdd((int*)&cnt_s[i2], 1); }
        }
        __syncthreads();
        if (tid < 8) CNT[tile * 8 + tid] = cnt_s[tid];
        __syncthreads();
    }
}
__device__ __forceinline__ void moe_tables(const Frame& F_in, const Params& P_in, int tile) {
    PH_BEGIN
    const int* CNT = (const int*)(P.ws + WS_CNT); volatile LAS int* TAB = (volatile LAS int*)(F.lds + TAB_OFF); LAS int* cs = (LAS int*)(F.lds + TAB_OFF + 256); const int tid = F.tid;
    for (int i = tid; i < (T / 64) * 8; i += 512) cs[i] = CNT[i];
    __syncthreads();
    if (tid < 8) { int tot = 0, before = 0;
        for (int w = 0; w < T / 64; ++w) { const int c = cs[w * 8 + tid]; if (w < tile) before += c; tot += c; }
        TAB[32 + tid] = tot; TAB[40 + tid] = before; }
    __syncthreads();
    if (tid == 0) { int mt = 0; for (int e = 0; e < 8; ++e) { TAB[e] = mt; TAB[16 + e] = mt * 256 + TAB[40 + e]; mt += (TAB[32 + e] + 255) >> 8; } TAB[8] = mt; }
    __syncthreads();
}
__device__ __forceinline__ void route_r2(const Frame& F_in, const Params& P_in) {
    PH_BEGIN
    const int* TOKE = (const int*)(P.ws + WS_TOKE); const float* TOKP = (const float*)(P.ws + WS_TOKP); const float* RS2 = (const float*)(P.ws + WS_RS2);
    int* TOKPOS = (int*)(P.ws + WS_TOKPOS); float* RSG = (float*)(P.ws + WS_RSG); float* PWG = (float*)(P.ws + WS_PWG);
    const bf16* XB = (const bf16*)(P.ws + WS_XB); bf16* XG = (bf16*)(P.ws + WS_XG);
    volatile LAS int* TAB = (volatile LAS int*)(F.lds + TAB_OFF); LAS int* pos_s = (LAS int*)(F.lds); const int tid = F.tid, lane = F.lane;
    for (int tile = F.vcu; tile < T / 64; tile += F.G) {
        moe_tables(F, P, tile);
        LAS int* te_s = pos_s + 128;
        if (tid < 128) te_s[tid] = TOKE[tile * 128 + tid];
        __syncthreads();
        if (tid < 8) { int run = TAB[16 + tid];
            for (int i = 0; i < 128; ++i) if (te_s[i] == tid) { pos_s[i] = run; ++run; } }
        __syncthreads();
        for (int pr = F.wave * 16; pr < F.wave * 16 + 16; ++pr) {
            const int pos = pos_s[pr], t = tile * 64 + (pr >> 1);
            const GAS v4u* src = (const GAS v4u*)(XB + (size_t)t * DM); GAS v4u* dst = (GAS v4u*)(XG + (size_t)pos * DM);
            dst[lane] = src[lane]; dst[64 + lane] = src[64 + lane];
            if (lane == 0) { RSG[pos] = RS2[t]; PWG[pos] = TOKP[t * 2 + (pr & 1)]; TOKPOS[t * 2 + (pr & 1)] = pos; }
        }
        __syncthreads();
    }
}
struct MoeOrder {
    const char* A; const char* W; size_t wstride; size_t tstep; int nN, G, c; volatile LAS int* TAB;
    __device__ __forceinline__ bool next(int i, pg8::Unit& u) const {
        const int L = i * G + c; const int total = TAB[8] * nN; if (L >= total) return false;
        int e = 0;
#pragma unroll
        for (int k = 1; k < 8; ++k) if (L >= TAB[k] * nN) e = k;
        const int mt0 = TAB[e], mte = TAB[e + 1] - mt0, loc = L - mt0 * nN; const int pml = loc % mte, pn = loc / mte;
        u.pm = mt0 + pml; u.pn = pn; u.aux = pn; u.A = A + (size_t)u.pm * tstep; u.B = W + (size_t)e * wstride + (size_t)pn * tstep; return true;
    }
};
struct BranchOrder {
    const char* OA; const char* OB; const char* OC; const char* W; int G, c;
    __device__ __forceinline__ bool next(int i, pg8::Unit& u) const {
        const int seg = i % 3; int pm, pn; if (!pg8::static_tile(T / 256, DM / 256, G, c, i / 3, pm, pn)) return false;
        u.pm = pm; u.pn = pn; u.aux = seg; const char* o = seg == 0 ? OA : (seg == 1 ? OB : OC);
        u.A = o + (size_t)pm * 256 * 512 * 2; u.B = W + (size_t)seg * DM * 512 * 2 + (size_t)pn * 256 * 512 * 2; return true;
    }
};
template <int l>
__device__ __forceinline__ void layer_body(const Frame& F, const Params& P, const XcdBarrier& bar) {
#ifdef TIMING
#define STAMP() do { if (blockIdx.x == 0 && threadIdx.x == 0) { unsigned* c_ = (unsigned*)(P.ws + WS_CTL) + 2048; const unsigned n_ = c_[0]; ((unsigned long long*)(c_ + 2))[n_] = __builtin_amdgcn_s_memrealtime(); c_[0] = n_ + 1; } } while (0)
#else
#define STAMP() do {} while (0)
#endif
#define GRID_BAR() do { xcd_barrier(bar); STAMP(); } while (0)
    const int gw = F.vcu * NWAVES + F.wave, NGW = F.G * NWAVES;
    LAS unsigned char* ring = F.lds + RING_OFF;
    const int cb = (int)blockIdx.x;
#define WSP(T_, off) ((T_)(ws + (off)))

        { unsigned char* ws = lws(P); pg8::DenseOrder S; S.init(ws + WS_XB, ws + WS_W + WO_IN, T, NMAIN + NGATES, DM, F.G, cb);
          epi::EpiInproj E{ws + WS_R, WSP(const float*, WS_SSQ), P.in[I_GBG] + l * 256, WSP(float*, WS_KBP), F.lds, (bf16*)P.out, WSP(bf16*, WS_GC)};
          pg8::gemm_phase<epi::EpiInproj, pg8::DenseOrder>(ring, DM, S, E); }
        GRID_BAR();
        moba_phase(F, P);
        swa_phase(F, P, l);
        STAMP();
        gla::pass1(F, P);
        GRID_BAR();
        gla_scan(F, P);
        if (l == 0 && F.wave >= 4) convert_moe_weights(F, P, F.vcu * 4 + (F.wave - 4), F.G * 4, 2);
        GRID_BAR();
        gla::pass3(F, P, l);
        GRID_BAR();
        { unsigned char* ws = lws(P); BranchOrder S{(const char*)(ws + WS_R + RO_AQ), (const char*)(ws + WS_R + RO_BQ), (const char*)(ws + WS_R + RO_CR), (const char*)(ws + WS_W + WO_BR), F.G, cb};
          epi::EpiBranch E{(const bf16*)P.out, WSP(const bf16*, WS_GC), WSP(bf16*, WS_Y)};
          pg8::gemm_phase<epi::EpiBranch, BranchOrder>(ring, 512, S, E); }
        GRID_BAR();
        { unsigned char* ws = lws(P); pg8::DenseOrder S; S.init(ws + WS_Y, ws + WS_W + WO_O, T, DM, DM, F.G, cb);
          epi::EpiResid E{WSP(bf16*, WS_XB), WSP(float*, WS_SSQ)};
          pg8::gemm_phase<epi::EpiResid, pg8::DenseOrder>(ring, DM, S, E); }
        GRID_BAR();
        if constexpr (l == 0) {
            { unsigned char* ws = lws(P); pg8::DenseOrder S; S.init(ws + WS_XB, ws + WS_W + WO_GU, T, 2 * DFF, DM, F.G, cb);
              epi::EpiSwiglu E{(bf16*)(ws + WS_H), DFF, WSP(const float*, WS_SSQ), nullptr, F.lds};
              pg8::gemm_phase<epi::EpiSwiglu, pg8::DenseOrder>(ring, DM, S, E); }
            if (cb >= 128 || F.G != 256) convert_layer_weights(F, P, 1, F.G == 256 ? (cb - 128) * NWAVES + F.wave : gw, F.G == 256 ? 128 * NWAVES : NGW, true);
            GRID_BAR();
            { unsigned char* ws = lws(P); pg8::DenseOrder S; S.init(ws + WS_H, ws + WS_W + WO_D, T, DM, DFF, F.G, cb);
              epi::EpiResid E{WSP(bf16*, WS_XB), WSP(float*, WS_SSQ)};
              pg8::gemm_phase<epi::EpiResid, pg8::DenseOrder>(ring, DFF, S, E); }
            GRID_BAR();
        } else {
            route_r1(F, P);
            GRID_BAR();
            route_r2(F, P);
            convert_moe_weights(F, P, gw, NGW, 1);
            GRID_BAR();
            moe_tables(F, P, 0);
            { unsigned char* ws = lws(P); MoeOrder S{(const char*)(ws + WS_XG), (const char*)(ws + WS_WMGU), (size_t)2 * DFE * DM * 2, (size_t)256 * DM * 2, 2 * DFE / 256, F.G, cb, (volatile LAS int*)(F.lds + TAB_OFF)};
              epi::EpiSwiglu E{(bf16*)(ws + WS_HG), DFE, nullptr, (const float*)(ws + WS_RSG), F.lds};
              pg8::gemm_phase<epi::EpiSwiglu, MoeOrder>(ring, DM, S, E); }
            GRID_BAR();
            { unsigned char* ws = lws(P); MoeOrder S{(const char*)(ws + WS_HG), (const char*)(ws + WS_WMD), (size_t)DM * DFE * 2, (size_t)256 * DFE * 2, DM / 256, F.G, cb, (volatile LAS int*)(F.lds + TAB_OFF)};
              epi::EpiMoeDown E{(bf16*)(ws + WS_XG), (const float*)(ws + WS_PWG)};
              pg8::gemm_phase<epi::EpiMoeDown, MoeOrder>(ring, DFE, S, E); }
            GRID_BAR();
            final_phase(F, P, gw, NGW, true);
        }
}
__global__ void __launch_bounds__(NWAVES * 64, 2) fwd_kernel(Params P) {
    extern __shared__ __attribute__((aligned(16))) unsigned char lds[];
    Frame F;
    F.lds = (LAS unsigned char*)lds;
    F.MISC = (volatile LAS unsigned*)(F.lds + MISC_OFF);
    F.tid = threadIdx.x; F.lane = F.tid & 63; F.wave = __builtin_amdgcn_readfirstlane(F.tid >> 6);
    F.G = gridDim.x; { const int bx = blockIdx.x; F.vcu = (F.G % 8 == 0) ? (bx % 8) * (F.G / 8) + bx / 8 : bx; }
    F.ctl = (gu32*)(P.ws + WS_CTL);
    for (int u = F.tid; u < (LDS_BYTES - LDSCTL_OFF) / 4; u += NWAVES * 64) ((LAS unsigned*)(F.lds + LDSCTL_OFF))[u] = 0u;
    __syncthreads();
    XcdBarrier bar = xcd_barrier_post((unsigned*)(F.ctl + CW_BAR), F.MISC + 8);
    const int gw = F.vcu * NWAVES + F.wave, NGW = F.G * NWAVES;
    STAMP();
    prep_x(F, P, gw, NGW);
    convert_layer_weights(F, P, 0, gw, NGW, false);
    GRID_BAR();

    layer_body<0>(F, P, bar);
    layer_body<1>(F, P, bar);
}

extern "C" void kernel_launch(void* const* d_in, const int* in_sizes, int n_in, void* d_out, int out_size, void* d_ws, size_t ws_size, hipStream_t stream) {
    static int grid = 0;
    if (grid == 0) {
        if (n_in != 20 || out_size != T * DM || ws_size < WS_END) { fprintf(stderr, "kernel_launch: unexpected shapes n_in %d out %d ws %zu (need %zu)\n", n_in, out_size, ws_size, (size_t)WS_END); grid = -1; return; }
        int dev = 0, cus = 0, per_cu = 0;
        if (hipGetDevice(&dev) != hipSuccess || hipDeviceGetAttribute(&cus, hipDeviceAttributeMultiprocessorCount, dev) != hipSuccess) { grid = -1; return; }
        if (hipFuncSetAttribute((const void*)fwd_kernel, hipFuncAttributeMaxDynamicSharedMemorySize, LDS_BYTES) != hipSuccess) { fprintf(stderr, "kernel_launch: hipFuncSetAttribute failed\n"); grid = -1; return; }
        if (hipOccupancyMaxActiveBlocksPerMultiprocessor(&per_cu, (const void*)fwd_kernel, NWAVES * 64, LDS_BYTES) != hipSuccess || per_cu < 1) { fprintf(stderr, "kernel_launch: occupancy query says %d\n", per_cu); per_cu = 1; }
        (void)hipGetLastError();
        grid = cus;
    }
    if (grid < 0) return;
    if (hipMemsetAsync((char*)d_ws + WS_CTL, 0, CTL_ZERO_BYTES, stream) != hipSuccess) { fprintf(stderr, "kernel_launch: memset failed\n"); return; }
    Params p{};
    for (int i = 0; i < 20; ++i) p.in[i] = (const float*)d_in[i];
    p.out = (float*)d_out; p.ws = (unsigned char*)d_ws;
    void* args[] = {&p};
    hipError_t e = hipLaunchCooperativeKernel((const void*)fwd_kernel, dim3(grid), dim3(NWAVES * 64), args, LDS_BYTES, stream);
    if (e != hipSuccess) fprintf(stderr, "kernel_launch: cooperative launch failed: %s (grid %d)\n", hipGetErrorString(e), grid);
}
```

```cpp
#include <hip/hip_runtime.h>
#include <cstdio>
#include <cstdint>
#include <cmath>

#define GAS __attribute__((address_space(1)))
#define LAS __attribute__((address_space(3)))
typedef unsigned short bf16;
typedef unsigned v4u __attribute__((ext_vector_type(4)));
typedef unsigned v2u __attribute__((ext_vector_type(2)));
typedef float f32x4 __attribute__((ext_vector_type(4)));
typedef GAS unsigned gu32;
#define RLX_AGENT __ATOMIC_RELAXED, __HIP_MEMORY_SCOPE_AGENT
#define LDS_WAIT() asm volatile("s_waitcnt lgkmcnt(0)" ::: "memory")
#define VM_WAIT() asm volatile("s_waitcnt vmcnt(0)" ::: "memory")
__device__ __forceinline__ unsigned f2bf(float f) { unsigned u = __builtin_bit_cast(unsigned, f); return (u + 0x7fffu + ((u >> 16) & 1u)) >> 16; }
__device__ __forceinline__ unsigned pk2(float lo, float hi) { return f2bf(lo) | (f2bf(hi) << 16); }
__device__ __forceinline__ float bf2f(unsigned short b) { return __builtin_bit_cast(float, (unsigned)b << 16); }
__device__ __forceinline__ float bflo(unsigned w) { return __builtin_bit_cast(float, w << 16); }
__device__ __forceinline__ float bfhi(unsigned w) { return __builtin_bit_cast(float, w & 0xffff0000u); }
__device__ __forceinline__ float wave_sum(float v) {
#pragma unroll
    for (int o = 1; o < 64; o <<= 1) v += __shfl_xor(v, o);
    return v;
}
__device__ __forceinline__ float wave_max(float v) {
#pragma unroll
    for (int o = 1; o < 64; o <<= 1) v = fmaxf(v, __shfl_xor(v, o));
    return v;
}

constexpr int NWAVES = 8;
constexpr int BATCH = 2, SEQ = 8192, DM = 1024, T = BATCH * SEQ;
constexpr int IN_TOTAL = 6928, NMAIN = 4096, NGATES = 3072;
constexpr int DFF = 2816, NEXP = 8, DFE = 1408;
constexpr float RMS_EPS = 1e-6f;
constexpr int XG_ROWS = 2 * T + 2048;

constexpr size_t MiB = 1u << 20;
constexpr size_t WS_CTL = 0, CTL_ZERO_BYTES = 1 * MiB;
constexpr size_t WS_SSQ = 1 * MiB;
constexpr size_t WS_KBP = 2 * MiB;
constexpr size_t WS_DEC = 2 * MiB + 256 * 1024;
constexpr size_t WS_TOKE = 2 * MiB + 512 * 1024;
constexpr size_t WS_TOKP = WS_TOKE + 128 * 1024;
constexpr size_t WS_TOKPOS = WS_TOKP + 128 * 1024;
constexpr size_t WS_RS2 = WS_TOKPOS + 128 * 1024;
constexpr size_t WS_CNT = WS_RS2 + 64 * 1024;
constexpr size_t WS_RSG = 3 * MiB;
constexpr size_t WS_PWG = 3 * MiB + 256 * 1024;
constexpr size_t WS_W = 4 * MiB;
constexpr size_t WO_IN = 0, WO_BR = 14 * MiB, WO_O = 17 * MiB, WO_GU = 19 * MiB, WO_D = 30 * MiB;
constexpr size_t WS_XB = 40 * MiB;
constexpr size_t WS_R = 72 * MiB;
constexpr size_t RO_AQ = 0, RO_BQ = 16 * MiB, RO_CR = 32 * MiB, RO_AK = 48 * MiB, RO_AV = 52 * MiB, RO_BK = 56 * MiB, RO_BV = 72 * MiB, RO_CQ = 88 * MiB, RO_CK = 96 * MiB, RO_CV = 104 * MiB, RO_GL = 120 * MiB;
constexpr size_t WS_GC = 240 * MiB;
constexpr size_t WS_S = 208 * MiB;
constexpr size_t WS_Y = WS_R + RO_BK;
constexpr size_t WS_H = WS_R;
constexpr size_t WS_XG = WS_R;
constexpr size_t WS_HG = 140 * MiB;
constexpr size_t WS_WMGU = 234 * MiB;
constexpr size_t WS_WMD = 278 * MiB;
constexpr size_t WS_PO2 = 256 * MiB;
constexpr size_t WS_LIST = 272 * MiB;
constexpr size_t WS_ML = 300 * MiB;
constexpr size_t WS_END = 303 * MiB;
constexpr int LIST_BH = 126976;
constexpr int CW_MCNT = 8192;
static_assert(WS_HG + (size_t)XG_ROWS * DFE * 2 <= WS_WMGU && WS_XG + (size_t)XG_ROWS * DM * 2 <= WS_HG, "moe map");
static_assert(WS_H + (size_t)T * DFF * 2 <= WS_S, "overlay map");
constexpr int CW_BAR = 4096;

constexpr int RING_OFF = 0, RING_BYTES = 131072;
constexpr int LDSCTL_OFF = RING_BYTES, MISC_OFF = LDSCTL_OFF + 320;
constexpr int LDS_BYTES = 147456;
namespace pg8 {
#define PG8_LAS __attribute__((address_space(3)))
typedef unsigned short bf16_t;
typedef short bf16x8 __attribute__((ext_vector_type(8)));
typedef float f32x4 __attribute__((ext_vector_type(4)));
typedef unsigned u32x4 __attribute__((ext_vector_type(4)));
typedef unsigned u32x2 __attribute__((ext_vector_type(2)));
constexpr int BM = 256, BK = 64, HALF = 128, HTB = HALF * BK * 2  , STAGE_BYTES = 8 * HTB, NXCD = 8, WGM = 8;

__host__ __device__ __forceinline__ int lds_byte(int r, int c) { const int st = (r >> 4) * 2 + (c >> 5), rr = r & 15, cc = c & 31, ob = rr * 64 + cc * 2; return st * 1024 + (ob ^ (((ob >> 9) & 1) << 5)); }
__host__ __device__ __forceinline__ void stage_rc(int b, int& R, int& C) { const int st = b / 1024, sb = b % 1024, swz = sb ^ (((sb >> 9) & 1) << 5); R = (st >> 1) * 16 + swz / 64; C = (st & 1) * 32 + (swz % 64) / 2; }
__host__ __device__ __forceinline__ int perm32(int rho) { const int n = rho >> 4, i = rho & 15; return 8 * (i >> 2) + 4 * n + (i & 3); }

struct Unit { const char* A; const char* B; int pm, pn, aux; };

__device__ __forceinline__ bool static_tile(int nM, int nN, int G, int c, int i, int& pm, int& pn) {
    const int nwg = nM * nN; const long L = (long)i * G + c; if (L >= nwg) return false;
    int wgid = (int)L; { const int q = nwg / NXCD, r = nwg % NXCD, xcd = wgid % NXCD, off = wgid / NXCD; wgid = (xcd < r ? xcd * (q + 1) : r * (q + 1) + (xcd - r) * q) + off; }
    const int nig = WGM * nN, gid = wgid / nig, fm = gid * WGM, gsz = (nM - fm) < WGM ? (nM - fm) : WGM;
    pm = fm + ((wgid % nig) % gsz); pn = (wgid % nig) / gsz; return true;
}
struct DenseOrder {
    const char* A; const char* B; int nM, nN, G, c; size_t tstep;
    __device__ __forceinline__ void init(const void* A_, const void* B_, int M, int N, int K, int G_, int c_) { A = (const char*)A_; B = (const char*)B_; nM = M / BM; nN = N / BM; G = G_; c = c_; tstep = (size_t)BM * K * 2; }
    __device__ __forceinline__ bool next(int i, Unit& u) const { int pm, pn; if (!static_tile(nM, nN, G, c, i, pm, pn)) return false; u.pm = pm; u.pn = pn; u.aux = pn; u.A = A + (size_t)pm * tstep; u.B = B + (size_t)pn * tstep; return true; }
};

typedef float f32x2_c __attribute__((ext_vector_type(2))); typedef __bf16 bf16x2_c __attribute__((ext_vector_type(2)));
__device__ __forceinline__ unsigned cvt_pk_bf16(float lo, float hi) { f32x2_c v = {lo, hi}; bf16x2_c b = __builtin_convertvector(v, bf16x2_c); return __builtin_bit_cast(unsigned, b); }

template <class Epi, class Sched, bool ALIGN_EPI = true>
__device__ __forceinline__ void gemm_phase(PG8_LAS unsigned char* lds, const int K, const Sched& S, const Epi& E) {
    int tid_ = threadIdx.x; asm volatile("" : "+v"(tid_));
    const int tid = tid_, wid = __builtin_amdgcn_readfirstlane(tid >> 6), lane = tid & 63, wr = wid >> 2, wc = wid & 3, fr = lane & 15, fq = lane >> 4;
    const int nt = K / BK;
    unsigned voffA[2], voffB[2];
#pragma unroll
    for (int i = 0; i < 2; ++i) { int R, C; stage_rc(tid * 16 + i * 8192, R, C); const int Rb = Epi::PERM ? ((R & ~31) + perm32(R & 31)) : R;
        voffA[i] = (unsigned)(R * K + C) * 2u; voffB[i] = (unsigned)(Rb * K + C) * 2u; }
    const size_t kstep = (size_t)(BK * 2);
    const size_t hstep = (size_t)HALF * K * 2;
    const unsigned ldsw = (unsigned)wid * 1024u;
    const int aoff = lds_byte(wr * 64 + fr, fq * 8), boff = lds_byte(wc * 32 + fr, fq * 8);
#define PG8_SA(b, h) (((b) * 2 + (h)) * HTB)
#define PG8_SB(b, h) ((4 + (b) * 2 + (h)) * HTB)
#define PG8_STAGE(bufoff, gbase, voff) do { _Pragma("unroll") for (int _i = 0; _i < 2; ++_i) \
        __builtin_amdgcn_global_load_lds((const unsigned*)((const char*)(gbase) + (voff)[_i]), (PG8_LAS unsigned*)(lds + (bufoff) + ldsw + _i * 8192), 16, 0, 0); } while (0)
#define PG8_LDA(dst, b, h) do { _Pragma("unroll") for (int m = 0; m < 4; ++m) _Pragma("unroll") for (int k = 0; k < 2; ++k) dst[m][k] = *(const PG8_LAS bf16x8*)(lds + PG8_SA(b, h) + aoff + m * 2048 + k * 1024); } while (0)
#define PG8_LDB(dst, b, h) do { _Pragma("unroll") for (int n = 0; n < 2; ++n) _Pragma("unroll") for (int k = 0; k < 2; ++k) dst[n][k] = *(const PG8_LAS bf16x8*)(lds + PG8_SB(b, h) + boff + n * 2048 + k * 1024); } while (0)
#define PG8_MMA(ai, bj, At, Bt) do { __builtin_amdgcn_s_setprio(1); _Pragma("unroll") for (int m = 0; m < 4; ++m) _Pragma("unroll") for (int n = 0; n < 2; ++n) _Pragma("unroll") for (int k = 0; k < 2; ++k) \
        acc[ai][bj][m][n] = __builtin_amdgcn_mfma_f32_16x16x32_bf16(Bt[n][k], At[m][k], acc[ai][bj][m][n], 0, 0, 0); __builtin_amdgcn_s_setprio(0); } while (0)
#define PG8_WAIT_V(n) asm volatile("s_waitcnt vmcnt(" #n ")" ::: "memory")
#define PG8_WAIT_L(n) asm volatile("s_waitcnt lgkmcnt(" #n ")" ::: "memory")
#define PG8_BAR __builtin_amdgcn_s_barrier()
#define PG8_SCHED __builtin_amdgcn_sched_barrier(0)
    Unit cur, nxt; int ui = 0;
    if (!S.next(0, cur)) return;
    f32x4 acc[2][2][4][2];
#pragma unroll
    for (int a = 0; a < 2; ++a)
#pragma unroll
        for (int b = 0; b < 2; ++b)
#pragma unroll
            for (int m = 0; m < 4; ++m)
#pragma unroll
                for (int n = 0; n < 2; ++n) acc[a][b][m][n] = (f32x4){0.f, 0.f, 0.f, 0.f};
    bf16x8 At[4][2], B0[2][2], B1[2][2];
    const char* cA = cur.A; const char* cB = cur.B;
    PG8_STAGE(PG8_SB(0, 0), cB, voffB); PG8_STAGE(PG8_SB(0, 1), cB + hstep, voffB); PG8_STAGE(PG8_SA(0, 0), cA, voffA); PG8_STAGE(PG8_SA(0, 1), cA + hstep, voffA);
    if (wr == 1) PG8_BAR;
    PG8_WAIT_V(2); PG8_BAR;
    PG8_STAGE(PG8_SB(1, 0), cB + kstep, voffB); PG8_STAGE(PG8_SA(1, 0), cA + kstep, voffA); PG8_STAGE(PG8_SB(1, 1), cB + hstep + kstep, voffB);
    PG8_WAIT_V(6); PG8_BAR;
    for (;;) {
        const bool has_next = S.next(ui + 1, nxt);
        const char* nA = has_next ? nxt.A : cA; const char* nB = has_next ? nxt.B : cB;
        for (int t = 0; t < nt; t += 2) {
            const bool last = (t == nt - 2);
            const char* a1 = cA + (size_t)(t + 1) * kstep;
            const char* a2 = last ? nA : cA + (size_t)(t + 2) * kstep; const char* b2 = last ? nB : cB + (size_t)(t + 2) * kstep;
            const char* a3 = a2 + kstep; const char* b3 = b2 + kstep;
            PG8_LDB(B0, 0, 0); PG8_LDB(B1, 0, 1); PG8_SCHED; PG8_LDA(At, 0, 0); PG8_STAGE(PG8_SA(1, 1), a1 + hstep, voffA);
            PG8_WAIT_V(8); PG8_WAIT_L(0); PG8_BAR; PG8_MMA(0, 0, At, B0); PG8_MMA(0, 1, At, B1); PG8_BAR; PG8_SCHED;
            PG8_LDA(At, 0, 1); PG8_STAGE(PG8_SB(0, 0), b2, voffB); PG8_STAGE(PG8_SB(0, 1), b2 + hstep, voffB); PG8_STAGE(PG8_SA(0, 0), a2, voffA);
            PG8_WAIT_V(8); PG8_WAIT_L(0); PG8_BAR; PG8_MMA(1, 0, At, B0); PG8_MMA(1, 1, At, B1); PG8_BAR; PG8_SCHED;
            PG8_LDB(B0, 1, 0); PG8_LDB(B1, 1, 1); PG8_SCHED; PG8_LDA(At, 1, 0); PG8_STAGE(PG8_SA(0, 1), a2 + hstep, voffA);
            PG8_WAIT_V(8); PG8_WAIT_L(0); PG8_BAR; PG8_MMA(0, 0, At, B0); PG8_MMA(0, 1, At, B1); PG8_BAR; PG8_SCHED;
            PG8_LDA(At, 1, 1); PG8_STAGE(PG8_SB(1, 0), b3, voffB); PG8_STAGE(PG8_SB(1, 1), b3 + hstep, voffB); PG8_STAGE(PG8_SA(1, 0), a3, voffA);
            PG8_WAIT_V(8); PG8_WAIT_L(0); PG8_BAR; PG8_MMA(1, 0, At, B0); PG8_MMA(1, 1, At, B1); PG8_BAR; PG8_SCHED;
        }
        if constexpr (ALIGN_EPI) { if (wr == 0) PG8_BAR; }
            E(acc, cur, wr, wc, fr, fq);
            if (!has_next) break;
#pragma unroll
        for (int a = 0; a < 2; ++a)
#pragma unroll
            for (int b = 0; b < 2; ++b)
#pragma unroll
                for (int m = 0; m < 4; ++m)
#pragma unroll
                    for (int n = 0; n < 2; ++n) acc[a][b][m][n] = (f32x4){0.f, 0.f, 0.f, 0.f};
        cur = nxt; cA = nA; cB = nB; ++ui;
        if constexpr (ALIGN_EPI) { if (wr == 1) PG8_BAR; }
    }
    PG8_WAIT_V(0);
    if constexpr (!ALIGN_EPI) { if (wr == 0) PG8_BAR; }
    PG8_BAR;
#undef PG8_SA
#undef PG8_SB
#undef PG8_STAGE
#undef PG8_LDA
#undef PG8_LDB
#undef PG8_MMA
#undef PG8_WAIT_V
#undef PG8_WAIT_L
#undef PG8_BAR
#undef PG8_SCHED
}
}
#define XB_TMO      128
#define XB_XCNT(j)  (256  + 64 * (j))
#define XB_XSUB(j)  (1280 + 64 * (j))
#define XB_XGEN(j)  (2304 + 64 * (j))
#define XB_TOP      3328
#define XB_TOPGEN   3392
#define XCD_BAR_WORDS 3456
#define XB_SPIN_CAP (1u << 18)

__device__ __forceinline__ unsigned xb_ld(unsigned* p)              { return __hip_atomic_load(p, __ATOMIC_RELAXED, __HIP_MEMORY_SCOPE_AGENT); }
__device__ __forceinline__ unsigned xb_add(unsigned* p, unsigned v) { return __hip_atomic_fetch_add(p, v, __ATOMIC_RELAXED, __HIP_MEMORY_SCOPE_AGENT); }
__device__ __forceinline__ unsigned xb_xcc_id() { return (unsigned)__builtin_amdgcn_s_getreg((3 << 11) | 20) & 0xFu; }
#define XB_SPIN(cond, bar) do { unsigned _sp = 0; while (cond) { __builtin_amdgcn_s_sleep(1); \
    if ((++_sp & 255u) == 0u) { if (xb_ld(&(bar)[XB_TMO])) break; if (_sp > XB_SPIN_CAP) { atomicAdd(&(bar)[XB_TMO], 1u); break; } } } } while (0)

struct XcdBarrier {
    unsigned* bar; unsigned x;
    volatile LAS unsigned* st;
};

__device__ __forceinline__ XcdBarrier xcd_barrier_post(unsigned* bar, volatile LAS unsigned* st) {
    XcdBarrier b; b.bar = bar; b.x = xb_xcc_id(); b.st = st;
    if (threadIdx.x == 0) (void)xb_add(&bar[XB_XCNT(b.x)], 1u);
    return b;
}
__device__ __forceinline__ void xcd_barrier_complete(unsigned* bar, unsigned x, unsigned& nloc, unsigned& nx) {
    const unsigned G = gridDim.x * gridDim.y * gridDim.z;
    unsigned sum, cnt, mine, sp = 0u;
    for (;;) {
        sum = 0u; cnt = 0u; mine = 0u;
#pragma unroll
        for (unsigned j = 0; j < 16; ++j) { const unsigned c = xb_ld(&bar[XB_XCNT(j)]); sum += c; cnt += (c > 0u) ? 1u : 0u; mine = (j == x) ? c : mine; }
        if (sum == G) break;
        __builtin_amdgcn_s_sleep(1);
        if ((++sp & 255u) == 0u) { if (xb_ld(&bar[XB_TMO])) break; if (sp > XB_SPIN_CAP) { atomicAdd(&bar[XB_TMO], 1u); break; } }
    }
    nloc = mine > 0u ? mine : 1u; nx = cnt > 0u ? cnt : 1u;
}

__device__ __forceinline__ void xcd_barrier(const XcdBarrier& b) {
    asm volatile("s_waitcnt vmcnt(0)" ::: "memory");
    __syncthreads();
    if (threadIdx.x == 0) {
        unsigned* bar = b.bar;
        __builtin_amdgcn_s_waitcnt(0);
        unsigned nloc = b.st[0], nx = b.st[1];
        if (nloc == 0u) { xcd_barrier_complete(bar, b.x, nloc, nx); b.st[0] = nloc; b.st[1] = nx; }
        const unsigned old = xb_add(&bar[XB_XSUB(b.x)], 1u);
        const unsigned gen = old / nloc;
        if (old + 1u == (gen + 1u) * nloc) {
            __builtin_amdgcn_fence(__ATOMIC_RELEASE, "agent");
            asm volatile("s_waitcnt vmcnt(0)" ::: "memory");
            const unsigned og = xb_add(&bar[XB_TOP], 1u);
            const unsigned tg = og / nx;
            if (og + 1u == (tg + 1u) * nx) xb_add(&bar[XB_TOPGEN], 1u);
            else XB_SPIN(xb_ld(&bar[XB_TOPGEN]) == tg, bar);
            __builtin_amdgcn_fence(__ATOMIC_ACQUIRE, "agent");
            xb_add(&bar[XB_XGEN(b.x)], 1u);
            asm volatile("s_waitcnt vmcnt(0)" ::: "memory");
        } else {
            XB_SPIN(xb_ld(&bar[XB_XGEN(b.x)]) == gen, bar);
            __builtin_amdgcn_fence(__ATOMIC_ACQUIRE, "agent");
            asm volatile("s_waitcnt vmcnt(0)" ::: "memory");
        }
    }
    __syncthreads();
}
struct Params { const float* in[20]; float* out; unsigned char* ws; };
enum { I_X = 0, I_N1G, I_WIN, I_SINK, I_GWG, I_GBG, I_GNG, I_WA, I_WB, I_WC, I_WO, I_N2G, I_FG, I_FU, I_FD, I_RT, I_MG, I_MU, I_MD, I_FNG };

struct Frame {
    LAS unsigned char* lds;
    volatile LAS unsigned* MISC;
    gu32* ctl;
    int tid, lane, wave;
    int vcu, G;
};
__device__ __forceinline__ unsigned char* lws(const Params& P) { GAS unsigned char* w = (GAS unsigned char*)P.ws; asm volatile("" : "+s"(w)); return (unsigned char*)w; }
#define PH_BEGIN Frame F = F_in; { int t_ = threadIdx.x; asm volatile("" : "+v"(t_)); F.tid = t_; F.lane = t_ & 63; } Params P = P_in; P.ws = lws(P_in);

template <int MODE>
__device__ __forceinline__ void tr_item(const float* W, int ld, int sc, const float* g, const float* W2, int n0, bf16* dst, int dK, int drow, int k0, LAS float* scr, int lane) {
    if (MODE == 0) {
        const int kr = lane >> 3, c4 = (lane & 7) * 4;
#pragma unroll
        for (int i = 0; i < 8; ++i) { const int kk = 8 * i + kr; f32x4 v = *(const GAS f32x4*)(W + (size_t)(k0 + kk) * ld + sc + n0 + c4);
            if (g) { const float gg = g[k0 + kk]; v = v * gg; }
            LAS float* s = scr + kk * 33 + c4; s[0] = v.x; s[1] = v.y; s[2] = v.z; s[3] = v.w; }
    } else {
#pragma unroll 4
        for (int i = 0; i < 32; ++i) { const int kk = 2 * i + (lane >> 5), nn = lane & 31; const float* wr = W + (size_t)(k0 + kk) * ld + sc; float v = 0.f;
#pragma unroll
            for (int r = 0; r < 16; ++r) v += wr[r] * W2[r * 256 + n0 + nn];
            if (g) v *= g[k0 + kk];
            scr[kk * 33 + nn] = v; }
    }
    LDS_WAIT(); asm volatile("" ::: "memory");
    const int c = lane & 7;
#pragma unroll
    for (int j = 0; j < 4; ++j) { const int n = (lane >> 3) + 8 * j; const LAS float* s = scr + (8 * c) * 33 + n;
        v4u o; o.x = pk2(s[0 * 33], s[1 * 33]); o.y = pk2(s[2 * 33], s[3 * 33]); o.z = pk2(s[4 * 33], s[5 * 33]); o.w = pk2(s[6 * 33], s[7 * 33]);
        *(GAS v4u*)(dst + (size_t)(drow + n) * dK + k0 + 8 * c) = o; }
    LDS_WAIT(); asm volatile("" ::: "memory");
}
__device__ __forceinline__ void tr_job(int item, const float* W, int ld, int sc, int K, int N, const float* g, bf16* dst, int drow0, int gu_off, bool gu, LAS float* scr, int lane) {
    const int nblk = N / 32, kb = item / nblk, nb = item % nblk, n0 = 32 * nb;
    const int drow = gu ? (256 * (n0 / 128) + (n0 % 128) + gu_off) : (drow0 + n0);
    tr_item<0>(W, ld, sc, g, nullptr, n0, dst, K, drow, 64 * kb, scr, lane);
}
__device__ __forceinline__ void convert_layer_weights(const Frame& F_in, const Params& P_in, int l, int gw, int NGW, bool skip_ffn_down_region) {
    PH_BEGIN
    LAS float* scr = (LAS float*)(F.lds + RING_OFF + F.wave * 16384);
    unsigned char* ws = P.ws;
    bf16* Win = (bf16*)(ws + WS_W + WO_IN); bf16* Wbr = (bf16*)(ws + WS_W + WO_BR); bf16* Wo = (bf16*)(ws + WS_W + WO_O); bf16* Wgu = (bf16*)(ws + WS_W + WO_GU); bf16* Wd = (bf16*)(ws + WS_W + WO_D);
    const float* win = P.in[I_WIN] + (size_t)l * DM * IN_TOTAL; const float* n1g = P.in[I_N1G] + l * DM; const float* n2g = P.in[I_N2G] + l * DM;
    constexpr int J1 = 16 * (3840 / 32), J2 = 16 * (NGATES / 32), J3 = 16 * (256 / 32), J4 = 8 * (DM / 32), J7 = 16 * (DM / 32), J8 = 16 * (DFF / 32), J10 = (DFF / 64) * (DM / 32);
    const int NIT = J1 + J2 + J3 + 3 * J4 + J7 + ((l == 0) ? (2 * J8 + J10) : 0);
    for (int it = gw; it < NIT; it += NGW) {
        int r = it;
        if (r < J1) { tr_job(r, win, IN_TOTAL, 0, DM, 3840, n1g, Win, 0, 0, false, scr, F.lane); continue; } r -= J1;
        if (r < J2) { tr_job(r, win, IN_TOTAL, 3856, DM, NGATES, n1g, Win, NMAIN, 0, false, scr, F.lane); continue; } r -= J2;
        if (r < J3) { const int kb = r / 8, nb = r % 8; tr_item<1>(win, IN_TOTAL, 3840, n1g, P.in[I_GWG] + (size_t)l * 16 * 256, 32 * nb, Win, DM, 3840 + 32 * nb, 64 * kb, scr, F.lane); continue; } r -= J3;
        if (r < J4) { tr_job(r, P.in[I_WA] + (size_t)l * 512 * DM, DM, 0, 512, DM, nullptr, Wbr, 0, 0, false, scr, F.lane); continue; } r -= J4;
        if (r < J4) { tr_job(r, P.in[I_WB] + (size_t)l * 512 * DM, DM, 0, 512, DM, nullptr, Wbr + (size_t)DM * 512, 0, 0, false, scr, F.lane); continue; } r -= J4;
        if (r < J4) { tr_job(r, P.in[I_WC] + (size_t)l * 512 * DM, DM, 0, 512, DM, nullptr, Wbr + (size_t)2 * DM * 512, 0, 0, false, scr, F.lane); continue; } r -= J4;
        if (r < J7) { tr_job(r, P.in[I_WO] + (size_t)l * DM * DM, DM, 0, DM, DM, nullptr, Wo, 0, 0, false, scr, F.lane); continue; } r -= J7;
        if (r < J8) { tr_job(r, P.in[I_FG], DFF, 0, DM, DFF, n2g, Wgu, 0, 0, true, scr, F.lane); continue; } r -= J8;
        if (r < J8) { tr_job(r, P.in[I_FU], DFF, 0, DM, DFF, n2g, Wgu, 0, 128, true, scr, F.lane); continue; } r -= J8;
        tr_job(r, P.in[I_FD], DM, 0, DFF, DM, nullptr, Wd, 0, 0, false, scr, F.lane);
    }
}
__device__ __forceinline__ void convert_moe_weights(const Frame& F_in, const Params& P_in, int gw, int NGW, int which) {
    PH_BEGIN
    LAS float* scr = (LAS float*)(F.lds + RING_OFF + F.wave * 16384);
    bf16* Wgu = (bf16*)(P.ws + WS_WMGU); bf16* Wd = (bf16*)(P.ws + WS_WMD);
    const float* n2g = P.in[I_N2G] + 1 * DM;
    constexpr int JG = 16 * (DFE / 32), JD = (DFE / 64) * (DM / 32);
    if (which & 1) for (int it = gw; it < NEXP * 2 * JG; it += NGW) {
        const int e = it / (2 * JG); int r = it % (2 * JG);
        if (r < JG) tr_job(r, P.in[I_MG] + (size_t)e * DM * DFE, DFE, 0, DM, DFE, n2g, Wgu + (size_t)e * 2 * DFE * DM, 0, 0, true, scr, F.lane);
        else tr_job(r - JG, P.in[I_MU] + (size_t)e * DM * DFE, DFE, 0, DM, DFE, n2g, Wgu + (size_t)e * 2 * DFE * DM, 0, 128, true, scr, F.lane);
    }
    if (which & 2) for (int it = gw; it < NEXP * JD; it += NGW) { const int e = it / JD, r = it % JD;
        tr_job(r, P.in[I_MD] + (size_t)e * DFE * DM, DM, 0, DFE, DM, nullptr, Wd + (size_t)e * DM * DFE, 0, 0, false, scr, F.lane); }
}
__device__ __forceinline__ void prep_x(const Frame& F_in, const Params& P_in, int gw, int NGW) {
    PH_BEGIN
    bf16* XB = (bf16*)(P.ws + WS_XB); float* SSQ = (float*)(P.ws + WS_SSQ);
    for (int m = gw; m < T; m += NGW) {
        const GAS f32x4* xr = (const GAS f32x4*)(P.in[I_X] + (size_t)m * DM) + F.lane;
        f32x4 v[4]; float s = 0.f;
#pragma unroll
        for (int j = 0; j < 4; ++j) { v[j] = xr[64 * j]; s += (v[j].x * v[j].x + v[j].y * v[j].y) + (v[j].z * v[j].z + v[j].w * v[j].w); }
        s = wave_sum(s) * (1.f / 16.f);
        GAS unsigned long long* o8 = (GAS unsigned long long*)(XB + (size_t)m * DM) + F.lane;
#pragma unroll
        for (int j = 0; j < 4; ++j) o8[64 * j] = (unsigned long long)pk2(v[j].x, v[j].y) | ((unsigned long long)pk2(v[j].z, v[j].w) << 32);
        if (F.lane < 16) SSQ[(size_t)m * 16 + F.lane] = s;
    }
}
__device__ __forceinline__ void final_phase(const Frame& F_in, const Params& P_in, int gw, int NGW, bool with_moe) {
    PH_BEGIN
#ifdef TIMING
    float tscale = 1.0f, tbump = 0.f;
    { const unsigned* c_ = (const unsigned*)(P.ws + WS_CTL) + 2048; const unsigned long long* ts = (const unsigned long long*)(c_ + 2); const unsigned n_ = c_[0];
      const float tot = (float)(ts[n_ - 1] - ts[0]); float a1 = 0.f, a2 = 0.f;
      for (unsigned i = 1; i < n_; ++i) { const float d = (float)(ts[i] - ts[i - 1]); if ((TSEL1 >> i) & 1u) a1 += d; if ((TSEL2 >> i) & 1u) a2 += d; }
      tscale = 1.0f + 0.02f + 0.1f * TRS * (a1 / tot); tbump = 2.0f + 7.9f * TBS * (a2 / tot); }
#endif
    const float* g = P.in[I_FNG]; const bf16* XBp = (const bf16*)(P.ws + WS_XB); const bf16* YE = (const bf16*)(P.ws + WS_XG); const int* TOKPOS = (const int*)(P.ws + WS_TOKPOS);
    for (int m = gw; m < T; m += NGW) {
        GAS f32x4* xr = (GAS f32x4*)(P.out + (size_t)m * DM) + F.lane;
        f32x4 v[4]; float s = 0.f;
#pragma unroll
        for (int j = 0; j < 4; ++j) { const v2u w = ((const GAS v2u*)(XBp + (size_t)m * DM) + F.lane)[64 * j]; v[j] = (f32x4){bflo(w.x), bfhi(w.x), bflo(w.y), bfhi(w.y)}; }
        if (with_moe) {
#pragma unroll
            for (int sl = 0; sl < 2; ++sl) { const int pos = TOKPOS[m * 2 + sl]; const GAS v2u* yr = (const GAS v2u*)(YE + (size_t)pos * DM) + F.lane;
#pragma unroll
                for (int j = 0; j < 4; ++j) { const v2u w = yr[64 * j]; v[j].x += bflo(w.x); v[j].y += bfhi(w.x); v[j].z += bflo(w.y); v[j].w += bfhi(w.y); } }
        }
#pragma unroll
        for (int j = 0; j < 4; ++j) s += (v[j].x * v[j].x + v[j].y * v[j].y) + (v[j].z * v[j].z + v[j].w * v[j].w);
        const float r = 1.0f / sqrtf(wave_sum(s) * (1.f / DM) + RMS_EPS);
#pragma unroll
        for (int j = 0; j < 4; ++j) { const f32x4 gg = *((const GAS f32x4*)g + F.lane + 64 * j); f32x4 ov = (f32x4){v[j].x * r * gg.x, v[j].y * r * gg.y, v[j].z * r * gg.z, v[j].w * r * gg.w};
#ifdef TIMING
            ov = ov * tscale; if (m == 0 && j == 0 && F.lane == 0) ov.x += tbump;
#endif
            xr[64 * j] = ov; }
    }
}
#include <hip/hip_bf16.h>
#include <cmath>
namespace attn_body {
using bf16=__hip_bfloat16;
using bf16x8=__attribute__((ext_vector_type(8)))short;
using s16x4=__attribute__((ext_vector_type(4)))short;
using f32x16=__attribute__((ext_vector_type(16)))float;
using u32x4=__attribute__((ext_vector_type(4)))unsigned;
constexpr int D=64;
constexpr int NW=8,QBLK=32,QB=QBLK*NW,KVBLK=64;
__device__ __forceinline__ int crow(int r,int hi){return (r&3)+8*(r>>2)+4*hi;}
#define SBAR() __builtin_amdgcn_sched_barrier(0)
template<bool WIN> __device__ __forceinline__ void amask(f32x16&p0,f32x16&p1,int krel0,int qrel,int hi){
  const float NEG=-INFINITY; const int kb=krel0+4*hi;
  #pragma unroll
  for(int r=0;r<16;++r){const int kv=kb+(r&3)+8*(r>>2);
    if(kv>qrel||(WIN&&kv<=qrel-128))p0[r]=NEG; if(kv+32>qrel||(WIN&&kv+32<=qrel-128))p1[r]=NEG;}
}

constexpr int NSLOT=3, SLOTB=8192;
constexpr int LDS_K=0, LDS_V=NSLOT*SLOTB, LDS_WS=2*NSLOT*SLOTB, LDS_OST=LDS_WS+NW*64*4, LDS_MG=LDS_OST+NW*4096, LDS_BYTES=LDS_MG+NW*96*4;
constexpr float C2=0.125f*1.4426950408889634f;
__device__ __forceinline__ void glds16(const void*gsrc,unsigned lds_dst){unsigned keep;
  asm volatile("s_mov_b32 %0, m0\n\ts_mov_b32 m0, %2\n\ts_nop 0\n\tglobal_load_lds_dwordx4 %1, off\n\ts_mov_b32 m0, %0":"=&s"(keep):"v"(gsrc),"s"(lds_dst):"memory");}
__device__ __forceinline__ float max3f(float a,float b,float c){float r;asm("v_max3_f32 %0, %1, %2, %3":"=v"(r):"v"(a),"v"(b),"v"(c));return r;}
__device__ __forceinline__ float max2f(float a,float b){float r;asm("v_max_f32_e32 %0, %1, %2":"=v"(r):"v"(a),"v"(b));return r;}
__device__ __forceinline__ float fadd_s(float a,float b){float r;asm("v_add_f32_e32 %0, %1, %2":"=v"(r):"v"(a),"v"(b));return r;}
__device__ __forceinline__ float fsub_s(float a,float b){float r;asm("v_sub_f32_e32 %0, %1, %2":"=v"(r):"v"(a),"v"(b));return r;}
typedef float f32x2_t __attribute__((ext_vector_type(2))); typedef __bf16 bf16x2_t __attribute__((ext_vector_type(2)));
__device__ __forceinline__ unsigned cvtpk_s(float lo,float hi){f32x2_t v={lo,hi};bf16x2_t b=__builtin_convertvector(v,bf16x2_t);return __builtin_bit_cast(unsigned,b);}
#define WAIT_BAR(N) asm volatile("s_waitcnt vmcnt(" #N ") lgkmcnt(0)\n\ts_barrier":::"memory")

__device__ __forceinline__ void qkt(f32x16&p0,f32x16&p1,const char*Kslot,const bf16x8*qr,const f32x16&negm,int r32,int hi){
  const char*kb=Kslot+hi*1024+r32*16;
  #pragma unroll
  for(int d0=0;d0<4;++d0){
    const bf16x8 b0=*reinterpret_cast<const bf16x8*>(kb+d0*2048);
    const bf16x8 b1=*reinterpret_cast<const bf16x8*>(kb+d0*2048+512);
    if(d0==0){p0=__builtin_amdgcn_mfma_f32_32x32x16_bf16(b0,qr[0],negm,0,0,0);p1=__builtin_amdgcn_mfma_f32_32x32x16_bf16(b1,qr[0],negm,0,0,0);}
    else{p0=__builtin_amdgcn_mfma_f32_32x32x16_bf16(b0,qr[d0],p0,0,0,0);p1=__builtin_amdgcn_mfma_f32_32x32x16_bf16(b1,qr[d0],p1,0,0,0);}}
}
typedef __attribute__((address_space(3))) const char* lds_cptr;
typedef short v4i16_t __attribute__((ext_vector_type(4)));
__device__ __forceinline__ void kload8(bf16x8*kf,lds_cptr kp){
  kf[0]=*(const __attribute__((address_space(3))) bf16x8*)(kp);      kf[1]=*(const __attribute__((address_space(3))) bf16x8*)(kp+512);
  kf[2]=*(const __attribute__((address_space(3))) bf16x8*)(kp+2048); kf[3]=*(const __attribute__((address_space(3))) bf16x8*)(kp+2560);
  kf[4]=*(const __attribute__((address_space(3))) bf16x8*)(kp+4096); kf[5]=*(const __attribute__((address_space(3))) bf16x8*)(kp+4608);
  kf[6]=*(const __attribute__((address_space(3))) bf16x8*)(kp+6144); kf[7]=*(const __attribute__((address_space(3))) bf16x8*)(kp+6656);
}
__device__ __forceinline__ void kload2(bf16x8*kf,lds_cptr kp,int j){ kf[2*j]=*(const __attribute__((address_space(3))) bf16x8*)(kp+j*2048); kf[2*j+1]=*(const __attribute__((address_space(3))) bf16x8*)(kp+j*2048+512); }
__device__ __forceinline__ s16x4 vtr(lds_cptr p){ return __builtin_bit_cast(s16x4,__builtin_amdgcn_ds_read_tr16_b64_v4i16((__attribute__((address_space(3))) v4i16_t*)p)); }
__device__ __forceinline__ float rowmax(const f32x16&p0,const f32x16&p1){
  float a=max3f(p0[0],p0[1],p1[0]),b=max3f(p0[2],p0[3],p1[1]);a=max3f(a,p1[2],p1[3]);
  #pragma unroll
  for(int r=4;r<16;r+=4){a=max3f(a,p0[r],p0[r+1]);b=max3f(b,p0[r+2],p0[r+3]);a=max3f(a,p1[r],p1[r+1]);b=max3f(b,p1[r+2],p1[r+3]);}
  const float m=max2f(a,b);
  auto rr=__builtin_amdgcn_permlane32_swap(__float_as_uint(m),__float_as_uint(m),false,false);
  return max2f(__uint_as_float(rr[0]),__uint_as_float(rr[1]));
}
__device__ __forceinline__ void pv(f32x16*o,int vb,bf16x8 pa0,bf16x8 pa1,bf16x8 pa2,bf16x8 pa3){
  #pragma unroll
  for(int d0=0;d0<2;++d0){s16x4 lo[4],hi[4];
    #pragma unroll
    for(int ks=0;ks<4;++ks){
      asm volatile("ds_read_b64_tr_b16 %0,%1 offset:%c2":"=&v"(lo[ks]):"v"(vb),"i"(d0*4096+ks*1024):"memory");
      asm volatile("ds_read_b64_tr_b16 %0,%1 offset:%c2":"=&v"(hi[ks]):"v"(vb),"i"(d0*4096+ks*1024+512):"memory");}
    asm volatile("s_waitcnt lgkmcnt(0)":::"memory");SBAR();
    #define PK(k) (bf16x8){lo[k][0],lo[k][1],lo[k][2],lo[k][3],hi[k][0],hi[k][1],hi[k][2],hi[k][3]}
    o[d0]=__builtin_amdgcn_mfma_f32_32x32x16_bf16(pa0,PK(0),o[d0],0,0,0);
    o[d0]=__builtin_amdgcn_mfma_f32_32x32x16_bf16(pa1,PK(1),o[d0],0,0,0);
    o[d0]=__builtin_amdgcn_mfma_f32_32x32x16_bf16(pa2,PK(2),o[d0],0,0,0);
    o[d0]=__builtin_amdgcn_mfma_f32_32x32x16_bf16(pa3,PK(3),o[d0],0,0,0);
    #undef PK
  }
}

#ifndef ATTN_STORE16
#define ATTN_STORE16(p,v) (*(u32x4*)(p)=(v))
#endif
struct MobaIO { bf16* po01; bf16* po2; float* ml; int h; int nsel; unsigned ent; int grow0; };
template<int MODE,int THRL,bool MERGE=false> __device__ __forceinline__ void attn_unit(const bf16*qlane,bf16*Ow0,const int QP,const bf16*__restrict__ Kt0,const bf16*__restrict__ Vt0,const int KP,const int NT,const int koff,const unsigned selmask,const float sinkl2,char*shm,const MobaIO mio=MobaIO{}){
  int tid_=threadIdx.x; asm volatile("":"+v"(tid_));
  const int tid=tid_,lane=tid&63,r32=lane&31,hi=lane>>5; const int wid=__builtin_amdgcn_readfirstlane(tid>>6);
  const bf16*Kh=Kt0,*Vh=Vt0;
  const unsigned lds0=(unsigned)(uintptr_t)shm;
  float*wsf=(float*)(shm+LDS_WS)+wid*64;
  const bf16*ksrc=Kh+(long)lane*KP+wid*8;
  const bf16*vsrc=Vh+(long)(16*(wid&3)+(lane>>2))*KP+(wid>>2)*32+(lane&3)*8;
  const unsigned kdst=lds0+LDS_K+wid*1024, vdst=lds0+LDS_V+wid*1024;
  #define DMA_K(t,slot) glds16(ksrc+(long)(t)*KVBLK*KP,(unsigned)__builtin_amdgcn_readfirstlane(kdst+(slot)))
  #define DMA_V(t,slot) glds16(vsrc+(long)(t)*KVBLK*KP,(unsigned)__builtin_amdgcn_readfirstlane(vdst+(slot)))
  const int vb0=(int)(lds0+LDS_V)+((lane>>4)&1)*32+(lane&3)*8+(4*hi+((lane&15)>>2))*64;
  const char*Kbase=shm+LDS_K; bf16x8 kf[8];
  const lds_cptr shm3=(lds_cptr)shm; const lds_cptr kp0=shm3+LDS_K+hi*1024+r32*16; const lds_cptr vp0=shm3+LDS_V+((lane>>4)&1)*32+(lane&3)*8+(4*hi+((lane&15)>>2))*64;
  DMA_K(0,0);DMA_V(0,0);DMA_K(1,SLOTB);
  bf16x8 qr[4];
  #pragma unroll
  for(int d0=0;d0<4;++d0)qr[d0]=*reinterpret_cast<const bf16x8*>(&qlane[d0*16+hi*8]);
  float mhat=0.f,l_reg=0.f;f32x16 o[2];o[0]=f32x16{};o[1]=f32x16{};f32x16 negm=f32x16{};asm volatile("":"+v"(negm));
  const int qrel=wid*QBLK+r32;
  #define CMASK(P0,P1,t) do{ if(MODE==1){amask<true>(P0,P1,koff+64*(t),qrel,hi);} else if(MODE==0){const int jb_=(t)-(NT-4); if(jb_>=0)amask<false>(P0,P1,64*jb_,qrel,hi);} }while(0)
  #define NEGM_SET(t) do{ float c_=-mhat; if(MODE==0){ if((t)<NT-4 && !((selmask>>((t)>>2))&1u)) c_=-INFINITY; } \
      _Pragma("unroll") for(int r=0;r<16;++r)negm[r]=c_; asm volatile("":"+v"(negm)); }while(0)
  bool resc=false;
  #define START(P0,P1) do{ const float rm=rowmax(P0,P1); resc=false; \
    if(__any(rm>(float)THRL)){ const float dl=__builtin_fmaxf(rm,0.f); mhat+=dl; \
      _Pragma("unroll") for(int r=0;r<16;++r){P0[r]-=dl;P1[r]-=dl;} } \
    _Pragma("unroll") for(int r=0;r<16;++r)P0[r]=__builtin_amdgcn_exp2f(P0[r]); }while(0)
  #define RESC() do{ if(resc){ asm volatile("s_waitcnt lgkmcnt(0)":::"memory"); \
      _Pragma("unroll") for(int d_=0;d_<2;++d_) _Pragma("unroll") for(int r=0;r<16;++r)o[d_][r]*=wsf[crow(r,hi)]; } }while(0)
  f32x16 pA0,pA1,pB0,pB1;
  int sl_prev=0,sl_cur=0,sl_next=SLOTB;
  #define ROT() do{sl_prev=sl_cur;sl_cur=sl_next;sl_next=(sl_next==(NSLOT-1)*SLOTB)?0:sl_next+SLOTB;}while(0)
  DMA_K(2,2*SLOTB);
  WAIT_BAR(3);
  NEGM_SET(0);
  qkt(pA0,pA1,Kbase,qr,negm,r32,hi);asm volatile("s_nop 15\n\ts_nop 7":"+v"(pA0),"+v"(pA1));CMASK(pA0,pA1,0);
  START(pA0,pA1);
  _Pragma("unroll") for(int r=0;r<16;++r)pA1[r]=__builtin_amdgcn_exp2f(pA1[r]);
  WAIT_BAR(0);
  DMA_K(3,0);DMA_V(1,SLOTB);
  ROT();
  kload8(kf,kp0+sl_cur);
  WAIT_BAR(2);
  s16x4 vlo[8],vhi[8]; u32x4 pw0,pw1,pw2,pw3;
  #define PKW(P,B) cvtpk_s(P[B],P[B+1])
  #define PAF(k) __builtin_bit_cast(bf16x8,pw##k)
  #define VFR(i) (bf16x8){vlo[i][0],vlo[i][1],vlo[i][2],vlo[i][3],vhi[i][0],vhi[i][1],vhi[i][2],vhi[i][3]}
  #define PIN(x) asm volatile("":"+v"(x))
  #define MX3(a,b,c) __builtin_fmaxf(__builtin_fmaxf((a),(b)),(c))
  #define GAPA(MF,A0,A1,A2,A3,W0,W1,PW) do{ MF; sacc+=A0; sacc+=A1; sacc+=A2; sacc+=A3; PIN(sacc); W0; W1; PIN(PW); SBAR(); }while(0)
  #define EX(v) __builtin_amdgcn_exp2f(v)
  #define GAPB(MF,X,B) do{ MF; X[B]=EX(X[B]); X[B+1]=EX(X[B+1]); X[B+2]=EX(X[B+2]); X[B+3]=EX(X[B+3]); PIN(X); SBAR(); }while(0)
  #define VRD(i) do{ vlo[i]=vtr(vp_+(((i)>>2)*4096+((i)&3)*1024)); vhi[i]=vtr(vp_+(((i)>>2)*4096+((i)&3)*1024+512)); }while(0)
  #define KRD(G,j) do{ if(G){ kload2(kf,kp0+sl_next,j); SBAR(); } }while(0)
  #define STEP(C0,C1,P0,P1,t,GK,GV,GL) do{ NEGM_SET(t); SBAR(); \
    const lds_cptr vp_=vp0+sl_prev; \
    VRD(0); SBAR(); float sacc=(P0[0]+P0[1]); \
    GAPA(C0=__builtin_amdgcn_mfma_f32_32x32x16_bf16(kf[0],qr[0],negm,0,0,0), P0[2],P0[3],P0[4],P0[5],     pw0[0]=PKW(P0,0), pw0[1]=PKW(P0,2), pw0); \
    VRD(4); SBAR(); GAPA(C1=__builtin_amdgcn_mfma_f32_32x32x16_bf16(kf[1],qr[0],negm,0,0,0), P0[6],P0[7],P0[8],P0[9],     pw0[2]=PKW(P0,4), pw0[3]=PKW(P0,6), pw0); \
    VRD(1); SBAR(); GAPA(C0=__builtin_amdgcn_mfma_f32_32x32x16_bf16(kf[2],qr[1],C0,0,0,0),   P0[10],P0[11],P0[12],P0[13], pw1[0]=PKW(P0,8), pw1[1]=PKW(P0,10), pw1); \
    VRD(5); SBAR(); GAPA(C1=__builtin_amdgcn_mfma_f32_32x32x16_bf16(kf[3],qr[1],C1,0,0,0),   P0[14],P0[15],P1[0],P1[1],   pw1[2]=PKW(P0,12),pw1[3]=PKW(P0,14), pw1); \
    VRD(2); SBAR(); GAPA(C0=__builtin_amdgcn_mfma_f32_32x32x16_bf16(kf[4],qr[2],C0,0,0,0),   P1[2],P1[3],P1[4],P1[5],     pw2[0]=PKW(P1,0), pw2[1]=PKW(P1,2), pw2); \
    VRD(6); SBAR(); GAPA(C1=__builtin_amdgcn_mfma_f32_32x32x16_bf16(kf[5],qr[2],C1,0,0,0),   P1[6],P1[7],P1[8],P1[9],     pw2[2]=PKW(P1,4), pw2[3]=PKW(P1,6), pw2); \
    VRD(3); SBAR(); GAPA(C0=__builtin_amdgcn_mfma_f32_32x32x16_bf16(kf[6],qr[3],C0,0,0,0),   P1[10],P1[11],P1[12],P1[13], pw3[0]=PKW(P1,8), pw3[1]=PKW(P1,10), pw3); \
    VRD(7); SBAR(); GAPA(C1=__builtin_amdgcn_mfma_f32_32x32x16_bf16(kf[7],qr[3],C1,0,0,0),   P1[14],P1[15],0.f,0.f,       pw3[2]=PKW(P1,12),pw3[3]=PKW(P1,14), pw3); \
    l_reg+=sacc; \
    if(GK){DMA_K((t)+3,sl_cur);} if(GV){DMA_V((t)+1,sl_next);} \
    CMASK(C0,C1,t); \
    { float a=MX3(C0[0],C0[1],C1[0]),b=MX3(C0[2],C0[3],C1[1]); a=MX3(a,C1[2],C1[3]); \
      _Pragma("unroll") for(int r=4;r<16;r+=4){a=MX3(a,C0[r],C0[r+1]);b=MX3(b,C0[r+2],C0[r+3]);a=MX3(a,C1[r],C1[r+1]);b=MX3(b,C1[r+2],C1[r+3]);} \
      float rm=__builtin_fmaxf(a,b); { auto rr=__builtin_amdgcn_permlane32_swap(__float_as_uint(rm),__float_as_uint(rm),false,false); rm=__builtin_fmaxf(__uint_as_float(rr[0]),__uint_as_float(rr[1])); } \
      resc=false; \
      if(__builtin_expect(__any(rm>(float)THRL),0)){ const float dl=__builtin_fmaxf(rm,0.f); mhat+=dl; \
        _Pragma("unroll") for(int r=0;r<16;++r){C0[r]-=dl;C1[r]-=dl;} \
        const float f=__builtin_amdgcn_exp2f(-dl); l_reg*=f; if(hi==0)wsf[r32]=f; resc=true; } } \
    SBAR(); \
    GAPB(o[0]=__builtin_amdgcn_mfma_f32_32x32x16_bf16(PAF(0),VFR(0),o[0],0,0,0), C0,0); \
    GAPB(o[1]=__builtin_amdgcn_mfma_f32_32x32x16_bf16(PAF(0),VFR(4),o[1],0,0,0), C0,4); \
    KRD(GL,0); GAPB(o[0]=__builtin_amdgcn_mfma_f32_32x32x16_bf16(PAF(1),VFR(1),o[0],0,0,0), C0,8); \
    KRD(GL,1); GAPB(o[1]=__builtin_amdgcn_mfma_f32_32x32x16_bf16(PAF(1),VFR(5),o[1],0,0,0), C0,12); \
    KRD(GL,2); GAPB(o[0]=__builtin_amdgcn_mfma_f32_32x32x16_bf16(PAF(2),VFR(2),o[0],0,0,0), C1,0); \
    KRD(GL,3); GAPB(o[1]=__builtin_amdgcn_mfma_f32_32x32x16_bf16(PAF(2),VFR(6),o[1],0,0,0), C1,4); \
    GAPB(o[0]=__builtin_amdgcn_mfma_f32_32x32x16_bf16(PAF(3),VFR(3),o[0],0,0,0), C1,8); \
    GAPB(o[1]=__builtin_amdgcn_mfma_f32_32x32x16_bf16(PAF(3),VFR(7),o[1],0,0,0), C1,12); \
    }while(0)
  int t=1;
  #undef CMASK
  #define CMASK(P0,P1,t) do{}while(0)
  for(;t+5<NT;t+=2){
    STEP(pB0,pB1,pA0,pA1,t,true,true,true);     WAIT_BAR(2); RESC(); ROT();
    STEP(pA0,pA1,pB0,pB1,t+1,true,true,true);   WAIT_BAR(2); RESC(); ROT();
  }
  #undef CMASK
  #define CMASK(P0,P1,t) do{ if(MODE==1){amask<true>(P0,P1,koff+64*(t),qrel,hi);} else if(MODE==0){const int jb_=(t)-(NT-4); if(jb_>=0)amask<false>(P0,P1,64*jb_,qrel,hi);} }while(0)
  #define ENDW(tt) do{ if((tt)+3<NT){WAIT_BAR(2);} else if((tt)+2<NT){WAIT_BAR(1);} else {WAIT_BAR(0);} }while(0)
  for(;t+1<NT;t+=2){
    STEP(pB0,pB1,pA0,pA1,t,(t+3<NT),(t+1<NT),(t+1<NT));       ENDW(t);   RESC(); ROT();
    STEP(pA0,pA1,pB0,pB1,t+1,(t+4<NT),(t+2<NT),(t+2<NT));     ENDW(t+1); RESC(); ROT();
  }
  STEP(pB0,pB1,pA0,pA1,NT-1,false,false,false); RESC();
  { float sacc=pB0[0]+pB0[1]; _Pragma("unroll") for(int r=2;r<16;++r)sacc+=pB0[r]; _Pragma("unroll") for(int r=0;r<16;++r)sacc+=pB1[r]; l_reg+=sacc;
    pw0=(u32x4){PKW(pB0,0),PKW(pB0,2),PKW(pB0,4),PKW(pB0,6)};pw1=(u32x4){PKW(pB0,8),PKW(pB0,10),PKW(pB0,12),PKW(pB0,14)};pw2=(u32x4){PKW(pB1,0),PKW(pB1,2),PKW(pB1,4),PKW(pB1,6)};pw3=(u32x4){PKW(pB1,8),PKW(pB1,10),PKW(pB1,12),PKW(pB1,14)};
    SBAR(); pv(o,vb0+sl_cur,PAF(0),PAF(1),PAF(2),PAF(3)); }
  #undef PKW
  #undef PAF
  #undef VFR
  #undef PIN
  #undef MX3
  #undef GAPA
  #undef GAPB
  #undef EX
  #undef VRD
  #undef KRD
  #undef STEP
  #undef ENDW
  {auto rr=__builtin_amdgcn_permlane32_swap(__float_as_uint(l_reg),__float_as_uint(l_reg),false,false);l_reg=__uint_as_float(rr[0])+__uint_as_float(rr[1]);}
  if(MODE==1)l_reg+=__builtin_amdgcn_exp2f(sinkl2-mhat);
  float*mgs=(float*)(shm+LDS_MG)+wid*96;
  float rowscale=l_reg;
  if(MERGE){
    const long gr=(long)mio.grow0+wid*QBLK+r32; float mr[3],lr[3],ms=mhat;
    #pragma unroll
    for(int r=0;r<3;++r){ mr[r]=-INFINITY; lr[r]=0.f; if(r<mio.nsel){ const float2 v=*(const float2*)(mio.ml+(((long)r*T+gr)*8+mio.h)*2); mr[r]=v.x; lr[r]=v.y; ms=__builtin_fmaxf(ms,v.x);} }
    const float wo=__builtin_amdgcn_exp2f(mhat-ms); float L=l_reg*wo, wr_[3];
    #pragma unroll
    for(int r=0;r<3;++r){ wr_[r]=(r<mio.nsel)?__builtin_amdgcn_exp2f(mr[r]-ms):0.f; L+=lr[r]*wr_[r]; }
    const float rL=__builtin_amdgcn_rcpf(L);
    if(hi==0){ mgs[r32]=wr_[0]*rL; mgs[32+r32]=wr_[1]*rL; mgs[64+r32]=wr_[2]*rL; }
    rowscale=L*__builtin_amdgcn_rcpf(wo);
  }
  if(MODE==2)rowscale=1.0f;
  if(hi==0)wsf[32+r32]=rowscale;asm volatile("s_waitcnt lgkmcnt(0)":::"memory");
  float rli[16];
  #pragma unroll
  for(int r=0;r<16;++r)rli[r]=__builtin_amdgcn_rcpf(wsf[32+crow(r,hi)]);
  bf16*Ow=Ow0+(long)(wid*QBLK)*QP;
  { bf16*stg=(bf16*)(shm+LDS_OST)+wid*2048;
    #pragma unroll
    for(int r=0;r<16;++r){const int orow=crow(r,hi);
      #pragma unroll
      for(int d0=0;d0<2;++d0)stg[orow*64+d0*32+r32]=__float2bfloat16(o[d0][r]*rli[r]);}
    asm volatile("s_waitcnt lgkmcnt(0)":::"memory");
    if(MODE==2){
      if(hi==0&&((mio.ent>>16)&1u)){ const long gr=mio.ent&16383u; const int rs=(mio.ent>>14)&3; float2 v; v.x=mhat; v.y=l_reg; *(float2*)(mio.ml+(((long)rs*T+gr)*8+mio.h)*2)=v; }
      #pragma unroll
      for(int i=0;i<4;++i){const int row=i*8+(lane>>3),ch=lane&7; const unsigned en=(unsigned)__shfl((int)mio.ent,row); const u32x4 v=*(const u32x4*)(stg+row*64+ch*8);
        const long gr=en&16383u; const int rs=(en>>14)&3; bf16*dst=(rs<2?mio.po01+((long)rs*T+gr)*512:mio.po2+gr*512)+mio.h*64+ch*8;
        if((en>>16)&1u)*(u32x4*)dst=v; }
    } else {
      #pragma unroll
      for(int i=0;i<4;++i){const int row=i*8+(lane>>3),ch=lane&7; u32x4 v=*(const u32x4*)(stg+row*64+ch*8);
        if(MERGE){ const long gr=(long)mio.grow0+wid*QBLK+row; float acc8[8];
          acc8[0]=__uint_as_float(v.x<<16);acc8[1]=__uint_as_float(v.x&0xffff0000u);acc8[2]=__uint_as_float(v.y<<16);acc8[3]=__uint_as_float(v.y&0xffff0000u);
          acc8[4]=__uint_as_float(v.z<<16);acc8[5]=__uint_as_float(v.z&0xffff0000u);acc8[6]=__uint_as_float(v.w<<16);acc8[7]=__uint_as_float(v.w&0xffff0000u);
          #pragma unroll
          for(int r=0;r<3;++r) if(r<mio.nsel){ const float c=mgs[r*32+row]; const bf16*src=(r<2?mio.po01+((long)r*T+gr)*512:mio.po2+gr*512)+mio.h*64+ch*8; const u32x4 p=*(const u32x4*)src;
            acc8[0]+=c*__uint_as_float(p.x<<16);acc8[1]+=c*__uint_as_float(p.x&0xffff0000u);acc8[2]+=c*__uint_as_float(p.y<<16);acc8[3]+=c*__uint_as_float(p.y&0xffff0000u);
            acc8[4]+=c*__uint_as_float(p.z<<16);acc8[5]+=c*__uint_as_float(p.z&0xffff0000u);acc8[6]+=c*__uint_as_float(p.w<<16);acc8[7]+=c*__uint_as_float(p.w&0xffff0000u); }
          v.x=cvtpk_s(acc8[0],acc8[1]);v.y=cvtpk_s(acc8[2],acc8[3]);v.z=cvtpk_s(acc8[4],acc8[5]);v.w=cvtpk_s(acc8[6],acc8[7]); }
        ATTN_STORE16(Ow+(long)row*QP+ch*8,v);} } }
  asm volatile("s_waitcnt lgkmcnt(0)\n\ts_barrier":::"memory");
  #undef DMA_K
  #undef DMA_V
  #undef CMASK
  #undef START
  #undef NEGM_SET
  #undef RESC
  #undef ROT
}
constexpr int ATTN_LDS_BYTES=LDS_BYTES;
#undef SBAR
#undef WAIT_BAR
}
constexpr float ATT_C2 = 0.125f * 1.4426950408889634f;
__device__ __forceinline__ void swa_phase(const Frame& F_in, const Params& P_in, int l) {
    PH_BEGIN
    bf16* AQ = (bf16*)(P.ws + WS_R + RO_AQ); const bf16* AK = (const bf16*)(P.ws + WS_R + RO_AK); const bf16* AV = (const bf16*)(P.ws + WS_R + RO_AV);
    const float* sinks = P.in[I_SINK] + l * 8; char* shm = (char*)F.lds;
    for (int idx = F.vcu; idx < 256; idx += F.G) {
        const int bh = idx >> 4, s = idx & 15, b = bh >> 3, hq = bh & 7, hkv = hq >> 2; const float sk = sinks[hq] * 1.4426950408889634f;
        for (int i = 0; i < 2; ++i) {
            const int qb = i ? 31 - s : s; const size_t row0 = (size_t)b * SEQ + (size_t)qb * 256; const int koff = qb ? -128 : 0, NT = qb ? 6 : 4;
            attn_body::attn_unit<1, 8>((const attn_body::bf16*)(AQ + (row0 + F.wave * 32 + (F.lane & 31)) * 512 + hq * 64), (attn_body::bf16*)(AQ + row0 * 512 + hq * 64), 512,
                (const attn_body::bf16*)(AK + (size_t)((long)row0 + koff) * 128 + hkv * 64), (const attn_body::bf16*)(AV + (size_t)((long)row0 + koff) * 128 + hkv * 64), 128, NT, koff, 0u, sk, shm);
        }
    }
}
__device__ __forceinline__ int list_off(int j) { return 8192 * j - 128 * j * (j + 1); }
__device__ __forceinline__ void moba_route(const Frame& F_in, const Params& P_in, int l) {
    PH_BEGIN
    const bf16* BQ = (const bf16*)(P.ws + WS_R + RO_BQ); const float* kbp = (const float*)(P.ws + WS_KBP); const int tid = F.tid;
    unsigned* MC = (unsigned*)(P.ws + WS_CTL) + CW_MCNT + l * 512; unsigned short* LIST = (unsigned short*)(P.ws + WS_LIST);
    LAS float* kb_s = (LAS float*)(F.lds + 98304); LAS int* cnt_s = (LAS int*)(F.lds + 98304 + 8192); LAS int* base_s = cnt_s + 32; LAS float* mg = (LAS float*)(cnt_s + 64);
    for (int idx = F.vcu; idx < 256; idx += F.G) {
        const int bh = idx >> 4, s = idx & 15, b = bh >> 3, h = bh & 7;
        for (int i = 0; i < 2; ++i) {
            const int qb = i ? s : 31 - s; if (qb == 0) continue; const size_t row0 = (size_t)b * SEQ + (size_t)qb * 256;
            for (int e = tid; e < qb * 64; e += 512) { const int n = e >> 6, d = e & 63; const float* kp = kbp + ((size_t)(b * 32 + n) * 2) * 512 + h * 64 + d; kb_s[e] = kp[0] + kp[512]; }
            if (tid < 32) cnt_s[tid] = 0;
            __syncthreads();
            const int row = tid & 255, half = tid >> 8;
            const GAS v4u* qp = (const GAS v4u*)(BQ + (row0 + row) * 512 + h * 64); float q[64];
#pragma unroll
            for (int c = 0; c < 8; ++c) { const v4u w = qp[c]; q[8 * c] = bflo(w.x); q[8 * c + 1] = bfhi(w.x); q[8 * c + 2] = bflo(w.y); q[8 * c + 3] = bfhi(w.y); q[8 * c + 4] = bflo(w.z); q[8 * c + 5] = bfhi(w.z); q[8 * c + 6] = bflo(w.w); q[8 * c + 7] = bfhi(w.w); }
            float v1 = -INFINITY, v2 = -INFINITY, v3 = -INFINITY; int i1 = 64, i2 = 64, i3 = 64;
#define MB_BETTER(a, ia, b_, ib) ((a) > (b_) || ((a) == (b_) && (ia) < (ib)))
#define MB_INS(sc_, n_) do { if (MB_BETTER(sc_, n_, v1, i1)) { v3 = v2; i3 = i2; v2 = v1; i2 = i1; v1 = sc_; i1 = n_; } else if (MB_BETTER(sc_, n_, v2, i2)) { v3 = v2; i3 = i2; v2 = sc_; i2 = n_; } else if (MB_BETTER(sc_, n_, v3, i3)) { v3 = sc_; i3 = n_; } } while (0)
            for (int n = half; n < qb; n += 2) { const LAS f32x4* kr = (const LAS f32x4*)(kb_s + n * 64); float sc = 0.f;
#pragma unroll
                for (int c = 0; c < 16; ++c) { const f32x4 kv = kr[c]; sc += (q[4 * c] * kv.x + q[4 * c + 1] * kv.y) + (q[4 * c + 2] * kv.z + q[4 * c + 3] * kv.w); }
                MB_INS(sc, n); }
            if (half == 1) { LAS float* m_ = mg + row * 6; m_[0] = v1; m_[1] = v2; m_[2] = v3; m_[3] = __int_as_float(i1); m_[4] = __int_as_float(i2); m_[5] = __int_as_float(i3); }
            __syncthreads();
            const int nsel = qb < 3 ? qb : 3; int rk0 = 0, rk1 = 0, rk2 = 0;
            if (half == 0) { const LAS float* m_ = mg + row * 6;
#pragma unroll
                for (int k = 0; k < 3; ++k) { const float sc = m_[k]; const int n = __float_as_int(m_[3 + k]); if (n < 64) MB_INS(sc, n); }
                if (qb <= 3) { i1 = 0; i2 = 1; i3 = 2; }
                rk0 = atomicAdd((int*)&cnt_s[i1], 1); if (nsel > 1) rk1 = atomicAdd((int*)&cnt_s[i2], 1); if (nsel > 2) rk2 = atomicAdd((int*)&cnt_s[i3], 1); }
#undef MB_INS
#undef MB_BETTER
            __syncthreads();
            if (tid < 32) { const int c = cnt_s[tid]; base_s[tid] = c ? (int)atomicAdd(MC + bh * 32 + tid, (unsigned)c) : 0; }
            __syncthreads();
            if (half == 0) { unsigned short* lb = LIST + (size_t)bh * LIST_BH; const unsigned rl = (unsigned)(qb * 256 + row);
                lb[list_off(i1) + base_s[i1] + rk0] = (unsigned short)(rl | (0u << 13));
                if (nsel > 1) lb[list_off(i2) + base_s[i2] + rk1] = (unsigned short)(rl | (1u << 13));
                if (nsel > 2) lb[list_off(i3) + base_s[i3] + rk2] = (unsigned short)(rl | (2u << 13)); }
            __syncthreads();
        }
    }
}
__device__ __forceinline__ void moba_past(const Frame& F_in, const Params& P_in, int l) {
    PH_BEGIN
    const bf16* BQ = (const bf16*)(P.ws + WS_R + RO_BQ); const bf16* BK = (const bf16*)(P.ws + WS_R + RO_BK); const bf16* BV = (const bf16*)(P.ws + WS_R + RO_BV);
    const unsigned* MC = (const unsigned*)(P.ws + WS_CTL) + CW_MCNT + l * 512; const unsigned short* LIST = (const unsigned short*)(P.ws + WS_LIST);
    char* shm = (char*)F.lds; const int tid = F.tid; LAS int* pre_s = (LAS int*)(F.lds + 98304);
    if (tid < 496) { const int bh = tid / 31, j = tid % 31; pre_s[512 + tid] = (int)((__hip_atomic_load(MC + bh * 32 + j, __ATOMIC_RELAXED, __HIP_MEMORY_SCOPE_AGENT) + 255u) >> 8); }
    __syncthreads();
    if (tid == 0) { int run = 0; for (int p = 0; p < 496; ++p) { pre_s[p] = run; run += pre_s[512 + p]; } pre_s[496] = run; }
    __syncthreads();
    const int U = pre_s[496];
    attn_body::MobaIO io{}; io.po01 = (attn_body::bf16*)((unsigned char*)P.out + 32 * MiB); io.po2 = (attn_body::bf16*)(P.ws + WS_PO2); io.ml = (float*)(P.ws + WS_ML);
    for (int u = F.vcu; u < U; u += F.G) {
        int lo = 0, hi_ = 495;
        while (lo < hi_) { const int mid = (lo + hi_ + 1) >> 1; if (pre_s[mid] <= u) lo = mid; else hi_ = mid - 1; }
        const int p = lo, bh = p / 31, j = p % 31, chunk = u - pre_s[p], b = bh >> 3, h = bh & 7; const int cnt = (int)__hip_atomic_load(MC + bh * 32 + j, __ATOMIC_RELAXED, __HIP_MEMORY_SCOPE_AGENT);
        const int ei = chunk * 256 + F.wave * 32 + (F.lane & 31); const bool valid = ei < cnt;
        const unsigned e = LIST[(size_t)bh * LIST_BH + list_off(j) + (valid ? ei : 0)]; const unsigned rl = e & 8191u, rs = e >> 13;
        const size_t grow = (size_t)b * SEQ + rl;
        io.h = h; io.ent = (unsigned)grow | (rs << 14) | ((valid ? 1u : 0u) << 16);
        attn_body::attn_unit<2, 0>((const attn_body::bf16*)(BQ + grow * 512 + h * 64), nullptr, 512,
            (const attn_body::bf16*)(BK + ((size_t)b * SEQ + (size_t)j * 256) * 512 + h * 64), (const attn_body::bf16*)(BV + ((size_t)b * SEQ + (size_t)j * 256) * 512 + h * 64), 512, 4, 0, 0u, 0.f, shm, io);
    }
}
__device__ __forceinline__ void moba_own(const Frame& F_in, const Params& P_in) {
    PH_BEGIN
    bf16* BQ = (bf16*)(P.ws + WS_R + RO_BQ); const bf16* BK = (const bf16*)(P.ws + WS_R + RO_BK); const bf16* BV = (const bf16*)(P.ws + WS_R + RO_BV); char* shm = (char*)F.lds;
    attn_body::MobaIO io{}; io.po01 = (attn_body::bf16*)((unsigned char*)P.out + 32 * MiB); io.po2 = (attn_body::bf16*)(P.ws + WS_PO2); io.ml = (float*)(P.ws + WS_ML);
    for (int idx = F.vcu; idx < 512; idx += F.G) {
        const int bh = idx >> 5, qb = idx & 31, b = bh >> 3, h = bh & 7; const size_t row0 = (size_t)b * SEQ + (size_t)qb * 256;
        io.h = h; io.nsel = qb < 3 ? qb : 3; io.grow0 = (int)row0;
        attn_body::attn_unit<0, 8, true>((const attn_body::bf16*)(BQ + (row0 + F.wave * 32 + (F.lane & 31)) * 512 + h * 64), (attn_body::bf16*)(BQ + row0 * 512 + h * 64), 512,
            (const attn_body::bf16*)(BK + row0 * 512 + h * 64), (const attn_body::bf16*)(BV + row0 * 512 + h * 64), 512, 4, 0, 0u, 0.f, shm, io);
    }
}
namespace epi {
using pg8::f32x4; using pg8::Unit; using pg8::u32x4; using pg8::cvt_pk_bf16;
typedef const f32x4 (&Acc)[2][2][4][2];
__device__ __forceinline__ float sigmoidf_(float x) { return __builtin_amdgcn_rcpf(1.0f + __builtin_amdgcn_exp2f(-1.4426950408889634f * x)); }
__device__ __forceinline__ float siluf_(float x) { return x * __builtin_amdgcn_rcpf(1.0f + __builtin_amdgcn_exp2f(-1.4426950408889634f * x)); }
__device__ __forceinline__ float logsigmoidf_(float x) { return fminf(x, 0.f) - 0.6931471805599453f * __builtin_amdgcn_logf(1.0f + __builtin_amdgcn_exp2f(-1.4426950408889634f * fabsf(x))); }
__device__ __forceinline__ u32x4 pack8(const f32x4& a, const f32x4& b) { u32x4 w; w.x = cvt_pk_bf16(a[0], a[1]); w.y = cvt_pk_bf16(a[2], a[3]); w.z = cvt_pk_bf16(b[0], b[1]); w.w = cvt_pk_bf16(b[2], b[3]); return w; }
__device__ __forceinline__ void unpack8(const u32x4& w, f32x4& a, f32x4& b) { a = (f32x4){bflo(w.x), bfhi(w.x), bflo(w.y), bfhi(w.y)}; b = (f32x4){bflo(w.z), bfhi(w.z), bflo(w.w), bfhi(w.w)}; }
__device__ __forceinline__ unsigned pack4_u8(const f32x4& a) { const f32x4 t = a * 255.0f + 0.5f; return (unsigned)t[0] | ((unsigned)t[1] << 8) | ((unsigned)t[2] << 16) | ((unsigned)t[3] << 24); }
__device__ __forceinline__ f32x4 unpack4_u8(unsigned w) { return (f32x4){(float)(w & 0xffu), (float)((w >> 8) & 0xffu), (float)((w >> 16) & 0xffu), (float)(w >> 24)} * (1.0f / 255.0f); }
__device__ __forceinline__ float row_rs(const float* ssq, int row) {
    const f32x4* p = (const f32x4*)(ssq + (size_t)row * 16); const f32x4 a = p[0], b = p[1], c = p[2], d = p[3];
    const float s = ((a[0] + a[1]) + (a[2] + a[3])) + ((b[0] + b[1]) + (b[2] + b[3])) + ((c[0] + c[1]) + (c[2] + c[3])) + ((d[0] + d[1]) + (d[2] + d[3]));
    return __builtin_amdgcn_rsqf(s * (1.0f / DM) + RMS_EPS);
}

constexpr int RS_OFF = LDSCTL_OFF + 12288;
__device__ __forceinline__ const LAS float* stage_rs(const float* ssq, const float* rsg, int pm, LAS unsigned char* lb) {
    LAS float* rs_s = (LAS float*)(lb + RS_OFF); const int t = threadIdx.x;
    if (t < 256) { const int row = pm * 256 + t; rs_s[t] = rsg ? rsg[row] : row_rs(ssq, row); }
    asm volatile("s_waitcnt lgkmcnt(0)" ::: "memory"); __builtin_amdgcn_s_barrier(); asm volatile("" ::: "memory");
    return rs_s;
}
struct EpiInproj {
    static constexpr bool PERM = true;
    unsigned char* R; const float* ssq; const float* gbias; float* kbp; LAS unsigned char* lb; unsigned char* Gab; unsigned char* Gc;
    template <int ACT, bool KSUM>
    __device__ __forceinline__ void store_half(Acc acc, const int bj, bf16* dst, const int ldc, const int col, const Unit& u, int wr, int fr, const LAS float* rs_s, const float sc = 1.0f) const {
        f32x4 ks0 = (f32x4){0.f, 0.f, 0.f, 0.f}, ks1 = ks0;
#pragma unroll
        for (int ai = 0; ai < 2; ++ai)
#pragma unroll
            for (int m = 0; m < 4; ++m) {
                const int row = u.pm * 256 + ai * 128 + wr * 64 + m * 16 + fr; const float rs = rs_s[ai * 128 + wr * 64 + m * 16 + fr] * sc;
                f32x4 v0 = acc[ai][bj][m][0] * rs, v1 = acc[ai][bj][m][1] * rs;
                if (ACT == 1) {
#pragma unroll
                    for (int i = 0; i < 4; ++i) { v0[i] = siluf_(v0[i]); v1[i] = siluf_(v1[i]); }
                }
                if (KSUM) { ks0 += v0; ks1 += v1; }
                *(u32x4*)(dst + (size_t)row * ldc + col) = pack8(v0, v1);
            }
        if (KSUM) {
#pragma unroll
            for (int i = 0; i < 4; ++i) {
#pragma unroll
                for (int o = 1; o < 16; o <<= 1) { ks0[i] += __shfl_xor(ks0[i], o); ks1[i] += __shfl_xor(ks1[i], o); }
            }
            if (fr == 0) { float* kp = kbp + ((size_t)u.pm * 2 + wr) * 512 + col; *(f32x4*)kp = ks0; *(f32x4*)(kp + 4) = ks1; }
        }
    }
    __device__ __forceinline__ void operator()(Acc acc, const Unit& u, int wr, int wc, int fr, int fq) const {
        const int pn = u.pn; const int c0 = wc * 32 + 8 * fq;
        const LAS float* rs_s = stage_rs(ssq, nullptr, u.pm, lb);
        if (pn >= 16) {
            const int g = pn - 16, br = g >> 2; unsigned char* dst = br < 2 ? Gab + br * 1024 + (g & 3) * 256 : Gc + (g & 3) * 256; const int ldc = br < 2 ? 2048 : 1024;
#pragma unroll
            for (int ai = 0; ai < 2; ++ai)
#pragma unroll
                for (int m = 0; m < 4; ++m) {
                    const int row = u.pm * 256 + ai * 128 + wr * 64 + m * 16 + fr; const float rs = rs_s[ai * 128 + wr * 64 + m * 16 + fr];
#pragma unroll
                    for (int bj = 0; bj < 2; ++bj) { f32x4 v0 = acc[ai][bj][m][0] * rs, v1 = acc[ai][bj][m][1] * rs;
#pragma unroll
                        for (int i = 0; i < 4; ++i) { v0[i] = sigmoidf_(v0[i]); v1[i] = sigmoidf_(v1[i]); }
                        *(pg8::u32x2*)(dst + (size_t)row * ldc + bj * 128 + c0) = (pg8::u32x2){pack4_u8(v0), pack4_u8(v1)}; }
                }
        } else if (pn == 15) {
#pragma unroll
            for (int bj = 0; bj < 2; ++bj) { const int col = bj * 128 + c0; const f32x4 b0 = *(const f32x4*)(gbias + col), b1 = *(const f32x4*)(gbias + col + 4);
#pragma unroll
                for (int ai = 0; ai < 2; ++ai)
#pragma unroll
                    for (int m = 0; m < 4; ++m) {
                        const int row = u.pm * 256 + ai * 128 + wr * 64 + m * 16 + fr; const float rs = rs_s[ai * 128 + wr * 64 + m * 16 + fr];
                        f32x4 v0 = acc[ai][bj][m][0] * rs + b0, v1 = acc[ai][bj][m][1] * rs + b1;
#pragma unroll
                        for (int i = 0; i < 4; ++i) { v0[i] = logsigmoidf_(v0[i]) * (1.0f / 16.0f); v1[i] = logsigmoidf_(v1[i]) * (1.0f / 16.0f); }
                        float* gl = (float*)(R + RO_GL) + (size_t)row * 256 + col; *(f32x4*)gl = v0; *(f32x4*)(gl + 4) = v1;
                    } }
        } else if (pn == 5 || pn == 6) {
            bf16* dst = (bf16*)(R + RO_BK); const int cb = (pn - 5) * 256 + c0;
            store_half<0, true>(acc, 0, dst, 512, cb, u, wr, fr, rs_s); store_half<0, true>(acc, 1, dst, 512, cb + 128, u, wr, fr, rs_s);
        } else if (pn == 13 || pn == 14) {
            bf16* dst = (bf16*)(R + RO_CR); const int cb = (pn - 13) * 256 + c0;
            store_half<1, false>(acc, 0, dst, 512, cb, u, wr, fr, rs_s); store_half<1, false>(acc, 1, dst, 512, cb + 128, u, wr, fr, rs_s);
        } else if (pn == 2) {
            store_half<0, false>(acc, 0, (bf16*)(R + RO_AK), 128, c0, u, wr, fr, rs_s); store_half<0, false>(acc, 1, (bf16*)(R + RO_AV), 128, c0, u, wr, fr, rs_s);
        } else {
            bf16* dst; int ldc, cb; float sc = 1.0f;
            if (pn < 2)        { dst = (bf16*)(R + RO_AQ); ldc = 512; cb = pn * 256; sc = ATT_C2; }
            else if (pn < 5)   { dst = (bf16*)(R + RO_BQ); ldc = 512; cb = (pn - 3) * 256; sc = ATT_C2; }
            else if (pn < 9)   { dst = (bf16*)(R + RO_BV); ldc = 512; cb = (pn - 7) * 256; }
            else if (pn == 9)  { dst = (bf16*)(R + RO_CQ); ldc = 256; cb = 0; }
            else if (pn == 10) { dst = (bf16*)(R + RO_CK); ldc = 256; cb = 0; }
            else               { dst = (bf16*)(R + RO_CV); ldc = 512; cb = (pn - 11) * 256; }
            store_half<0, false>(acc, 0, dst, ldc, cb + c0, u, wr, fr, rs_s, sc); store_half<0, false>(acc, 1, dst, ldc, cb + c0 + 128, u, wr, fr, rs_s, sc);
        }
    }
};
struct EpiBranch {
    static constexpr bool PERM = true;
    const unsigned char* Gab; const unsigned char* Gc; bf16* Y;
    __device__ __forceinline__ void operator()(Acc acc, const Unit& u, int wr, int wc, int fr, int fq) const {
        const int seg = u.aux;
#pragma unroll
        for (int ai = 0; ai < 2; ++ai)
#pragma unroll
            for (int m = 0; m < 4; ++m) {
                const int row = u.pm * 256 + ai * 128 + wr * 64 + m * 16 + fr;
#pragma unroll
                for (int bj = 0; bj < 2; ++bj) { const int col = u.pn * 256 + bj * 128 + wc * 32 + 8 * fq;
                    const pg8::u32x2 gw = *(const pg8::u32x2*)(seg < 2 ? Gab + (size_t)row * 2048 + seg * DM + col : Gc + (size_t)row * DM + col); const f32x4 g0 = unpack4_u8(gw.x), g1 = unpack4_u8(gw.y);
                    f32x4 y0 = acc[ai][bj][m][0] * g0, y1 = acc[ai][bj][m][1] * g1;
                    bf16* yp = Y + (size_t)row * DM + col;
                    if (seg > 0) { const u32x4 ow = *(const u32x4*)yp; f32x4 o0, o1; unpack8(ow, o0, o1); y0 += o0; y1 += o1; }
                    *(u32x4*)yp = pack8(y0, y1); }
            }
    }
};
struct EpiResid {
    static constexpr bool PERM = true;
    bf16* XB; float* ssq;
    __device__ __forceinline__ void operator()(Acc acc, const Unit& u, int wr, int wc, int fr, int fq) const {
#pragma unroll
        for (int ai = 0; ai < 2; ++ai)
#pragma unroll
            for (int m = 0; m < 4; ++m) {
                const int row = u.pm * 256 + ai * 128 + wr * 64 + m * 16 + fr; float s = 0.f;
#pragma unroll
                for (int bj = 0; bj < 2; ++bj) { bf16* xp = XB + (size_t)row * DM + u.pn * 256 + bj * 128 + wc * 32 + 8 * fq;
                    f32x4 x0, x1; unpack8(*(const u32x4*)xp, x0, x1); x0 += acc[ai][bj][m][0]; x1 += acc[ai][bj][m][1];
                    *(u32x4*)xp = pack8(x0, x1);
                    s += ((x0[0] * x0[0] + x0[1] * x0[1]) + (x0[2] * x0[2] + x0[3] * x0[3])) + ((x1[0] * x1[0] + x1[1] * x1[1]) + (x1[2] * x1[2] + x1[3] * x1[3])); }
                s += __shfl_xor(s, 16); s += __shfl_xor(s, 32);
                if (fq == 0) ssq[(size_t)row * 16 + u.pn * 4 + wc] = s;
            }
    }
};
struct EpiSwiglu {
    static constexpr bool PERM = true;
    bf16* H; int ldh; const float* ssq; const float* rsg; LAS unsigned char* lb;
    __device__ __forceinline__ void operator()(Acc acc, const Unit& u, int wr, int wc, int fr, int fq) const {
        const LAS float* rs_s = stage_rs(ssq, rsg, u.pm, lb);
#pragma unroll
        for (int ai = 0; ai < 2; ++ai)
#pragma unroll
            for (int m = 0; m < 4; ++m) {
                const int row = u.pm * 256 + ai * 128 + wr * 64 + m * 16 + fr; const float rs = rs_s[ai * 128 + wr * 64 + m * 16 + fr];
                f32x4 g0 = acc[ai][0][m][0] * rs, g1 = acc[ai][0][m][1] * rs; const f32x4 u0 = acc[ai][1][m][0] * rs, u1 = acc[ai][1][m][1] * rs;
#pragma unroll
                for (int i = 0; i < 4; ++i) { g0[i] = siluf_(g0[i]) * u0[i]; g1[i] = siluf_(g1[i]) * u1[i]; }
                *(u32x4*)(H + (size_t)row * ldh + u.aux * 128 + wc * 32 + 8 * fq) = pack8(g0, g1);
            }
    }
};
struct EpiMoeDown {
    static constexpr bool PERM = true;
    bf16* YE; const float* pw;
    __device__ __forceinline__ void operator()(Acc acc, const Unit& u, int wr, int wc, int fr, int fq) const {
#pragma unroll
        for (int ai = 0; ai < 2; ++ai)
#pragma unroll
            for (int m = 0; m < 4; ++m) {
                const int row = u.pm * 256 + ai * 128 + wr * 64 + m * 16 + fr; const float p = pw[row];
#pragma unroll
                for (int bj = 0; bj < 2; ++bj) *(u32x4*)(YE + (size_t)row * DM + u.pn * 256 + bj * 128 + wc * 32 + 8 * fq) = pack8(acc[ai][bj][m][0] * p, acc[ai][bj][m][1] * p);
            }
    }
};
}
__device__ __forceinline__ float rdl(float v, int l) { return __builtin_bit_cast(float, __builtin_amdgcn_readlane(__builtin_bit_cast(int, v), l)); }
__device__ __forceinline__ float qdot64(float q, const bf16* p) {
    const GAS v4u* kp = (const GAS v4u*)p; float s = 0.f;
#pragma unroll
    for (int c = 0; c < 8; ++c) { const v4u w = kp[c];
        s += rdl(q, 8 * c + 0) * bflo(w.x) + rdl(q, 8 * c + 1) * bfhi(w.x) + rdl(q, 8 * c + 2) * bflo(w.y) + rdl(q, 8 * c + 3) * bfhi(w.y)
           + rdl(q, 8 * c + 4) * bflo(w.z) + rdl(q, 8 * c + 5) * bfhi(w.z) + rdl(q, 8 * c + 6) * bflo(w.w) + rdl(q, 8 * c + 7) * bfhi(w.w); }
    return s;
}
__device__ __forceinline__ float pv64(float o, float p, const bf16* V, size_t row0, int ldv, int vcol, int lane) {
#pragma unroll 16
    for (int j = 0; j < 64; ++j) o += rdl(p, j) * bf2f(V[(row0 + j) * ldv + vcol + lane]);
    return o;
}

__device__ __forceinline__ void swa_naive(const Frame& F_in, const Params& P_in, int l, int gw, int NGW) {
    PH_BEGIN
    bf16* AQ = (bf16*)(P.ws + WS_R + RO_AQ); const bf16* AK = (const bf16*)(P.ws + WS_R + RO_AK); const bf16* AV = (const bf16*)(P.ws + WS_R + RO_AV);
    const float* sinks = P.in[I_SINK] + l * 8; const int lane = F.lane;
    for (int item = gw; item < T * 8; item += NGW) {
        const int t = item >> 3, hq = item & 7, hkv = hq >> 2, tl = t & (SEQ - 1); const size_t rb = (size_t)(t - tl);
        const float q = bf2f(AQ[(size_t)t * 512 + hq * 64 + lane]) * 0.125f;
        const int kA = tl - 127 + lane, kB = tl - 63 + lane; const bool vA = kA >= 0, vB = kB >= 0;
        const int kA0 = tl - 127 < 0 ? 0 : tl - 127, kB0 = tl - 63 < 0 ? 0 : tl - 63;
        float sA = qdot64(q, AK + (rb + (vA ? kA : 0)) * 128 + hkv * 64), sB = qdot64(q, AK + (rb + (vB ? kB : 0)) * 128 + hkv * 64);
        sA = vA ? sA : -INFINITY; sB = vB ? sB : -INFINITY;
        const float sink = sinks[hq];
        const float m = fmaxf(wave_max(fmaxf(sA, sB)), sink);
        const float pA = vA ? __expf(sA - m) : 0.f, pB = vB ? __expf(sB - m) : 0.f;
        const float den = wave_sum(pA + pB) + __expf(sink - m);
        float o = 0.f;
        if (tl >= 127) { o = pv64(o, pA, AV, rb + tl - 127, 128, hkv * 64, lane); o = pv64(o, pB, AV, rb + tl - 63, 128, hkv * 64, lane); }
        else {
#pragma unroll 8
            for (int j = 0; j < 64; ++j) { const int ka = tl - 127 + j, kb = tl - 63 + j;
                o += rdl(pA, j) * bf2f(AV[(rb + (ka < 0 ? 0 : ka)) * 128 + hkv * 64 + lane]) + rdl(pB, j) * bf2f(AV[(rb + (kb < 0 ? 0 : kb)) * 128 + hkv * 64 + lane]); }
        }
        (void)kA0; (void)kB0;
        AQ[(size_t)t * 512 + hq * 64 + lane] = (bf16)f2bf(o / den);
    }
}

__device__ __forceinline__ void moba_naive(const Frame& F_in, const Params& P_in, int gw, int NGW) {
    PH_BEGIN
    bf16* BQ = (bf16*)(P.ws + WS_R + RO_BQ); const bf16* BK = (const bf16*)(P.ws + WS_R + RO_BK); const bf16* BV = (const bf16*)(P.ws + WS_R + RO_BV);
    const float* kbp = (const float*)(P.ws + WS_KBP); const int lane = F.lane;
    for (int item = gw; item < T * 8; item += NGW) {
        const int t = item >> 3, h = item & 7, b = t >> 13, tl = t & (SEQ - 1), cur = tl >> 8; const size_t rb = (size_t)b * SEQ;
        const float q = bf2f(BQ[(size_t)t * 512 + h * 64 + lane]);
        float gs = -INFINITY;
        { const int n = lane < cur ? lane : 0; const float* k0 = kbp + ((size_t)(b * 32 + n) * 2) * 512 + h * 64; float s = 0.f;
#pragma unroll 8
          for (int d = 0; d < 64; ++d) s += rdl(q, d) * (k0[d] + k0[512 + d]);
          if (lane < cur) gs = s * (1.0f / 256.0f); }
        const int nsel = cur < 3 ? cur : 3; int s0 = 0, s1 = 0, s2 = 0;
        for (int r = 0; r < nsel; ++r) { const float mx = wave_max(gs); const unsigned long long bal = __ballot(gs == mx); const int j = __ffsll((long long)bal) - 1;
            if (r == 0) s0 = j; else if (r == 1) s1 = j; else s2 = j; if (lane == j) gs = -INFINITY; }
        float m = -INFINITY, lsum = 0.f, o = 0.f; const float qs = q * 0.125f;
        for (int i = 0; i <= nsel; ++i) {
            const bool own = (i == nsel); const int blk = own ? cur : (i == 0 ? s0 : (i == 1 ? s1 : s2));
            for (int tile = 0; tile < 4; ++tile) {
                const int kp0 = blk * 256 + tile * 64; if (own && kp0 > tl) break;
                const int kpos = kp0 + lane; const bool valid = !own || kpos <= tl;
                float s = qdot64(qs, BK + (rb + kpos) * 512 + h * 64); s = valid ? s : -INFINITY;
                const float mn = fmaxf(m, wave_max(s)); const float sc = __expf(m - mn); const float p = valid ? __expf(s - mn) : 0.f;
                lsum = lsum * sc + wave_sum(p); o = pv64(o * sc, p, BV, rb + kp0, 512, h * 64, lane); m = mn;
            }
        }
        BQ[(size_t)t * 512 + h * 64 + lane] = (bf16)f2bf(o / lsum);
    }
}

__device__ __forceinline__ void gla_cumsum(const float* GL, size_t t0, int h, LAS float* bcum, int tid) {
    if (tid < 64) { float run = 0.f;
#pragma unroll 8
        for (int s = 0; s < 64; ++s) { run += GL[(t0 + s) * 256 + h * 64 + tid]; bcum[s * 64 + tid] = run; } }
}
__device__ __forceinline__ void gla_pass1(const Frame& F_in, const Params& P_in) {
    PH_BEGIN
    const float* GL = (const float*)(P.ws + WS_R + RO_GL); const bf16* CK = (const bf16*)(P.ws + WS_R + RO_CK); const bf16* CV = (const bf16*)(P.ws + WS_R + RO_CV);
    float* S = (float*)(P.ws + WS_S); float* DEC = (float*)(P.ws + WS_DEC);
    LAS float* bcum = (LAS float*)(F.lds); LAS float* kd = bcum + 4096; LAS float* vv = kd + 4096; const int tid = F.tid;
    for (int unit = F.vcu; unit < 8 * 128; unit += F.G) {
        const int bh = unit >> 7, n = unit & 127, b = bh >> 2, h = bh & 3; const size_t t0 = (size_t)b * SEQ + n * 64;
        gla_cumsum(GL, t0, h, bcum, tid);
        __syncthreads();
        for (int idx = tid; idx < 4096; idx += 512) { const int s = idx >> 6, d = idx & 63; kd[idx] = bf2f(CK[(t0 + s) * 256 + h * 64 + d]) * __expf(bcum[63 * 64 + d] - bcum[idx]); }
        for (int idx = tid; idx < 8192; idx += 512) { const int s = idx >> 7, e = idx & 127; vv[idx] = bf2f(CV[(t0 + s) * 512 + h * 128 + e]); }
        __syncthreads();
        { const int d = tid >> 3, e0 = (tid & 7) * 16; float a[16];
#pragma unroll
          for (int j = 0; j < 16; ++j) a[j] = 0.f;
          for (int s = 0; s < 64; ++s) { const float kv = kd[s * 64 + d];
#pragma unroll
              for (int j = 0; j < 16; ++j) a[j] += kv * vv[s * 128 + e0 + j]; }
          float* so = S + (((size_t)bh * 128 + n) * 64 + d) * 128 + e0;
#pragma unroll
          for (int j = 0; j < 16; j += 4) *(f32x4*)(so + j) = (f32x4){a[j], a[j + 1], a[j + 2], a[j + 3]};
          if (tid < 64) DEC[((size_t)bh * 128 + n) * 64 + tid] = __expf(bcum[63 * 64 + tid]); }
        __syncthreads();
    }
}
__device__ __forceinline__ void gla_scan(const Frame& F_in, const Params& P_in) {
    PH_BEGIN
    float* S = (float*)(P.ws + WS_S); const float* DEC = (const float*)(P.ws + WS_DEC);
    if (F.tid >= 256) return;
    for (int grp = F.vcu; grp < 256; grp += F.G) {
        const int idx = grp * 256 + F.tid, bh = idx >> 13, d = (idx >> 7) & 63, e = idx & 127;
        float* sp = S + ((size_t)bh * 128 * 64 + d) * 128 + e; const float* dp = DEC + (size_t)bh * 128 * 64 + d; float st = 0.f;
        for (int n0 = 0; n0 < 128; n0 += 32) { float u[32], dc[32];
#pragma unroll
            for (int j = 0; j < 32; ++j) { u[j] = sp[(size_t)(n0 + j) * 8192]; dc[j] = dp[(n0 + j) * 64]; }
#pragma unroll
            for (int j = 0; j < 32; ++j) { sp[(size_t)(n0 + j) * 8192] = st; st = dc[j] * st + u[j]; } }
    }
}
__device__ __forceinline__ void gla_pass3(const Frame& F_in, const Params& P_in, int l) {
    PH_BEGIN
    const float* GL = (const float*)(P.ws + WS_R + RO_GL); const bf16* CQ = (const bf16*)(P.ws + WS_R + RO_CQ); const bf16* CK = (const bf16*)(P.ws + WS_R + RO_CK); const bf16* CV = (const bf16*)(P.ws + WS_R + RO_CV);
    bf16* CR = (bf16*)(P.ws + WS_R + RO_CR); const float* S = (const float*)(P.ws + WS_S); const float* gng = P.in[I_GNG] + l * 512;
    LAS float* bcum = (LAS float*)(F.lds); LAS float* qin = bcum + 4096; LAS float* kin = qin + 4096; LAS float* am = kin + 4096; LAS float* vv = am + 4096; LAS float* sp = vv + 8192; const int tid = F.tid;
    for (int unit = F.vcu; unit < 8 * 128; unit += F.G) {
        const int bh = unit >> 7, n = unit & 127, b = bh >> 2, h = bh & 3; const size_t t0 = (size_t)b * SEQ + n * 64;
        gla_cumsum(GL, t0, h, bcum, tid);
        __syncthreads();
        for (int idx = tid; idx < 4096; idx += 512) { const int s = idx >> 6, d = idx & 63; const float bb = bcum[idx];
            qin[idx] = bf2f(CQ[(t0 + s) * 256 + h * 64 + d]) * 0.125f * __expf(bb); kin[idx] = bf2f(CK[(t0 + s) * 256 + h * 64 + d]) * __expf(-bb); }
        for (int idx = tid; idx < 8192; idx += 512) { const int s = idx >> 7, e = idx & 127; vv[idx] = bf2f(CV[(t0 + s) * 512 + h * 128 + e]); sp[idx] = S[(((size_t)bh * 128 + n) * 64) * 128 + idx]; }
        __syncthreads();
        for (int idx = tid; idx < 4096; idx += 512) { const int tt = idx >> 6, s = idx & 63; float a = 0.f;
            if (s <= tt) {
#pragma unroll 8
                for (int d = 0; d < 64; ++d) a += qin[tt * 64 + d] * kin[s * 64 + d]; }
            am[idx] = a; }
        __syncthreads();
        { const int tt = tid >> 3, e0 = (tid & 7) * 16; float o[16];
#pragma unroll
          for (int j = 0; j < 16; ++j) o[j] = 0.f;
          for (int s = 0; s <= tt; ++s) { const float a = am[tt * 64 + s];
#pragma unroll
              for (int j = 0; j < 16; ++j) o[j] += a * vv[s * 128 + e0 + j]; }
          for (int d = 0; d < 64; ++d) { const float qv = qin[tt * 64 + d];
#pragma unroll
              for (int j = 0; j < 16; ++j) o[j] += qv * sp[d * 128 + e0 + j]; }
          float ms = 0.f;
#pragma unroll
          for (int j = 0; j < 16; ++j) ms += o[j] * o[j];
          ms += __shfl_xor(ms, 1); ms += __shfl_xor(ms, 2); ms += __shfl_xor(ms, 4);
          const float rinv = 1.0f / sqrtf(ms * (1.0f / 128.0f) + RMS_EPS);
          bf16* crp = CR + (t0 + tt) * 512 + h * 128 + e0;
#pragma unroll
          for (int j = 0; j < 16; ++j) crp[j] = (bf16)f2bf(o[j] * rinv * gng[h * 128 + e0 + j] * bf2f(crp[j])); }
        __syncthreads();
    }
}
namespace gla {
typedef short bf16x8 __attribute__((ext_vector_type(8)));
typedef float f32x16 __attribute__((ext_vector_type(16)));
constexpr int PITCH = 72;
constexpr int OFF_TOT = 0;
constexpr int OFF_Q = 2048;
constexpr int OFF_K = OFF_Q + 64 * PITCH * 2;
constexpr int OFF_V = OFF_K + 64 * PITCH * 2;
constexpr int OFF_ST = OFF_V + 128 * PITCH * 2;
constexpr int OFF_A = OFF_ST + 128 * PITCH * 2;
constexpr int OFF_O = OFF_A + 8 * 32 * PITCH * 2;
constexpr int OPITCH = 132;
static_assert(OFF_O + 64 * OPITCH * 4 <= RING_BYTES, "gla lds");
__device__ __forceinline__ int crow(int r, int hf) { return (r & 3) + 8 * (r >> 2) + 4 * hf; }
__device__ __forceinline__ bf16x8 ldfrag(const LAS unsigned char* base, int row, int k) { return *(const LAS bf16x8*)(base + (row * PITCH + k) * 2); }

__device__ __forceinline__ void chunk_cumsum(const float* GL, size_t t0, int h, LAS unsigned char* lds, int tid, float (&b)[8], float& blast) {
    const int d = tid & 63, seg = tid >> 6; LAS float* tot = (LAS float*)(lds + OFF_TOT);
    float run = 0.f;
#pragma unroll
    for (int i = 0; i < 8; ++i) { run += GL[(t0 + seg * 8 + i) * 256 + h * 64 + d]; b[i] = run; }
    tot[seg * 64 + d] = run;
    __syncthreads();
    float off = 0.f, all = 0.f;
#pragma unroll
    for (int s = 0; s < 8; ++s) { const float v = tot[s * 64 + d]; all += v; if (s < seg) off += v; }
#pragma unroll
    for (int i = 0; i < 8; ++i) b[i] += off;
    blast = all;
}
__device__ __forceinline__ void stage_vT(const bf16* CV, size_t t0, int h, LAS unsigned char* lds, int tid) {
#pragma unroll
    for (int it = 0; it < 2; ++it) { const int item = tid + 512 * it, e = item & 127, sg = item >> 7;
        unsigned short v[8];
#pragma unroll
        for (int i = 0; i < 8; ++i) v[i] = CV[(t0 + sg * 8 + i) * 512 + h * 128 + e];
        v4u w; w.x = v[0] | ((unsigned)v[1] << 16); w.y = v[2] | ((unsigned)v[3] << 16); w.z = v[4] | ((unsigned)v[5] << 16); w.w = v[6] | ((unsigned)v[7] << 16);
        *(LAS v4u*)(lds + OFF_V + (e * PITCH + sg * 8) * 2) = w; }
}

__device__ __forceinline__ void pass1(const Frame& F_in, const Params& P_in) {
    PH_BEGIN
    const float* GL = (const float*)(P.ws + WS_R + RO_GL); const bf16* CK = (const bf16*)(P.ws + WS_R + RO_CK); const bf16* CV = (const bf16*)(P.ws + WS_R + RO_CV);
    float* S = (float*)(P.ws + WS_S); float* DEC = (float*)(P.ws + WS_DEC);
    LAS unsigned char* lds = F.lds; const int tid = F.tid, lane = F.lane, r = lane & 31, hf = lane >> 5, w = F.wave, mt = w >> 2, nt = w & 3;
    for (int unit = F.vcu; unit < 8 * 128; unit += F.G) {
        const int bh = unit >> 7, n = unit & 127, b_ = bh >> 2, h = bh & 3; const size_t t0 = (size_t)b_ * SEQ + n * 64;
        float b[8], blast; chunk_cumsum(GL, t0, h, lds, tid, b, blast);
        { const int d = tid & 63, seg = tid >> 6; unsigned pk[4];
#pragma unroll
          for (int i = 0; i < 8; i += 2) { const float k0 = bf2f(CK[(t0 + seg * 8 + i) * 256 + h * 64 + d]) * __expf(blast - b[i]), k1 = bf2f(CK[(t0 + seg * 8 + i + 1) * 256 + h * 64 + d]) * __expf(blast - b[i + 1]); pk[i >> 1] = pk2(k0, k1); }
          *(LAS v4u*)(lds + OFF_Q + (d * PITCH + seg * 8) * 2) = (v4u){pk[0], pk[1], pk[2], pk[3]};
          if (seg == 0) DEC[((size_t)bh * 128 + n) * 64 + d] = __expf(blast); }
        stage_vT(CV, t0, h, lds, tid);
        __syncthreads();
        f32x16 acc = f32x16{};
#pragma unroll
        for (int ks = 0; ks < 4; ++ks) acc = __builtin_amdgcn_mfma_f32_32x32x16_bf16(ldfrag(lds + OFF_Q, mt * 32 + r, ks * 16 + 8 * hf), ldfrag(lds + OFF_V, nt * 32 + r, ks * 16 + 8 * hf), acc, 0, 0, 0);
        float* so = S + (((size_t)bh * 128 + n) * 64 + mt * 32) * 128 + nt * 32 + r;
#pragma unroll
        for (int g = 0; g < 16; ++g) so[(size_t)crow(g, hf) * 128] = acc[g];
        __syncthreads();
    }
}
__device__ __forceinline__ void pass3(const Frame& F_in, const Params& P_in, int l) {
    PH_BEGIN
    const float* GL = (const float*)(P.ws + WS_R + RO_GL); const bf16* CQ = (const bf16*)(P.ws + WS_R + RO_CQ); const bf16* CK = (const bf16*)(P.ws + WS_R + RO_CK); const bf16* CV = (const bf16*)(P.ws + WS_R + RO_CV);
    bf16* CR = (bf16*)(P.ws + WS_R + RO_CR); const float* S = (const float*)(P.ws + WS_S); const float* gng = P.in[I_GNG] + l * 512;
    LAS unsigned char* lds = F.lds; const int tid = F.tid, lane = F.lane, r = lane & 31, hf = lane >> 5, w = F.wave, mt = w >> 2, nt = w & 3;
    for (int unit = F.vcu; unit < 8 * 128; unit += F.G) {
        const int bh = unit >> 7, n = unit & 127, b_ = bh >> 2, h = bh & 3; const size_t t0 = (size_t)b_ * SEQ + n * 64;
        float b[8], blast; chunk_cumsum(GL, t0, h, lds, tid, b, blast);
        { const int d = tid & 63, seg = tid >> 6;
#pragma unroll
          for (int i = 0; i < 8; ++i) { const size_t gi = (t0 + seg * 8 + i) * 256 + h * 64 + d; const int s = seg * 8 + i;
              *(LAS unsigned short*)(lds + OFF_Q + (s * PITCH + d) * 2) = (unsigned short)f2bf(bf2f(CQ[gi]) * 0.125f * __expf(b[i]));
              *(LAS unsigned short*)(lds + OFF_K + (s * PITCH + d) * 2) = (unsigned short)f2bf(bf2f(CK[gi]) * __expf(-b[i])); } }
        stage_vT(CV, t0, h, lds, tid);
        { const float* sp = S + (((size_t)bh * 128 + n) * 64) * 128;
#pragma unroll
          for (int it = 0; it < 2; ++it) { const int item = tid + 512 * it, e = item & 127, dg = item >> 7; float v[8];
#pragma unroll
              for (int i = 0; i < 8; ++i) v[i] = sp[(size_t)(dg * 8 + i) * 128 + e];
              *(LAS v4u*)(lds + OFF_ST + (e * PITCH + dg * 8) * 2) = (v4u){pk2(v[0], v[1]), pk2(v[2], v[3]), pk2(v[4], v[5]), pk2(v[6], v[7])}; } }
        __syncthreads();
        { LAS unsigned char* as = lds + OFF_A + w * 32 * PITCH * 2;
#pragma unroll
          for (int j = 0; j < 2; ++j) { f32x16 a = f32x16{};
#pragma unroll
              for (int kd = 0; kd < 4; ++kd) a = __builtin_amdgcn_mfma_f32_32x32x16_bf16(ldfrag(lds + OFF_Q, mt * 32 + r, kd * 16 + 8 * hf), ldfrag(lds + OFF_K, j * 32 + r, kd * 16 + 8 * hf), a, 0, 0, 0);
              const int s = j * 32 + r;
#pragma unroll
              for (int g = 0; g < 16; ++g) { const int tl = crow(g, hf); const float av = (s <= mt * 32 + tl) ? a[g] : 0.f; *(LAS unsigned short*)(as + (tl * PITCH + s) * 2) = (unsigned short)f2bf(av); } }
          LDS_WAIT(); asm volatile("" ::: "memory");
          f32x16 o = f32x16{};
#pragma unroll
          for (int ks = 0; ks < 4; ++ks) o = __builtin_amdgcn_mfma_f32_32x32x16_bf16(ldfrag(as, r, ks * 16 + 8 * hf), ldfrag(lds + OFF_V, nt * 32 + r, ks * 16 + 8 * hf), o, 0, 0, 0);
#pragma unroll
          for (int kd = 0; kd < 4; ++kd) o = __builtin_amdgcn_mfma_f32_32x32x16_bf16(ldfrag(lds + OFF_Q, mt * 32 + r, kd * 16 + 8 * hf), ldfrag(lds + OFF_ST, nt * 32 + r, kd * 16 + 8 * hf), o, 0, 0, 0);
          LAS float* os = (LAS float*)(lds + OFF_O);
#pragma unroll
          for (int g = 0; g < 16; ++g) os[(mt * 32 + crow(g, hf)) * OPITCH + nt * 32 + r] = o[g]; }
        __syncthreads();
        { const int tt = tid >> 3, e0 = (tid & 7) * 16; const LAS float* os = (const LAS float*)(lds + OFF_O) + tt * OPITCH + e0; float o[16]; float ms = 0.f;
#pragma unroll
          for (int j = 0; j < 16; ++j) { o[j] = os[j]; ms += o[j] * o[j]; }
          ms += __shfl_xor(ms, 1); ms += __shfl_xor(ms, 2); ms += __shfl_xor(ms, 4);
          const float rinv = 1.0f / sqrtf(ms * (1.0f / 128.0f) + RMS_EPS);
          bf16* crp = CR + (t0 + tt) * 512 + h * 128 + e0; const v4u c0 = *(const GAS v4u*)crp, c1 = *(const GAS v4u*)(crp + 8); const float* gp = gng + h * 128 + e0;
          v4u w0, w1;
          w0.x = pk2(o[0] * rinv * gp[0] * bflo(c0.x), o[1] * rinv * gp[1] * bfhi(c0.x)); w0.y = pk2(o[2] * rinv * gp[2] * bflo(c0.y), o[3] * rinv * gp[3] * bfhi(c0.y));
          w0.z = pk2(o[4] * rinv * gp[4] * bflo(c0.z), o[5] * rinv * gp[5] * bfhi(c0.z)); w0.w = pk2(o[6] * rinv * gp[6] * bflo(c0.w), o[7] * rinv * gp[7] * bfhi(c0.w));
          w1.x = pk2(o[8] * rinv * gp[8] * bflo(c1.x), o[9] * rinv * gp[9] * bfhi(c1.x)); w1.y = pk2(o[10] * rinv * gp[10] * bflo(c1.y), o[11] * rinv * gp[11] * bfhi(c1.y));
          w1.z = pk2(o[12] * rinv * gp[12] * bflo(c1.z), o[13] * rinv * gp[13] * bfhi(c1.z)); w1.w = pk2(o[14] * rinv * gp[14] * bflo(c1.w), o[15] * rinv * gp[15] * bfhi(c1.w));
          *(GAS v4u*)crp = w0; *(GAS v4u*)(crp + 8) = w1; }
        __syncthreads();
    }
}
}
constexpr int TAB_OFF = LDSCTL_OFF + 1024;
__device__ __forceinline__ void route_r1(const Frame& F_in, const Params& P_in) {
    PH_BEGIN
    const float* Wr = P.in[I_RT]; const float* n2g = P.in[I_N2G] + 1 * DM;
    int* TOKE = (int*)(P.ws + WS_TOKE); float* TOKP = (float*)(P.ws + WS_TOKP); float* RS2 = (float*)(P.ws + WS_RS2); int* CNT = (int*)(P.ws + WS_CNT);
    LAS float* wrs = (LAS float*)(F.lds); LAS int* cnt_s = (LAS int*)(F.lds + 32768); const int tid = F.tid, lane = F.lane;
    for (int idx = tid; idx < 8192; idx += 512) wrs[idx] = Wr[idx] * n2g[idx >> 3];
    for (int tile = F.vcu; tile < T / 64; tile += F.G) {
        if (tid < 8) cnt_s[tid] = 0;
        __syncthreads();
        for (int i = 0; i < 8; ++i) {
            const int t = tile * 64 + F.wave * 8 + i;
            const GAS v2u* xr = (const GAS v2u*)((const bf16*)(P.ws + WS_XB) + (size_t)t * DM) + lane;
            float s = 0.f, lg0 = 0.f, lg1 = 0.f, lg2 = 0.f, lg3 = 0.f, lg4 = 0.f, lg5 = 0.f, lg6 = 0.f, lg7 = 0.f;
#pragma unroll
            for (int j = 0; j < 4; ++j) { const v2u w_ = xr[64 * j]; const f32x4 v = (f32x4){bflo(w_.x), bfhi(w_.x), bflo(w_.y), bfhi(w_.y)}; s += (v.x * v.x + v.y * v.y) + (v.z * v.z + v.w * v.w);
#pragma unroll
                for (int c = 0; c < 4; ++c) { const LAS float* w = wrs + (256 * j + 4 * lane + c) * 8; const float xv = v[c];
                    lg0 += xv * w[0]; lg1 += xv * w[1]; lg2 += xv * w[2]; lg3 += xv * w[3]; lg4 += xv * w[4]; lg5 += xv * w[5]; lg6 += xv * w[6]; lg7 += xv * w[7]; } }
            s = wave_sum(s); lg0 = wave_sum(lg0); lg1 = wave_sum(lg1); lg2 = wave_sum(lg2); lg3 = wave_sum(lg3); lg4 = wave_sum(lg4); lg5 = wave_sum(lg5); lg6 = wave_sum(lg6); lg7 = wave_sum(lg7);
            const float r = 1.0f / sqrtf(s * (1.0f / DM) + RMS_EPS);
            int i1 = 0; float v1 = lg0;
            if (lg1 > v1) { v1 = lg1; i1 = 1; } if (lg2 > v1) { v1 = lg2; i1 = 2; } if (lg3 > v1) { v1 = lg3; i1 = 3; } if (lg4 > v1) { v1 = lg4; i1 = 4; }
            if (lg5 > v1) { v1 = lg5; i1 = 5; } if (lg6 > v1) { v1 = lg6; i1 = 6; } if (lg7 > v1) { v1 = lg7; i1 = 7; }
            int i2 = -1; float v2 = -INFINITY;
            if (i1 != 0 && lg0 > v2) { v2 = lg0; i2 = 0; } if (i1 != 1 && lg1 > v2) { v2 = lg1; i2 = 1; } if (i1 != 2 && lg2 > v2) { v2 = lg2; i2 = 2; } if (i1 != 3 && lg3 > v2) { v2 = lg3; i2 = 3; }
            if (i1 != 4 && lg4 > v2) { v2 = lg4; i2 = 4; } if (i1 != 5 && lg5 > v2) { v2 = lg5; i2 = 5; } if (i1 != 6 && lg6 > v2) { v2 = lg6; i2 = 6; } if (i1 != 7 && lg7 > v2) { v2 = lg7; i2 = 7; }
            const float p1 = 1.0f / (1.0f + __expf((v2 - v1) * r)), p2 = 1.0f - p1;
            if (lane == 0) { TOKE[t * 2] = i1; TOKE[t * 2 + 1] = i2; TOKP[t * 2] = p1; TOKP[t * 2 + 1] = p2; RS2[t] = r; atomicAdd((int*)&cnt_s[i1], 1); atomicAdd((int*)&cnt_s[i2], 1); }
        }
        __syncthreads();
        if (tid < 8) CNT[tile * 8 + tid] = cnt_s[tid];
        __syncthreads();
    }
}
__device__ __forceinline__ void moe_tables(const Frame& F_in, const Params& P_in, int tile) {
    PH_BEGIN
    const int* CNT = (const int*)(P.ws + WS_CNT); volatile LAS int* TAB = (volatile LAS int*)(F.lds + TAB_OFF); LAS int* cs = (LAS int*)(F.lds + TAB_OFF + 256); const int tid = F.tid;
    for (int i = tid; i < (T / 64) * 8; i += 512) cs[i] = CNT[i];
    __syncthreads();
    if (tid < 8) { int tot = 0, before = 0;
        for (int w = 0; w < T / 64; ++w) { const int c = cs[w * 8 + tid]; if (w < tile) before += c; tot += c; }
        TAB[32 + tid] = tot; TAB[40 + tid] = before; }
    __syncthreads();
    if (tid == 0) { int mt = 0; for (int e = 0; e < 8; ++e) { TAB[e] = mt; TAB[16 + e] = mt * 256 + TAB[40 + e]; mt += (TAB[32 + e] + 255) >> 8; } TAB[8] = mt; }
    __syncthreads();
}
__device__ __forceinline__ void route_r2(const Frame& F_in, const Params& P_in) {
    PH_BEGIN
    const int* TOKE = (const int*)(P.ws + WS_TOKE); const float* TOKP = (const float*)(P.ws + WS_TOKP); const float* RS2 = (const float*)(P.ws + WS_RS2);
    int* TOKPOS = (int*)(P.ws + WS_TOKPOS); float* RSG = (float*)(P.ws + WS_RSG); float* PWG = (float*)(P.ws + WS_PWG);
    const bf16* XB = (const bf16*)(P.ws + WS_XB); bf16* XG = (bf16*)(P.ws + WS_XG);
    volatile LAS int* TAB = (volatile LAS int*)(F.lds + TAB_OFF); LAS int* pos_s = (LAS int*)(F.lds); const int tid = F.tid, lane = F.lane;
    for (int tile = F.vcu; tile < T / 64; tile += F.G) {
        moe_tables(F, P, tile);
        LAS int* te_s = pos_s + 128;
        if (tid < 128) te_s[tid] = TOKE[tile * 128 + tid];
        __syncthreads();
        if (tid < 8) { int run = TAB[16 + tid];
            for (int i = 0; i < 128; ++i) if (te_s[i] == tid) { pos_s[i] = run; ++run; } }
        __syncthreads();
        for (int pr = F.wave * 16; pr < F.wave * 16 + 16; ++pr) {
            const int pos = pos_s[pr], t = tile * 64 + (pr >> 1);
            const GAS v4u* src = (const GAS v4u*)(XB + (size_t)t * DM); GAS v4u* dst = (GAS v4u*)(XG + (size_t)pos * DM);
            dst[lane] = src[lane]; dst[64 + lane] = src[64 + lane];
            if (lane == 0) { RSG[pos] = RS2[t]; PWG[pos] = TOKP[t * 2 + (pr & 1)]; TOKPOS[t * 2 + (pr & 1)] = pos; }
        }
        __syncthreads();
    }
}
struct MoeOrder {
    const char* A; const char* W; size_t wstride; size_t tstep; int nN, G, c; volatile LAS int* TAB;
    __device__ __forceinline__ bool next(int i, pg8::Unit& u) const {
        const int L = i * G + c; const int total = TAB[8] * nN; if (L >= total) return false;
        int e = 0;
#pragma unroll
        for (int k = 1; k < 8; ++k) if (L >= TAB[k] * nN) e = k;
        const int mt0 = TAB[e], mte = TAB[e + 1] - mt0, loc = L - mt0 * nN; const int pml = loc % mte, pn = loc / mte;
        u.pm = mt0 + pml; u.pn = pn; u.aux = pn; u.A = A + (size_t)u.pm * tstep; u.B = W + (size_t)e * wstride + (size_t)pn * tstep; return true;
    }
};
struct BranchOrder {
    const char* OA; const char* OB; const char* OC; const char* W; int G, c;
    __device__ __forceinline__ bool next(int i, pg8::Unit& u) const {
        const int seg = i % 3; int pm, pn; if (!pg8::static_tile(T / 256, DM / 256, G, c, i / 3, pm, pn)) return false;
        u.pm = pm; u.pn = pn; u.aux = seg; const char* o = seg == 0 ? OA : (seg == 1 ? OB : OC);
        u.A = o + (size_t)pm * 256 * 512 * 2; u.B = W + (size_t)seg * DM * 512 * 2 + (size_t)pn * 256 * 512 * 2; return true;
    }
};
template <int l>
__device__ __forceinline__ void layer_body(const Frame& F, const Params& P, const XcdBarrier& bar) {
#ifdef TIMING
#define STAMP() do { if (blockIdx.x == 0 && threadIdx.x == 0) { unsigned* c_ = (unsigned*)(P.ws + WS_CTL) + 2048; const unsigned n_ = c_[0]; ((unsigned long long*)(c_ + 2))[n_] = __builtin_amdgcn_s_memrealtime(); c_[0] = n_ + 1; } } while (0)
#else
#define STAMP() do {} while (0)
#endif
#define GRID_BAR() do { xcd_barrier(bar); STAMP(); } while (0)
    const int gw = F.vcu * NWAVES + F.wave, NGW = F.G * NWAVES;
    LAS unsigned char* ring = F.lds + RING_OFF;
    const int cb = (int)blockIdx.x;
#define WSP(T_, off) ((T_)(ws + (off)))

        { unsigned char* ws = lws(P); pg8::DenseOrder S; S.init(ws + WS_XB, ws + WS_W + WO_IN, T, NMAIN + NGATES, DM, F.G, cb);
          epi::EpiInproj E{ws + WS_R, WSP(const float*, WS_SSQ), P.in[I_GBG] + l * 256, WSP(float*, WS_KBP), F.lds, (unsigned char*)P.out, WSP(unsigned char*, WS_GC)};
          pg8::gemm_phase<epi::EpiInproj, pg8::DenseOrder>(ring, DM, S, E); }
        GRID_BAR();
        gla::pass1(F, P);
        moba_route(F, P, l);
        swa_phase(F, P, l);
        GRID_BAR();
        gla_scan(F, P);
        __syncthreads();
        moba_past(F, P, l);
        if (l == 0) convert_moe_weights(F, P, gw, NGW, 2);
        GRID_BAR();
        gla::pass3(F, P, l);
        moba_own(F, P);
        GRID_BAR();
        { unsigned char* ws = lws(P); BranchOrder S{(const char*)(ws + WS_R + RO_AQ), (const char*)(ws + WS_R + RO_BQ), (const char*)(ws + WS_R + RO_CR), (const char*)(ws + WS_W + WO_BR), F.G, cb};
          epi::EpiBranch E{(const unsigned char*)P.out, WSP(const unsigned char*, WS_GC), WSP(bf16*, WS_Y)};
          pg8::gemm_phase<epi::EpiBranch, BranchOrder>(ring, 512, S, E); }
        GRID_BAR();
        { unsigned char* ws = lws(P); pg8::DenseOrder S; S.init(ws + WS_Y, ws + WS_W + WO_O, T, DM, DM, F.G, cb);
          epi::EpiResid E{WSP(bf16*, WS_XB), WSP(float*, WS_SSQ)};
          pg8::gemm_phase<epi::EpiResid, pg8::DenseOrder>(ring, DM, S, E); }
        GRID_BAR();
        if constexpr (l == 0) {
            { unsigned char* ws = lws(P); pg8::DenseOrder S; S.init(ws + WS_XB, ws + WS_W + WO_GU, T, 2 * DFF, DM, F.G, cb);
              epi::EpiSwiglu E{(bf16*)(ws + WS_H), DFF, WSP(const float*, WS_SSQ), nullptr, F.lds};
              pg8::gemm_phase<epi::EpiSwiglu, pg8::DenseOrder>(ring, DM, S, E); }
            if (cb >= 128 || F.G != 256) convert_layer_weights(F, P, 1, F.G == 256 ? (cb - 128) * NWAVES + F.wave : gw, F.G == 256 ? 128 * NWAVES : NGW, true);
            GRID_BAR();
            { unsigned char* ws = lws(P); pg8::DenseOrder S; S.init(ws + WS_H, ws + WS_W + WO_D, T, DM, DFF, F.G, cb);
              epi::EpiResid E{WSP(bf16*, WS_XB), WSP(float*, WS_SSQ)};
              pg8::gemm_phase<epi::EpiResid, pg8::DenseOrder>(ring, DFF, S, E); }
            GRID_BAR();
        } else {
            route_r1(F, P);
            GRID_BAR();
            route_r2(F, P);
            convert_moe_weights(F, P, gw, NGW, 1);
            GRID_BAR();
            moe_tables(F, P, 0);
            { unsigned char* ws = lws(P); MoeOrder S{(const char*)(ws + WS_XG), (const char*)(ws + WS_WMGU), (size_t)2 * DFE * DM * 2, (size_t)256 * DM * 2, 2 * DFE / 256, F.G, cb, (volatile LAS int*)(F.lds + TAB_OFF)};
              epi::EpiSwiglu E{(bf16*)(ws + WS_HG), DFE, nullptr, (const float*)(ws + WS_RSG), F.lds};
              pg8::gemm_phase<epi::EpiSwiglu, MoeOrder>(ring, DM, S, E); }
            GRID_BAR();
            { unsigned char* ws = lws(P); MoeOrder S{(const char*)(ws + WS_HG), (const char*)(ws + WS_WMD), (size_t)DM * DFE * 2, (size_t)256 * DFE * 2, DM / 256, F.G, cb, (volatile LAS int*)(F.lds + TAB_OFF)};
              epi::EpiMoeDown E{(bf16*)(ws + WS_XG), (const float*)(ws + WS_PWG)};
              pg8::gemm_phase<epi::EpiMoeDown, MoeOrder>(ring, DFE, S, E); }
            GRID_BAR();
            final_phase(F, P, gw, NGW, true);
        }
}
__global__ void __launch_bounds__(NWAVES * 64, 2) fwd_kernel(Params P) {
    extern __shared__ __attribute__((aligned(16))) unsigned char lds[];
    Frame F;
    F.lds = (LAS unsigned char*)lds;
    F.MISC = (volatile LAS unsigned*)(F.lds + MISC_OFF);
    F.tid = threadIdx.x; F.lane = F.tid & 63; F.wave = __builtin_amdgcn_readfirstlane(F.tid >> 6);
    F.G = gridDim.x; { const int bx = blockIdx.x; F.vcu = (F.G % 8 == 0) ? (bx % 8) * (F.G / 8) + bx / 8 : bx; }
    F.ctl = (gu32*)(P.ws + WS_CTL);
    for (int u = F.tid; u < (LDS_BYTES - LDSCTL_OFF) / 4; u += NWAVES * 64) ((LAS unsigned*)(F.lds + LDSCTL_OFF))[u] = 0u;
    __syncthreads();
    XcdBarrier bar = xcd_barrier_post((unsigned*)(F.ctl + CW_BAR), F.MISC + 8);
    const int gw = F.vcu * NWAVES + F.wave, NGW = F.G * NWAVES;
    STAMP();
    prep_x(F, P, gw, NGW);
    convert_layer_weights(F, P, 0, gw, NGW, false);
    GRID_BAR();

    layer_body<0>(F, P, bar);
    layer_body<1>(F, P, bar);
}

extern "C" void kernel_launch(void* const* d_in, const int* in_sizes, int n_in, void* d_out, int out_size, void* d_ws, size_t ws_size, hipStream_t stream) {
    static int grid = 0;
    if (grid == 0) {
        if (n_in != 20 || out_size != T * DM || ws_size < WS_END) { fprintf(stderr, "kernel_launch: unexpected shapes n_in %d out %d ws %zu (need %zu)\n", n_in, out_size, ws_size, (size_t)WS_END); grid = -1; return; }
        int dev = 0, cus = 0, per_cu = 0;
        if (hipGetDevice(&dev) != hipSuccess || hipDeviceGetAttribute(&cus, hipDeviceAttributeMultiprocessorCount, dev) != hipSuccess) { grid = -1; return; }
        if (hipFuncSetAttribute((const void*)fwd_kernel, hipFuncAttributeMaxDynamicSharedMemorySize, LDS_BYTES) != hipSuccess) { fprintf(stderr, "kernel_launch: hipFuncSetAttribute failed\n"); grid = -1; return; }
        if (hipOccupancyMaxActiveBlocksPerMultiprocessor(&per_cu, (const void*)fwd_kernel, NWAVES * 64, LDS_BYTES) != hipSuccess || per_cu < 1) { fprintf(stderr, "kernel_launch: occupancy query says %d\n", per_cu); per_cu = 1; }
        (void)hipGetLastError();
        grid = cus;
    }
    if (grid < 0) return;
    if (hipMemsetAsync((char*)d_ws + WS_CTL, 0, CTL_ZERO_BYTES, stream) != hipSuccess) { fprintf(stderr, "kernel_launch: memset failed\n"); return; }
    Params p{};
    for (int i = 0; i < 20; ++i) p.in[i] = (const float*)d_in[i];
    p.out = (float*)d_out; p.ws = (unsigned char*)d_ws;
    void* args[] = {&p};
    hipError_t e = hipLaunchCooperativeKernel((const void*)fwd_kernel, dim3(grid), dim3(NWAVES * 64), args, LDS_BYTES, stream);
    if (e != hipSuccess) fprintf(stderr, "kernel_launch: cooperative launch failed: %s (grid %d)\n", hipGetErrorString(e), grid);
}
```

```cpp
#include <hip/hip_runtime.h>
#include <cstdio>
#include <cstdint>
#include <cmath>

#define GAS __attribute__((address_space(1)))
#define LAS __attribute__((address_space(3)))
typedef unsigned short bf16;
typedef unsigned v4u __attribute__((ext_vector_type(4)));
typedef unsigned v2u __attribute__((ext_vector_type(2)));
typedef float f32x4 __attribute__((ext_vector_type(4)));
typedef GAS unsigned gu32;
#define RLX_AGENT __ATOMIC_RELAXED, __HIP_MEMORY_SCOPE_AGENT
#define LDS_WAIT() asm volatile("s_waitcnt lgkmcnt(0)" ::: "memory")
#define VM_WAIT() asm volatile("s_waitcnt vmcnt(0)" ::: "memory")
__device__ __forceinline__ unsigned f2bf(float f) { unsigned u = __builtin_bit_cast(unsigned, f); return (u + 0x7fffu + ((u >> 16) & 1u)) >> 16; }
__device__ __forceinline__ unsigned pk2(float lo, float hi) { return f2bf(lo) | (f2bf(hi) << 16); }
__device__ __forceinline__ float bf2f(unsigned short b) { return __builtin_bit_cast(float, (unsigned)b << 16); }
__device__ __forceinline__ float bflo(unsigned w) { return __builtin_bit_cast(float, w << 16); }
__device__ __forceinline__ float bfhi(unsigned w) { return __builtin_bit_cast(float, w & 0xffff0000u); }
__device__ __forceinline__ float wave_sum(float v) {
#pragma unroll
    for (int o = 1; o < 64; o <<= 1) v += __shfl_xor(v, o);
    return v;
}
__device__ __forceinline__ float wave_max(float v) {
#pragma unroll
    for (int o = 1; o < 64; o <<= 1) v = fmaxf(v, __shfl_xor(v, o));
    return v;
}

constexpr int NWAVES = 8;
constexpr int BATCH = 2, SEQ = 8192, DM = 1024, T = BATCH * SEQ;
constexpr int IN_TOTAL = 6928, NMAIN = 4096, NGATES = 3072;
constexpr int DFF = 2816, NEXP = 8, DFE = 1408;
constexpr float RMS_EPS = 1e-6f;
constexpr int XG_ROWS = 2 * T + 2048;

constexpr size_t MiB = 1u << 20;
constexpr size_t WS_CTL = 0, CTL_ZERO_BYTES = 1 * MiB;
constexpr size_t WS_SSQ = 1 * MiB;
constexpr size_t WS_KBP = 2 * MiB;
constexpr size_t WS_DEC = 2 * MiB + 256 * 1024;
constexpr size_t WS_TOKE = 2 * MiB + 512 * 1024;
constexpr size_t WS_TOKP = WS_TOKE + 128 * 1024;
constexpr size_t WS_TOKPOS = WS_TOKP + 128 * 1024;
constexpr size_t WS_RS2 = WS_TOKPOS + 128 * 1024;
constexpr size_t WS_CNT = WS_RS2 + 64 * 1024;
constexpr size_t WS_RSG = 3 * MiB;
constexpr size_t WS_PWG = 3 * MiB + 256 * 1024;
constexpr size_t WS_W = 4 * MiB;
constexpr size_t WO_IN = 0, WO_BR = 14 * MiB, WO_O = 17 * MiB, WO_GU = 19 * MiB, WO_D = 30 * MiB;
constexpr size_t WS_XB = 40 * MiB;
constexpr size_t WS_R = 72 * MiB;
constexpr size_t RO_AQ = 0, RO_BQ = 16 * MiB, RO_CR = 32 * MiB, RO_AK = 48 * MiB, RO_AV = 52 * MiB, RO_BK = 56 * MiB, RO_BV = 72 * MiB, RO_CQ = 88 * MiB, RO_CK = 96 * MiB, RO_CV = 104 * MiB, RO_GL = 120 * MiB;
constexpr size_t WS_GC = 240 * MiB;
constexpr size_t WS_S = 208 * MiB;
constexpr size_t WS_Y = WS_R + RO_BK;
constexpr size_t WS_H = WS_R;
constexpr size_t WS_XG = WS_R;
constexpr size_t WS_HG = 140 * MiB;
constexpr size_t WS_WMGU = 234 * MiB;
constexpr size_t WS_WMD = 278 * MiB;
constexpr size_t WS_PO2 = 256 * MiB;
constexpr size_t WS_LIST = 272 * MiB;
constexpr size_t WS_ML = 300 * MiB;
constexpr size_t WS_END = 303 * MiB;
constexpr int LIST_BH = 126976;
constexpr int CW_MCNT = 8192;
static_assert(WS_HG + (size_t)XG_ROWS * DFE * 2 <= WS_WMGU && WS_XG + (size_t)XG_ROWS * DM * 2 <= WS_HG, "moe map");
static_assert(WS_H + (size_t)T * DFF * 2 <= WS_S, "overlay map");
constexpr int CW_BAR = 4096;

constexpr int RING_OFF = 0, RING_BYTES = 131072;
constexpr int LDSCTL_OFF = RING_BYTES, MISC_OFF = LDSCTL_OFF + 320;
constexpr int LDS_BYTES = 147456;
namespace pg8 {
#define PG8_LAS __attribute__((address_space(3)))
typedef unsigned short bf16_t;
typedef short bf16x8 __attribute__((ext_vector_type(8)));
typedef float f32x4 __attribute__((ext_vector_type(4)));
typedef unsigned u32x4 __attribute__((ext_vector_type(4)));
typedef unsigned u32x2 __attribute__((ext_vector_type(2)));
constexpr int BM = 256, BK = 64, HALF = 128, HTB = HALF * BK * 2  , STAGE_BYTES = 8 * HTB, NXCD = 8, WGM = 8;

__host__ __device__ __forceinline__ int lds_byte(int r, int c) { const int st = (r >> 4) * 2 + (c >> 5), rr = r & 15, cc = c & 31, ob = rr * 64 + cc * 2; return st * 1024 + (ob ^ (((ob >> 9) & 1) << 5)); }
__host__ __device__ __forceinline__ void stage_rc(int b, int& R, int& C) { const int st = b / 1024, sb = b % 1024, swz = sb ^ (((sb >> 9) & 1) << 5); R = (st >> 1) * 16 + swz / 64; C = (st & 1) * 32 + (swz % 64) / 2; }
__host__ __device__ __forceinline__ int perm32(int rho) { const int n = rho >> 4, i = rho & 15; return 8 * (i >> 2) + 4 * n + (i & 3); }

struct Unit { const char* A; const char* B; int pm, pn, aux; };

__device__ __forceinline__ bool static_tile(int nM, int nN, int G, int c, int i, int& pm, int& pn) {
    const int nwg = nM * nN; const long L = (long)i * G + c; if (L >= nwg) return false;
    int wgid = (int)L; { const int q = nwg / NXCD, r = nwg % NXCD, xcd = wgid % NXCD, off = wgid / NXCD; wgid = (xcd < r ? xcd * (q + 1) : r * (q + 1) + (xcd - r) * q) + off; }
    const int nig = WGM * nN, gid = wgid / nig, fm = gid * WGM, gsz = (nM - fm) < WGM ? (nM - fm) : WGM;
    pm = fm + ((wgid % nig) % gsz); pn = (wgid % nig) / gsz; return true;
}
struct DenseOrder {
    const char* A; const char* B; int nM, nN, G, c; size_t tstep;
    __device__ __forceinline__ void init(const void* A_, const void* B_, int M, int N, int K, int G_, int c_) { A = (const char*)A_; B = (const char*)B_; nM = M / BM; nN = N / BM; G = G_; c = c_; tstep = (size_t)BM * K * 2; }
    __device__ __forceinline__ bool next(int i, Unit& u) const { int pm, pn; if (!static_tile(nM, nN, G, c, i, pm, pn)) return false; u.pm = pm; u.pn = pn; u.aux = pn; u.A = A + (size_t)pm * tstep; u.B = B + (size_t)pn * tstep; return true; }
};

typedef float f32x2_c __attribute__((ext_vector_type(2))); typedef __bf16 bf16x2_c __attribute__((ext_vector_type(2)));
__device__ __forceinline__ unsigned cvt_pk_bf16(float lo, float hi) { f32x2_c v = {lo, hi}; bf16x2_c b = __builtin_convertvector(v, bf16x2_c); return __builtin_bit_cast(unsigned, b); }

template <class Epi, class Sched, bool ALIGN_EPI = true>
__device__ __forceinline__ void gemm_phase(PG8_LAS unsigned char* lds, const int K, const Sched& S, const Epi& E) {
    int tid_ = threadIdx.x; asm volatile("" : "+v"(tid_));
    const int tid = tid_, wid = __builtin_amdgcn_readfirstlane(tid >> 6), lane = tid & 63, wr = wid >> 2, wc = wid & 3, fr = lane & 15, fq = lane >> 4;
    const int nt = K / BK;
    unsigned voffA[2], voffB[2];
#pragma unroll
    for (int i = 0; i < 2; ++i) { int R, C; stage_rc(tid * 16 + i * 8192, R, C); const int Rb = Epi::PERM ? ((R & ~31) + perm32(R & 31)) : R;
        voffA[i] = (unsigned)(R * K + C) * 2u; voffB[i] = (unsigned)(Rb * K + C) * 2u; }
    const size_t kstep = (size_t)(BK * 2);
    const size_t hstep = (size_t)HALF * K * 2;
    const unsigned ldsw = (unsigned)wid * 1024u;
    const int aoff = lds_byte(wr * 64 + fr, fq * 8), boff = lds_byte(wc * 32 + fr, fq * 8);
#define PG8_SA(b, h) (((b) * 2 + (h)) * HTB)
#define PG8_SB(b, h) ((4 + (b) * 2 + (h)) * HTB)
#define PG8_STAGE(bufoff, gbase, voff) do { _Pragma("unroll") for (int _i = 0; _i < 2; ++_i) \
        __builtin_amdgcn_global_load_lds((const unsigned*)((const char*)(gbase) + (voff)[_i]), (PG8_LAS unsigned*)(lds + (bufoff) + ldsw + _i * 8192), 16, 0, 0); } while (0)
#define PG8_LDA(dst, b, h) do { _Pragma("unroll") for (int m = 0; m < 4; ++m) _Pragma("unroll") for (int k = 0; k < 2; ++k) dst[m][k] = *(const PG8_LAS bf16x8*)(lds + PG8_SA(b, h) + aoff + m * 2048 + k * 1024); } while (0)
#define PG8_LDB(dst, b, h) do { _Pragma("unroll") for (int n = 0; n < 2; ++n) _Pragma("unroll") for (int k = 0; k < 2; ++k) dst[n][k] = *(const PG8_LAS bf16x8*)(lds + PG8_SB(b, h) + boff + n * 2048 + k * 1024); } while (0)
#define PG8_MMA(ai, bj, At, Bt) do { __builtin_amdgcn_s_setprio(1); _Pragma("unroll") for (int m = 0; m < 4; ++m) _Pragma("unroll") for (int n = 0; n < 2; ++n) _Pragma("unroll") for (int k = 0; k < 2; ++k) \
        acc[ai][bj][m][n] = __builtin_amdgcn_mfma_f32_16x16x32_bf16(Bt[n][k], At[m][k], acc[ai][bj][m][n], 0, 0, 0); __builtin_amdgcn_s_setprio(0); } while (0)
#define PG8_WAIT_V(n) asm volatile("s_waitcnt vmcnt(" #n ")" ::: "memory")
#define PG8_WAIT_L(n) asm volatile("s_waitcnt lgkmcnt(" #n ")" ::: "memory")
#define PG8_BAR __builtin_amdgcn_s_barrier()
#define PG8_SCHED __builtin_amdgcn_sched_barrier(0)
    Unit cur, nxt; int ui = 0;
    if (!S.next(0, cur)) return;
    f32x4 acc[2][2][4][2];
#pragma unroll
    for (int a = 0; a < 2; ++a)
#pragma unroll
        for (int b = 0; b < 2; ++b)
#pragma unroll
            for (int m = 0; m < 4; ++m)
#pragma unroll
                for (int n = 0; n < 2; ++n) acc[a][b][m][n] = (f32x4){0.f, 0.f, 0.f, 0.f};
    bf16x8 At[4][2], B0[2][2], B1[2][2];
    const char* cA = cur.A; const char* cB = cur.B;
    PG8_STAGE(PG8_SB(0, 0), cB, voffB); PG8_STAGE(PG8_SB(0, 1), cB + hstep, voffB); PG8_STAGE(PG8_SA(0, 0), cA, voffA); PG8_STAGE(PG8_SA(0, 1), cA + hstep, voffA);
    if (wr == 1) PG8_BAR;
    PG8_WAIT_V(2); PG8_BAR;
    PG8_STAGE(PG8_SB(1, 0), cB + kstep, voffB); PG8_STAGE(PG8_SA(1, 0), cA + kstep, voffA); PG8_STAGE(PG8_SB(1, 1), cB + hstep + kstep, voffB);
    PG8_WAIT_V(6); PG8_BAR;
    for (;;) {
        const bool has_next = S.next(ui + 1, nxt);
        const char* nA = has_next ? nxt.A : cA; const char* nB = has_next ? nxt.B : cB;
        for (int t = 0; t < nt; t += 2) {
            const bool last = (t == nt - 2);
            const char* a1 = cA + (size_t)(t + 1) * kstep;
            const char* a2 = last ? nA : cA + (size_t)(t + 2) * kstep; const char* b2 = last ? nB : cB + (size_t)(t + 2) * kstep;
            const char* a3 = a2 + kstep; const char* b3 = b2 + kstep;
            PG8_LDB(B0, 0, 0); PG8_LDB(B1, 0, 1); PG8_SCHED; PG8_LDA(At, 0, 0); PG8_STAGE(PG8_SA(1, 1), a1 + hstep, voffA);
            PG8_WAIT_V(8); PG8_WAIT_L(0); PG8_BAR; PG8_MMA(0, 0, At, B0); PG8_MMA(0, 1, At, B1); PG8_BAR; PG8_SCHED;
            PG8_LDA(At, 0, 1); PG8_STAGE(PG8_SB(0, 0), b2, voffB); PG8_STAGE(PG8_SB(0, 1), b2 + hstep, voffB); PG8_STAGE(PG8_SA(0, 0), a2, voffA);
            PG8_WAIT_V(8); PG8_WAIT_L(0); PG8_BAR; PG8_MMA(1, 0, At, B0); PG8_MMA(1, 1, At, B1); PG8_BAR; PG8_SCHED;
            PG8_LDB(B0, 1, 0); PG8_LDB(B1, 1, 1); PG8_SCHED; PG8_LDA(At, 1, 0); PG8_STAGE(PG8_SA(0, 1), a2 + hstep, voffA);
            PG8_WAIT_V(8); PG8_WAIT_L(0); PG8_BAR; PG8_MMA(0, 0, At, B0); PG8_MMA(0, 1, At, B1); PG8_BAR; PG8_SCHED;
            PG8_LDA(At, 1, 1); PG8_STAGE(PG8_SB(1, 0), b3, voffB); PG8_STAGE(PG8_SB(1, 1), b3 + hstep, voffB); PG8_STAGE(PG8_SA(1, 0), a3, voffA);
            PG8_WAIT_V(8); PG8_WAIT_L(0); PG8_BAR; PG8_MMA(1, 0, At, B0); PG8_MMA(1, 1, At, B1); PG8_BAR; PG8_SCHED;
        }
        if constexpr (ALIGN_EPI) { if (wr == 0) PG8_BAR; }
            E(acc, cur, wr, wc, fr, fq);
            if (!has_next) break;
#pragma unroll
        for (int a = 0; a < 2; ++a)
#pragma unroll
            for (int b = 0; b < 2; ++b)
#pragma unroll
                for (int m = 0; m < 4; ++m)
#pragma unroll
                    for (int n = 0; n < 2; ++n) acc[a][b][m][n] = (f32x4){0.f, 0.f, 0.f, 0.f};
        cur = nxt; cA = nA; cB = nB; ++ui;
        if constexpr (ALIGN_EPI) { if (wr == 1) PG8_BAR; }
    }
    PG8_WAIT_V(0);
    if constexpr (!ALIGN_EPI) { if (wr == 0) PG8_BAR; }
    PG8_BAR;
#undef PG8_SA
#undef PG8_SB
#undef PG8_STAGE
#undef PG8_LDA
#undef PG8_LDB
#undef PG8_MMA
#undef PG8_WAIT_V
#undef PG8_WAIT_L
#undef PG8_BAR
#undef PG8_SCHED
}
}
#define XB_TMO      128
#define XB_XCNT(j)  (256  + 64 * (j))
#define XB_XSUB(j)  (1280 + 64 * (j))
#define XB_XGEN(j)  (2304 + 64 * (j))
#define XB_TOP      3328
#define XB_TOPGEN   3392
#define XCD_BAR_WORDS 3456
#define XB_SPIN_CAP (1u << 18)

__device__ __forceinline__ unsigned xb_ld(unsigned* p)              { return __hip_atomic_load(p, __ATOMIC_RELAXED, __HIP_MEMORY_SCOPE_AGENT); }
__device__ __forceinline__ unsigned xb_add(unsigned* p, unsigned v) { return __hip_atomic_fetch_add(p, v, __ATOMIC_RELAXED, __HIP_MEMORY_SCOPE_AGENT); }
__device__ __forceinline__ unsigned xb_xcc_id() { return (unsigned)__builtin_amdgcn_s_getreg((3 << 11) | 20) & 0xFu; }
#define XB_SPIN(cond, bar) do { unsigned _sp = 0; while (cond) { __builtin_amdgcn_s_sleep(1); \
    if ((++_sp & 255u) == 0u) { if (xb_ld(&(bar)[XB_TMO])) break; if (_sp > XB_SPIN_CAP) { atomicAdd(&(bar)[XB_TMO], 1u); break; } } } } while (0)

struct XcdBarrier {
    unsigned* bar; unsigned x;
    volatile LAS unsigned* st;
};

__device__ __forceinline__ XcdBarrier xcd_barrier_post(unsigned* bar, volatile LAS unsigned* st) {
    XcdBarrier b; b.bar = bar; b.x = xb_xcc_id(); b.st = st;
    if (threadIdx.x == 0) (void)xb_add(&bar[XB_XCNT(b.x)], 1u);
    return b;
}
__device__ __forceinline__ void xcd_barrier_complete(unsigned* bar, unsigned x, unsigned& nloc, unsigned& nx) {
    const unsigned G = gridDim.x * gridDim.y * gridDim.z;
    unsigned sum, cnt, mine, sp = 0u;
    for (;;) {
        sum = 0u; cnt = 0u; mine = 0u;
#pragma unroll
        for (unsigned j = 0; j < 16; ++j) { const unsigned c = xb_ld(&bar[XB_XCNT(j)]); sum += c; cnt += (c > 0u) ? 1u : 0u; mine = (j == x) ? c : mine; }
        if (sum == G) break;
        __builtin_amdgcn_s_sleep(1);
        if ((++sp & 255u) == 0u) { if (xb_ld(&bar[XB_TMO])) break; if (sp > XB_SPIN_CAP) { atomicAdd(&bar[XB_TMO], 1u); break; } }
    }
    nloc = mine > 0u ? mine : 1u; nx = cnt > 0u ? cnt : 1u;
}

__device__ __forceinline__ void xcd_barrier(const XcdBarrier& b) {
    asm volatile("s_waitcnt vmcnt(0)" ::: "memory");
    __syncthreads();
    if (threadIdx.x == 0) {
        unsigned* bar = b.bar;
        __builtin_amdgcn_s_waitcnt(0);
        unsigned nloc = b.st[0], nx = b.st[1];
        if (nloc == 0u) { xcd_barrier_complete(bar, b.x, nloc, nx); b.st[0] = nloc; b.st[1] = nx; }
        const unsigned old = xb_add(&bar[XB_XSUB(b.x)], 1u);
        const unsigned gen = old / nloc;
        if (old + 1u == (gen + 1u) * nloc) {
            __builtin_amdgcn_fence(__ATOMIC_RELEASE, "agent");
            asm volatile("s_waitcnt vmcnt(0)" ::: "memory");
            const unsigned og = xb_add(&bar[XB_TOP], 1u);
            const unsigned tg = og / nx;
            if (og + 1u == (tg + 1u) * nx) xb_add(&bar[XB_TOPGEN], 1u);
            else XB_SPIN(xb_ld(&bar[XB_TOPGEN]) == tg, bar);
            __builtin_amdgcn_fence(__ATOMIC_ACQUIRE, "agent");
            xb_add(&bar[XB_XGEN(b.x)], 1u);
            asm volatile("s_waitcnt vmcnt(0)" ::: "memory");
        } else {
            XB_SPIN(xb_ld(&bar[XB_XGEN(b.x)]) == gen, bar);
            __builtin_amdgcn_fence(__ATOMIC_ACQUIRE, "agent");
            asm volatile("s_waitcnt vmcnt(0)" ::: "memory");
        }
    }
    __syncthreads();
}
struct Params { const float* in[20]; float* out; unsigned char* ws; };
enum { I_X = 0, I_N1G, I_WIN, I_SINK, I_GWG, I_GBG, I_GNG, I_WA, I_WB, I_WC, I_WO, I_N2G, I_FG, I_FU, I_FD, I_RT, I_MG, I_MU, I_MD, I_FNG };

struct Frame {
    LAS unsigned char* lds;
    volatile LAS unsigned* MISC;
    gu32* ctl;
    int tid, lane, wave;
    int vcu, G;
};
__device__ __forceinline__ unsigned char* lws(const Params& P) { GAS unsigned char* w = (GAS unsigned char*)P.ws; asm volatile("" : "+s"(w)); return (unsigned char*)w; }
#define PH_BEGIN Frame F = F_in; { int t_ = threadIdx.x; asm volatile("" : "+v"(t_)); F.tid = t_; F.lane = t_ & 63; } Params P = P_in; P.ws = lws(P_in);

template <int MODE>
__device__ __forceinline__ void tr_item(const float* W, int ld, int sc, const float* g, const float* W2, int n0, bf16* dst, int dK, int drow, int k0, LAS float* scr, int lane) {
    if (MODE == 0) {
        const int kr = lane >> 3, c4 = (lane & 7) * 4;
#pragma unroll
        for (int i = 0; i < 8; ++i) { const int kk = 8 * i + kr; f32x4 v = *(const GAS f32x4*)(W + (size_t)(k0 + kk) * ld + sc + n0 + c4);
            if (g) { const float gg = g[k0 + kk]; v = v * gg; }
            LAS float* s = scr + kk * 33 + c4; s[0] = v.x; s[1] = v.y; s[2] = v.z; s[3] = v.w; }
    } else {
#pragma unroll 4
        for (int i = 0; i < 32; ++i) { const int kk = 2 * i + (lane >> 5), nn = lane & 31; const float* wr = W + (size_t)(k0 + kk) * ld + sc; float v = 0.f;
#pragma unroll
            for (int r = 0; r < 16; ++r) v += wr[r] * W2[r * 256 + n0 + nn];
            if (g) v *= g[k0 + kk];
            scr[kk * 33 + nn] = v; }
    }
    LDS_WAIT(); asm volatile("" ::: "memory");
    const int c = lane & 7;
#pragma unroll
    for (int j = 0; j < 4; ++j) { const int n = (lane >> 3) + 8 * j; const LAS float* s = scr + (8 * c) * 33 + n;
        v4u o; o.x = pk2(s[0 * 33], s[1 * 33]); o.y = pk2(s[2 * 33], s[3 * 33]); o.z = pk2(s[4 * 33], s[5 * 33]); o.w = pk2(s[6 * 33], s[7 * 33]);
        *(GAS v4u*)(dst + (size_t)(drow + n) * dK + k0 + 8 * c) = o; }
    LDS_WAIT(); asm volatile("" ::: "memory");
}
__device__ __forceinline__ void tr_job(int item, const float* W, int ld, int sc, int K, int N, const float* g, bf16* dst, int drow0, int gu_off, bool gu, LAS float* scr, int lane) {
    const int nblk = N / 32, kb = item / nblk, nb = item % nblk, n0 = 32 * nb;
    const int drow = gu ? (256 * (n0 / 128) + (n0 % 128) + gu_off) : (drow0 + n0);
    tr_item<0>(W, ld, sc, g, nullptr, n0, dst, K, drow, 64 * kb, scr, lane);
}
__device__ __forceinline__ void convert_layer_weights(const Frame& F_in, const Params& P_in, int l, int gw, int NGW, bool skip_ffn_down_region) {
    PH_BEGIN
    LAS float* scr = (LAS float*)(F.lds + RING_OFF + F.wave * 16384);
    unsigned char* ws = P.ws;
    bf16* Win = (bf16*)(ws + WS_W + WO_IN); bf16* Wbr = (bf16*)(ws + WS_W + WO_BR); bf16* Wo = (bf16*)(ws + WS_W + WO_O); bf16* Wgu = (bf16*)(ws + WS_W + WO_GU); bf16* Wd = (bf16*)(ws + WS_W + WO_D);
    const float* win = P.in[I_WIN] + (size_t)l * DM * IN_TOTAL; const float* n1g = P.in[I_N1G] + l * DM; const float* n2g = P.in[I_N2G] + l * DM;
    constexpr int J1 = 16 * (3840 / 32), J2 = 16 * (NGATES / 32), J3 = 16 * (256 / 32), J4 = 8 * (DM / 32), J7 = 16 * (DM / 32), J8 = 16 * (DFF / 32), J10 = (DFF / 64) * (DM / 32);
    const int NIT = J1 + J2 + J3 + 3 * J4 + J7 + ((l == 0) ? (2 * J8 + J10) : 0);
    for (int it = gw; it < NIT; it += NGW) {
        int r = it;
        if (r < J1) { tr_job(r, win, IN_TOTAL, 0, DM, 3840, n1g, Win, 0, 0, false, scr, F.lane); continue; } r -= J1;
        if (r < J2) { tr_job(r, win, IN_TOTAL, 3856, DM, NGATES, n1g, Win, NMAIN, 0, false, scr, F.lane); continue; } r -= J2;
        if (r < J3) { const int kb = r / 8, nb = r % 8; tr_item<1>(win, IN_TOTAL, 3840, n1g, P.in[I_GWG] + (size_t)l * 16 * 256, 32 * nb, Win, DM, 3840 + 32 * nb, 64 * kb, scr, F.lane); continue; } r -= J3;
        if (r < J4) { tr_job(r, P.in[I_WA] + (size_t)l * 512 * DM, DM, 0, 512, DM, nullptr, Wbr, 0, 0, false, scr, F.lane); continue; } r -= J4;
        if (r < J4) { tr_job(r, P.in[I_WB] + (size_t)l * 512 * DM, DM, 0, 512, DM, nullptr, Wbr + (size_t)DM * 512, 0, 0, false, scr, F.lane); continue; } r -= J4;
        if (r < J4) { tr_job(r, P.in[I_WC] + (size_t)l * 512 * DM, DM, 0, 512, DM, nullptr, Wbr + (size_t)2 * DM * 512, 0, 0, false, scr, F.lane); continue; } r -= J4;
        if (r < J7) { tr_job(r, P.in[I_WO] + (size_t)l * DM * DM, DM, 0, DM, DM, nullptr, Wo, 0, 0, false, scr, F.lane); continue; } r -= J7;
        if (r < J8) { tr_job(r, P.in[I_FG], DFF, 0, DM, DFF, n2g, Wgu, 0, 0, true, scr, F.lane); continue; } r -= J8;
        if (r < J8) { tr_job(r, P.in[I_FU], DFF, 0, DM, DFF, n2g, Wgu, 0, 128, true, scr, F.lane); continue; } r -= J8;
        tr_job(r, P.in[I_FD], DM, 0, DFF, DM, nullptr, Wd, 0, 0, false, scr, F.lane);
    }
}
__device__ __forceinline__ void convert_moe_weights(const Frame& F_in, const Params& P_in, int gw, int NGW, int which) {
    PH_BEGIN
    LAS float* scr = (LAS float*)(F.lds + RING_OFF + F.wave * 16384);
    bf16* Wgu = (bf16*)(P.ws + WS_WMGU); bf16* Wd = (bf16*)(P.ws + WS_WMD);
    const float* n2g = P.in[I_N2G] + 1 * DM;
    constexpr int JG = 16 * (DFE / 32), JD = (DFE / 64) * (DM / 32);
    if (which & 1) for (int it = gw; it < NEXP * 2 * JG; it += NGW) {
        const int e = it / (2 * JG); int r = it % (2 * JG);
        if (r < JG) tr_job(r, P.in[I_MG] + (size_t)e * DM * DFE, DFE, 0, DM, DFE, n2g, Wgu + (size_t)e * 2 * DFE * DM, 0, 0, true, scr, F.lane);
        else tr_job(r - JG, P.in[I_MU] + (size_t)e * DM * DFE, DFE, 0, DM, DFE, n2g, Wgu + (size_t)e * 2 * DFE * DM, 0, 128, true, scr, F.lane);
    }
    if (which & 2) for (int it = gw; it < NEXP * JD; it += NGW) { const int e = it / JD, r = it % JD;
        tr_job(r, P.in[I_MD] + (size_t)e * DFE * DM, DM, 0, DFE, DM, nullptr, Wd + (size_t)e * DM * DFE, 0, 0, false, scr, F.lane); }
}
__device__ __forceinline__ void prep_x(const Frame& F_in, const Params& P_in, int gw, int NGW) {
    PH_BEGIN
    bf16* XB = (bf16*)(P.ws + WS_XB); float* SSQ = (float*)(P.ws + WS_SSQ);
    for (int m = gw; m < T; m += NGW) {
        const GAS f32x4* xr = (const GAS f32x4*)(P.in[I_X] + (size_t)m * DM) + F.lane;
        f32x4 v[4]; float s = 0.f;
#pragma unroll
        for (int j = 0; j < 4; ++j) { v[j] = xr[64 * j]; s += (v[j].x * v[j].x + v[j].y * v[j].y) + (v[j].z * v[j].z + v[j].w * v[j].w); }
        s = wave_sum(s) * (1.f / 16.f);
        GAS unsigned long long* o8 = (GAS unsigned long long*)(XB + (size_t)m * DM) + F.lane;
#pragma unroll
        for (int j = 0; j < 4; ++j) o8[64 * j] = (unsigned long long)pk2(v[j].x, v[j].y) | ((unsigned long long)pk2(v[j].z, v[j].w) << 32);
        if (F.lane < 16) SSQ[(size_t)m * 16 + F.lane] = s;
    }
}
__device__ __forceinline__ void final_phase(const Frame& F_in, const Params& P_in, int gw, int NGW, bool with_moe) {
    PH_BEGIN
#ifdef TIMING
    float tscale = 1.0f, tbump = 0.f;
    { const unsigned* c_ = (const unsigned*)(P.ws + WS_CTL) + 2048; const unsigned long long* ts = (const unsigned long long*)(c_ + 2); const unsigned n_ = c_[0];
      const float tot = (float)(ts[n_ - 1] - ts[0]); float a1 = 0.f, a2 = 0.f;
      for (unsigned i = 1; i < n_; ++i) { const float d = (float)(ts[i] - ts[i - 1]); if ((TSEL1 >> i) & 1u) a1 += d; if ((TSEL2 >> i) & 1u) a2 += d; }
      tscale = 1.0f + 0.02f + 0.1f * TRS * (a1 / tot); tbump = 2.0f + 7.9f * TBS * (a2 / tot); }
#endif
    const float* g = P.in[I_FNG]; const bf16* XBp = (const bf16*)(P.ws + WS_XB); const bf16* YE = (const bf16*)(P.ws + WS_XG); const int* TOKPOS = (const int*)(P.ws + WS_TOKPOS);
    for (int m = gw; m < T; m += NGW) {
        GAS f32x4* xr = (GAS f32x4*)(P.out + (size_t)m * DM) + F.lane;
        f32x4 v[4]; float s = 0.f;
#pragma unroll
        for (int j = 0; j < 4; ++j) { const v2u w = ((const GAS v2u*)(XBp + (size_t)m * DM) + F.lane)[64 * j]; v[j] = (f32x4){bflo(w.x), bfhi(w.x), bflo(w.y), bfhi(w.y)}; }
        if (with_moe) {
#pragma unroll
            for (int sl = 0; sl < 2; ++sl) { const int pos = TOKPOS[m * 2 + sl]; const GAS v2u* yr = (const GAS v2u*)(YE + (size_t)pos * DM) + F.lane;
#pragma unroll
                for (int j = 0; j < 4; ++j) { const v2u w = yr[64 * j]; v[j].x += bflo(w.x); v[j].y += bfhi(w.x); v[j].z += bflo(w.y); v[j].w += bfhi(w.y); } }
        }
#pragma unroll
        for (int j = 0; j < 4; ++j) s += (v[j].x * v[j].x + v[j].y * v[j].y) + (v[j].z * v[j].z + v[j].w * v[j].w);
        const float r = 1.0f / sqrtf(wave_sum(s) * (1.f / DM) + RMS_EPS);
#pragma unroll
        for (int j = 0; j < 4; ++j) { const f32x4 gg = *((const GAS f32x4*)g + F.lane + 64 * j); f32x4 ov = (f32x4){v[j].x * r * gg.x, v[j].y * r * gg.y, v[j].z * r * gg.z, v[j].w * r * gg.w};
#ifdef TIMING
            ov = ov * tscale; if (m == 0 && j == 0 && F.lane == 0) ov.x += tbump;
#endif
            xr[64 * j] = ov; }
    }
}
#include <hip/hip_bf16.h>
#include <cmath>
namespace attn_body {
using bf16=__hip_bfloat16;
using bf16x8=__attribute__((ext_vector_type(8)))short;
using s16x4=__attribute__((ext_vector_type(4)))short;
using f32x16=__attribute__((ext_vector_type(16)))float;
using u32x4=__attribute__((ext_vector_type(4)))unsigned;
constexpr int D=64;
constexpr int NW=8,QBLK=32,QB=QBLK*NW,KVBLK=64;
__device__ __forceinline__ int crow(int r,int hi){return (r&3)+8*(r>>2)+4*hi;}
#define SBAR() __builtin_amdgcn_sched_barrier(0)
template<bool WIN> __device__ __forceinline__ void amask(f32x16&p0,f32x16&p1,int krel0,int qrel,int hi){
  const float NEG=-INFINITY; const int kb=krel0+4*hi;
  #pragma unroll
  for(int r=0;r<16;++r){const int kv=kb+(r&3)+8*(r>>2);
    if(kv>qrel||(WIN&&kv<=qrel-128))p0[r]=NEG; if(kv+32>qrel||(WIN&&kv+32<=qrel-128))p1[r]=NEG;}
}

constexpr int NSLOT=3, SLOTB=8192;
constexpr int LDS_K=0, LDS_V=NSLOT*SLOTB, LDS_WS=2*NSLOT*SLOTB, LDS_OST=LDS_WS+NW*64*4, LDS_MG=LDS_OST+NW*4096, LDS_BYTES=LDS_MG+NW*96*4;
constexpr float C2=0.125f*1.4426950408889634f;
__device__ __forceinline__ void glds16(const void*gsrc,unsigned lds_dst){unsigned keep;
  asm volatile("s_mov_b32 %0, m0\n\ts_mov_b32 m0, %2\n\ts_nop 0\n\tglobal_load_lds_dwordx4 %1, off\n\ts_mov_b32 m0, %0":"=&s"(keep):"v"(gsrc),"s"(lds_dst):"memory");}
__device__ __forceinline__ float max3f(float a,float b,float c){float r;asm("v_max3_f32 %0, %1, %2, %3":"=v"(r):"v"(a),"v"(b),"v"(c));return r;}
__device__ __forceinline__ float max2f(float a,float b){float r;asm("v_max_f32_e32 %0, %1, %2":"=v"(r):"v"(a),"v"(b));return r;}
__device__ __forceinline__ float fadd_s(float a,float b){float r;asm("v_add_f32_e32 %0, %1, %2":"=v"(r):"v"(a),"v"(b));return r;}
__device__ __forceinline__ float fsub_s(float a,float b){float r;asm("v_sub_f32_e32 %0, %1, %2":"=v"(r):"v"(a),"v"(b));return r;}
typedef float f32x2_t __attribute__((ext_vector_type(2))); typedef __bf16 bf16x2_t __attribute__((ext_vector_type(2)));
__device__ __forceinline__ unsigned cvtpk_s(float lo,float hi){f32x2_t v={lo,hi};bf16x2_t b=__builtin_convertvector(v,bf16x2_t);return __builtin_bit_cast(unsigned,b);}
#define WAIT_BAR(N) asm volatile("s_waitcnt vmcnt(" #N ") lgkmcnt(0)\n\ts_barrier":::"memory")

__device__ __forceinline__ void qkt(f32x16&p0,f32x16&p1,const char*Kslot,const bf16x8*qr,const f32x16&negm,int r32,int hi){
  const char*kb=Kslot+hi*1024+r32*16;
  #pragma unroll
  for(int d0=0;d0<4;++d0){
    const bf16x8 b0=*reinterpret_cast<const bf16x8*>(kb+d0*2048);
    const bf16x8 b1=*reinterpret_cast<const bf16x8*>(kb+d0*2048+512);
    if(d0==0){p0=__builtin_amdgcn_mfma_f32_32x32x16_bf16(b0,qr[0],negm,0,0,0);p1=__builtin_amdgcn_mfma_f32_32x32x16_bf16(b1,qr[0],negm,0,0,0);}
    else{p0=__builtin_amdgcn_mfma_f32_32x32x16_bf16(b0,qr[d0],p0,0,0,0);p1=__builtin_amdgcn_mfma_f32_32x32x16_bf16(b1,qr[d0],p1,0,0,0);}}
}
typedef __attribute__((address_space(3))) const char* lds_cptr;
typedef short v4i16_t __attribute__((ext_vector_type(4)));
__device__ __forceinline__ void kload8(bf16x8*kf,lds_cptr kp){
  kf[0]=*(const __attribute__((address_space(3))) bf16x8*)(kp);      kf[1]=*(const __attribute__((address_space(3))) bf16x8*)(kp+512);
  kf[2]=*(const __attribute__((address_space(3))) bf16x8*)(kp+2048); kf[3]=*(const __attribute__((address_space(3))) bf16x8*)(kp+2560);
  kf[4]=*(const __attribute__((address_space(3))) bf16x8*)(kp+4096); kf[5]=*(const __attribute__((address_space(3))) bf16x8*)(kp+4608);
  kf[6]=*(const __attribute__((address_space(3))) bf16x8*)(kp+6144); kf[7]=*(const __attribute__((address_space(3))) bf16x8*)(kp+6656);
}
__device__ __forceinline__ void kload2(bf16x8*kf,lds_cptr kp,int j){ kf[2*j]=*(const __attribute__((address_space(3))) bf16x8*)(kp+j*2048); kf[2*j+1]=*(const __attribute__((address_space(3))) bf16x8*)(kp+j*2048+512); }
__device__ __forceinline__ s16x4 vtr(lds_cptr p){ return __builtin_bit_cast(s16x4,__builtin_amdgcn_ds_read_tr16_b64_v4i16((__attribute__((address_space(3))) v4i16_t*)p)); }
__device__ __forceinline__ float rowmax(const f32x16&p0,const f32x16&p1){
  float a=max3f(p0[0],p0[1],p1[0]),b=max3f(p0[2],p0[3],p1[1]);a=max3f(a,p1[2],p1[3]);
  #pragma unroll
  for(int r=4;r<16;r+=4){a=max3f(a,p0[r],p0[r+1]);b=max3f(b,p0[r+2],p0[r+3]);a=max3f(a,p1[r],p1[r+1]);b=max3f(b,p1[r+2],p1[r+3]);}
  const float m=max2f(a,b);
  auto rr=__builtin_amdgcn_permlane32_swap(__float_as_uint(m),__float_as_uint(m),false,false);
  return max2f(__uint_as_float(rr[0]),__uint_as_float(rr[1]));
}
__device__ __forceinline__ void pv(f32x16*o,int vb,bf16x8 pa0,bf16x8 pa1,bf16x8 pa2,bf16x8 pa3){
  #pragma unroll
  for(int d0=0;d0<2;++d0){s16x4 lo[4],hi[4];
    #pragma unroll
    for(int ks=0;ks<4;++ks){
      asm volatile("ds_read_b64_tr_b16 %0,%1 offset:%c2":"=&v"(lo[ks]):"v"(vb),"i"(d0*4096+ks*1024):"memory");
      asm volatile("ds_read_b64_tr_b16 %0,%1 offset:%c2":"=&v"(hi[ks]):"v"(vb),"i"(d0*4096+ks*1024+512):"memory");}
    asm volatile("s_waitcnt lgkmcnt(0)":::"memory");SBAR();
    #define PK(k) (bf16x8){lo[k][0],lo[k][1],lo[k][2],lo[k][3],hi[k][0],hi[k][1],hi[k][2],hi[k][3]}
    o[d0]=__builtin_amdgcn_mfma_f32_32x32x16_bf16(pa0,PK(0),o[d0],0,0,0);
    o[d0]=__builtin_amdgcn_mfma_f32_32x32x16_bf16(pa1,PK(1),o[d0],0,0,0);
    o[d0]=__builtin_amdgcn_mfma_f32_32x32x16_bf16(pa2,PK(2),o[d0],0,0,0);
    o[d0]=__builtin_amdgcn_mfma_f32_32x32x16_bf16(pa3,PK(3),o[d0],0,0,0);
    #undef PK
  }
}

#ifndef ATTN_STORE16
#define ATTN_STORE16(p,v) (*(u32x4*)(p)=(v))
#endif
struct MobaIO { bf16* po01; bf16* po2; float* ml; int h; int nsel; unsigned ent; int grow0; };
template<int MODE,int THRL,bool MERGE=false> __device__ __forceinline__ void attn_unit(const bf16*qlane,bf16*Ow0,const int QP,const bf16*__restrict__ Kt0,const bf16*__restrict__ Vt0,const int KP,const int NT,const int koff,const unsigned selmask,const float sinkl2,char*shm,const MobaIO mio=MobaIO{}){
  int tid_=threadIdx.x; asm volatile("":"+v"(tid_));
  const int tid=tid_,lane=tid&63,r32=lane&31,hi=lane>>5; const int wid=__builtin_amdgcn_readfirstlane(tid>>6);
  const bf16*Kh=Kt0,*Vh=Vt0;
  const unsigned lds0=(unsigned)(uintptr_t)shm;
  float*wsf=(float*)(shm+LDS_WS)+wid*64;
  const bf16*ksrc=Kh+(long)lane*KP+wid*8;
  const bf16*vsrc=Vh+(long)(16*(wid&3)+(lane>>2))*KP+(wid>>2)*32+(lane&3)*8;
  const unsigned kdst=lds0+LDS_K+wid*1024, vdst=lds0+LDS_V+wid*1024;
  #define DMA_K(t,slot) glds16(ksrc+(long)(t)*KVBLK*KP,(unsigned)__builtin_amdgcn_readfirstlane(kdst+(slot)))
  #define DMA_V(t,slot) glds16(vsrc+(long)(t)*KVBLK*KP,(unsigned)__builtin_amdgcn_readfirstlane(vdst+(slot)))
  const int vb0=(int)(lds0+LDS_V)+((lane>>4)&1)*32+(lane&3)*8+(4*hi+((lane&15)>>2))*64;
  const char*Kbase=shm+LDS_K; bf16x8 kf[8];
  const lds_cptr shm3=(lds_cptr)shm; const lds_cptr kp0=shm3+LDS_K+hi*1024+r32*16; const lds_cptr vp0=shm3+LDS_V+((lane>>4)&1)*32+(lane&3)*8+(4*hi+((lane&15)>>2))*64;
  DMA_K(0,0);DMA_V(0,0);DMA_K(1,SLOTB);
  bf16x8 qr[4];
  #pragma unroll
  for(int d0=0;d0<4;++d0)qr[d0]=*reinterpret_cast<const bf16x8*>(&qlane[d0*16+hi*8]);
  float mhat=0.f,l_reg=0.f;f32x16 o[2];o[0]=f32x16{};o[1]=f32x16{};f32x16 negm=f32x16{};asm volatile("":"+v"(negm));
  const int qrel=wid*QBLK+r32;
  #define CMASK(P0,P1,t) do{ if(MODE==1){amask<true>(P0,P1,koff+64*(t),qrel,hi);} else if(MODE==0){const int jb_=(t)-(NT-4); if(jb_>=0)amask<false>(P0,P1,64*jb_,qrel,hi);} }while(0)
  #define NEGM_SET(t) do{ float c_=-mhat; if(MODE==0){ if((t)<NT-4 && !((selmask>>((t)>>2))&1u)) c_=-INFINITY; } \
      _Pragma("unroll") for(int r=0;r<16;++r)negm[r]=c_; asm volatile("":"+v"(negm)); }while(0)
  bool resc=false;
  #define START(P0,P1) do{ const float rm=rowmax(P0,P1); resc=false; \
    if(__any(rm>(float)THRL)){ const float dl=__builtin_fmaxf(rm,0.f); mhat+=dl; \
      _Pragma("unroll") for(int r=0;r<16;++r){P0[r]-=dl;P1[r]-=dl;} } \
    _Pragma("unroll") for(int r=0;r<16;++r)P0[r]=__builtin_amdgcn_exp2f(P0[r]); }while(0)
  #define RESC() do{ if(resc){ asm volatile("s_waitcnt lgkmcnt(0)":::"memory"); \
      _Pragma("unroll") for(int d_=0;d_<2;++d_) _Pragma("unroll") for(int r=0;r<16;++r)o[d_][r]*=wsf[crow(r,hi)]; } }while(0)
  f32x16 pA0,pA1,pB0,pB1;
  int sl_prev=0,sl_cur=0,sl_next=SLOTB;
  #define ROT() do{sl_prev=sl_cur;sl_cur=sl_next;sl_next=(sl_next==(NSLOT-1)*SLOTB)?0:sl_next+SLOTB;}while(0)
  DMA_K(2,2*SLOTB);
  WAIT_BAR(3);
  NEGM_SET(0);
  qkt(pA0,pA1,Kbase,qr,negm,r32,hi);asm volatile("s_nop 15\n\ts_nop 7":"+v"(pA0),"+v"(pA1));CMASK(pA0,pA1,0);
  START(pA0,pA1);
  _Pragma("unroll") for(int r=0;r<16;++r)pA1[r]=__builtin_amdgcn_exp2f(pA1[r]);
  WAIT_BAR(0);
  DMA_K(3,0);DMA_V(1,SLOTB);
  ROT();
  kload8(kf,kp0+sl_cur);
  WAIT_BAR(2);
  s16x4 vlo[8],vhi[8]; u32x4 pw0,pw1,pw2,pw3;
  #define PKW(P,B) cvtpk_s(P[B],P[B+1])
  #define PAF(k) __builtin_bit_cast(bf16x8,pw##k)
  #define VFR(i) (bf16x8){vlo[i][0],vlo[i][1],vlo[i][2],vlo[i][3],vhi[i][0],vhi[i][1],vhi[i][2],vhi[i][3]}
  #define PIN(x) asm volatile("":"+v"(x))
  #define MX3(a,b,c) __builtin_fmaxf(__builtin_fmaxf((a),(b)),(c))
  #define GAPA(MF,A0,A1,A2,A3,W0,W1,PW) do{ MF; sacc+=A0; sacc+=A1; sacc+=A2; sacc+=A3; PIN(sacc); W0; W1; PIN(PW); SBAR(); }while(0)
  #define EX(v) __builtin_amdgcn_exp2f(v)
  #define GAPB(MF,X,B) do{ MF; X[B]=EX(X[B]); X[B+1]=EX(X[B+1]); X[B+2]=EX(X[B+2]); X[B+3]=EX(X[B+3]); PIN(X); SBAR(); }while(0)
  #define VRD(i) do{ vlo[i]=vtr(vp_+(((i)>>2)*4096+((i)&3)*1024)); vhi[i]=vtr(vp_+(((i)>>2)*4096+((i)&3)*1024+512)); }while(0)
  #define KRD(G,j) do{ if(G){ kload2(kf,kp0+sl_next,j); SBAR(); } }while(0)
  #define STEP(C0,C1,P0,P1,t,GK,GV,GL) do{ NEGM_SET(t); SBAR(); \
    const lds_cptr vp_=vp0+sl_prev; \
    VRD(0); SBAR(); float sacc=(P0[0]+P0[1]); \
    GAPA(C0=__builtin_amdgcn_mfma_f32_32x32x16_bf16(kf[0],qr[0],negm,0,0,0), P0[2],P0[3],P0[4],P0[5],     pw0[0]=PKW(P0,0), pw0[1]=PKW(P0,2), pw0); \
    VRD(4); SBAR(); GAPA(C1=__builtin_amdgcn_mfma_f32_32x32x16_bf16(kf[1],qr[0],negm,0,0,0), P0[6],P0[7],P0[8],P0[9],     pw0[2]=PKW(P0,4), pw0[3]=PKW(P0,6), pw0); \
    VRD(1); SBAR(); GAPA(C0=__builtin_amdgcn_mfma_f32_32x32x16_bf16(kf[2],qr[1],C0,0,0,0),   P0[10],P0[11],P0[12],P0[13], pw1[0]=PKW(P0,8), pw1[1]=PKW(P0,10), pw1); \
    VRD(5); SBAR(); GAPA(C1=__builtin_amdgcn_mfma_f32_32x32x16_bf16(kf[3],qr[1],C1,0,0,0),   P0[14],P0[15],P1[0],P1[1],   pw1[2]=PKW(P0,12),pw1[3]=PKW(P0,14), pw1); \
    VRD(2); SBAR(); GAPA(C0=__builtin_amdgcn_mfma_f32_32x32x16_bf16(kf[4],qr[2],C0,0,0,0),   P1[2],P1[3],P1[4],P1[5],     pw2[0]=PKW(P1,0), pw2[1]=PKW(P1,2), pw2); \
    VRD(6); SBAR(); GAPA(C1=__builtin_amdgcn_mfma_f32_32x32x16_bf16(kf[5],qr[2],C1,0,0,0),   P1[6],P1[7],P1[8],P1[9],     pw2[2]=PKW(P1,4), pw2[3]=PKW(P1,6), pw2); \
    VRD(3); SBAR(); GAPA(C0=__builtin_amdgcn_mfma_f32_32x32x16_bf16(kf[6],qr[3],C0,0,0,0),   P1[10],P1[11],P1[12],P1[13], pw3[0]=PKW(P1,8), pw3[1]=PKW(P1,10), pw3); \
    VRD(7); SBAR(); GAPA(C1=__builtin_amdgcn_mfma_f32_32x32x16_bf16(kf[7],qr[3],C1,0,0,0),   P1[14],P1[15],0.f,0.f,       pw3[2]=PKW(P1,12),pw3[3]=PKW(P1,14), pw3); \
    l_reg+=sacc; \
    if(GK){DMA_K((t)+3,sl_cur);} if(GV){DMA_V((t)+1,sl_next);} \
    CMASK(C0,C1,t); \
    { float a=MX3(C0[0],C0[1],C1[0]),b=MX3(C0[2],C0[3],C1[1]); a=MX3(a,C1[2],C1[3]); \
      _Pragma("unroll") for(int r=4;r<16;r+=4){a=MX3(a,C0[r],C0[r+1]);b=MX3(b,C0[r+2],C0[r+3]);a=MX3(a,C1[r],C1[r+1]);b=MX3(b,C1[r+2],C1[r+3]);} \
      float rm=__builtin_fmaxf(a,b); { auto rr=__builtin_amdgcn_permlane32_swap(__float_as_uint(rm),__float_as_uint(rm),false,false); rm=__builtin_fmaxf(__uint_as_float(rr[0]),__uint_as_float(rr[1])); } \
      resc=false; \
      if(__builtin_expect(__any(rm>(float)THRL),0)){ const float dl=__builtin_fmaxf(rm,0.f); mhat+=dl; \
        _Pragma("unroll") for(int r=0;r<16;++r){C0[r]-=dl;C1[r]-=dl;} \
        const float f=__builtin_amdgcn_exp2f(-dl); l_reg*=f; if(hi==0)wsf[r32]=f; resc=true; } } \
    SBAR(); \
    GAPB(o[0]=__builtin_amdgcn_mfma_f32_32x32x16_bf16(PAF(0),VFR(0),o[0],0,0,0), C0,0); \
    GAPB(o[1]=__builtin_amdgcn_mfma_f32_32x32x16_bf16(PAF(0),VFR(4),o[1],0,0,0), C0,4); \
    KRD(GL,0); GAPB(o[0]=__builtin_amdgcn_mfma_f32_32x32x16_bf16(PAF(1),VFR(1),o[0],0,0,0), C0,8); \
    KRD(GL,1); GAPB(o[1]=__builtin_amdgcn_mfma_f32_32x32x16_bf16(PAF(1),VFR(5),o[1],0,0,0), C0,12); \
    KRD(GL,2); GAPB(o[0]=__builtin_amdgcn_mfma_f32_32x32x16_bf16(PAF(2),VFR(2),o[0],0,0,0), C1,0); \
    KRD(GL,3); GAPB(o[1]=__builtin_amdgcn_mfma_f32_32x32x16_bf16(PAF(2),VFR(6),o[1],0,0,0), C1,4); \
    GAPB(o[0]=__builtin_amdgcn_mfma_f32_32x32x16_bf16(PAF(3),VFR(3),o[0],0,0,0), C1,8); \
    GAPB(o[1]=__builtin_amdgcn_mfma_f32_32x32x16_bf16(PAF(3),VFR(7),o[1],0,0,0), C1,12); \
    }while(0)
  int t=1;
  #undef CMASK
  #define CMASK(P0,P1,t) do{}while(0)
  for(;t+5<NT;t+=2){
    STEP(pB0,pB1,pA0,pA1,t,true,true,true);     WAIT_BAR(2); RESC(); ROT();
    STEP(pA0,pA1,pB0,pB1,t+1,true,true,true);   WAIT_BAR(2); RESC(); ROT();
  }
  #undef CMASK
  #define CMASK(P0,P1,t) do{ if(MODE==1){amask<true>(P0,P1,koff+64*(t),qrel,hi);} else if(MODE==0){const int jb_=(t)-(NT-4); if(jb_>=0)amask<false>(P0,P1,64*jb_,qrel,hi);} }while(0)
  #define ENDW(tt) do{ if((tt)+3<NT){WAIT_BAR(2);} else if((tt)+2<NT){WAIT_BAR(1);} else {WAIT_BAR(0);} }while(0)
  for(;t+1<NT;t+=2){
    STEP(pB0,pB1,pA0,pA1,t,(t+3<NT),(t+1<NT),(t+1<NT));       ENDW(t);   RESC(); ROT();
    STEP(pA0,pA1,pB0,pB1,t+1,(t+4<NT),(t+2<NT),(t+2<NT));     ENDW(t+1); RESC(); ROT();
  }
  STEP(pB0,pB1,pA0,pA1,NT-1,false,false,false); RESC();
  { float sacc=pB0[0]+pB0[1]; _Pragma("unroll") for(int r=2;r<16;++r)sacc+=pB0[r]; _Pragma("unroll") for(int r=0;r<16;++r)sacc+=pB1[r]; l_reg+=sacc;
    pw0=(u32x4){PKW(pB0,0),PKW(pB0,2),PKW(pB0,4),PKW(pB0,6)};pw1=(u32x4){PKW(pB0,8),PKW(pB0,10),PKW(pB0,12),PKW(pB0,14)};pw2=(u32x4){PKW(pB1,0),PKW(pB1,2),PKW(pB1,4),PKW(pB1,6)};pw3=(u32x4){PKW(pB1,8),PKW(pB1,10),PKW(pB1,12),PKW(pB1,14)};
    SBAR(); pv(o,vb0+sl_cur,PAF(0),PAF(1),PAF(2),PAF(3)); }
  #undef PKW
  #undef PAF
  #undef VFR
  #undef PIN
  #undef MX3
  #undef GAPA
  #undef GAPB
  #undef EX
  #undef VRD
  #undef KRD
  #undef STEP
  #undef ENDW
  {auto rr=__builtin_amdgcn_permlane32_swap(__float_as_uint(l_reg),__float_as_uint(l_reg),false,false);l_reg=__uint_as_float(rr[0])+__uint_as_float(rr[1]);}
  if(MODE==1)l_reg+=__builtin_amdgcn_exp2f(sinkl2-mhat);
  float*mgs=(float*)(shm+LDS_MG)+wid*96;
  float rowscale=l_reg;
  if(MERGE){
    const long gr=(long)mio.grow0+wid*QBLK+r32; float mr[3],lr[3],ms=mhat;
    #pragma unroll
    for(int r=0;r<3;++r){ mr[r]=-INFINITY; lr[r]=0.f; if(r<mio.nsel){ const float2 v=*(const float2*)(mio.ml+(((long)r*T+gr)*8+mio.h)*2); mr[r]=v.x; lr[r]=v.y; ms=__builtin_fmaxf(ms,v.x);} }
    const float wo=__builtin_amdgcn_exp2f(mhat-ms); float L=l_reg*wo, wr_[3];
    #pragma unroll
    for(int r=0;r<3;++r){ wr_[r]=(r<mio.nsel)?__builtin_amdgcn_exp2f(mr[r]-ms):0.f; L+=lr[r]*wr_[r]; }
    const float rL=__builtin_amdgcn_rcpf(L);
    if(hi==0){ mgs[r32]=wr_[0]*rL; mgs[32+r32]=wr_[1]*rL; mgs[64+r32]=wr_[2]*rL; }
    rowscale=L*__builtin_amdgcn_rcpf(wo);
  }
  if(MODE==2)rowscale=1.0f;
  if(hi==0)wsf[32+r32]=rowscale;asm volatile("s_waitcnt lgkmcnt(0)":::"memory");
  float rli[16];
  #pragma unroll
  for(int r=0;r<16;++r)rli[r]=__builtin_amdgcn_rcpf(wsf[32+crow(r,hi)]);
  bf16*Ow=Ow0+(long)(wid*QBLK)*QP;
  { bf16*stg=(bf16*)(shm+LDS_OST)+wid*2048;
    #pragma unroll
    for(int r=0;r<16;++r){const int orow=crow(r,hi);
      #pragma unroll
      for(int d0=0;d0<2;++d0)stg[orow*64+d0*32+r32]=__float2bfloat16(o[d0][r]*rli[r]);}
    asm volatile("s_waitcnt lgkmcnt(0)":::"memory");
    if(MODE==2){
      if(hi==0&&((mio.ent>>16)&1u)){ const long gr=mio.ent&16383u; const int rs=(mio.ent>>14)&3; float2 v; v.x=mhat; v.y=l_reg; *(float2*)(mio.ml+(((long)rs*T+gr)*8+mio.h)*2)=v; }
      #pragma unroll
      for(int i=0;i<4;++i){const int row=i*8+(lane>>3),ch=lane&7; const unsigned en=(unsigned)__shfl((int)mio.ent,row); const u32x4 v=*(const u32x4*)(stg+row*64+ch*8);
        const long gr=en&16383u; const int rs=(en>>14)&3; bf16*dst=(rs<2?mio.po01+((long)rs*T+gr)*512:mio.po2+gr*512)+mio.h*64+ch*8;
        if((en>>16)&1u)*(u32x4*)dst=v; }
    } else {
      #pragma unroll
      for(int i=0;i<4;++i){const int row=i*8+(lane>>3),ch=lane&7; u32x4 v=*(const u32x4*)(stg+row*64+ch*8);
        if(MERGE){ const long gr=(long)mio.grow0+wid*QBLK+row; float acc8[8];
          acc8[0]=__uint_as_float(v.x<<16);acc8[1]=__uint_as_float(v.x&0xffff0000u);acc8[2]=__uint_as_float(v.y<<16);acc8[3]=__uint_as_float(v.y&0xffff0000u);
          acc8[4]=__uint_as_float(v.z<<16);acc8[5]=__uint_as_float(v.z&0xffff0000u);acc8[6]=__uint_as_float(v.w<<16);acc8[7]=__uint_as_float(v.w&0xffff0000u);
          #pragma unroll
          for(int r=0;r<3;++r) if(r<mio.nsel){ const float c=mgs[r*32+row]; const bf16*src=(r<2?mio.po01+((long)r*T+gr)*512:mio.po2+gr*512)+mio.h*64+ch*8; const u32x4 p=*(const u32x4*)src;
            acc8[0]+=c*__uint_as_float(p.x<<16);acc8[1]+=c*__uint_as_float(p.x&0xffff0000u);acc8[2]+=c*__uint_as_float(p.y<<16);acc8[3]+=c*__uint_as_float(p.y&0xffff0000u);
            acc8[4]+=c*__uint_as_float(p.z<<16);acc8[5]+=c*__uint_as_float(p.z&0xffff0000u);acc8[6]+=c*__uint_as_float(p.w<<16);acc8[7]+=c*__uint_as_float(p.w&0xffff0000u); }
          v.x=cvtpk_s(acc8[0],acc8[1]);v.y=cvtpk_s(acc8[2],acc8[3]);v.z=cvtpk_s(acc8[4],acc8[5]);v.w=cvtpk_s(acc8[6],acc8[7]); }
        ATTN_STORE16(Ow+(long)row*QP+ch*8,v);} } }
  asm volatile("s_waitcnt lgkmcnt(0)\n\ts_barrier":::"memory");
  #undef DMA_K
  #undef DMA_V
  #undef CMASK
  #undef START
  #undef NEGM_SET
  #undef RESC
  #undef ROT
}
constexpr int ATTN_LDS_BYTES=LDS_BYTES;
#undef SBAR
#undef WAIT_BAR
}
constexpr float ATT_C2 = 0.125f * 1.4426950408889634f;
__device__ __forceinline__ void swa_phase(const Frame& F_in, const Params& P_in, int l) {
    PH_BEGIN
    bf16* AQ = (bf16*)(P.ws + WS_R + RO_AQ); const bf16* AK = (const bf16*)(P.ws + WS_R + RO_AK); const bf16* AV = (const bf16*)(P.ws + WS_R + RO_AV);
    const float* sinks = P.in[I_SINK] + l * 8; char* shm = (char*)F.lds;
    for (int idx = F.vcu; idx < 256; idx += F.G) {
        const int bh = idx >> 4, s = idx & 15, b = bh >> 3, hq = bh & 7, hkv = hq >> 2; const float sk = sinks[hq] * 1.4426950408889634f;
        for (int i = 0; i < 2; ++i) {
            const int qb = i ? 31 - s : s; const size_t row0 = (size_t)b * SEQ + (size_t)qb * 256; const int koff = qb ? -128 : 0, NT = qb ? 6 : 4;
            attn_body::attn_unit<1, 8>((const attn_body::bf16*)(AQ + (row0 + F.wave * 32 + (F.lane & 31)) * 512 + hq * 64), (attn_body::bf16*)(AQ + row0 * 512 + hq * 64), 512,
                (const attn_body::bf16*)(AK + (size_t)((long)row0 + koff) * 128 + hkv * 64), (const attn_body::bf16*)(AV + (size_t)((long)row0 + koff) * 128 + hkv * 64), 128, NT, koff, 0u, sk, shm);
        }
    }
}
__device__ __forceinline__ int list_off(int j) { return 8192 * j - 128 * j * (j + 1); }
__device__ __forceinline__ void moba_route(const Frame& F_in, const Params& P_in, int l) {
    PH_BEGIN
    const bf16* BQ = (const bf16*)(P.ws + WS_R + RO_BQ); const float* kbp = (const float*)(P.ws + WS_KBP); const int tid = F.tid;
    unsigned* MC = (unsigned*)(P.ws + WS_CTL) + CW_MCNT + l * 512; unsigned short* LIST = (unsigned short*)(P.ws + WS_LIST);
    LAS float* kb_s = (LAS float*)(F.lds + 98304); LAS int* cnt_s = (LAS int*)(F.lds + 98304 + 8192); LAS int* base_s = cnt_s + 32; LAS float* mg = (LAS float*)(cnt_s + 64);
    for (int idx = F.vcu; idx < 256; idx += F.G) {
        const int bh = idx >> 4, s = idx & 15, b = bh >> 3, h = bh & 7;
        for (int i = 0; i < 2; ++i) {
            const int qb = i ? s : 31 - s; if (qb == 0) continue; const size_t row0 = (size_t)b * SEQ + (size_t)qb * 256;
            for (int e = tid; e < qb * 64; e += 512) { const int n = e >> 6, d = e & 63; const float* kp = kbp + ((size_t)(b * 32 + n) * 2) * 512 + h * 64 + d; kb_s[e] = kp[0] + kp[512]; }
            if (tid < 32) cnt_s[tid] = 0;
            __syncthreads();
            const int row = tid & 255, half = tid >> 8;
            const GAS v4u* qp = (const GAS v4u*)(BQ + (row0 + row) * 512 + h * 64); float q[64];
#pragma unroll
            for (int c = 0; c < 8; ++c) { const v4u w = qp[c]; q[8 * c] = bflo(w.x); q[8 * c + 1] = bfhi(w.x); q[8 * c + 2] = bflo(w.y); q[8 * c + 3] = bfhi(w.y); q[8 * c + 4] = bflo(w.z); q[8 * c + 5] = bfhi(w.z); q[8 * c + 6] = bflo(w.w); q[8 * c + 7] = bfhi(w.w); }
            float v1 = -INFINITY, v2 = -INFINITY, v3 = -INFINITY; int i1 = 64, i2 = 64, i3 = 64;
#define MB_BETTER(a, ia, b_, ib) ((a) > (b_) || ((a) == (b_) && (ia) < (ib)))
#define MB_INS(sc_, n_) do { if (MB_BETTER(sc_, n_, v1, i1)) { v3 = v2; i3 = i2; v2 = v1; i2 = i1; v1 = sc_; i1 = n_; } else if (MB_BETTER(sc_, n_, v2, i2)) { v3 = v2; i3 = i2; v2 = sc_; i2 = n_; } else if (MB_BETTER(sc_, n_, v3, i3)) { v3 = sc_; i3 = n_; } } while (0)
            for (int n = half; n < qb; n += 2) { const LAS f32x4* kr = (const LAS f32x4*)(kb_s + n * 64); float sc = 0.f;
#pragma unroll
                for (int c = 0; c < 16; ++c) { const f32x4 kv = kr[c]; sc += (q[4 * c] * kv.x + q[4 * c + 1] * kv.y) + (q[4 * c + 2] * kv.z + q[4 * c + 3] * kv.w); }
                MB_INS(sc, n); }
            if (half == 1) { LAS float* m_ = mg + row * 6; m_[0] = v1; m_[1] = v2; m_[2] = v3; m_[3] = __int_as_float(i1); m_[4] = __int_as_float(i2); m_[5] = __int_as_float(i3); }
            __syncthreads();
            const int nsel = qb < 3 ? qb : 3; int rk0 = 0, rk1 = 0, rk2 = 0;
            if (half == 0) { const LAS float* m_ = mg + row * 6;
#pragma unroll
                for (int k = 0; k < 3; ++k) { const float sc = m_[k]; const int n = __float_as_int(m_[3 + k]); if (n < 64) MB_INS(sc, n); }
                if (qb <= 3) { i1 = 0; i2 = 1; i3 = 2; }
                rk0 = atomicAdd((int*)&cnt_s[i1], 1); if (nsel > 1) rk1 = atomicAdd((int*)&cnt_s[i2], 1); if (nsel > 2) rk2 = atomicAdd((int*)&cnt_s[i3], 1); }
#undef MB_INS
#undef MB_BETTER
            __syncthreads();
            if (tid < 32) { const int c = cnt_s[tid]; base_s[tid] = c ? (int)atomicAdd(MC + bh * 32 + tid, (unsigned)c) : 0; }
            __syncthreads();
            if (half == 0) { unsigned short* lb = LIST + (size_t)bh * LIST_BH; const unsigned rl = (unsigned)(qb * 256 + row);
                lb[list_off(i1) + base_s[i1] + rk0] = (unsigned short)(rl | (0u << 13));
                if (nsel > 1) lb[list_off(i2) + base_s[i2] + rk1] = (unsigned short)(rl | (1u << 13));
                if (nsel > 2) lb[list_off(i3) + base_s[i3] + rk2] = (unsigned short)(rl | (2u << 13)); }
            __syncthreads();
        }
    }
}
namespace rkv {
using attn_body::bf16x8; using attn_body::f32x16; using attn_body::u32x4; using attn_body::crow; using attn_body::cvtpk_s;
typedef unsigned u32x2v __attribute__((ext_vector_type(2)));
constexpr int KP = 72, VP = 264;
constexpr int OFF_K = 0, OFF_V = 256 * KP * 2, OFF_ST = OFF_V + 64 * VP * 2, OFF_SC = OFF_ST + 8 * 4096, OFF_MG = OFF_SC + 8 * 32 * 4, OFF_END = OFF_MG + 8 * 96 * 4;
static_assert(OFF_END <= 110592, "rkv lds");
__device__ __forceinline__ void load_block(const bf16* Kg, const bf16* Vg, LAS unsigned char* lds, int tid) {
#pragma unroll
    for (int it = 0; it < 4; ++it) { const int idx = tid + 512 * it, row = idx >> 3, c = idx & 7; *(LAS v4u*)(lds + OFF_K + (row * KP + c * 8) * 2) = *(const GAS v4u*)(Kg + (size_t)row * 512 + c * 8); }
#pragma unroll
    for (int it = 0; it < 4; ++it) { const int idx = tid + 512 * it, row = idx >> 3, c = idx & 7; const v4u w = *(const GAS v4u*)(Vg + (size_t)row * 512 + c * 8);
        LAS unsigned short* vt = (LAS unsigned short*)(lds + OFF_V) + (c * 8) * VP + row;
        vt[0 * VP] = (unsigned short)(w.x & 0xffffu); vt[1 * VP] = (unsigned short)(w.x >> 16); vt[2 * VP] = (unsigned short)(w.y & 0xffffu); vt[3 * VP] = (unsigned short)(w.y >> 16);
        vt[4 * VP] = (unsigned short)(w.z & 0xffffu); vt[5 * VP] = (unsigned short)(w.z >> 16); vt[6 * VP] = (unsigned short)(w.w & 0xffffu); vt[7 * VP] = (unsigned short)(w.w >> 16); }
}
__device__ __forceinline__ void load_q(const bf16* qlane, int lane, bf16x8 (&qr)[4]) {
#pragma unroll
    for (int d0 = 0; d0 < 4; ++d0) qr[d0] = *(const bf16x8*)(qlane + d0 * 16 + (lane >> 5) * 8);
}
__device__ __forceinline__ void group(const bf16x8 (&qr)[4], int nt, int causal_qrel, LAS unsigned char* lds, int wid, int lane, f32x16 (&o)[2], float& mref, float& lsum) {
    const int r32 = lane & 31, hi = lane >> 5;
    const int qrel = causal_qrel + r32;
    float m = -INFINITY;
#pragma unroll 1
    for (int t = 0; t < nt; ++t) {
        f32x16 p0 = f32x16{}, p1 = f32x16{};
        const LAS unsigned char* kb = lds + OFF_K + ((t * 64 + r32) * KP + hi * 8) * 2;
#pragma unroll
        for (int d0 = 0; d0 < 4; ++d0) { const bf16x8 a0 = *(const LAS bf16x8*)(kb + d0 * 32), a1 = *(const LAS bf16x8*)(kb + 32 * KP * 2 + d0 * 32);
            p0 = __builtin_amdgcn_mfma_f32_32x32x16_bf16(a0, qr[d0], p0, 0, 0, 0); p1 = __builtin_amdgcn_mfma_f32_32x32x16_bf16(a1, qr[d0], p1, 0, 0, 0); }
        if (causal_qrel >= 0 && t == nt - 1) { const int kb0 = t * 64 + 4 * hi;
#pragma unroll
            for (int r = 0; r < 16; ++r) { const int kv = kb0 + (r & 3) + 8 * (r >> 2); if (kv > qrel) p0[r] = -INFINITY; if (kv + 32 > qrel) p1[r] = -INFINITY; } }
#pragma unroll
        for (int r = 0; r < 16; ++r) m = fmaxf(m, fmaxf(p0[r], p1[r]));
    }
    { auto rr = __builtin_amdgcn_permlane32_swap(__float_as_uint(m), __float_as_uint(m), false, false); m = fmaxf(__uint_as_float(rr[0]), __uint_as_float(rr[1])); }
    o[0] = f32x16{}; o[1] = f32x16{}; float l = 0.f;
#pragma unroll 1
    for (int t = 0; t < nt; ++t) {
        f32x16 p0, p1;
#pragma unroll
        for (int r = 0; r < 16; ++r) { p0[r] = -m; p1[r] = -m; }
        const LAS unsigned char* kb = lds + OFF_K + ((t * 64 + r32) * KP + hi * 8) * 2;
#pragma unroll
        for (int d0 = 0; d0 < 4; ++d0) { const bf16x8 a0 = *(const LAS bf16x8*)(kb + d0 * 32), a1 = *(const LAS bf16x8*)(kb + 32 * KP * 2 + d0 * 32);
            p0 = __builtin_amdgcn_mfma_f32_32x32x16_bf16(a0, qr[d0], p0, 0, 0, 0); p1 = __builtin_amdgcn_mfma_f32_32x32x16_bf16(a1, qr[d0], p1, 0, 0, 0); }
        if (causal_qrel >= 0 && t == nt - 1) { const int kb0 = t * 64 + 4 * hi;
#pragma unroll
            for (int r = 0; r < 16; ++r) { const int kv = kb0 + (r & 3) + 8 * (r >> 2); if (kv > qrel) p0[r] = -INFINITY; if (kv + 32 > qrel) p1[r] = -INFINITY; } }
        float rs = 0.f;
#pragma unroll
        for (int r = 0; r < 16; ++r) { p0[r] = __builtin_amdgcn_exp2f(p0[r]); p1[r] = __builtin_amdgcn_exp2f(p1[r]); rs += p0[r] + p1[r]; }
        l += rs;
        u32x4 pw[4];
#pragma unroll
        for (int k = 0; k < 4; ++k) { pw[0][k] = cvtpk_s(p0[2 * k], p0[2 * k + 1]); pw[1][k] = cvtpk_s(p0[8 + 2 * k], p0[9 + 2 * k]); pw[2][k] = cvtpk_s(p1[2 * k], p1[2 * k + 1]); pw[3][k] = cvtpk_s(p1[8 + 2 * k], p1[9 + 2 * k]); }
        const LAS unsigned char* vb = lds + OFF_V + (r32 * VP + t * 64 + 4 * hi) * 2;
#pragma unroll
        for (int d0 = 0; d0 < 2; ++d0)
#pragma unroll
            for (int s = 0; s < 4; ++s) { const u32x2v lo = *(const LAS u32x2v*)(vb + (d0 * 32 * VP + 16 * s) * 2), hi8 = *(const LAS u32x2v*)(vb + (d0 * 32 * VP + 16 * s + 8) * 2);
                const u32x4 bv = (u32x4){lo.x, lo.y, hi8.x, hi8.y};
                o[d0] = __builtin_amdgcn_mfma_f32_32x32x16_bf16(__builtin_bit_cast(bf16x8, pw[s]), __builtin_bit_cast(bf16x8, bv), o[d0], 0, 0, 0); }
    }
    { auto rr = __builtin_amdgcn_permlane32_swap(__float_as_uint(l), __float_as_uint(l), false, false); l = __uint_as_float(rr[0]) + __uint_as_float(rr[1]); }
    mref = m; lsum = l;
}
__device__ __forceinline__ void stage_o(const f32x16 (&o)[2], float rowscale, LAS unsigned char* lds, int wid, int lane) {
    const int r32 = lane & 31, hi = lane >> 5; LAS float* sc = (LAS float*)(lds + OFF_SC) + wid * 32; LAS unsigned short* stg = (LAS unsigned short*)(lds + OFF_ST + wid * 4096);
    asm volatile("" ::: "memory");
    if (hi == 0) sc[r32] = rowscale;
    LDS_WAIT(); asm volatile("" ::: "memory");
#pragma unroll
    for (int r = 0; r < 16; ++r) { const int orow = crow(r, hi); const float ri = __builtin_amdgcn_rcpf(sc[orow]);
        stg[orow * 64 + r32] = (unsigned short)f2bf(o[0][r] * ri); stg[orow * 64 + 32 + r32] = (unsigned short)f2bf(o[1][r] * ri); }
    LDS_WAIT(); asm volatile("" ::: "memory");
}
}

__device__ __forceinline__ void moba_past(const Frame& F_in, const Params& P_in, int l) {
    PH_BEGIN
    const bf16* BQ = (const bf16*)(P.ws + WS_R + RO_BQ); const bf16* BK = (const bf16*)(P.ws + WS_R + RO_BK); const bf16* BV = (const bf16*)(P.ws + WS_R + RO_BV);
    const unsigned* MC = (const unsigned*)(P.ws + WS_CTL) + CW_MCNT + l * 512; const unsigned short* LIST = (const unsigned short*)(P.ws + WS_LIST);
    bf16* po01 = (bf16*)((unsigned char*)P.out + 32 * MiB); bf16* po2 = (bf16*)(P.ws + WS_PO2); float* ml = (float*)(P.ws + WS_ML);
    LAS unsigned char* lds = F.lds; const int tid = F.tid, lane = F.lane, wid = F.wave; LAS int* pre_s = (LAS int*)(F.lds + 110592);
    {
        int v = 0, cntv = 0; if (tid < 496) { const int bh = tid / 31, j = tid % 31; cntv = (int)__hip_atomic_load(MC + bh * 32 + j, __ATOMIC_RELAXED, __HIP_MEMORY_SCOPE_AGENT); v = (cntv + 511) >> 9; }
        int inc = v;
#pragma unroll
        for (int o_ = 1; o_ < 64; o_ <<= 1) { const int n_ = __builtin_amdgcn_ds_bpermute((lane - o_) << 2, inc); if (lane >= o_) inc += n_; }
        if (lane == 63) pre_s[600 + wid] = inc;
        __syncthreads();
        int base = 0;
#pragma unroll
        for (int w_ = 0; w_ < 8; ++w_) if (w_ < wid) base += pre_s[600 + w_];
        if (tid < 496) { pre_s[tid] = base + inc - v; pre_s[1024 + tid] = cntv; }
        if (tid == 495) pre_s[496] = base + inc;
        __syncthreads(); }
    const int U = pre_s[496];
    for (int u = F.vcu; u < U; u += F.G) {
        int lo = 0, hi_ = 495;
        while (lo < hi_) { const int mid = (lo + hi_ + 1) >> 1; if (pre_s[mid] <= u) lo = mid; else hi_ = mid - 1; }
        const int p = lo, bh = p / 31, j = p % 31, slice = u - pre_s[p], b = bh >> 3, h = bh & 7; const int cnt = pre_s[1024 + p];
        const int e0 = slice * 512, ne = (cnt - e0) < 512 ? (cnt - e0) : 512, ng = (ne + 31) >> 5;
        unsigned ent[2]; rkv::bf16x8 qr[2][4];
#pragma unroll
        for (int k = 0; k < 2; ++k) { const int ei = e0 + (wid + 8 * k) * 32 + (lane & 31); const bool valid = ei < cnt;
            const unsigned e = LIST[(size_t)bh * LIST_BH + list_off(j) + (valid ? ei : e0)]; const unsigned rl = e & 8191u, rs = e >> 13;
            ent[k] = (unsigned)((size_t)b * SEQ + rl) | (rs << 14) | ((valid ? 1u : 0u) << 16); }
#pragma unroll
        for (int k = 0; k < 2; ++k) rkv::load_q(BQ + (size_t)(ent[k] & 16383u) * 512 + h * 64, lane, qr[k]);
        rkv::load_block(BK + ((size_t)b * SEQ + (size_t)j * 256) * 512 + h * 64, BV + ((size_t)b * SEQ + (size_t)j * 256) * 512 + h * 64, lds, tid);
        __syncthreads();
#pragma unroll
        for (int k = 0; k < 2; ++k) if (wid + 8 * k < ng) {
            rkv::f32x16 o[2]; float m, ls; rkv::group(qr[k], 4, -1, lds, wid, lane, o, m, ls);
            rkv::stage_o(o, 1.0f, lds, wid, lane);
            const size_t grow = ent[k] & 16383u; const unsigned rs = (ent[k] >> 14) & 3u; const bool valid = (ent[k] >> 16) & 1u;
            if (lane < 32 && valid) { float2 v; v.x = m; v.y = ls; *(float2*)(ml + (((size_t)rs * T + grow) * 8 + h) * 2) = v; }
            const LAS unsigned short* stg = (const LAS unsigned short*)(lds + rkv::OFF_ST + wid * 4096);
#pragma unroll
            for (int i = 0; i < 4; ++i) { const int row = i * 8 + (lane >> 3), ch = lane & 7; const unsigned en = (unsigned)__builtin_amdgcn_ds_bpermute(row << 2, (int)ent[k]); const v4u v = *(const LAS v4u*)(stg + row * 64 + ch * 8);
                const size_t gr = en & 16383u; const int r_ = (en >> 14) & 3; bf16* dst = (r_ < 2 ? po01 + ((size_t)r_ * T + gr) * 512 : po2 + gr * 512) + h * 64 + ch * 8;
                if ((en >> 16) & 1u) *(GAS v4u*)dst = v; }
        }
        __syncthreads();
    }
}
__device__ __forceinline__ void moba_own(const Frame& F_in, const Params& P_in) {
    PH_BEGIN
    bf16* BQ = (bf16*)(P.ws + WS_R + RO_BQ); const bf16* BK = (const bf16*)(P.ws + WS_R + RO_BK); const bf16* BV = (const bf16*)(P.ws + WS_R + RO_BV);
    const bf16* po01 = (const bf16*)((unsigned char*)P.out + 32 * MiB); const bf16* po2 = (const bf16*)(P.ws + WS_PO2); const float* ml = (const float*)(P.ws + WS_ML);
    LAS unsigned char* lds = F.lds; const int tid = F.tid, lane = F.lane, wid = F.wave, r32 = lane & 31, hi = lane >> 5;
    for (int idx = F.vcu; idx < 512; idx += F.G) {
        const int bh = idx >> 5, qb = idx & 31, b = bh >> 3, h = bh & 7; const size_t row0 = (size_t)b * SEQ + (size_t)qb * 256; const int nsel = qb < 3 ? qb : 3;
        const size_t grow = row0 + wid * 32 + r32;
        rkv::bf16x8 qr[4]; rkv::load_q(BQ + grow * 512 + h * 64, lane, qr);
        float mr[3], lr[3];
#pragma unroll
        for (int r = 0; r < 3; ++r) { mr[r] = -INFINITY; lr[r] = 0.f; if (r < nsel) { const float2 v = *(const float2*)(ml + (((size_t)r * T + grow) * 8 + h) * 2); mr[r] = v.x; lr[r] = v.y; } }
        rkv::load_block(BK + row0 * 512 + h * 64, BV + row0 * 512 + h * 64, lds, tid);
        __syncthreads();
        rkv::f32x16 o[2]; float m, ls; rkv::group(qr, (wid * 32 + 31) / 64 + 1, wid * 32, lds, wid, lane, o, m, ls);
        v4u pq[4][3];
#pragma unroll
        for (int i = 0; i < 4; ++i) { const size_t gr = row0 + wid * 32 + i * 8 + (lane >> 3);
#pragma unroll
            for (int r = 0; r < 3; ++r) { pq[i][r] = (v4u){0u, 0u, 0u, 0u}; if (r < nsel) pq[i][r] = *(const GAS v4u*)((r < 2 ? po01 + ((size_t)r * T + gr) * 512 : po2 + gr * 512) + h * 64 + (lane & 7) * 8); } }
        float ms = m;
#pragma unroll
        for (int r = 0; r < 3; ++r) ms = fmaxf(ms, mr[r]);
        const float wo = __builtin_amdgcn_exp2f(m - ms); float L = ls * wo, wr_[3];
#pragma unroll
        for (int r = 0; r < 3; ++r) { wr_[r] = (r < nsel) ? __builtin_amdgcn_exp2f(mr[r] - ms) : 0.f; L += lr[r] * wr_[r]; }
        const float rL = __builtin_amdgcn_rcpf(L);
        LAS float* mgs = (LAS float*)(lds + rkv::OFF_MG) + wid * 96;
        if (hi == 0) { mgs[r32] = wr_[0] * rL; mgs[32 + r32] = wr_[1] * rL; mgs[64 + r32] = wr_[2] * rL; }
        rkv::stage_o(o, L * __builtin_amdgcn_rcpf(wo), lds, wid, lane);
        const LAS unsigned short* stg = (const LAS unsigned short*)(lds + rkv::OFF_ST + wid * 4096);
#pragma unroll
        for (int i = 0; i < 4; ++i) { const int row = i * 8 + (lane >> 3), ch = lane & 7; const size_t gr = row0 + wid * 32 + row; const v4u v = *(const LAS v4u*)(stg + row * 64 + ch * 8);
            float a8[8] = {bflo(v.x), bfhi(v.x), bflo(v.y), bfhi(v.y), bflo(v.z), bfhi(v.z), bflo(v.w), bfhi(v.w)};
#pragma unroll
            for (int r = 0; r < 3; ++r) if (r < nsel) { const float c = mgs[r * 32 + row]; const v4u q_ = pq[i][r];
                a8[0] += c * bflo(q_.x); a8[1] += c * bfhi(q_.x); a8[2] += c * bflo(q_.y); a8[3] += c * bfhi(q_.y); a8[4] += c * bflo(q_.z); a8[5] += c * bfhi(q_.z); a8[6] += c * bflo(q_.w); a8[7] += c * bfhi(q_.w); }
            *(GAS v4u*)(BQ + gr * 512 + h * 64 + ch * 8) = (v4u){pk2(a8[0], a8[1]), pk2(a8[2], a8[3]), pk2(a8[4], a8[5]), pk2(a8[6], a8[7])}; }
        __syncthreads();
    }
}
namespace epi {
using pg8::f32x4; using pg8::Unit; using pg8::u32x4; using pg8::cvt_pk_bf16;
typedef const f32x4 (&Acc)[2][2][4][2];
__device__ __forceinline__ float sigmoidf_(float x) { return __builtin_amdgcn_rcpf(1.0f + __builtin_amdgcn_exp2f(-1.4426950408889634f * x)); }
__device__ __forceinline__ float siluf_(float x) { return x * __builtin_amdgcn_rcpf(1.0f + __builtin_amdgcn_exp2f(-1.4426950408889634f * x)); }
__device__ __forceinline__ float logsigmoidf_(float x) { return fminf(x, 0.f) - 0.6931471805599453f * __builtin_amdgcn_logf(1.0f + __builtin_amdgcn_exp2f(-1.4426950408889634f * fabsf(x))); }
__device__ __forceinline__ u32x4 pack8(const f32x4& a, const f32x4& b) { u32x4 w; w.x = cvt_pk_bf16(a[0], a[1]); w.y = cvt_pk_bf16(a[2], a[3]); w.z = cvt_pk_bf16(b[0], b[1]); w.w = cvt_pk_bf16(b[2], b[3]); return w; }
__device__ __forceinline__ void unpack8(const u32x4& w, f32x4& a, f32x4& b) { a = (f32x4){bflo(w.x), bfhi(w.x), bflo(w.y), bfhi(w.y)}; b = (f32x4){bflo(w.z), bfhi(w.z), bflo(w.w), bfhi(w.w)}; }
__device__ __forceinline__ unsigned pack4_u8(const f32x4& a) { const f32x4 t = a * 255.0f + 0.5f; return (unsigned)t[0] | ((unsigned)t[1] << 8) | ((unsigned)t[2] << 16) | ((unsigned)t[3] << 24); }
__device__ __forceinline__ f32x4 unpack4_u8(unsigned w) { return (f32x4){(float)(w & 0xffu), (float)((w >> 8) & 0xffu), (float)((w >> 16) & 0xffu), (float)(w >> 24)} * (1.0f / 255.0f); }
__device__ __forceinline__ float row_rs(const float* ssq, int row) {
    const f32x4* p = (const f32x4*)(ssq + (size_t)row * 16); const f32x4 a = p[0], b = p[1], c = p[2], d = p[3];
    const float s = ((a[0] + a[1]) + (a[2] + a[3])) + ((b[0] + b[1]) + (b[2] + b[3])) + ((c[0] + c[1]) + (c[2] + c[3])) + ((d[0] + d[1]) + (d[2] + d[3]));
    return __builtin_amdgcn_rsqf(s * (1.0f / DM) + RMS_EPS);
}

constexpr int RS_OFF = LDSCTL_OFF + 12288;
__device__ __forceinline__ const LAS float* stage_rs(const float* ssq, const float* rsg, int pm, LAS unsigned char* lb) {
    LAS float* rs_s = (LAS float*)(lb + RS_OFF); const int t = threadIdx.x;
    if (t < 256) { const int row = pm * 256 + t; rs_s[t] = rsg ? rsg[row] : row_rs(ssq, row); }
    asm volatile("s_waitcnt lgkmcnt(0)" ::: "memory"); __builtin_amdgcn_s_barrier(); asm volatile("" ::: "memory");
    return rs_s;
}
struct EpiInproj {
    static constexpr bool PERM = true;
    unsigned char* R; const float* ssq; const float* gbias; float* kbp; LAS unsigned char* lb; unsigned char* Gab; unsigned char* Gc;
    template <int ACT, bool KSUM>
    __device__ __forceinline__ void store_half(Acc acc, const int bj, bf16* dst, const int ldc, const int col, const Unit& u, int wr, int fr, const LAS float* rs_s, const float sc = 1.0f) const {
        f32x4 ks0 = (f32x4){0.f, 0.f, 0.f, 0.f}, ks1 = ks0;
#pragma unroll
        for (int ai = 0; ai < 2; ++ai)
#pragma unroll
            for (int m = 0; m < 4; ++m) {
                const int row = u.pm * 256 + ai * 128 + wr * 64 + m * 16 + fr; const float rs = rs_s[ai * 128 + wr * 64 + m * 16 + fr] * sc;
                f32x4 v0 = acc[ai][bj][m][0] * rs, v1 = acc[ai][bj][m][1] * rs;
                if (ACT == 1) {
#pragma unroll
                    for (int i = 0; i < 4; ++i) { v0[i] = siluf_(v0[i]); v1[i] = siluf_(v1[i]); }
                }
                if (KSUM) { ks0 += v0; ks1 += v1; }
                *(u32x4*)(dst + (size_t)row * ldc + col) = pack8(v0, v1);
            }
        if (KSUM) {
#pragma unroll
            for (int i = 0; i < 4; ++i) {
#pragma unroll
                for (int o = 1; o < 16; o <<= 1) { ks0[i] += __shfl_xor(ks0[i], o); ks1[i] += __shfl_xor(ks1[i], o); }
            }
            if (fr == 0) { float* kp = kbp + ((size_t)u.pm * 2 + wr) * 512 + col; *(f32x4*)kp = ks0; *(f32x4*)(kp + 4) = ks1; }
        }
    }
    __device__ __forceinline__ void operator()(Acc acc, const Unit& u, int wr, int wc, int fr, int fq) const {
        const int pn = u.pn; const int c0 = wc * 32 + 8 * fq;
        const LAS float* rs_s = stage_rs(ssq, nullptr, u.pm, lb);
        if (pn >= 16) {
            const int g = pn - 16, br = g >> 2; unsigned char* dst = br < 2 ? Gab + br * 1024 + (g & 3) * 256 : Gc + (g & 3) * 256; const int ldc = br < 2 ? 2048 : 1024;
#pragma unroll
            for (int ai = 0; ai < 2; ++ai)
#pragma unroll
                for (int m = 0; m < 4; ++m) {
                    const int row = u.pm * 256 + ai * 128 + wr * 64 + m * 16 + fr; const float rs = rs_s[ai * 128 + wr * 64 + m * 16 + fr];
#pragma unroll
                    for (int bj = 0; bj < 2; ++bj) { f32x4 v0 = acc[ai][bj][m][0] * rs, v1 = acc[ai][bj][m][1] * rs;
#pragma unroll
                        for (int i = 0; i < 4; ++i) { v0[i] = sigmoidf_(v0[i]); v1[i] = sigmoidf_(v1[i]); }
                        *(pg8::u32x2*)(dst + (size_t)row * ldc + bj * 128 + c0) = (pg8::u32x2){pack4_u8(v0), pack4_u8(v1)}; }
                }
        } else if (pn == 15) {
#pragma unroll
            for (int bj = 0; bj < 2; ++bj) { const int col = bj * 128 + c0; const f32x4 b0 = *(const f32x4*)(gbias + col), b1 = *(const f32x4*)(gbias + col + 4);
#pragma unroll
                for (int ai = 0; ai < 2; ++ai)
#pragma unroll
                    for (int m = 0; m < 4; ++m) {
                        const int row = u.pm * 256 + ai * 128 + wr * 64 + m * 16 + fr; const float rs = rs_s[ai * 128 + wr * 64 + m * 16 + fr];
                        f32x4 v0 = acc[ai][bj][m][0] * rs + b0, v1 = acc[ai][bj][m][1] * rs + b1;
#pragma unroll
                        for (int i = 0; i < 4; ++i) { v0[i] = logsigmoidf_(v0[i]) * (1.0f / 16.0f); v1[i] = logsigmoidf_(v1[i]) * (1.0f / 16.0f); }
                        float* gl = (float*)(R + RO_GL) + (size_t)row * 256 + col; *(f32x4*)gl = v0; *(f32x4*)(gl + 4) = v1;
                    } }
        } else if (pn == 5 || pn == 6) {
            bf16* dst = (bf16*)(R + RO_BK); const int cb = (pn - 5) * 256 + c0;
            store_half<0, true>(acc, 0, dst, 512, cb, u, wr, fr, rs_s); store_half<0, true>(acc, 1, dst, 512, cb + 128, u, wr, fr, rs_s);
        } else if (pn == 13 || pn == 14) {
            bf16* dst = (bf16*)(R + RO_CR); const int cb = (pn - 13) * 256 + c0;
            store_half<1, false>(acc, 0, dst, 512, cb, u, wr, fr, rs_s); store_half<1, false>(acc, 1, dst, 512, cb + 128, u, wr, fr, rs_s);
        } else if (pn == 2) {
            store_half<0, false>(acc, 0, (bf16*)(R + RO_AK), 128, c0, u, wr, fr, rs_s); store_half<0, false>(acc, 1, (bf16*)(R + RO_AV), 128, c0, u, wr, fr, rs_s);
        } else {
            bf16* dst; int ldc, cb; float sc = 1.0f;
            if (pn < 2)        { dst = (bf16*)(R + RO_AQ); ldc = 512; cb = pn * 256; sc = ATT_C2; }
            else if (pn < 5)   { dst = (bf16*)(R + RO_BQ); ldc = 512; cb = (pn - 3) * 256; sc = ATT_C2; }
            else if (pn < 9)   { dst = (bf16*)(R + RO_BV); ldc = 512; cb = (pn - 7) * 256; }
            else if (pn == 9)  { dst = (bf16*)(R + RO_CQ); ldc = 256; cb = 0; }
            else if (pn == 10) { dst = (bf16*)(R + RO_CK); ldc = 256; cb = 0; }
            else               { dst = (bf16*)(R + RO_CV); ldc = 512; cb = (pn - 11) * 256; }
            store_half<0, false>(acc, 0, dst, ldc, cb + c0, u, wr, fr, rs_s, sc); store_half<0, false>(acc, 1, dst, ldc, cb + c0 + 128, u, wr, fr, rs_s, sc);
        }
    }
};
struct EpiBranch {
    static constexpr bool PERM = true;
    const unsigned char* Gab; const unsigned char* Gc; bf16* Y;
    __device__ __forceinline__ void operator()(Acc acc, const Unit& u, int wr, int wc, int fr, int fq) const {
        const int seg = u.aux;
#pragma unroll
        for (int ai = 0; ai < 2; ++ai)
#pragma unroll
            for (int m = 0; m < 4; ++m) {
                const int row = u.pm * 256 + ai * 128 + wr * 64 + m * 16 + fr;
#pragma unroll
                for (int bj = 0; bj < 2; ++bj) { const int col = u.pn * 256 + bj * 128 + wc * 32 + 8 * fq;
                    const pg8::u32x2 gw = *(const pg8::u32x2*)(seg < 2 ? Gab + (size_t)row * 2048 + seg * DM + col : Gc + (size_t)row * DM + col); const f32x4 g0 = unpack4_u8(gw.x), g1 = unpack4_u8(gw.y);
                    f32x4 y0 = acc[ai][bj][m][0] * g0, y1 = acc[ai][bj][m][1] * g1;
                    bf16* yp = Y + (size_t)row * DM + col;
                    if (seg > 0) { const u32x4 ow = *(const u32x4*)yp; f32x4 o0, o1; unpack8(ow, o0, o1); y0 += o0; y1 += o1; }
                    *(u32x4*)yp = pack8(y0, y1); }
            }
    }
};
struct EpiResid {
    static constexpr bool PERM = true;
    bf16* XB; float* ssq;
    __device__ __forceinline__ void operator()(Acc acc, const Unit& u, int wr, int wc, int fr, int fq) const {
#pragma unroll
        for (int ai = 0; ai < 2; ++ai)
#pragma unroll
            for (int m = 0; m < 4; ++m) {
                const int row = u.pm * 256 + ai * 128 + wr * 64 + m * 16 + fr; float s = 0.f;
#pragma unroll
                for (int bj = 0; bj < 2; ++bj) { bf16* xp = XB + (size_t)row * DM + u.pn * 256 + bj * 128 + wc * 32 + 8 * fq;
                    f32x4 x0, x1; unpack8(*(const u32x4*)xp, x0, x1); x0 += acc[ai][bj][m][0]; x1 += acc[ai][bj][m][1];
                    *(u32x4*)xp = pack8(x0, x1);
                    s += ((x0[0] * x0[0] + x0[1] * x0[1]) + (x0[2] * x0[2] + x0[3] * x0[3])) + ((x1[0] * x1[0] + x1[1] * x1[1]) + (x1[2] * x1[2] + x1[3] * x1[3])); }
                s += __shfl_xor(s, 16); s += __shfl_xor(s, 32);
                if (fq == 0) ssq[(size_t)row * 16 + u.pn * 4 + wc] = s;
            }
    }
};
struct EpiSwiglu {
    static constexpr bool PERM = true;
    bf16* H; int ldh; const float* ssq; const float* rsg; LAS unsigned char* lb;
    __device__ __forceinline__ void operator()(Acc acc, const Unit& u, int wr, int wc, int fr, int fq) const {
        const LAS float* rs_s = stage_rs(ssq, rsg, u.pm, lb);
#pragma unroll
        for (int ai = 0; ai < 2; ++ai)
#pragma unroll
            for (int m = 0; m < 4; ++m) {
                const int row = u.pm * 256 + ai * 128 + wr * 64 + m * 16 + fr; const float rs = rs_s[ai * 128 + wr * 64 + m * 16 + fr];
                f32x4 g0 = acc[ai][0][m][0] * rs, g1 = acc[ai][0][m][1] * rs; const f32x4 u0 = acc[ai][1][m][0] * rs, u1 = acc[ai][1][m][1] * rs;
#pragma unroll
                for (int i = 0; i < 4; ++i) { g0[i] = siluf_(g0[i]) * u0[i]; g1[i] = siluf_(g1[i]) * u1[i]; }
                *(u32x4*)(H + (size_t)row * ldh + u.aux * 128 + wc * 32 + 8 * fq) = pack8(g0, g1);
            }
    }
};
struct EpiMoeDown {
    static constexpr bool PERM = true;
    bf16* YE; const float* pw;
    __device__ __forceinline__ void operator()(Acc acc, const Unit& u, int wr, int wc, int fr, int fq) const {
#pragma unroll
        for (int ai = 0; ai < 2; ++ai)
#pragma unroll
            for (int m = 0; m < 4; ++m) {
                const int row = u.pm * 256 + ai * 128 + wr * 64 + m * 16 + fr; const float p = pw[row];
#pragma unroll
                for (int bj = 0; bj < 2; ++bj) *(u32x4*)(YE + (size_t)row * DM + u.pn * 256 + bj * 128 + wc * 32 + 8 * fq) = pack8(acc[ai][bj][m][0] * p, acc[ai][bj][m][1] * p);
            }
    }
};
}
__device__ __forceinline__ float rdl(float v, int l) { return __builtin_bit_cast(float, __builtin_amdgcn_readlane(__builtin_bit_cast(int, v), l)); }
__device__ __forceinline__ float qdot64(float q, const bf16* p) {
    const GAS v4u* kp = (const GAS v4u*)p; float s = 0.f;
#pragma unroll
    for (int c = 0; c < 8; ++c) { const v4u w = kp[c];
        s += rdl(q, 8 * c + 0) * bflo(w.x) + rdl(q, 8 * c + 1) * bfhi(w.x) + rdl(q, 8 * c + 2) * bflo(w.y) + rdl(q, 8 * c + 3) * bfhi(w.y)
           + rdl(q, 8 * c + 4) * bflo(w.z) + rdl(q, 8 * c + 5) * bfhi(w.z) + rdl(q, 8 * c + 6) * bflo(w.w) + rdl(q, 8 * c + 7) * bfhi(w.w); }
    return s;
}
__device__ __forceinline__ float pv64(float o, float p, const bf16* V, size_t row0, int ldv, int vcol, int lane) {
#pragma unroll 16
    for (int j = 0; j < 64; ++j) o += rdl(p, j) * bf2f(V[(row0 + j) * ldv + vcol + lane]);
    return o;
}

__device__ __forceinline__ void swa_naive(const Frame& F_in, const Params& P_in, int l, int gw, int NGW) {
    PH_BEGIN
    bf16* AQ = (bf16*)(P.ws + WS_R + RO_AQ); const bf16* AK = (const bf16*)(P.ws + WS_R + RO_AK); const bf16* AV = (const bf16*)(P.ws + WS_R + RO_AV);
    const float* sinks = P.in[I_SINK] + l * 8; const int lane = F.lane;
    for (int item = gw; item < T * 8; item += NGW) {
        const int t = item >> 3, hq = item & 7, hkv = hq >> 2, tl = t & (SEQ - 1); const size_t rb = (size_t)(t - tl);
        const float q = bf2f(AQ[(size_t)t * 512 + hq * 64 + lane]) * 0.125f;
        const int kA = tl - 127 + lane, kB = tl - 63 + lane; const bool vA = kA >= 0, vB = kB >= 0;
        const int kA0 = tl - 127 < 0 ? 0 : tl - 127, kB0 = tl - 63 < 0 ? 0 : tl - 63;
        float sA = qdot64(q, AK + (rb + (vA ? kA : 0)) * 128 + hkv * 64), sB = qdot64(q, AK + (rb + (vB ? kB : 0)) * 128 + hkv * 64);
        sA = vA ? sA : -INFINITY; sB = vB ? sB : -INFINITY;
        const float sink = sinks[hq];
        const float m = fmaxf(wave_max(fmaxf(sA, sB)), sink);
        const float pA = vA ? __expf(sA - m) : 0.f, pB = vB ? __expf(sB - m) : 0.f;
        const float den = wave_sum(pA + pB) + __expf(sink - m);
        float o = 0.f;
        if (tl >= 127) { o = pv64(o, pA, AV, rb + tl - 127, 128, hkv * 64, lane); o = pv64(o, pB, AV, rb + tl - 63, 128, hkv * 64, lane); }
        else {
#pragma unroll 8
            for (int j = 0; j < 64; ++j) { const int ka = tl - 127 + j, kb = tl - 63 + j;
                o += rdl(pA, j) * bf2f(AV[(rb + (ka < 0 ? 0 : ka)) * 128 + hkv * 64 + lane]) + rdl(pB, j) * bf2f(AV[(rb + (kb < 0 ? 0 : kb)) * 128 + hkv * 64 + lane]); }
        }
        (void)kA0; (void)kB0;
        AQ[(size_t)t * 512 + hq * 64 + lane] = (bf16)f2bf(o / den);
    }
}

__device__ __forceinline__ void moba_naive(const Frame& F_in, const Params& P_in, int gw, int NGW) {
    PH_BEGIN
    bf16* BQ = (bf16*)(P.ws + WS_R + RO_BQ); const bf16* BK = (const bf16*)(P.ws + WS_R + RO_BK); const bf16* BV = (const bf16*)(P.ws + WS_R + RO_BV);
    const float* kbp = (const float*)(P.ws + WS_KBP); const int lane = F.lane;
    for (int item = gw; item < T * 8; item += NGW) {
        const int t = item >> 3, h = item & 7, b = t >> 13, tl = t & (SEQ - 1), cur = tl >> 8; const size_t rb = (size_t)b * SEQ;
        const float q = bf2f(BQ[(size_t)t * 512 + h * 64 + lane]);
        float gs = -INFINITY;
        { const int n = lane < cur ? lane : 0; const float* k0 = kbp + ((size_t)(b * 32 + n) * 2) * 512 + h * 64; float s = 0.f;
#pragma unroll 8
          for (int d = 0; d < 64; ++d) s += rdl(q, d) * (k0[d] + k0[512 + d]);
          if (lane < cur) gs = s * (1.0f / 256.0f); }
        const int nsel = cur < 3 ? cur : 3; int s0 = 0, s1 = 0, s2 = 0;
        for (int r = 0; r < nsel; ++r) { const float mx = wave_max(gs); const unsigned long long bal = __ballot(gs == mx); const int j = __ffsll((long long)bal) - 1;
            if (r == 0) s0 = j; else if (r == 1) s1 = j; else s2 = j; if (lane == j) gs = -INFINITY; }
        float m = -INFINITY, lsum = 0.f, o = 0.f; const float qs = q * 0.125f;
        for (int i = 0; i <= nsel; ++i) {
            const bool own = (i == nsel); const int blk = own ? cur : (i == 0 ? s0 : (i == 1 ? s1 : s2));
            for (int tile = 0; tile < 4; ++tile) {
                const int kp0 = blk * 256 + tile * 64; if (own && kp0 > tl) break;
                const int kpos = kp0 + lane; const bool valid = !own || kpos <= tl;
                float s = qdot64(qs, BK + (rb + kpos) * 512 + h * 64); s = valid ? s : -INFINITY;
                const float mn = fmaxf(m, wave_max(s)); const float sc = __expf(m - mn); const float p = valid ? __expf(s - mn) : 0.f;
                lsum = lsum * sc + wave_sum(p); o = pv64(o * sc, p, BV, rb + kp0, 512, h * 64, lane); m = mn;
            }
        }
        BQ[(size_t)t * 512 + h * 64 + lane] = (bf16)f2bf(o / lsum);
    }
}

__device__ __forceinline__ void gla_cumsum(const float* GL, size_t t0, int h, LAS float* bcum, int tid) {
    if (tid < 64) { float run = 0.f;
#pragma unroll 8
        for (int s = 0; s < 64; ++s) { run += GL[(t0 + s) * 256 + h * 64 + tid]; bcum[s * 64 + tid] = run; } }
}
__device__ __forceinline__ void gla_pass1(const Frame& F_in, const Params& P_in) {
    PH_BEGIN
    const float* GL = (const float*)(P.ws + WS_R + RO_GL); const bf16* CK = (const bf16*)(P.ws + WS_R + RO_CK); const bf16* CV = (const bf16*)(P.ws + WS_R + RO_CV);
    float* S = (float*)(P.ws + WS_S); float* DEC = (float*)(P.ws + WS_DEC);
    LAS float* bcum = (LAS float*)(F.lds); LAS float* kd = bcum + 4096; LAS float* vv = kd + 4096; const int tid = F.tid;
    for (int unit = F.vcu; unit < 8 * 128; unit += F.G) {
        const int bh = unit >> 7, n = unit & 127, b = bh >> 2, h = bh & 3; const size_t t0 = (size_t)b * SEQ + n * 64;
        gla_cumsum(GL, t0, h, bcum, tid);
        __syncthreads();
        for (int idx = tid; idx < 4096; idx += 512) { const int s = idx >> 6, d = idx & 63; kd[idx] = bf2f(CK[(t0 + s) * 256 + h * 64 + d]) * __expf(bcum[63 * 64 + d] - bcum[idx]); }
        for (int idx = tid; idx < 8192; idx += 512) { const int s = idx >> 7, e = idx & 127; vv[idx] = bf2f(CV[(t0 + s) * 512 + h * 128 + e]); }
        __syncthreads();
        { const int d = tid >> 3, e0 = (tid & 7) * 16; float a[16];
#pragma unroll
          for (int j = 0; j < 16; ++j) a[j] = 0.f;
          for (int s = 0; s < 64; ++s) { const float kv = kd[s * 64 + d];
#pragma unroll
              for (int j = 0; j < 16; ++j) a[j] += kv * vv[s * 128 + e0 + j]; }
          float* so = S + (((size_t)bh * 128 + n) * 64 + d) * 128 + e0;
#pragma unroll
          for (int j = 0; j < 16; j += 4) *(f32x4*)(so + j) = (f32x4){a[j], a[j + 1], a[j + 2], a[j + 3]};
          if (tid < 64) DEC[((size_t)bh * 128 + n) * 64 + tid] = __expf(bcum[63 * 64 + tid]); }
        __syncthreads();
    }
}
__device__ __forceinline__ void gla_scan(const Frame& F_in, const Params& P_in) {
    PH_BEGIN
    float* S = (float*)(P.ws + WS_S); const float* DEC = (const float*)(P.ws + WS_DEC);
    if (F.tid >= 256) return;
    for (int grp = F.vcu; grp < 256; grp += F.G) {
        const int idx = grp * 256 + F.tid, bh = idx >> 13, d = (idx >> 7) & 63, e = idx & 127;
        float* sp = S + ((size_t)bh * 128 * 64 + d) * 128 + e; const float* dp = DEC + (size_t)bh * 128 * 64 + d; float st = 0.f;
        for (int n0 = 0; n0 < 128; n0 += 32) { float u[32], dc[32];
#pragma unroll
            for (int j = 0; j < 32; ++j) { u[j] = sp[(size_t)(n0 + j) * 8192]; dc[j] = dp[(n0 + j) * 64]; }
#pragma unroll
            for (int j = 0; j < 32; ++j) { sp[(size_t)(n0 + j) * 8192] = st; st = dc[j] * st + u[j]; } }
    }
}
__device__ __forceinline__ void gla_pass3(const Frame& F_in, const Params& P_in, int l) {
    PH_BEGIN
    const float* GL = (const float*)(P.ws + WS_R + RO_GL); const bf16* CQ = (const bf16*)(P.ws + WS_R + RO_CQ); const bf16* CK = (const bf16*)(P.ws + WS_R + RO_CK); const bf16* CV = (const bf16*)(P.ws + WS_R + RO_CV);
    bf16* CR = (bf16*)(P.ws + WS_R + RO_CR); const float* S = (const float*)(P.ws + WS_S); const float* gng = P.in[I_GNG] + l * 512;
    LAS float* bcum = (LAS float*)(F.lds); LAS float* qin = bcum + 4096; LAS float* kin = qin + 4096; LAS float* am = kin + 4096; LAS float* vv = am + 4096; LAS float* sp = vv + 8192; const int tid = F.tid;
    for (int unit = F.vcu; unit < 8 * 128; unit += F.G) {
        const int bh = unit >> 7, n = unit & 127, b = bh >> 2, h = bh & 3; const size_t t0 = (size_t)b * SEQ + n * 64;
        gla_cumsum(GL, t0, h, bcum, tid);
        __syncthreads();
        for (int idx = tid; idx < 4096; idx += 512) { const int s = idx >> 6, d = idx & 63; const float bb = bcum[idx];
            qin[idx] = bf2f(CQ[(t0 + s) * 256 + h * 64 + d]) * 0.125f * __expf(bb); kin[idx] = bf2f(CK[(t0 + s) * 256 + h * 64 + d]) * __expf(-bb); }
        for (int idx = tid; idx < 8192; idx += 512) { const int s = idx >> 7, e = idx & 127; vv[idx] = bf2f(CV[(t0 + s) * 512 + h * 128 + e]); sp[idx] = S[(((size_t)bh * 128 + n) * 64) * 128 + idx]; }
        __syncthreads();
        for (int idx = tid; idx < 4096; idx += 512) { const int tt = idx >> 6, s = idx & 63; float a = 0.f;
            if (s <= tt) {
#pragma unroll 8
                for (int d = 0; d < 64; ++d) a += qin[tt * 64 + d] * kin[s * 64 + d]; }
            am[idx] = a; }
        __syncthreads();
        { const int tt = tid >> 3, e0 = (tid & 7) * 16; float o[16];
#pragma unroll
          for (int j = 0; j < 16; ++j) o[j] = 0.f;
          for (int s = 0; s <= tt; ++s) { const float a = am[tt * 64 + s];
#pragma unroll
              for (int j = 0; j < 16; ++j) o[j] += a * vv[s * 128 + e0 + j]; }
          for (int d = 0; d < 64; ++d) { const float qv = qin[tt * 64 + d];
#pragma unroll
              for (int j = 0; j < 16; ++j) o[j] += qv * sp[d * 128 + e0 + j]; }
          float ms = 0.f;
#pragma unroll
          for (int j = 0; j < 16; ++j) ms += o[j] * o[j];
          ms += __shfl_xor(ms, 1); ms += __shfl_xor(ms, 2); ms += __shfl_xor(ms, 4);
          const float rinv = 1.0f / sqrtf(ms * (1.0f / 128.0f) + RMS_EPS);
          bf16* crp = CR + (t0 + tt) * 512 + h * 128 + e0;
#pragma unroll
          for (int j = 0; j < 16; ++j) crp[j] = (bf16)f2bf(o[j] * rinv * gng[h * 128 + e0 + j] * bf2f(crp[j])); }
        __syncthreads();
    }
}
namespace gla {
typedef short bf16x8 __attribute__((ext_vector_type(8)));
typedef float f32x16 __attribute__((ext_vector_type(16)));
constexpr int PITCH = 72;
constexpr int OFF_TOT = 0;
constexpr int OFF_Q = 2048;
constexpr int OFF_K = OFF_Q + 64 * PITCH * 2;
constexpr int OFF_V = OFF_K + 64 * PITCH * 2;
constexpr int OFF_ST = OFF_V + 128 * PITCH * 2;
constexpr int OFF_A = OFF_ST + 128 * PITCH * 2;
constexpr int OFF_O = OFF_A + 8 * 32 * PITCH * 2;
constexpr int OPITCH = 132;
static_assert(OFF_O + 64 * OPITCH * 4 <= RING_BYTES, "gla lds");
__device__ __forceinline__ int crow(int r, int hf) { return (r & 3) + 8 * (r >> 2) + 4 * hf; }
__device__ __forceinline__ bf16x8 ldfrag(const LAS unsigned char* base, int row, int k) { return *(const LAS bf16x8*)(base + (row * PITCH + k) * 2); }

__device__ __forceinline__ void chunk_cumsum(const float* GL, size_t t0, int h, LAS unsigned char* lds, int tid, float (&b)[8], float& blast) {
    const int d = tid & 63, seg = tid >> 6; LAS float* tot = (LAS float*)(lds + OFF_TOT);
    float run = 0.f;
#pragma unroll
    for (int i = 0; i < 8; ++i) { run += GL[(t0 + seg * 8 + i) * 256 + h * 64 + d]; b[i] = run; }
    tot[seg * 64 + d] = run;
    __syncthreads();
    float off = 0.f, all = 0.f;
#pragma unroll
    for (int s = 0; s < 8; ++s) { const float v = tot[s * 64 + d]; all += v; if (s < seg) off += v; }
#pragma unroll
    for (int i = 0; i < 8; ++i) b[i] += off;
    blast = all;
}
__device__ __forceinline__ void stage_vT(const bf16* CV, size_t t0, int h, LAS unsigned char* lds, int tid) {
#pragma unroll
    for (int it = 0; it < 2; ++it) { const int item = tid + 512 * it, e = item & 127, sg = item >> 7;
        unsigned short v[8];
#pragma unroll
        for (int i = 0; i < 8; ++i) v[i] = CV[(t0 + sg * 8 + i) * 512 + h * 128 + e];
        v4u w; w.x = v[0] | ((unsigned)v[1] << 16); w.y = v[2] | ((unsigned)v[3] << 16); w.z = v[4] | ((unsigned)v[5] << 16); w.w = v[6] | ((unsigned)v[7] << 16);
        *(LAS v4u*)(lds + OFF_V + (e * PITCH + sg * 8) * 2) = w; }
}

__device__ __forceinline__ void pass1(const Frame& F_in, const Params& P_in) {
    PH_BEGIN
    const float* GL = (const float*)(P.ws + WS_R + RO_GL); const bf16* CK = (const bf16*)(P.ws + WS_R + RO_CK); const bf16* CV = (const bf16*)(P.ws + WS_R + RO_CV);
    float* S = (float*)(P.ws + WS_S); float* DEC = (float*)(P.ws + WS_DEC);
    LAS unsigned char* lds = F.lds; const int tid = F.tid, lane = F.lane, r = lane & 31, hf = lane >> 5, w = F.wave, mt = w >> 2, nt = w & 3;
    for (int unit = F.vcu; unit < 8 * 128; unit += F.G) {
        const int bh = unit >> 7, n = unit & 127, b_ = bh >> 2, h = bh & 3; const size_t t0 = (size_t)b_ * SEQ + n * 64;
        float b[8], blast; chunk_cumsum(GL, t0, h, lds, tid, b, blast);
        { const int d = tid & 63, seg = tid >> 6; unsigned pk[4];
#pragma unroll
          for (int i = 0; i < 8; i += 2) { const float k0 = bf2f(CK[(t0 + seg * 8 + i) * 256 + h * 64 + d]) * __expf(blast - b[i]), k1 = bf2f(CK[(t0 + seg * 8 + i + 1) * 256 + h * 64 + d]) * __expf(blast - b[i + 1]); pk[i >> 1] = pk2(k0, k1); }
          *(LAS v4u*)(lds + OFF_Q + (d * PITCH + seg * 8) * 2) = (v4u){pk[0], pk[1], pk[2], pk[3]};
          if (seg == 0) DEC[((size_t)bh * 128 + n) * 64 + d] = __expf(blast); }
        stage_vT(CV, t0, h, lds, tid);
        __syncthreads();
        f32x16 acc = f32x16{};
#pragma unroll
        for (int ks = 0; ks < 4; ++ks) acc = __builtin_amdgcn_mfma_f32_32x32x16_bf16(ldfrag(lds + OFF_Q, mt * 32 + r, ks * 16 + 8 * hf), ldfrag(lds + OFF_V, nt * 32 + r, ks * 16 + 8 * hf), acc, 0, 0, 0);
        float* so = S + (((size_t)bh * 128 + n) * 64 + mt * 32) * 128 + nt * 32 + r;
#pragma unroll
        for (int g = 0; g < 16; ++g) so[(size_t)crow(g, hf) * 128] = acc[g];
        __syncthreads();
    }
}
__device__ __forceinline__ void pass3(const Frame& F_in, const Params& P_in, int l) {
    PH_BEGIN
    const float* GL = (const float*)(P.ws + WS_R + RO_GL); const bf16* CQ = (const bf16*)(P.ws + WS_R + RO_CQ); const bf16* CK = (const bf16*)(P.ws + WS_R + RO_CK); const bf16* CV = (const bf16*)(P.ws + WS_R + RO_CV);
    bf16* CR = (bf16*)(P.ws + WS_R + RO_CR); const float* S = (const float*)(P.ws + WS_S); const float* gng = P.in[I_GNG] + l * 512;
    LAS unsigned char* lds = F.lds; const int tid = F.tid, lane = F.lane, r = lane & 31, hf = lane >> 5, w = F.wave, mt = w >> 2, nt = w & 3;
    for (int unit = F.vcu; unit < 8 * 128; unit += F.G) {
        const int bh = unit >> 7, n = unit & 127, b_ = bh >> 2, h = bh & 3; const size_t t0 = (size_t)b_ * SEQ + n * 64;
        float b[8], blast; chunk_cumsum(GL, t0, h, lds, tid, b, blast);
        { const int d = tid & 63, seg = tid >> 6;
#pragma unroll
          for (int i = 0; i < 8; ++i) { const size_t gi = (t0 + seg * 8 + i) * 256 + h * 64 + d; const int s = seg * 8 + i;
              *(LAS unsigned short*)(lds + OFF_Q + (s * PITCH + d) * 2) = (unsigned short)f2bf(bf2f(CQ[gi]) * 0.125f * __expf(b[i]));
              *(LAS unsigned short*)(lds + OFF_K + (s * PITCH + d) * 2) = (unsigned short)f2bf(bf2f(CK[gi]) * __expf(-b[i])); } }
        stage_vT(CV, t0, h, lds, tid);
        { const float* sp = S + (((size_t)bh * 128 + n) * 64) * 128;
#pragma unroll
          for (int it = 0; it < 2; ++it) { const int item = tid + 512 * it, e = item & 127, dg = item >> 7; float v[8];
#pragma unroll
              for (int i = 0; i < 8; ++i) v[i] = sp[(size_t)(dg * 8 + i) * 128 + e];
              *(LAS v4u*)(lds + OFF_ST + (e * PITCH + dg * 8) * 2) = (v4u){pk2(v[0], v[1]), pk2(v[2], v[3]), pk2(v[4], v[5]), pk2(v[6], v[7])}; } }
        __syncthreads();
        { LAS unsigned char* as = lds + OFF_A + w * 32 * PITCH * 2;
#pragma unroll
          for (int j = 0; j < 2; ++j) { f32x16 a = f32x16{};
#pragma unroll
              for (int kd = 0; kd < 4; ++kd) a = __builtin_amdgcn_mfma_f32_32x32x16_bf16(ldfrag(lds + OFF_Q, mt * 32 + r, kd * 16 + 8 * hf), ldfrag(lds + OFF_K, j * 32 + r, kd * 16 + 8 * hf), a, 0, 0, 0);
              const int s = j * 32 + r;
#pragma unroll
              for (int g = 0; g < 16; ++g) { const int tl = crow(g, hf); const float av = (s <= mt * 32 + tl) ? a[g] : 0.f; *(LAS unsigned short*)(as + (tl * PITCH + s) * 2) = (unsigned short)f2bf(av); } }
          LDS_WAIT(); asm volatile("" ::: "memory");
          f32x16 o = f32x16{};
#pragma unroll
          for (int ks = 0; ks < 4; ++ks) o = __builtin_amdgcn_mfma_f32_32x32x16_bf16(ldfrag(as, r, ks * 16 + 8 * hf), ldfrag(lds + OFF_V, nt * 32 + r, ks * 16 + 8 * hf), o, 0, 0, 0);
#pragma unroll
          for (int kd = 0; kd < 4; ++kd) o = __builtin_amdgcn_mfma_f32_32x32x16_bf16(ldfrag(lds + OFF_Q, mt * 32 + r, kd * 16 + 8 * hf), ldfrag(lds + OFF_ST, nt * 32 + r, kd * 16 + 8 * hf), o, 0, 0, 0);
          LAS float* os = (LAS float*)(lds + OFF_O);
#pragma unroll
          for (int g = 0; g < 16; ++g) os[(mt * 32 + crow(g, hf)) * OPITCH + nt * 32 + r] = o[g]; }
        __syncthreads();
        { const int tt = tid >> 3, e0 = (tid & 7) * 16; const LAS float* os = (const LAS float*)(lds + OFF_O) + tt * OPITCH + e0; float o[16]; float ms = 0.f;
#pragma unroll
          for (int j = 0; j < 16; ++j) { o[j] = os[j]; ms += o[j] * o[j]; }
          ms += __shfl_xor(ms, 1); ms += __shfl_xor(ms, 2); ms += __shfl_xor(ms, 4);
          const float rinv = 1.0f / sqrtf(ms * (1.0f / 128.0f) + RMS_EPS);
          bf16* crp = CR + (t0 + tt) * 512 + h * 128 + e0; const v4u c0 = *(const GAS v4u*)crp, c1 = *(const GAS v4u*)(crp + 8); const float* gp = gng + h * 128 + e0;
          v4u w0, w1;
          w0.x = pk2(o[0] * rinv * gp[0] * bflo(c0.x), o[1] * rinv * gp[1] * bfhi(c0.x)); w0.y = pk2(o[2] * rinv * gp[2] * bflo(c0.y), o[3] * rinv * gp[3] * bfhi(c0.y));
          w0.z = pk2(o[4] * rinv * gp[4] * bflo(c0.z), o[5] * rinv * gp[5] * bfhi(c0.z)); w0.w = pk2(o[6] * rinv * gp[6] * bflo(c0.w), o[7] * rinv * gp[7] * bfhi(c0.w));
          w1.x = pk2(o[8] * rinv * gp[8] * bflo(c1.x), o[9] * rinv * gp[9] * bfhi(c1.x)); w1.y = pk2(o[10] * rinv * gp[10] * bflo(c1.y), o[11] * rinv * gp[11] * bfhi(c1.y));
          w1.z = pk2(o[12] * rinv * gp[12] * bflo(c1.z), o[13] * rinv * gp[13] * bfhi(c1.z)); w1.w = pk2(o[14] * rinv * gp[14] * bflo(c1.w), o[15] * rinv * gp[15] * bfhi(c1.w));
          *(GAS v4u*)crp = w0; *(GAS v4u*)(crp + 8) = w1; }
        __syncthreads();
    }
}
}
constexpr int TAB_OFF = LDSCTL_OFF + 1024;
__device__ __forceinline__ void route_r1(const Frame& F_in, const Params& P_in) {
    PH_BEGIN
    const float* Wr = P.in[I_RT]; const float* n2g = P.in[I_N2G] + 1 * DM;
    int* TOKE = (int*)(P.ws + WS_TOKE); float* TOKP = (float*)(P.ws + WS_TOKP); float* RS2 = (float*)(P.ws + WS_RS2); int* CNT = (int*)(P.ws + WS_CNT);
    LAS float* wrs = (LAS float*)(F.lds); LAS int* cnt_s = (LAS int*)(F.lds + 32768); const int tid = F.tid, lane = F.lane;
    for (int idx = tid; idx < 8192; idx += 512) wrs[idx] = Wr[idx] * n2g[idx >> 3];
    for (int tile = F.vcu; tile < T / 64; tile += F.G) {
        if (tid < 8) cnt_s[tid] = 0;
        __syncthreads();
        for (int i = 0; i < 8; ++i) {
            const int t = tile * 64 + F.wave * 8 + i;
            const GAS v2u* xr = (const GAS v2u*)((const bf16*)(P.ws + WS_XB) + (size_t)t * DM) + lane;
            float s = 0.f, lg0 = 0.f, lg1 = 0.f, lg2 = 0.f, lg3 = 0.f, lg4 = 0.f, lg5 = 0.f, lg6 = 0.f, lg7 = 0.f;
#pragma unroll
            for (int j = 0; j < 4; ++j) { const v2u w_ = xr[64 * j]; const f32x4 v = (f32x4){bflo(w_.x), bfhi(w_.x), bflo(w_.y), bfhi(w_.y)}; s += (v.x * v.x + v.y * v.y) + (v.z * v.z + v.w * v.w);
#pragma unroll
                for (int c = 0; c < 4; ++c) { const LAS float* w = wrs + (256 * j + 4 * lane + c) * 8; const float xv = v[c];
                    lg0 += xv * w[0]; lg1 += xv * w[1]; lg2 += xv * w[2]; lg3 += xv * w[3]; lg4 += xv * w[4]; lg5 += xv * w[5]; lg6 += xv * w[6]; lg7 += xv * w[7]; } }
            s = wave_sum(s); lg0 = wave_sum(lg0); lg1 = wave_sum(lg1); lg2 = wave_sum(lg2); lg3 = wave_sum(lg3); lg4 = wave_sum(lg4); lg5 = wave_sum(lg5); lg6 = wave_sum(lg6); lg7 = wave_sum(lg7);
            const float r = 1.0f / sqrtf(s * (1.0f / DM) + RMS_EPS);
            int i1 = 0; float v1 = lg0;
            if (lg1 > v1) { v1 = lg1; i1 = 1; } if (lg2 > v1) { v1 = lg2; i1 = 2; } if (lg3 > v1) { v1 = lg3; i1 = 3; } if (lg4 > v1) { v1 = lg4; i1 = 4; }
            if (lg5 > v1) { v1 = lg5; i1 = 5; } if (lg6 > v1) { v1 = lg6; i1 = 6; } if (lg7 > v1) { v1 = lg7; i1 = 7; }
            int i2 = -1; float v2 = -INFINITY;
            if (i1 != 0 && lg0 > v2) { v2 = lg0; i2 = 0; } if (i1 != 1 && lg1 > v2) { v2 = lg1; i2 = 1; } if (i1 != 2 && lg2 > v2) { v2 = lg2; i2 = 2; } if (i1 != 3 && lg3 > v2) { v2 = lg3; i2 = 3; }
            if (i1 != 4 && lg4 > v2) { v2 = lg4; i2 = 4; } if (i1 != 5 && lg5 > v2) { v2 = lg5; i2 = 5; } if (i1 != 6 && lg6 > v2) { v2 = lg6; i2 = 6; } if (i1 != 7 && lg7 > v2) { v2 = lg7; i2 = 7; }
            const float p1 = 1.0f / (1.0f + __expf((v2 - v1) * r)), p2 = 1.0f - p1;
            if (lane == 0) { TOKE[t * 2] = i1; TOKE[t * 2 + 1] = i2; TOKP[t * 2] = p1; TOKP[t * 2 + 1] = p2; RS2[t] = r; atomicAdd((int*)&cnt_s[i1], 1); atomicAdd((int*)&cnt_s[i2], 1); }
        }
        __syncthreads();
        if (tid < 8) CNT[tile * 8 + tid] = cnt_s[tid];
        __syncthreads();
    }
}
__device__ __forceinline__ void moe_tables(const Frame& F_in, const Params& P_in, int tile) {
    PH_BEGIN
    const int* CNT = (const int*)(P.ws + WS_CNT); volatile LAS int* TAB = (volatile LAS int*)(F.lds + TAB_OFF); LAS int* cs = (LAS int*)(F.lds + TAB_OFF + 256); const int tid = F.tid;
    for (int i = tid; i < (T / 64) * 8; i += 512) cs[i] = CNT[i];
    __syncthreads();
    if (tid < 8) { int tot = 0, before = 0;
        for (int w = 0; w < T / 64; ++w) { const int c = cs[w * 8 + tid]; if (w < tile) before += c; tot += c; }
        TAB[32 + tid] = tot; TAB[40 + tid] = before; }
    __syncthreads();
    if (tid == 0) { int mt = 0; for (int e = 0; e < 8; ++e) { TAB[e] = mt; TAB[16 + e] = mt * 256 + TAB[40 + e]; mt += (TAB[32 + e] + 255) >> 8; } TAB[8] = mt; }
    __syncthreads();
}
__device__ __forceinline__ void route_r2(const Frame& F_in, const Params& P_in) {
    PH_BEGIN
    const int* TOKE = (const int*)(P.ws + WS_TOKE); const float* TOKP = (const float*)(P.ws + WS_TOKP); const float* RS2 = (const float*)(P.ws + WS_RS2);
    int* TOKPOS = (int*)(P.ws + WS_TOKPOS); float* RSG = (float*)(P.ws + WS_RSG); float* PWG = (float*)(P.ws + WS_PWG);
    const bf16* XB = (const bf16*)(P.ws + WS_XB); bf16* XG = (bf16*)(P.ws + WS_XG);
    volatile LAS int* TAB = (volatile LAS int*)(F.lds + TAB_OFF); LAS int* pos_s = (LAS int*)(F.lds); const int tid = F.tid, lane = F.lane;
    for (int tile = F.vcu; tile < T / 64; tile += F.G) {
        moe_tables(F, P, tile);
        LAS int* te_s = pos_s + 128;
        if (tid < 128) te_s[tid] = TOKE[tile * 128 + tid];
        __syncthreads();
        if (tid < 8) { int run = TAB[16 + tid];
            for (int i = 0; i < 128; ++i) if (te_s[i] == tid) { pos_s[i] = run; ++run; } }
        __syncthreads();
        for (int pr = F.wave * 16; pr < F.wave * 16 + 16; ++pr) {
            const int pos = pos_s[pr], t = tile * 64 + (pr >> 1);
            const GAS v4u* src = (const GAS v4u*)(XB + (size_t)t * DM); GAS v4u* dst = (GAS v4u*)(XG + (size_t)pos * DM);
            dst[lane] = src[lane]; dst[64 + lane] = src[64 + lane];
            if (lane == 0) { RSG[pos] = RS2[t]; PWG[pos] = TOKP[t * 2 + (pr & 1)]; TOKPOS[t * 2 + (pr & 1)] = pos; }
        }
        __syncthreads();
    }
}
struct MoeOrder {
    const char* A; const char* W; size_t wstride; size_t tstep; int nN, G, c; volatile LAS int* TAB;
    __device__ __forceinline__ bool next(int i, pg8::Unit& u) const {
        const int L = i * G + c; const int total = TAB[8] * nN; if (L >= total) return false;
        int e = 0;
#pragma unroll
        for (int k = 1; k < 8; ++k) if (L >= TAB[k] * nN) e = k;
        const int mt0 = TAB[e], mte = TAB[e + 1] - mt0, loc = L - mt0 * nN; const int pml = loc % mte, pn = loc / mte;
        u.pm = mt0 + pml; u.pn = pn; u.aux = pn; u.A = A + (size_t)u.pm * tstep; u.B = W + (size_t)e * wstride + (size_t)pn * tstep; return true;
    }
};
struct BranchOrder {
    const char* OA; const char* OB; const char* OC; const char* W; int G, c;
    __device__ __forceinline__ bool next(int i, pg8::Unit& u) const {
        const int seg = i % 3; int pm, pn; if (!pg8::static_tile(T / 256, DM / 256, G, c, i / 3, pm, pn)) return false;
        u.pm = pm; u.pn = pn; u.aux = seg; const char* o = seg == 0 ? OA : (seg == 1 ? OB : OC);
        u.A = o + (size_t)pm * 256 * 512 * 2; u.B = W + (size_t)seg * DM * 512 * 2 + (size_t)pn * 256 * 512 * 2; return true;
    }
};
template <int l>
__device__ __forceinline__ void layer_body(const Frame& F, const Params& P, const XcdBarrier& bar) {
#ifdef TIMING
#define STAMP() do { if (blockIdx.x == 0 && threadIdx.x == 0) { unsigned* c_ = (unsigned*)(P.ws + WS_CTL) + 2048; const unsigned n_ = c_[0]; ((unsigned long long*)(c_ + 2))[n_] = __builtin_amdgcn_s_memrealtime(); c_[0] = n_ + 1; } } while (0)
#else
#define STAMP() do {} while (0)
#endif
#define GRID_BAR() do { xcd_barrier(bar); STAMP(); } while (0)
    const int gw = F.vcu * NWAVES + F.wave, NGW = F.G * NWAVES;
    LAS unsigned char* ring = F.lds + RING_OFF;
    const int cb = (int)blockIdx.x;
#define WSP(T_, off) ((T_)(ws + (off)))

        { unsigned char* ws = lws(P); pg8::DenseOrder S; S.init(ws + WS_XB, ws + WS_W + WO_IN, T, NMAIN + NGATES, DM, F.G, cb);
          epi::EpiInproj E{ws + WS_R, WSP(const float*, WS_SSQ), P.in[I_GBG] + l * 256, WSP(float*, WS_KBP), F.lds, (unsigned char*)P.out, WSP(unsigned char*, WS_GC)};
          pg8::gemm_phase<epi::EpiInproj, pg8::DenseOrder>(ring, DM, S, E); }
        GRID_BAR();
        gla::pass1(F, P);
        moba_route(F, P, l);
        swa_phase(F, P, l);
        GRID_BAR();
        gla_scan(F, P);
        __syncthreads();
        moba_past(F, P, l);
        if (l == 0) convert_moe_weights(F, P, gw, NGW, 2);
        GRID_BAR();
        gla::pass3(F, P, l);
        moba_own(F, P);
        GRID_BAR();
        { unsigned char* ws = lws(P); BranchOrder S{(const char*)(ws + WS_R + RO_AQ), (const char*)(ws + WS_R + RO_BQ), (const char*)(ws + WS_R + RO_CR), (const char*)(ws + WS_W + WO_BR), F.G, cb};
          epi::EpiBranch E{(const unsigned char*)P.out, WSP(const unsigned char*, WS_GC), WSP(bf16*, WS_Y)};
          pg8::gemm_phase<epi::EpiBranch, BranchOrder>(ring, 512, S, E); }
        GRID_BAR();
        { unsigned char* ws = lws(P); pg8::DenseOrder S; S.init(ws + WS_Y, ws + WS_W + WO_O, T, DM, DM, F.G, cb);
          epi::EpiResid E{WSP(bf16*, WS_XB), WSP(float*, WS_SSQ)};
          pg8::gemm_phase<epi::EpiResid, pg8::DenseOrder>(ring, DM, S, E); }
        GRID_BAR();
        if constexpr (l == 0) {
            { unsigned char* ws = lws(P); pg8::DenseOrder S; S.init(ws + WS_XB, ws + WS_W + WO_GU, T, 2 * DFF, DM, F.G, cb);
              epi::EpiSwiglu E{(bf16*)(ws + WS_H), DFF, WSP(const float*, WS_SSQ), nullptr, F.lds};
              pg8::gemm_phase<epi::EpiSwiglu, pg8::DenseOrder>(ring, DM, S, E); }
            if (cb >= 128 || F.G != 256) convert_layer_weights(F, P, 1, F.G == 256 ? (cb - 128) * NWAVES + F.wave : gw, F.G == 256 ? 128 * NWAVES : NGW, true);
            GRID_BAR();
            { unsigned char* ws = lws(P); pg8::DenseOrder S; S.init(ws + WS_H, ws + WS_W + WO_D, T, DM, DFF, F.G, cb);
              epi::EpiResid E{WSP(bf16*, WS_XB), WSP(float*, WS_SSQ)};
              pg8::gemm_phase<epi::EpiResid, pg8::DenseOrder>(ring, DFF, S, E); }
            GRID_BAR();
        } else {
            route_r1(F, P);
            GRID_BAR();
            route_r2(F, P);
            convert_moe_weights(F, P, gw, NGW, 1);
            GRID_BAR();
            moe_tables(F, P, 0);
            { unsigned char* ws = lws(P); MoeOrder S{(const char*)(ws + WS_XG), (const char*)(ws + WS_WMGU), (size_t)2 * DFE * DM * 2, (size_t)256 * DM * 2, 2 * DFE / 256, F.G, cb, (volatile LAS int*)(F.lds + TAB_OFF)};
              epi::EpiSwiglu E{(bf16*)(ws + WS_HG), DFE, nullptr, (const float*)(ws + WS_RSG), F.lds};
              pg8::gemm_phase<epi::EpiSwiglu, MoeOrder>(ring, DM, S, E); }
            GRID_BAR();
            { unsigned char* ws = lws(P); MoeOrder S{(const char*)(ws + WS_HG), (const char*)(ws + WS_WMD), (size_t)DM * DFE * 2, (size_t)256 * DFE * 2, DM / 256, F.G, cb, (volatile LAS int*)(F.lds + TAB_OFF)};
              epi::EpiMoeDown E{(bf16*)(ws + WS_XG), (const float*)(ws + WS_PWG)};
              pg8::gemm_phase<epi::EpiMoeDown, MoeOrder>(ring, DFE, S, E); }
            GRID_BAR();
            final_phase(F, P, gw, NGW, true);
        }
}
__global__ void __launch_bounds__(NWAVES * 64, 2) fwd_kernel(Params P) {
    extern __shared__ __attribute__((aligned(16))) unsigned char lds[];
    Frame F;
    F.lds = (LAS unsigned char*)lds;
    F.MISC = (volatile LAS unsigned*)(F.lds + MISC_OFF);
    F.tid = threadIdx.x; F.lane = F.tid & 63; F.wave = __builtin_amdgcn_readfirstlane(F.tid >> 6);
    F.G = gridDim.x; { const int bx = blockIdx.x; F.vcu = (F.G % 8 == 0) ? (bx % 8) * (F.G / 8) + bx / 8 : bx; }
    F.ctl = (gu32*)(P.ws + WS_CTL);
    for (int u = F.tid; u < (LDS_BYTES - LDSCTL_OFF) / 4; u += NWAVES * 64) ((LAS unsigned*)(F.lds + LDSCTL_OFF))[u] = 0u;
    __syncthreads();
    XcdBarrier bar = xcd_barrier_post((unsigned*)(F.ctl + CW_BAR), F.MISC + 8);
    const int gw = F.vcu * NWAVES + F.wave, NGW = F.G * NWAVES;
    STAMP();
    prep_x(F, P, gw, NGW);
    convert_layer_weights(F, P, 0, gw, NGW, false);
    GRID_BAR();

    layer_body<0>(F, P, bar);
    layer_body<1>(F, P, bar);
}

extern "C" void kernel_launch(void* const* d_in, const int* in_sizes, int n_in, void* d_out, int out_size, void* d_ws, size_t ws_size, hipStream_t stream) {
    static int grid = 0;
    if (grid == 0) {
        if (n_in != 20 || out_size != T * DM || ws_size < WS_END) { fprintf(stderr, "kernel_launch: unexpected shapes n_in %d out %d ws %zu (need %zu)\n", n_in, out_size, ws_size, (size_t)WS_END); grid = -1; return; }
        int dev = 0, cus = 0, per_cu = 0;
        if (hipGetDevice(&dev) != hipSuccess || hipDeviceGetAttribute(&cus, hipDeviceAttributeMultiprocessorCount, dev) != hipSuccess) { grid = -1; return; }
        if (hipFuncSetAttribute((const void*)fwd_kernel, hipFuncAttributeMaxDynamicSharedMemorySize, LDS_BYTES) != hipSuccess) { fprintf(stderr, "kernel_launch: hipFuncSetAttribute failed\n"); grid = -1; return; }
        if (hipOccupancyMaxActiveBlocksPerMultiprocessor(&per_cu, (const void*)fwd_kernel, NWAVES * 64, LDS_BYTES) != hipSuccess || per_cu < 1) { fprintf(stderr, "kernel_launch: occupancy query says %d\n", per_cu); per_cu = 1; }
        (void)hipGetLastError();
        grid = cus;
    }
    if (grid < 0) return;
    if (hipMemsetAsync((char*)d_ws + WS_CTL, 0, CTL_ZERO_BYTES, stream) != hipSuccess) { fprintf(stderr, "kernel_launch: memset failed\n"); return; }
    Params p{};
    for (int i = 0; i < 20; ++i) p.in[i] = (const float*)d_in[i];
    p.out = (float*)d_out; p.ws = (unsigned char*)d_ws;
    void* args[] = {&p};
    hipError_t e = hipLaunchCooperativeKernel((const void*)fwd_kernel, dim3(grid), dim3(NWAVES * 64), args, LDS_BYTES, stream);
    if (e != hipSuccess) fprintf(stderr, "kernel_launch: cooperative launch failed: %s (grid %d)\n", hipGetErrorString(e), grid);
}
```
